# Optimizing an MI355X kernel written in HIP

```python
import math
import jax, jax.numpy as jnp
from jax import lax
import numpy as np

D_MODEL = 2048
BATCH = 4
SEQ = 2048
DEPTH = 4

HEAD_DIM = 128
MEM_LEN = 256
MEM_HEADS = 4
A_HEADS = 6
A_PATTERNS = ((128, 1), (512, 4), (2048, 16))
B_HEADS = 6
MOBA_BLOCK = 256
MOBA_TOPK = 3
MOBA_QCHUNK = 32
C_HEADS = 24
C_KV_HEADS = 3
C_HEAD_DIM = 64
C_WINDOW = 128
BAND_BLOCK = 128
ROPE_THETA = 10000.0
EPS = 1e-6
NEG = -1e30

EVEN_WIDTH = (A_HEADS + B_HEADS + MEM_HEADS) * HEAD_DIM
ODD_WIDTH = C_HEADS * C_HEAD_DIM + MEM_HEADS * HEAD_DIM
EVEN_SPLITS = [A_HEADS * HEAD_DIM] * 3 + [B_HEADS * HEAD_DIM] * 3 + [MEM_HEADS * HEAD_DIM, EVEN_WIDTH]
ODD_SPLITS = [C_HEADS * C_HEAD_DIM, C_KV_HEADS * C_HEAD_DIM, C_KV_HEADS * C_HEAD_DIM, MEM_HEADS * HEAD_DIM, ODD_WIDTH]
EVEN_IN = sum(EVEN_SPLITS)
ODD_IN = sum(ODD_SPLITS)
EVEN_OFFSETS = [sum(EVEN_SPLITS[:i + 1]) for i in range(len(EVEN_SPLITS) - 1)]
ODD_OFFSETS = [sum(ODD_SPLITS[:i + 1]) for i in range(len(ODD_SPLITS) - 1)]

kernel_name = "hybrid_dilated_moba_swa_sink_decoder"


def rmsnorm(x, g):
    xf = x.astype(jnp.float32)
    y = xf * lax.rsqrt(jnp.mean(xf * xf, axis=-1, keepdims=True) + EPS)
    return (y * g.astype(jnp.float32)).astype(x.dtype)


def rope(x, pos):
    d = x.shape[-1]
    half = d // 2
    inv_freq = jnp.exp(jnp.arange(half, dtype=jnp.float32) * (-2.0 * math.log(ROPE_THETA) / d))
    ang = pos.astype(jnp.float32)[:, None, :, None] * inv_freq
    cos, sin = jnp.cos(ang), jnp.sin(ang)
    xf = x.astype(jnp.float32)
    x1, x2 = xf[..., :half], xf[..., half:]
    return jnp.concatenate([x1 * cos - x2 * sin, x2 * cos + x1 * sin], axis=-1).astype(x.dtype)


def split_heads(t, n):
    b, s, _ = t.shape
    return t.reshape(b, s, n, -1).transpose(0, 2, 1, 3)


def merge_heads(t):
    b, h, s, d = t.shape
    return t.transpose(0, 2, 1, 3).reshape(b, s, h * d)


def banded_attention(q, k, v, max_dist, sink=None):
    n, r, L, d = q.shape
    blk = BAND_BLOCK
    nb = -(-L // blk)
    pad = nb * blk - L
    qp = jnp.pad(q, ((0, 0), (0, 0), (0, pad), (0, 0))).reshape(n, r, nb, blk, d)
    kc = jnp.pad(k, ((0, 0), (0, pad), (0, 0))).reshape(n, nb, blk, d)
    vc = jnp.pad(v, ((0, 0), (0, pad), (0, 0))).reshape(n, nb, blk, d)
    kb = jnp.concatenate([jnp.pad(kc[:, :-1], ((0, 0), (1, 0), (0, 0), (0, 0))), kc], axis=2)
    vb = jnp.concatenate([jnp.pad(vc[:, :-1], ((0, 0), (1, 0), (0, 0), (0, 0))), vc], axis=2)
    s = jnp.einsum('nrbqd,nbkd->nrbqk', qp, kb, preferred_element_type=jnp.float32) * (d ** -0.5)
    qi = jnp.arange(blk)[:, None]
    ki = jnp.arange(2 * blk)[None, :]
    dist = qi + blk - ki
    k_abs = jnp.arange(nb)[:, None, None] * blk - blk + ki[None]
    mask = ((dist >= 0) & (dist <= max_dist))[None] & (k_abs >= 0)
    s = jnp.where(mask, s, NEG)
    lse = jax.nn.logsumexp(s, axis=-1)
    if sink is not None:
        lse = jnp.logaddexp(lse, sink[:, :, None, None])
    p = jnp.exp(s - lse[..., None])
    out = jnp.einsum('nrbqk,nbkd->nrbqd', p.astype(v.dtype), vb)
    return out.reshape(n, r, nb * blk, d)[:, :, :L], lse.reshape(n, r, nb * blk)[:, :, :L]


def dilated_mixture_attention(q, k, v):
    b, h, s, d = q.shape
    outs, lses = [], []
    for window, dil in A_PATTERNS:
        L = s // dil

        def fold(t):
            return t.reshape(b, h, L, dil, d).transpose(0, 1, 3, 2, 4).reshape(b * h * dil, L, d)

        o, l = banded_attention(fold(q)[:, None], fold(k), fold(v), window // dil)
        outs.append(o[:, 0].reshape(b, h, dil, L, d).transpose(0, 1, 3, 2, 4).reshape(b, h, s, d))
        lses.append(l[:, 0].reshape(b, h, dil, L).transpose(0, 1, 3, 2).reshape(b, h, s))
    w = jax.nn.softmax(jnp.stack(lses), axis=0)
    out = jnp.einsum('gbhs,gbhsd->bhsd', w, jnp.stack(outs).astype(jnp.float32))
    return out.astype(q.dtype)


def moba_attention(q, k, v):
    b, h, s, d = q.shape
    scale = d ** -0.5
    nblk = -(-s // MOBA_BLOCK)
    sp = nblk * MOBA_BLOCK
    kp = jnp.pad(k, ((0, 0), (0, 0), (0, sp - s), (0, 0)))
    vp = jnp.pad(v, ((0, 0), (0, 0), (0, sp - s), (0, 0)))
    kblk = kp.reshape(b, h, nblk, MOBA_BLOCK, d)
    vblk = vp.reshape(b, h, nblk, MOBA_BLOCK, d)
    kmean = jnp.mean(kblk.astype(jnp.float32), axis=3)
    gate = jnp.einsum('bhsd,bhnd->bhsn', q.astype(jnp.float32), kmean)
    own = jnp.arange(s) // MOBA_BLOCK
    past = jnp.arange(nblk)[None, :] < own[:, None]
    gate = jnp.where(past, gate, NEG)
    topk = min(MOBA_TOPK, nblk)
    _, sel = lax.top_k(gate, topk)
    sel_valid = jnp.arange(topk)[None, :] < own[:, None]
    qc = MOBA_QCHUNK
    nq = s // qc
    nsel = topk * MOBA_BLOCK
    bi = jnp.arange(b)[:, None, None]
    hi = jnp.arange(h)[None, :, None]

    def chunk(args):
        c, q_c, sel_c, valid_c = args
        flat = sel_c.reshape(b, h, qc * topk)
        k_sel = kblk[bi, hi, flat].reshape(b, h, qc, nsel, d)
        v_sel = vblk[bi, hi, flat].reshape(b, h, qc, nsel, d)
        s_sel = jnp.einsum('bhqd,bhqkd->bhqk', q_c, k_sel, preferred_element_type=jnp.float32) * scale
        s_sel = jnp.where(jnp.repeat(valid_c, MOBA_BLOCK, axis=1), s_sel, NEG)
        start = (c * qc) // MOBA_BLOCK * MOBA_BLOCK
        k_own = lax.dynamic_slice_in_dim(kp, start, MOBA_BLOCK, axis=2)
        v_own = lax.dynamic_slice_in_dim(vp, start, MOBA_BLOCK, axis=2)
        s_own = jnp.einsum('bhqd,bhkd->bhqk', q_c, k_own, preferred_element_type=jnp.float32) * scale
        qpos = c * qc + jnp.arange(qc)
        kpos = start + jnp.arange(MOBA_BLOCK)
        s_own = jnp.where(kpos[None, :] <= qpos[:, None], s_own, NEG)
        p = jax.nn.softmax(jnp.concatenate([s_sel, s_own], axis=-1), axis=-1).astype(v.dtype)
        return (jnp.einsum('bhqk,bhqkd->bhqd', p[..., :nsel], v_sel)
                + jnp.einsum('bhqk,bhkd->bhqd', p[..., nsel:], v_own))

    xs = (jnp.arange(nq),
          q.reshape(b, h, nq, qc, d).transpose(2, 0, 1, 3, 4),
          sel.reshape(b, h, nq, qc, topk).transpose(2, 0, 1, 3, 4),
          sel_valid.reshape(nq, qc, topk))
    out = lax.map(chunk, xs)
    return out.transpose(1, 2, 0, 3, 4).reshape(b, h, s, d)


def swa_sink_attention(q, k, v, sinks):
    b, hq, s, d = q.shape
    g = k.shape[1]
    r = hq // g
    sink = jnp.broadcast_to(sinks.astype(jnp.float32).reshape(1, g, r), (b, g, r)).reshape(b * g, r)
    o, _ = banded_attention(q.reshape(b * g, r, s, d), k.reshape(b * g, s, d), v.reshape(b * g, s, d),
                            C_WINDOW - 1, sink)
    return o.reshape(b, hq, s, d)


def memory_attention(q, mk, mv):
    s = jnp.einsum('bhsd,bhmd->bhsm', q, mk, preferred_element_type=jnp.float32) * (q.shape[-1] ** -0.5)
    p = jax.nn.softmax(s, axis=-1).astype(mv.dtype)
    return jnp.einsum('bhsm,bhmd->bhsd', p, mv)


def memory_kv(mem_n, w_mem_kv):
    mk, mv = jnp.split(mem_n @ w_mem_kv, 2, axis=-1)
    return split_heads(mk, MEM_HEADS), split_heads(mv, MEM_HEADS)


def even_mixer(h, pos, mem_n, w_in, w_mem_kv, w_out):
    qa, ka, va, qb, kb, vb, qm, gate = jnp.split(h @ w_in, EVEN_OFFSETS, axis=-1)
    mk, mv = memory_kv(mem_n, w_mem_kv)
    ya = dilated_mixture_attention(rope(split_heads(qa, A_HEADS), pos), rope(split_heads(ka, A_HEADS), pos),
                                   split_heads(va, A_HEADS))
    yb = moba_attention(rope(split_heads(qb, B_HEADS), pos), rope(split_heads(kb, B_HEADS), pos),
                        split_heads(vb, B_HEADS))
    ym = memory_attention(split_heads(qm, MEM_HEADS), mk, mv)
    y = jnp.concatenate([merge_heads(ya), merge_heads(yb), merge_heads(ym)], axis=-1) * jax.nn.silu(gate)
    return y @ w_out


def odd_mixer(h, pos, mem_n, w_in, w_mem_kv, w_out, sinks):
    qc, kc, vc, qm, gate = jnp.split(h @ w_in, ODD_OFFSETS, axis=-1)
    mk, mv = memory_kv(mem_n, w_mem_kv)
    yc = swa_sink_attention(rope(split_heads(qc, C_HEADS), pos), rope(split_heads(kc, C_KV_HEADS), pos),
                            split_heads(vc, C_KV_HEADS), sinks)
    ym = memory_attention(split_heads(qm, MEM_HEADS), mk, mv)
    y = jnp.concatenate([merge_heads(yc), merge_heads(ym)], axis=-1) * jax.nn.silu(gate)
    return y @ w_out


def setup_inputs(seed: int = 0) -> dict:
    key = jax.random.key(seed)
    ks = jax.random.split(key, 16)
    n_even = (DEPTH + 1) // 2
    n_odd = DEPTH // 2
    f32 = jnp.float32
    x = jax.random.normal(ks[0], (BATCH, SEQ, D_MODEL), f32)
    mem = jax.random.normal(ks[1], (BATCH, MEM_LEN, D_MODEL), f32)
    offset = jax.random.randint(ks[2], (BATCH, 1), 0, 4096, dtype=jnp.int32)
    positions = (jnp.arange(SEQ, dtype=jnp.int32)[None, :] + offset).astype(jnp.int32)
    din = D_MODEL ** -0.5
    return {
        'x': x,
        'mem': mem,
        'positions': positions,
        'even_norm': 1.0 + 0.02 * jax.random.normal(ks[3], (n_even, D_MODEL), f32),
        'even_w_in': jax.random.normal(ks[4], (n_even, D_MODEL, EVEN_IN), f32) * din,
        'even_w_mem_kv': jax.random.normal(ks[5], (n_even, D_MODEL, 2 * MEM_HEADS * HEAD_DIM), f32) * din,
        'even_w_out': jax.random.normal(ks[6], (n_even, EVEN_WIDTH, D_MODEL), f32) * EVEN_WIDTH ** -0.5,
        'odd_norm': 1.0 + 0.02 * jax.random.normal(ks[7], (n_odd, D_MODEL), f32),
        'odd_w_in': jax.random.normal(ks[8], (n_odd, D_MODEL, ODD_IN), f32) * din,
        'odd_w_mem_kv': jax.random.normal(ks[9], (n_odd, D_MODEL, 2 * MEM_HEADS * HEAD_DIM), f32) * din,
        'odd_w_out': jax.random.normal(ks[10], (n_odd, ODD_WIDTH, D_MODEL), f32) * ODD_WIDTH ** -0.5,
        'odd_sinks': 0.5 * jax.random.normal(ks[11], (n_odd, C_HEADS), f32),
        'mem_norm': 1.0 + 0.02 * jax.random.normal(ks[12], (D_MODEL,), f32),
        'final_norm': 1.0 + 0.02 * jax.random.normal(ks[13], (D_MODEL,), f32),
    }


def reference(x, mem, positions, even_norm, even_w_in, even_w_mem_kv, even_w_out,
              odd_norm, odd_w_in, odd_w_mem_kv, odd_w_out, odd_sinks, mem_norm, final_norm):
    mem_n = rmsnorm(mem, mem_norm)
    for layer in range(DEPTH):
        i = layer // 2
        if layer % 2 == 0:
            x = x + even_mixer(rmsnorm(x, even_norm[i]), positions, mem_n,
                               even_w_in[i], even_w_mem_kv[i], even_w_out[i])
        else:
            x = x + odd_mixer(rmsnorm(x, odd_norm[i]), positions, mem_n,
                              odd_w_in[i], odd_w_mem_kv[i], odd_w_out[i], odd_sinks[i])
    return rmsnorm(x, final_norm)
```

```cpp
#include <hip/hip_runtime.h>
#include <cstdio>
#include <cstdint>

#ifndef AN_MASK
#define AN_MASK 63
#endif
#ifndef MK_PER_PHASE
#define MK_PER_PHASE 0
#endif

namespace {
#define LAS __attribute__((address_space(3)))
#define GAS __attribute__((address_space(1)))
typedef unsigned short bf16_t;
typedef short bf16x8 __attribute__((ext_vector_type(8)));
typedef short s16x4 __attribute__((ext_vector_type(4)));
typedef float f32x4 __attribute__((ext_vector_type(4)));
typedef float f32x16 __attribute__((ext_vector_type(16)));
typedef unsigned u32x4 __attribute__((ext_vector_type(4)));
typedef GAS unsigned gu32;
#define RLX_AGENT __ATOMIC_RELAXED, __HIP_MEMORY_SCOPE_AGENT
#define LDS_WAIT() asm volatile("s_waitcnt lgkmcnt(0)" ::: "memory")
#define VM_WAIT() asm volatile("s_waitcnt vmcnt(0)" ::: "memory")
#define SBAR() __builtin_amdgcn_sched_barrier(0)

constexpr int BATCH = 4, SEQ = 2048, DM = 2048, NTOK = BATCH * SEQ, MEML = 256, NMEM = BATCH * MEML;
constexpr int EVEN_N = 7168, ODD_N = 4480, ODD_NP = 4608;
constexpr int KDIM = 2048;
constexpr float EPS = 1e-6f;
constexpr int NWAVES = 8;

constexpr size_t MiB = 1u << 20;
constexpr size_t WS_CTL = 0, CTL_ZERO_BYTES = 1 * MiB;
constexpr size_t WS_WIN_E0 = 1 * MiB, WS_WIN_E1 = 29 * MiB, WS_WIN_O0 = 57 * MiB, WS_WIN_O1 = 75 * MiB;
constexpr size_t WS_WOUT = 93 * MiB;
constexpr size_t WS_WMKV = 125 * MiB;
constexpr size_t WS_XB = 141 * MiB;
constexpr size_t WS_QKV = 173 * MiB;
constexpr size_t WS_Y = 285 * MiB;
constexpr size_t WS_OG = 317 * MiB;
constexpr size_t WS_LSE = 353 * MiB;
constexpr size_t WS_MKV = 354 * MiB;
constexpr size_t WS_MEMN = 362 * MiB;
constexpr size_t WS_CS128 = 366 * MiB;
constexpr size_t WS_CS64 = 370 * MiB;
constexpr size_t WS_END = 372 * MiB;
constexpr int CW_BAR = 4096;
constexpr int CW_SSQ = 16384;
constexpr int CW_KM = 65536;
constexpr int CW_Q = 131072;
static_assert((CW_Q + 64 * 8) * 4 <= (int)CTL_ZERO_BYTES, "ctl");

constexpr int RING_BYTES = 131072;
constexpr int LDSCTL_OFF = RING_BYTES, MISC_OFF = LDSCTL_OFF + 320;
constexpr int LDS_BYTES = 147456;

__device__ __forceinline__ unsigned f2bf(float f) { unsigned u = __builtin_bit_cast(unsigned, f); return (u + 0x7fffu + ((u >> 16) & 1u)) >> 16; }
__device__ __forceinline__ unsigned pk2(float lo, float hi) { return f2bf(lo) | (f2bf(hi) << 16); }
__device__ __forceinline__ unsigned cvt_pk_bf16(float lo, float hi) { unsigned r; asm volatile("v_cvt_pk_bf16_f32 %0, %1, %2" : "=v"(r) : "v"(lo), "v"(hi)); return r; }
__device__ __forceinline__ float bflo(unsigned w) { return __builtin_bit_cast(float, w << 16); }
__device__ __forceinline__ float bfhi(unsigned w) { return __builtin_bit_cast(float, w & 0xffff0000u); }

constexpr int BM = 256, BK = 64, HALF = 128, HTB = HALF * BK * 2, NXCD = 8, WGM = 8;
__device__ __forceinline__ int lds_byte(int r, int c) { const int st = (r >> 4) * 2 + (c >> 5), rr = r & 15, cc = c & 31, ob = rr * 64 + cc * 2; return st * 1024 + (ob ^ (((ob >> 9) & 1) << 5)); }
__device__ __forceinline__ void stage_rc(int b, int& R, int& C) { const int st = b / 1024, sb = b % 1024, swz = sb ^ (((sb >> 9) & 1) << 5); R = (st >> 1) * 16 + swz / 64; C = (st & 1) * 32 + (swz % 64) / 2; }
__device__ __forceinline__ int perm32(int rho) { const int n = rho >> 4, i = rho & 15; return 8 * (i >> 2) + 4 * n + (i & 3); }

struct Unit { int pm, pn, s; };
enum { EM_PLAIN = 0, EM_INPROJ = 1, EM_OUTPROJ = 2 };
struct GemmP { const bf16_t* A; const bf16_t* Bt; int mode, l; unsigned char* ws; const float* xin; float* out; };
__device__ __forceinline__ void tile_of(int wgid, int nM, int nN, int& pm, int& pn) {
    const int nwg = nM * nN; { const int q = nwg / NXCD, r = nwg % NXCD, xcd = wgid % NXCD, off = wgid / NXCD; wgid = (xcd < r ? xcd * (q + 1) : r * (q + 1) + (xcd - r) * q) + off; }
    const int nig = WGM * nN, gid = wgid / nig, fm = gid * WGM, gsz = (nM - fm) < WGM ? (nM - fm) : WGM;
    pm = fm + ((wgid % nig) % gsz); pn = (wgid % nig) / gsz;
}
struct Order {
    int nwg0, nwg1, nM0, nN0, G, c;
    __device__ __forceinline__ bool next(int i, Unit& u) const {
        const int L = i * G + c; if (L >= nwg0 + nwg1) return false;
        if (L < nwg0) { u.s = 0; tile_of(L, nM0, nN0, u.pm, u.pn); } else { u.s = 1; tile_of(L - nwg0, 4, 16, u.pm, u.pn); }
        return true;
    }
};

__device__ __forceinline__ void epi_run(const GemmP& P, const f32x4 (&acc)[2][2][4][2], const Unit& u, int wr, int wc, int fr, int fq) {
    const int row0 = u.pm * BM + wr * 64 + fr;
    const int colt = u.pn * BM + wc * 32 + 8 * fq;
    const int mode = u.s ? EM_PLAIN : P.mode;
    unsigned char* ws = P.ws;
    if (mode == EM_PLAIN) {
        bf16_t* O = (bf16_t*)(ws + WS_MKV);
#pragma unroll
        for (int ai = 0; ai < 2; ++ai)
#pragma unroll
            for (int m = 0; m < 4; ++m) { bf16_t* rowp = O + (size_t)(row0 + ai * HALF + m * 16) * 4096 + colt;
#pragma unroll
                for (int bj = 0; bj < 2; ++bj) { const f32x4 v0 = acc[ai][bj][m][0], v1 = acc[ai][bj][m][1];
                    u32x4 w; w.x = cvt_pk_bf16(v0[0], v0[1]); w.y = cvt_pk_bf16(v0[2], v0[3]); w.z = cvt_pk_bf16(v1[0], v1[1]); w.w = cvt_pk_bf16(v1[2], v1[3]);
                    *(u32x4*)(rowp + bj * HALF) = w; } }
    } else if (mode == EM_INPROJ) {
        const int l = P.l, odd = l & 1, ldo = odd ? ODD_NP : EVEN_N;
        bf16_t* O = (bf16_t*)(ws + WS_QKV);
        const float* ssq = (const float*)(ws + WS_CTL) + CW_SSQ + l * NTOK;
        const float* cs128 = (const float*)(ws + WS_CS128); const float* cs64 = (const float*)(ws + WS_CS64);
        float* km = (float*)(ws + WS_CTL) + CW_KM + (size_t)(l >> 1) * (4 * 6 * 8 * 128);
        int kind; bool kmean = false;
        if (odd) { kind = (u.pn <= 6) ? 2 : (u.pn <= 9 ? 0 : 3); }
        else { kind = (u.pn < 6) ? 1 : (u.pn < 9 ? 0 : (u.pn < 15 ? 1 : (u.pn < 20 ? 0 : 3))); kmean = (u.pn >= 12 && u.pn < 15); }
        float ks[2][8];
#pragma unroll
        for (int bj = 0; bj < 2; ++bj)
#pragma unroll
            for (int e = 0; e < 8; ++e) ks[bj][e] = 0.f;
#pragma unroll
        for (int ai = 0; ai < 2; ++ai)
#pragma unroll
            for (int m = 0; m < 4; ++m) {
                const int row = row0 + ai * HALF + m * 16;
                const float rs = __builtin_amdgcn_rsqf(ssq[row] * (1.0f / DM) + EPS);
                f32x4 cs = {1.f, 1.f, 1.f, 1.f}, sn = {0.f, 0.f, 0.f, 0.f};
                if (kind == 1) { const float* t = cs128 + (size_t)row * 128 + (16 * wc + 4 * fq); cs = *(const f32x4*)t; sn = *(const f32x4*)(t + 64); }
                else if (kind == 2) { const float* t = cs64 + (size_t)row * 64 + (16 * (wc & 1) + 4 * fq); cs = *(const f32x4*)t; sn = *(const f32x4*)(t + 32); }
                bf16_t* rowp = O + (size_t)row * ldo + colt;
#pragma unroll
                for (int bj = 0; bj < 2; ++bj) {
                    f32x4 v0 = acc[ai][bj][m][0] * rs, v1 = acc[ai][bj][m][1] * rs;
                    if (kind == 1 || kind == 2) { const f32x4 o0 = v0 * cs - v1 * sn, o1 = v1 * cs + v0 * sn; v0 = o0; v1 = o1; }
                    else if (kind == 3) {
#pragma unroll
                        for (int j = 0; j < 4; ++j) { v0[j] = v0[j] * __builtin_amdgcn_rcpf(1.0f + __builtin_amdgcn_exp2f(-1.4426950408889634f * v0[j]));
                                                      v1[j] = v1[j] * __builtin_amdgcn_rcpf(1.0f + __builtin_amdgcn_exp2f(-1.4426950408889634f * v1[j])); }
                    }
                    if (kmean) {
#pragma unroll
                        for (int j = 0; j < 4; ++j) { ks[bj][j] += v0[j]; ks[bj][4 + j] += v1[j]; }
                    }
                    u32x4 w; w.x = cvt_pk_bf16(v0[0], v0[1]); w.y = cvt_pk_bf16(v0[2], v0[3]); w.z = cvt_pk_bf16(v1[0], v1[1]); w.w = cvt_pk_bf16(v1[2], v1[3]);
                    *(u32x4*)(rowp + bj * HALF) = w;
                }
            }
        if (kmean) {
#pragma unroll
            for (int bj = 0; bj < 2; ++bj)
#pragma unroll
                for (int e = 0; e < 8; ++e) { float s = ks[bj][e]; s += __shfl_xor(s, 1); s += __shfl_xor(s, 2); s += __shfl_xor(s, 4); s += __shfl_xor(s, 8); ks[bj][e] = s; }
            if (fr == 0) {
                const int b = u.pm >> 3, n = u.pm & 7;
#pragma unroll
                for (int bj = 0; bj < 2; ++bj) { const int h = (u.pn - 12) * 2 + bj; float* dst = km + ((size_t)((b * 6 + h) * 8 + n)) * 128 + wc * 32 + 8 * fq;
#pragma unroll
                    for (int e = 0; e < 8; ++e) atomicAdd(dst + e, ks[bj][e]); }
            }
        }
    } else {
        const int l = P.l;
        const float* xres = (l == 0) ? P.xin : (const float*)P.out; float* xout = P.out;
        bf16_t* xb = (bf16_t*)(ws + WS_XB); const bool wxb = (l != 3);
        float* ssq_out = (float*)(ws + WS_CTL) + CW_SSQ + (l + 1) * NTOK;
#pragma unroll
        for (int ai = 0; ai < 2; ++ai)
#pragma unroll
            for (int m = 0; m < 4; ++m) {
                const int row = row0 + ai * HALF + m * 16; float ss = 0.f;
#pragma unroll
                for (int bj = 0; bj < 2; ++bj) {
                    const size_t off = (size_t)row * DM + colt + bj * HALF;
                    const f32x4 a = *(const f32x4*)(xres + off), b = *(const f32x4*)(xres + off + 4);
                    const f32x4 v0 = acc[ai][bj][m][0] + a, v1 = acc[ai][bj][m][1] + b;
                    *(f32x4*)(xout + off) = v0; *(f32x4*)(xout + off + 4) = v1;
                    if (wxb) { u32x4 w; w.x = cvt_pk_bf16(v0[0], v0[1]); w.y = cvt_pk_bf16(v0[2], v0[3]); w.z = cvt_pk_bf16(v1[0], v1[1]); w.w = cvt_pk_bf16(v1[2], v1[3]); *(u32x4*)(xb + off) = w; }
                    ss += (v0[0] * v0[0] + v0[1] * v0[1]) + (v0[2] * v0[2] + v0[3] * v0[3]) + (v1[0] * v1[0] + v1[1] * v1[1]) + (v1[2] * v1[2] + v1[3] * v1[3]);
                }
                ss += __shfl_xor(ss, 16); ss += __shfl_xor(ss, 32);
                if (fq == 0) atomicAdd(ssq_out + row, ss);
            }
    }
}

__device__ __forceinline__ void gemm_phase(LAS unsigned char* lds, const GemmP& P, const Order& S, const int tid) {
    const int wid = __builtin_amdgcn_readfirstlane(tid >> 6), lane = tid & 63, wr = wid >> 2, wc = wid & 3, fr = lane & 15, fq = lane >> 4;
    constexpr int K = KDIM, nt = K / BK;
    unsigned voffA[2], voffB[2];
#pragma unroll
    for (int i = 0; i < 2; ++i) { int R, C; stage_rc(tid * 16 + i * 8192, R, C); const int Rb = (R & ~31) + perm32(R & 31);
        voffA[i] = (unsigned)(R * K + C) * 2u; voffB[i] = (unsigned)(Rb * K + C) * 2u; }
    constexpr size_t kstep = (size_t)(BK * 2);
    constexpr size_t hstep = (size_t)HALF * K * 2;
    constexpr size_t tstep = 2 * hstep;
    const unsigned ldsw = (unsigned)wid * 1024u;
    const int aoff = lds_byte(wr * 64 + fr, fq * 8), boff = lds_byte(wc * 32 + fr, fq * 8);
#define PG8_SA(b, h) (((b) * 2 + (h)) * HTB)
#define PG8_SB(b, h) ((4 + (b) * 2 + (h)) * HTB)
#define PG8_STAGE(bufoff, gbase, voff) do { _Pragma("unroll") for (int _i = 0; _i < 2; ++_i) \
        __builtin_amdgcn_global_load_lds((const unsigned*)((const char*)(gbase) + (voff)[_i]), (LAS unsigned*)(lds + (bufoff) + ldsw + _i * 8192), 16, 0, 0); } while (0)
#define PG8_LDA(dst, b, h) do { _Pragma("unroll") for (int m = 0; m < 4; ++m) _Pragma("unroll") for (int k = 0; k < 2; ++k) dst[m][k] = *(const LAS bf16x8*)(lds + PG8_SA(b, h) + aoff + m * 2048 + k * 1024); } while (0)
#define PG8_LDB(dst, b, h) do { _Pragma("unroll") for (int n = 0; n < 2; ++n) _Pragma("unroll") for (int k = 0; k < 2; ++k) dst[n][k] = *(const LAS bf16x8*)(lds + PG8_SB(b, h) + boff + n * 2048 + k * 1024); } while (0)
#define PG8_MMA(ai, bj, At, Bt) do { __builtin_amdgcn_s_setprio(1); _Pragma("unroll") for (int m = 0; m < 4; ++m) _Pragma("unroll") for (int n = 0; n < 2; ++n) _Pragma("unroll") for (int k = 0; k < 2; ++k) \
        acc[ai][bj][m][n] = __builtin_amdgcn_mfma_f32_16x16x32_bf16(Bt[n][k], At[m][k], acc[ai][bj][m][n], 0, 0, 0); __builtin_amdgcn_s_setprio(0); } while (0)
#define PG8_WAIT_V(n) asm volatile("s_waitcnt vmcnt(" #n ")" ::: "memory")
#define PG8_WAIT_L(n) asm volatile("s_waitcnt lgkmcnt(" #n ")" ::: "memory")
#define PG8_BAR __builtin_amdgcn_s_barrier()
#define PG8_SCHED __builtin_amdgcn_sched_barrier(0)
    Unit cur, nxt; int ui = 0;
    if (!S.next(0, cur)) return;
    f32x4 acc[2][2][4][2];
#pragma unroll
    for (int a = 0; a < 2; ++a)
#pragma unroll
        for (int b = 0; b < 2; ++b)
#pragma unroll
            for (int m = 0; m < 4; ++m)
#pragma unroll
                for (int n = 0; n < 2; ++n) acc[a][b][m][n] = (f32x4){0.f, 0.f, 0.f, 0.f};
    bf16x8 At[4][2], B0[2][2], B1[2][2];
    const char* cA = (cur.s ? (const char*)(P.ws + WS_MEMN) : (const char*)P.A) + (size_t)cur.pm * tstep; const char* cB = (cur.s ? (const char*)(P.ws + WS_WMKV) : (const char*)P.Bt) + (size_t)cur.pn * tstep;
    PG8_STAGE(PG8_SB(0, 0), cB, voffB); PG8_STAGE(PG8_SB(0, 1), cB + hstep, voffB); PG8_STAGE(PG8_SA(0, 0), cA, voffA); PG8_STAGE(PG8_SA(0, 1), cA + hstep, voffA);
    if (wr == 1) PG8_BAR;
    PG8_WAIT_V(2); PG8_BAR;
    PG8_STAGE(PG8_SB(1, 0), cB + kstep, voffB); PG8_STAGE(PG8_SA(1, 0), cA + kstep, voffA); PG8_STAGE(PG8_SB(1, 1), cB + hstep + kstep, voffB);
    PG8_WAIT_V(6); PG8_BAR;
    for (;;) {
        const bool has_next = S.next(ui + 1, nxt);
        const char* nA = has_next ? (nxt.s ? (const char*)(P.ws + WS_MEMN) : (const char*)P.A) + (size_t)nxt.pm * tstep : cA; const char* nB = has_next ? (nxt.s ? (const char*)(P.ws + WS_WMKV) : (const char*)P.Bt) + (size_t)nxt.pn * tstep : cB;
        for (int t = 0; t < nt; t += 2) {
            const bool last = (t == nt - 2);
            const char* a1 = cA + (size_t)(t + 1) * kstep;
            const char* a2 = last ? nA : cA + (size_t)(t + 2) * kstep; const char* b2 = last ? nB : cB + (size_t)(t + 2) * kstep;
            const char* a3 = a2 + kstep; const char* b3 = b2 + kstep;
            PG8_LDB(B0, 0, 0); PG8_LDB(B1, 0, 1); PG8_SCHED; PG8_LDA(At, 0, 0); PG8_STAGE(PG8_SA(1, 1), a1 + hstep, voffA);
            PG8_WAIT_V(8); PG8_WAIT_L(0); PG8_BAR; PG8_MMA(0, 0, At, B0); PG8_MMA(0, 1, At, B1); PG8_BAR; PG8_SCHED;
            PG8_LDA(At, 0, 1); PG8_STAGE(PG8_SB(0, 0), b2, voffB); PG8_STAGE(PG8_SB(0, 1), b2 + hstep, voffB); PG8_STAGE(PG8_SA(0, 0), a2, voffA);
            PG8_WAIT_V(8); PG8_WAIT_L(0); PG8_BAR; PG8_MMA(1, 0, At, B0); PG8_MMA(1, 1, At, B1); PG8_BAR; PG8_SCHED;
            PG8_LDB(B0, 1, 0); PG8_LDB(B1, 1, 1); PG8_SCHED; PG8_LDA(At, 1, 0); PG8_STAGE(PG8_SA(0, 1), a2 + hstep, voffA);
            PG8_WAIT_V(8); PG8_WAIT_L(0); PG8_BAR; PG8_MMA(0, 0, At, B0); PG8_MMA(0, 1, At, B1); PG8_BAR; PG8_SCHED;
            PG8_LDA(At, 1, 1); PG8_STAGE(PG8_SB(1, 0), b3, voffB); PG8_STAGE(PG8_SB(1, 1), b3 + hstep, voffB); PG8_STAGE(PG8_SA(1, 0), a3, voffA);
            PG8_WAIT_V(8); PG8_WAIT_L(0); PG8_BAR; PG8_MMA(1, 0, At, B0); PG8_MMA(1, 1, At, B1); PG8_BAR; PG8_SCHED;
        }
        if (wr == 0) PG8_BAR;
        epi_run(P, acc, cur, wr, wc, fr, fq);
        if (!has_next) break;
#pragma unroll
        for (int a = 0; a < 2; ++a)
#pragma unroll
            for (int b = 0; b < 2; ++b)
#pragma unroll
                for (int m = 0; m < 4; ++m)
#pragma unroll
                    for (int n = 0; n < 2; ++n) acc[a][b][m][n] = (f32x4){0.f, 0.f, 0.f, 0.f};
        cur = nxt; cA = nA; cB = nB; ++ui;
        if (wr == 1) PG8_BAR;
    }
    PG8_WAIT_V(0);
    PG8_BAR;
#undef PG8_SA
#undef PG8_SB
#undef PG8_STAGE
#undef PG8_LDA
#undef PG8_LDB
#undef PG8_MMA
#undef PG8_WAIT_V
#undef PG8_WAIT_L
#undef PG8_BAR
#undef PG8_SCHED
}

struct AU {
    int qoff, qs;
    int kvsel;
    int koff, voff, kd1, ks;
    int L, qrow_w, kt0, nsteps, kstep, koff1;
    int band, causal, pair, whalf, moba_n;
    int kmoff;
};
struct AE {
    int epi;
    int ooff, os, goff, gs, lseoff, lses, has_sink;
    float sink;
};
__device__ __forceinline__ int crow(int r, int hi) { return (r & 3) + 8 * (r >> 2) + 4 * hi; }
template <int OFF> __device__ __forceinline__ s16x4 tr_read(int vb) { s16x4 r; asm volatile("ds_read_b64_tr_b16 %0, %1 offset:%2" : "=&v"(r) : "v"(vb), "i"(OFF) : "memory"); return r; }
template <int D> __device__ __forceinline__ int kswz(int row, int colB) { if constexpr (D == 128) return row * 256 + (colB ^ ((row & 7) << 4)); else return row * 128 + (colB ^ (((row >> 1) & 7) << 4)); }
template <int D> __device__ __forceinline__ int v_st(int k, int c) { const int kk = (k & ~0xC) | ((k & 4) << 1) | ((k & 8) >> 1); return ((kk >> 3) * (D / 32) + (c >> 5)) * 512 + ((kk & 7) * 32 + (c & 31)) * 2; }
__device__ __forceinline__ int v_rd_base(int lane) { return ((lane & 3) << 3) | (((lane >> 2) & 3) << 6) | (((lane >> 4) & 1) << 5) | (((lane >> 5) & 1) << 8); }
template <int D> constexpr int v_rd_off(int d0, int ks, int half) { return d0 * 512 + (ks * 2 + half) * (D / 32) * 512; }

template <int D, int D0, int HF> __device__ __forceinline__ void pv_half(f32x16& od, int vb, bf16x8 pa, bf16x8 pb) {
    const s16x4 l0 = tr_read<v_rd_off<D>(D0, 2 * HF, 0)>(vb), h0 = tr_read<v_rd_off<D>(D0, 2 * HF, 1)>(vb), l1 = tr_read<v_rd_off<D>(D0, 2 * HF + 1, 0)>(vb), h1 = tr_read<v_rd_off<D>(D0, 2 * HF + 1, 1)>(vb);
    asm volatile("s_waitcnt lgkmcnt(0)" ::: "memory"); SBAR();
#define PKV(Lx, Hx) (bf16x8){Lx[0], Lx[1], Lx[2], Lx[3], Hx[0], Hx[1], Hx[2], Hx[3]}
    od = __builtin_amdgcn_mfma_f32_32x32x16_bf16(pa, PKV(l0, h0), od, 0, 0, 0);
    od = __builtin_amdgcn_mfma_f32_32x32x16_bf16(pb, PKV(l1, h1), od, 0, 0, 0);
#undef PKV
}
template <int D, int HF> __device__ __forceinline__ void pv_all(f32x16* o, int vb, bf16x8 pa, bf16x8 pb) {
    pv_half<D, 0, HF>(o[0], vb, pa, pb); pv_half<D, 1, HF>(o[1], vb, pa, pb);
    if constexpr (D == 128) { pv_half<D, 2, HF>(o[2], vb, pa, pb); pv_half<D, 3, HF>(o[3], vb, pa, pb); }
}

template <int D>
__device__ __forceinline__ void attn_main(const AU& u, unsigned char* ws, LAS unsigned char* lds, int tid, int wid, int lane, float& m_out, float& l_out, f32x16 (&o)[D / 32]) {
    constexpr int NQ = D / 16, NB = D / 32, KTB = 64 * D * 2;
    constexpr float SCALE = (D == 128) ? 0.088388347648318440f : 0.125f;
    constexpr float C = SCALE * 1.4426950408889634f;
    constexpr float THRS = 8.0f / SCALE;
    const int r32 = lane & 31, hi = lane >> 5;
    LAS unsigned char* Kl = lds; LAS unsigned char* Vl = lds + 2 * KTB;
    LAS float* wsf = (LAS float*)(lds + 65536 + wid * 8192);
    const bf16_t* QKVp = (const bf16_t*)(ws + WS_QKV);
    const bf16_t* KVp = u.kvsel ? (const bf16_t*)(ws + WS_MKV) : QKVp;
    bf16x8 qr[NQ];
    { const bf16_t* qrow = QKVp + (size_t)u.qoff + (size_t)(u.qrow_w + r32) * u.qs + hi * 8;
#pragma unroll
      for (int d0 = 0; d0 < NQ; ++d0) qr[d0] = *(const bf16x8*)(qrow + d0 * 16); }
    float m_reg = -1e30f, l_reg = 0.f;
#pragma unroll
    for (int d = 0; d < NB; ++d)
#pragma unroll
        for (int r = 0; r < 16; ++r) o[d][r] = 0.f;
    const int qidx = u.qrow_w + r32;
    unsigned selmask = 0;
    if constexpr (D == 128) {
        if (u.moba_n > 0) {
            const int n = u.moba_n; float g[7];
#pragma unroll
            for (int j = 0; j < 7; ++j) {
                g[j] = -INFINITY;
                if (j < n) {
                    const float* kmj = (const float*)(ws + WS_CTL) + CW_KM + u.kmoff + j * 128 + hi * 8; float s = 0.f;
#pragma unroll
                    for (int d0 = 0; d0 < NQ; ++d0) { const f32x4 a = *(const f32x4*)(kmj + d0 * 16), b = *(const f32x4*)(kmj + d0 * 16 + 4);
                        const u32x4 qw = __builtin_bit_cast(u32x4, qr[d0]);
                        s += bflo(qw.x) * a[0] + bfhi(qw.x) * a[1] + bflo(qw.y) * a[2] + bfhi(qw.y) * a[3] + bflo(qw.z) * b[0] + bfhi(qw.z) * b[1] + bflo(qw.w) * b[2] + bfhi(qw.w) * b[3]; }
                    auto rr = __builtin_amdgcn_permlane32_swap(__float_as_uint(s), __float_as_uint(s), false, false);
                    g[j] = __uint_as_float(rr[0]) + __uint_as_float(rr[1]);
                }
            }
#pragma unroll
            for (int j = 0; j < 7; ++j) { int cnt = 0;
#pragma unroll
                for (int i = 0; i < 7; ++i) if (i != j) cnt += (i < n && (g[i] > g[j] || (g[i] == g[j] && i < j))) ? 1 : 0;
                if (j < n && cnt < 3) selmask |= (1u << j); }
        }
    }
    const int sr = (D == 128) ? (tid >> 4) : (tid >> 3), sc = (D == 128) ? (tid & 15) * 8 : (tid & 7) * 8;
    bf16x8 sk0, sv0, sk1, sv1;
    auto clampk = [&](int kk) { return kk < 0 ? 0 : (kk > u.L - 1 ? u.L - 1 : kk); };
#define SLOAD(kb) do { if constexpr (D == 128) { const size_t i0 = (size_t)clampk((kb) + sr) * u.ks + sc, i1 = (size_t)clampk((kb) + sr + u.koff1) * u.ks + u.kd1 + sc; \
        sk0 = *(const bf16x8*)(KVp + u.koff + i0); sv0 = *(const bf16x8*)(KVp + u.voff + i0); sk1 = *(const bf16x8*)(KVp + u.koff + i1); sv1 = *(const bf16x8*)(KVp + u.voff + i1); } \
        else { const size_t i0 = (size_t)clampk((kb) + sr) * u.ks + sc; sk0 = *(const bf16x8*)(KVp + u.koff + i0); sv0 = *(const bf16x8*)(KVp + u.voff + i0); } } while (0)
#define SWRITE(buf) do { if constexpr (D == 128) { *(LAS bf16x8*)(Kl + (buf) * KTB + kswz<D>(sr, sc * 2)) = sk0; *(LAS bf16x8*)(Kl + (buf) * KTB + kswz<D>(32 + sr, sc * 2)) = sk1; \
        *(LAS bf16x8*)(Vl + (buf) * KTB + v_st<D>(sr, sc)) = sv0; *(LAS bf16x8*)(Vl + (buf) * KTB + v_st<D>(32 + sr, sc)) = sv1; } \
        else { *(LAS bf16x8*)(Kl + (buf) * KTB + kswz<D>(sr, sc * 2)) = sk0; *(LAS bf16x8*)(Vl + (buf) * KTB + v_st<D>(sr, sc)) = sv0; } } while (0)
    SLOAD(u.kt0); SWRITE(0); __syncthreads();
    const int vrb = (int)(uintptr_t)Vl + v_rd_base(lane);
    for (int t = 0; t < u.nsteps; ++t) {
        const int buf = t & 1;
        if (t + 1 < u.nsteps) SLOAD(u.kt0 + (t + 1) * u.kstep);
        {
            const int kb0 = u.kt0 + t * u.kstep, kb1 = kb0 + u.koff1;
            int lo_q, hi_q;
            if (u.moba_n >= 0 && t < 4 * u.moba_n) { const bool sel = (selmask >> (t >> 2)) & 1u; lo_q = sel ? -(1 << 28) : (1 << 28); hi_q = sel ? (1 << 28) : -(1 << 28); }
            else { lo_q = qidx - u.band; hi_q = u.causal ? qidx : (1 << 28); }
            bool any0 = __any(lo_q <= kb0 + 31 && hi_q >= kb0), any1 = __any(lo_q <= kb1 + 31 && hi_q >= kb1);
            if (u.pair) { any0 = any0 && (u.whalf == 0); any1 = any1 && (u.whalf == 1); }
            if (any0 || any1) {
                const bool all0 = __all(lo_q <= kb0 && hi_q >= kb0 + 31), all1 = __all(lo_q <= kb1 && hi_q >= kb1 + 31);
                f32x16 p0, p1;
#pragma unroll
                for (int r = 0; r < 16; ++r) { p0[r] = 0.f; p1[r] = 0.f; }
                LAS unsigned char* Kt = Kl + buf * KTB;
                if (any0) {
#pragma unroll
                    for (int d0 = 0; d0 < NQ; ++d0) { const bf16x8 b0 = *(const LAS bf16x8*)(Kt + kswz<D>(r32, (d0 * 16 + hi * 8) * 2)); p0 = __builtin_amdgcn_mfma_f32_32x32x16_bf16(b0, qr[d0], p0, 0, 0, 0); }
                    if (!all0) {
#pragma unroll
                        for (int r = 0; r < 16; ++r) { const int kk = kb0 + crow(r, hi); if (kk < lo_q || kk > hi_q) p0[r] = -INFINITY; }
                    }
                } else {
#pragma unroll
                    for (int r = 0; r < 16; ++r) p0[r] = -INFINITY;
                }
                if (any1) {
#pragma unroll
                    for (int d0 = 0; d0 < NQ; ++d0) { const bf16x8 b1 = *(const LAS bf16x8*)(Kt + kswz<D>(32 + r32, (d0 * 16 + hi * 8) * 2)); p1 = __builtin_amdgcn_mfma_f32_32x32x16_bf16(b1, qr[d0], p1, 0, 0, 0); }
                    if (!all1) {
#pragma unroll
                        for (int r = 0; r < 16; ++r) { const int kk = kb1 + crow(r, hi); if (kk < lo_q || kk > hi_q) p1[r] = -INFINITY; }
                    }
                } else {
#pragma unroll
                    for (int r = 0; r < 16; ++r) p1[r] = -INFINITY;
                }
                float pmax = p0[0];
#pragma unroll
                for (int r = 1; r < 16; ++r) pmax = fmaxf(pmax, p0[r]);
#pragma unroll
                for (int r = 0; r < 16; ++r) pmax = fmaxf(pmax, p1[r]);
                { auto rr = __builtin_amdgcn_permlane32_swap(__float_as_uint(pmax), __float_as_uint(pmax), false, false); pmax = fmaxf(__uint_as_float(rr[0]), __uint_as_float(rr[1])); }
                float alpha = 1.f;
                if (!__all(pmax - m_reg <= THRS)) { const float mn = fmaxf(m_reg, pmax); alpha = __builtin_amdgcn_exp2f((m_reg - mn) * C); m_reg = mn; }
                const float mnC = -m_reg * C;
                float ps = 0.f;
#pragma unroll
                for (int r = 0; r < 16; ++r) { p0[r] = __builtin_amdgcn_exp2f(fmaf(p0[r], C, mnC)); ps += p0[r]; }
#pragma unroll
                for (int r = 0; r < 16; ++r) { p1[r] = __builtin_amdgcn_exp2f(fmaf(p1[r], C, mnC)); ps += p1[r]; }
                { auto rr = __builtin_amdgcn_permlane32_swap(__float_as_uint(ps), __float_as_uint(ps), false, false); ps = __uint_as_float(rr[0]) + __uint_as_float(rr[1]); }
                l_reg = l_reg * alpha + ps;
                if (__any(alpha < 1.f)) {
                    if (hi == 0) wsf[r32] = alpha;
                    LDS_WAIT();
#pragma unroll
                    for (int d = 0; d < NB; ++d)
#pragma unroll
                        for (int r = 0; r < 16; ++r) o[d][r] *= wsf[crow(r, hi)];
                    LDS_WAIT();
                }
                bf16x8 pa0, pa1, pa2, pa3;
#define PK4(P, BASE, OUT) do { unsigned a0 = cvt_pk_bf16(P[BASE + 0], P[BASE + 1]), a1 = cvt_pk_bf16(P[BASE + 2], P[BASE + 3]);   \
    unsigned b0 = cvt_pk_bf16(P[BASE + 4], P[BASE + 5]), b1 = cvt_pk_bf16(P[BASE + 6], P[BASE + 7]);                              \
    auto r0 = __builtin_amdgcn_permlane32_swap(a0, b0, false, false); auto r1 = __builtin_amdgcn_permlane32_swap(a1, b1, false, false); \
    u32x4 w = {r0[0], r1[0], r0[1], r1[1]}; OUT = __builtin_bit_cast(bf16x8, w); } while (0)
                PK4(p0, 0, pa0); PK4(p0, 8, pa1); PK4(p1, 0, pa2); PK4(p1, 8, pa3);
#undef PK4
                const int vb = vrb + buf * KTB;
                SBAR();
                if (any0) pv_all<D, 0>(o, vb, pa0, pa1);
                if (any1) pv_all<D, 1>(o, vb, pa2, pa3);
            }
        }
        if (t + 1 < u.nsteps) SWRITE(buf ^ 1);
        __syncthreads();
    }
#undef SLOAD
#undef SWRITE
    m_out = m_reg; l_out = l_reg;
}

template <int D>
__device__ __forceinline__ void attn_epi(const AE& e, int qrow_w, unsigned char* ws, LAS unsigned char* lds, int wid, int lane, float m_reg, float l_reg, const f32x16 (&o)[D / 32]) {
    constexpr int NB = D / 32;
    constexpr float SCALE = (D == 128) ? 0.088388347648318440f : 0.125f;
    const int r32 = lane & 31, hi = lane >> 5;
    LAS float* wsf = (LAS float*)(lds + 65536 + wid * 8192);
    LAS bf16_t* stg = (LAS bf16_t*)(lds + 65536 + wid * 8192);
    float lt = l_reg;
    if (e.has_sink) lt += __builtin_amdgcn_exp2f((e.sink - m_reg * SCALE) * 1.4426950408889634f);
    if (hi == 0) wsf[r32] = lt;
    LDS_WAIT();
    float rli[16];
#pragma unroll
    for (int r = 0; r < 16; ++r) rli[r] = __builtin_amdgcn_rcpf(wsf[crow(r, hi)]);
    LDS_WAIT();
#pragma unroll
    for (int r = 0; r < 16; ++r) { const int orow = crow(r, hi);
#pragma unroll
        for (int d0 = 0; d0 < NB; ++d0) stg[orow * D + d0 * 32 + r32] = (bf16_t)f2bf(o[d0][r] * rli[r]); }
    LDS_WAIT();
    constexpr int CPR = D / 8, RPP = 64 / CPR;
    bf16_t* OB = (bf16_t*)(ws + (e.epi ? WS_Y : WS_OG));
    const bf16_t* GB = (const bf16_t*)(ws + WS_QKV);
#pragma unroll
    for (int i = 0; i < 32 / RPP; ++i) {
        const int row = i * RPP + lane / CPR, ch = lane % CPR;
        const u32x4 v = *(const LAS u32x4*)(stg + row * D + ch * 8);
        const size_t fidx = (size_t)(qrow_w + row);
        if (e.epi == 1) {
            const u32x4 g = *(const u32x4*)(GB + (size_t)e.goff + fidx * e.gs + ch * 8);
            u32x4 w;
            w.x = cvt_pk_bf16(bflo(v.x) * bflo(g.x), bfhi(v.x) * bfhi(g.x)); w.y = cvt_pk_bf16(bflo(v.y) * bflo(g.y), bfhi(v.y) * bfhi(g.y));
            w.z = cvt_pk_bf16(bflo(v.z) * bflo(g.z), bfhi(v.z) * bfhi(g.z)); w.w = cvt_pk_bf16(bflo(v.w) * bflo(g.w), bfhi(v.w) * bfhi(g.w));
            *(u32x4*)(OB + (size_t)e.ooff + fidx * e.os + ch * 8) = w;
        } else {
            *(u32x4*)(OB + (size_t)e.ooff + fidx * e.os + ch * 8) = v;
        }
    }
    if (e.epi == 0 && hi == 0) ((float*)(ws + WS_LSE))[(size_t)e.lseoff + (size_t)(qrow_w + r32) * e.lses] = m_reg * SCALE + __logf(l_reg);
    LDS_WAIT();
}

#define XB_TMO      128
#define XB_XCNT(j)  (256  + 64 * (j))
#define XB_XSUB(j)  (1280 + 64 * (j))
#define XB_XGEN(j)  (2304 + 64 * (j))
#define XB_TOP      3328
#define XB_TOPGEN   3392
#define XCD_BAR_WORDS 3456
#define XB_SPIN_CAP (1u << 18)
__device__ __forceinline__ unsigned xb_ld(unsigned* p)              { return __hip_atomic_load(p, __ATOMIC_RELAXED, __HIP_MEMORY_SCOPE_AGENT); }
__device__ __forceinline__ unsigned xb_add(unsigned* p, unsigned v) { return __hip_atomic_fetch_add(p, v, __ATOMIC_RELAXED, __HIP_MEMORY_SCOPE_AGENT); }
__device__ __forceinline__ unsigned xb_xcc_id() { return (unsigned)__builtin_amdgcn_s_getreg((3 << 11) | 20) & 0xFu; }
#define XB_SPIN(cond, bar) do { unsigned _sp = 0; while (cond) { __builtin_amdgcn_s_sleep(1); \
    if ((++_sp & 255u) == 0u) { if (xb_ld(&(bar)[XB_TMO])) break; if (_sp > XB_SPIN_CAP) { atomicAdd(&(bar)[XB_TMO], 1u); break; } } } } while (0)
struct XcdBarrier { unsigned* bar; unsigned x; volatile LAS unsigned* st; };
__device__ __forceinline__ XcdBarrier xcd_barrier_post(unsigned* bar, volatile LAS unsigned* st) {
    XcdBarrier b; b.bar = bar; b.x = xb_xcc_id(); b.st = st;
    if (threadIdx.x == 0) (void)xb_add(&bar[XB_XCNT(b.x)], 1u);
    return b;
}
__device__ __forceinline__ void xcd_barrier_complete(unsigned* bar, unsigned x, unsigned& nloc, unsigned& nx) {
    const unsigned G = gridDim.x * gridDim.y * gridDim.z;
    unsigned sum, cnt, mine, sp = 0u;
    for (;;) {
        sum = 0u; cnt = 0u; mine = 0u;
#pragma unroll
        for (unsigned j = 0; j < 16; ++j) { const unsigned c = xb_ld(&bar[XB_XCNT(j)]); sum += c; cnt += (c > 0u) ? 1u : 0u; mine = (j == x) ? c : mine; }
        if (sum == G) break;
        __builtin_amdgcn_s_sleep(1);
        if ((++sp & 255u) == 0u) { if (xb_ld(&bar[XB_TMO])) break; if (sp > XB_SPIN_CAP) { atomicAdd(&bar[XB_TMO], 1u); break; } }
    }
    nloc = mine > 0u ? mine : 1u; nx = cnt > 0u ? cnt : 1u;
}
__device__ __forceinline__ void xcd_barrier(const XcdBarrier& b) {
    asm volatile("s_waitcnt vmcnt(0)" ::: "memory");
    __syncthreads();
    if (threadIdx.x == 0) {
        unsigned* bar = b.bar;
        __builtin_amdgcn_s_waitcnt(0);
        unsigned nloc = b.st[0], nx = b.st[1];
        if (nloc == 0u) { xcd_barrier_complete(bar, b.x, nloc, nx); b.st[0] = nloc; b.st[1] = nx; }
        const unsigned old = xb_add(&bar[XB_XSUB(b.x)], 1u);
        const unsigned gen = old / nloc;
        if (old + 1u == (gen + 1u) * nloc) {
            __builtin_amdgcn_fence(__ATOMIC_RELEASE, "agent");
            asm volatile("s_waitcnt vmcnt(0)" ::: "memory");
            const unsigned og = xb_add(&bar[XB_TOP], 1u);
            const unsigned tg = og / nx;
            if (og + 1u == (tg + 1u) * nx) xb_add(&bar[XB_TOPGEN], 1u);
            else XB_SPIN(xb_ld(&bar[XB_TOPGEN]) == tg, bar);
            __builtin_amdgcn_fence(__ATOMIC_ACQUIRE, "agent");
            xb_add(&bar[XB_XGEN(b.x)], 1u);
            asm volatile("s_waitcnt vmcnt(0)" ::: "memory");
        } else {
            XB_SPIN(xb_ld(&bar[XB_XGEN(b.x)]) == gen, bar);
            __builtin_amdgcn_fence(__ATOMIC_ACQUIRE, "agent");
            asm volatile("s_waitcnt vmcnt(0)" ::: "memory");
        }
    }
    __syncthreads();
}

__device__ __forceinline__ float wave_sum(float v) {
#pragma unroll
    for (int o = 1; o < 64; o <<= 1) v += __shfl_xor(v, o);
    return v;
}
__device__ __forceinline__ int phys_even(int n) {
    if (n >= 4608) return n;
    const int seg = n / 768; if (seg == 2 || seg == 5) return n;
    const int i = n & 127, hb = n - i, ii = i & 63, g = ii >> 2, e = (ii & 3) + ((i >> 6) << 2);
    return hb + 8 * g + e;
}
__device__ __forceinline__ int phys_odd(int n) {
    if (n < 1728) { const int i = n & 63, hb = n - i, ii = i & 31, g = ii >> 2, e = (ii & 3) + ((i >> 5) << 2); return hb + 8 * g + e; }
    if (n < 1920) return n + 64;
    return n + 128;
}
__device__ __forceinline__ void transpose_item(const float* W, int N, const float* gk, bf16_t* WT, int mapkind, int rowoff, LAS float* scr, int item, int lane) {
    const int nblk = N / 32, kb = item / nblk, nb = item % nblk, k0 = 64 * kb, n0 = 32 * nb;
#pragma unroll 8
    for (int i = 0; i < 32; ++i) { const int kk = 2 * i + (lane >> 5); float w = W[(size_t)(k0 + kk) * N + n0 + (lane & 31)]; if (gk) w *= gk[k0 + kk]; scr[kk * 33 + (lane & 31)] = w; }
    LDS_WAIT(); asm volatile("" ::: "memory");
    const int c = lane & 7;
#pragma unroll
    for (int j = 0; j < 4; ++j) { const int n = (lane >> 3) + 8 * j; const LAS float* s = scr + (8 * c) * 33 + n;
        const int nl = n0 + n; const int p = (mapkind == 1 ? phys_even(nl) : (mapkind == 2 ? phys_odd(nl) : nl)) + rowoff;
        u32x4 o; o.x = pk2(s[0 * 33], s[1 * 33]); o.y = pk2(s[2 * 33], s[3 * 33]); o.z = pk2(s[4 * 33], s[5 * 33]); o.w = pk2(s[6 * 33], s[7 * 33]);
        *(u32x4*)(WT + (size_t)p * KDIM + k0 + 8 * c) = o; }
    LDS_WAIT(); asm volatile("" ::: "memory");
}

struct Args {
    const float* x; const float* mem; const int* pos;
    const float* even_norm; const float* even_w_in; const float* even_w_mkv; const float* even_w_out;
    const float* odd_norm; const float* odd_w_in; const float* odd_w_mkv; const float* odd_w_out; const float* odd_sinks;
    const float* mem_norm; const float* final_norm;
    float* out; unsigned char* ws;
    int ph_lo, ph_hi;
};
constexpr int N_PHASES = 18;

__device__ __forceinline__ bool decode_main(int idx, int l, int wave, AU& u) {
    const int odd = l & 1;
    u.koff1 = 32; u.kstep = 64; u.moba_n = -1; u.band = 1 << 28; u.causal = 1; u.kvsel = 0; u.kd1 = 0; u.pair = 0; u.whalf = 0; u.kmoff = 0;
    if (!odd) {
        if (idx < 192) {
            const int n = 7 - idx / 24, bh = idx % 24, b = bh / 6, h = bh % 6; const int tb = b * SEQ * EVEN_N;
            u.qoff = tb + 2304 + h * 128; u.qs = EVEN_N; u.koff = tb + 3072 + h * 128; u.voff = tb + 3840 + h * 128; u.ks = EVEN_N;
            u.L = SEQ; u.qrow_w = 256 * n + 32 * wave; u.kt0 = 0; u.nsteps = 4 * (n + 1); u.moba_n = n;
            u.kmoff = (l >> 1) * (4 * 6 * 8 * 128) + ((b * 6 + h) * 8) * 128;
        } else if (idx < 576) {
            const int i = idx - 192, pat = i / 192, j = i % 192, bh = j % 24, rr = j / 24, b = bh / 6, h = bh % 6;
            const int dil = pat ? 4 : 1, res = pat ? (rr & 3) : 0, kblk = pat ? (rr >> 2) : rr;
            const int tb = (b * SEQ + res) * EVEN_N;
            u.qoff = tb + h * 128; u.qs = dil * EVEN_N; u.koff = tb + 768 + h * 128; u.voff = tb + 1536 + h * 128; u.ks = dil * EVEN_N;
            u.L = SEQ / dil; u.qrow_w = 256 * kblk + 32 * wave; u.kt0 = (256 * kblk - 128) < 0 ? 0 : (256 * kblk - 128); u.nsteps = (256 * kblk + 256 - u.kt0) / 64; u.band = 128;
        } else if (idx < 704) {
            const int i = idx - 576, b = i / 32, hm = (i / 8) % 4, blk = i % 8;
            u.qoff = b * SEQ * EVEN_N + 4608 + hm * 128; u.qs = EVEN_N;
            u.kvsel = 1; u.koff = b * MEML * 4096 + l * 1024 + hm * 128; u.voff = u.koff + 512; u.ks = 4096;
            u.L = MEML; u.qrow_w = 256 * blk + 32 * wave; u.kt0 = 0; u.nsteps = 4; u.causal = 0;
        } else {
            const int i = idx - 704, bh = i % 24, u8 = i / 24, b = bh / 6, h = bh % 6; const int wh = wave >> 2;
            const int tp = (b * SEQ + 2 * u8) * EVEN_N;
            u.qoff = tp + wh * EVEN_N + h * 128; u.qs = 16 * EVEN_N; u.koff = tp + 768 + h * 128; u.voff = tp + 1536 + h * 128; u.kd1 = EVEN_N; u.ks = 16 * EVEN_N;
            u.L = 128; u.qrow_w = 32 * (wave & 3); u.kt0 = 0; u.nsteps = 4; u.kstep = 32; u.koff1 = 0; u.pair = 1; u.whalf = wh; u.band = 128;
        }
        return false;
    } else {
        if (idx < 128) {
            const int i = idx, b = i / 32, hm = (i / 8) % 4, blk = i % 8;
            u.qoff = b * SEQ * ODD_NP + 2048 + hm * 128; u.qs = ODD_NP;
            u.kvsel = 1; u.koff = b * MEML * 4096 + l * 1024 + hm * 128; u.voff = u.koff + 512; u.ks = 4096;
            u.L = MEML; u.qrow_w = 256 * blk + 32 * wave; u.kt0 = 0; u.nsteps = 4; u.causal = 0;
            return false;
        } else {
            const int i = idx - 128, b = i / 192, g = (i / 64) % 3, pblk = i % 64, hq = 8 * g + wave; const int tb = b * SEQ * ODD_NP;
            u.qoff = tb + hq * 64; u.qs = ODD_NP; u.koff = tb + 1536 + g * 64; u.voff = tb + 1792 + g * 64; u.ks = ODD_NP;
            u.L = SEQ; u.qrow_w = 32 * pblk; u.kt0 = (32 * pblk - 128) < 0 ? 0 : (32 * pblk - 128); u.nsteps = (32 * pblk + 32 - u.kt0 + 63) / 64; u.band = 127;
            return true;
        }
    }
}
__device__ __forceinline__ void decode_epi(int idx, int l, int wave, const float* sinks, AE& e) {
    const int odd = l & 1;
    e.has_sink = 0; e.sink = 0.f; e.lseoff = 0; e.lses = 0; e.goff = 0; e.gs = 0;
    if (!odd) {
        if (idx < 192) { const int bh = idx % 24, b = bh / 6, h = bh % 6;
            e.epi = 1; e.ooff = b * SEQ * DM + 768 + h * 128; e.os = DM; e.goff = b * SEQ * EVEN_N + 5120 + 768 + h * 128; e.gs = EVEN_N;
        } else if (idx < 576) { const int i = idx - 192, pat = i / 192, j = i % 192, bh = j % 24, rr = j / 24, b = bh / 6, h = bh % 6;
            const int dil = pat ? 4 : 1, res = pat ? (rr & 3) : 0; const int tok0 = b * SEQ + res;
            e.epi = 0; e.ooff = pat * NTOK * 768 + tok0 * 768 + h * 128; e.os = dil * 768; e.lseoff = pat * NTOK * 6 + tok0 * 6 + h; e.lses = dil * 6;
        } else if (idx < 704) { const int i = idx - 576, b = i / 32, hm = (i / 8) % 4;
            e.epi = 1; e.ooff = b * SEQ * DM + 1536 + hm * 128; e.os = DM; e.goff = b * SEQ * EVEN_N + 5120 + 1536 + hm * 128; e.gs = EVEN_N;
        } else { const int i = idx - 704, bh = i % 24, u8 = i / 24, b = bh / 6, h = bh % 6; const int tokw = b * SEQ + 2 * u8 + (wave >> 2);
            e.epi = 0; e.ooff = 2 * NTOK * 768 + tokw * 768 + h * 128; e.os = 16 * 768; e.lseoff = 2 * NTOK * 6 + tokw * 6 + h; e.lses = 16 * 6;
        }
    } else {
        if (idx < 128) { const int i = idx, b = i / 32, hm = (i / 8) % 4;
            e.epi = 1; e.ooff = b * SEQ * DM + 1536 + hm * 128; e.os = DM; e.goff = b * SEQ * ODD_NP + 2560 + 1536 + hm * 128; e.gs = ODD_NP;
        } else { const int i = idx - 128, b = i / 192, g = (i / 64) % 3, hq = 8 * g + wave;
            e.epi = 1; e.ooff = b * SEQ * DM + hq * 64; e.os = DM; e.goff = b * SEQ * ODD_NP + 2560 + hq * 64; e.gs = ODD_NP;
            e.has_sink = 1; e.sink = sinks[(l >> 1) * 24 + hq];
        }
    }
}

}

typedef __attribute__((address_space(4))) const Args* KArgs;
#define LAUNDER_S(p) asm volatile("" : "+s"(p))

__global__ void __launch_bounds__(NWAVES * 64, 2) fwd_kernel(Args args_unused) {
    extern __shared__ __attribute__((aligned(16))) unsigned char lds_raw[];
    LAS unsigned char* lds = (LAS unsigned char*)lds_raw;
    volatile LAS unsigned* MISC = (volatile LAS unsigned*)(lds + MISC_OFF);
    const int tid0 = threadIdx.x;
    const int G = gridDim.x; const int bx = blockIdx.x; const int vcu = (G % 8 == 0) ? (bx % 8) * (G / 8) + bx / 8 : bx;
    const KArgs ka0 = (KArgs)__builtin_amdgcn_kernarg_segment_ptr();
    for (int i = tid0; i < (LDS_BYTES - LDSCTL_OFF) / 4; i += NWAVES * 64) ((LAS unsigned*)(lds + LDSCTL_OFF))[i] = 0u;
    __syncthreads();
    XcdBarrier bar; { unsigned char* ws0 = ka0->ws; bar.bar = (unsigned*)(ws0 + WS_CTL) + CW_BAR; bar.x = 0; bar.st = nullptr;
        if (!MK_PER_PHASE) bar = xcd_barrier_post((unsigned*)(ws0 + WS_CTL) + CW_BAR, MISC + 8); }
    const int ph_lo = ka0->ph_lo, ph_hi = ka0->ph_hi;

    for (int ph = ph_lo; ph < ph_hi; ++ph) {
        int tid = tid0; asm volatile("" : "+v"(tid));
        const int lane = tid & 63, wave = __builtin_amdgcn_readfirstlane(tid >> 6);
        KArgs ka = ka0; LAUNDER_S(ka);
        unsigned char* ws = ka->ws;
        if (ph == 0 && (AN_MASK & 1)) {
            LAS float* scr = (LAS float*)(lds + wave * 16384);
            const int gw = vcu * NWAVES + wave, NGW = G * NWAVES;
            constexpr int I_E = 32 * (EVEN_N / 32), I_O = 32 * (ODD_N / 32), I_W = 32 * (DM / 32), I_M = 32 * (1024 / 32);
            constexpr int NITEMS = 2 * I_E + 2 * I_O + 4 * I_W + 4 * I_M;
            for (int it = gw; it < NITEMS; it += NGW) {
                int r = it;
                if (r < 2 * I_E) { const int i = r / I_E; r -= i * I_E; transpose_item(ka->even_w_in + (size_t)i * DM * EVEN_N, EVEN_N, ka->even_norm + i * DM, (bf16_t*)(ws + (i ? WS_WIN_E1 : WS_WIN_E0)), 1, 0, scr, r, lane); continue; } r -= 2 * I_E;
                if (r < 2 * I_O) { const int i = r / I_O; r -= i * I_O; transpose_item(ka->odd_w_in + (size_t)i * DM * ODD_N, ODD_N, ka->odd_norm + i * DM, (bf16_t*)(ws + (i ? WS_WIN_O1 : WS_WIN_O0)), 2, 0, scr, r, lane); continue; } r -= 2 * I_O;
                if (r < 4 * I_W) { const int l = r / I_W; r -= l * I_W; const float* W = ((l & 1) ? ka->odd_w_out : ka->even_w_out) + (size_t)(l >> 1) * DM * DM;
                    transpose_item(W, DM, nullptr, (bf16_t*)(ws + WS_WOUT + (size_t)l * 8 * MiB), 0, 0, scr, r, lane); continue; } r -= 4 * I_W;
                { const int l = r / I_M; r -= l * I_M; const float* W = ((l & 1) ? ka->odd_w_mkv : ka->even_w_mkv) + (size_t)(l >> 1) * DM * 1024;
                    transpose_item(W, 1024, nullptr, (bf16_t*)(ws + WS_WMKV), 0, l * 1024, scr, r, lane); }
            }
            bf16_t* XB = (bf16_t*)(ws + WS_XB); bf16_t* MEMN = (bf16_t*)(ws + WS_MEMN); float* SSQ = (float*)(ws + WS_CTL) + CW_SSQ;
            const float* xin = ka->x; const float* memin = ka->mem; const float* mnorm = ka->mem_norm;
            for (int m = gw; m < NTOK + NMEM; m += NGW) {
                const bool isx = m < NTOK; const int row = isx ? m : m - NTOK;
                const f32x4* xr = (const f32x4*)((isx ? xin : memin) + (size_t)row * DM) + lane;
                f32x4 v[8]; float s = 0.f;
#pragma unroll
                for (int j = 0; j < 8; ++j) { v[j] = xr[64 * j]; s += (v[j].x * v[j].x + v[j].y * v[j].y) + (v[j].z * v[j].z + v[j].w * v[j].w); }
                s = wave_sum(s);
                unsigned long long* o8 = (unsigned long long*)((isx ? XB : MEMN) + (size_t)row * DM) + lane;
                if (isx) {
                    if (lane == 0) SSQ[row] = s;
#pragma unroll
                    for (int j = 0; j < 8; ++j) o8[64 * j] = (unsigned long long)pk2(v[j].x, v[j].y) | ((unsigned long long)pk2(v[j].z, v[j].w) << 32);
                } else {
                    const float rs = 1.0f / sqrtf(s * (1.0f / DM) + EPS);
                    const f32x4* gr = (const f32x4*)mnorm + lane;
#pragma unroll
                    for (int j = 0; j < 8; ++j) { const f32x4 g = gr[64 * j]; o8[64 * j] = (unsigned long long)pk2(v[j].x * rs * g.x, v[j].y * rs * g.y) | ((unsigned long long)pk2(v[j].z * rs * g.z, v[j].w * rs * g.w) << 32); }
                }
            }
            float* CS128 = (float*)(ws + WS_CS128); float* CS64 = (float*)(ws + WS_CS64); const int* posp = ka->pos;
            for (int tk = gw; tk < NTOK; tk += NGW) {
                const float pf = (float)posp[tk];
                { const float inv = expf((float)lane * (float)(-2.0 * 9.210340371976184 / 128.0)); const float ang = pf * inv;
                  const double rev = (double)ang * 0.15915494309189535; const float fr = (float)(rev - rint(rev));
                  CS128[(size_t)tk * 128 + lane] = __builtin_amdgcn_cosf(fr); CS128[(size_t)tk * 128 + 64 + lane] = __builtin_amdgcn_sinf(fr); }
                if (lane < 32) { const float inv = expf((float)lane * (float)(-2.0 * 9.210340371976184 / 64.0)); const float ang = pf * inv;
                  const double rev = (double)ang * 0.15915494309189535; const float fr = (float)(rev - rint(rev));
                  CS64[(size_t)tk * 64 + lane] = __builtin_amdgcn_cosf(fr); CS64[(size_t)tk * 64 + 32 + lane] = __builtin_amdgcn_sinf(fr); }
            }
        } else if (ph == 17 && (AN_MASK & 2)) {
            const int gw = vcu * NWAVES + wave, NGW = G * NWAVES;
            const float* ssq = (const float*)(ws + WS_CTL) + CW_SSQ + 4 * NTOK; float* outp = ka->out; const float* fnorm = ka->final_norm;
            for (int m = gw; m < NTOK; m += NGW) {
                const float rs = 1.0f / sqrtf(ssq[m] * (1.0f / DM) + EPS);
                f32x4* xr = (f32x4*)(outp + (size_t)m * DM) + lane; const f32x4* gr = (const f32x4*)fnorm + lane;
#pragma unroll
                for (int j = 0; j < 8; ++j) { f32x4 v = xr[64 * j]; const f32x4 g = gr[64 * j]; v = v * rs * g; xr[64 * j] = v; }
            }
        } else if (ph >= 1 && ph <= 16) {
            const int l = (ph - 1) >> 2, sub = (ph - 1) & 3, odd = l & 1, li = l >> 1;
            if ((sub == 0 && (AN_MASK & 4)) || (sub == 3 && (AN_MASK & 8))) {
                GemmP P; P.ws = ws; P.l = l; P.xin = ka->x; P.out = ka->out;
                Order S; S.G = G; S.c = bx; S.nM0 = NTOK / 256;
                if (sub == 0) { P.mode = EM_INPROJ; P.A = (const bf16_t*)(ws + WS_XB); P.Bt = (const bf16_t*)(ws + (odd ? (li ? WS_WIN_O1 : WS_WIN_O0) : (li ? WS_WIN_E1 : WS_WIN_E0)));
                    S.nN0 = (odd ? ODD_NP : EVEN_N) / 256; S.nwg1 = (l == 0) ? 64 : 0; }
                else { P.mode = EM_OUTPROJ; P.A = (const bf16_t*)(ws + WS_Y); P.Bt = (const bf16_t*)(ws + WS_WOUT + (size_t)l * 8 * MiB); S.nN0 = DM / 256; S.nwg1 = 0; }
                S.nwg0 = S.nM0 * S.nN0;
                gemm_phase(lds, P, S, tid);
            } else if (sub == 2 && (AN_MASK & 16)) {
                if (!odd) {
                    const float* LSE = (const float*)(ws + WS_LSE); const bf16_t* OG = (const bf16_t*)(ws + WS_OG); const bf16_t* QKV = (const bf16_t*)(ws + WS_QKV); bf16_t* Y = (bf16_t*)(ws + WS_Y);
                    const long NIT = (long)NTOK * 96;
                    for (long it = (long)bx * 512 + tid; it < NIT; it += (long)G * 512) {
                        const int tok = (int)(it / 96), c = (int)(it % 96), h = c >> 4;
                        const float l0 = LSE[(size_t)tok * 6 + h], l1 = LSE[(size_t)NTOK * 6 + (size_t)tok * 6 + h], l2 = LSE[(size_t)2 * NTOK * 6 + (size_t)tok * 6 + h];
                        const float mx = fmaxf(l0, fmaxf(l1, l2));
                        float w0 = __expf(l0 - mx), w1 = __expf(l1 - mx), w2 = __expf(l2 - mx); const float inv = 1.0f / (w0 + w1 + w2); w0 *= inv; w1 *= inv; w2 *= inv;
                        const u32x4 a = *(const u32x4*)(OG + (size_t)tok * 768 + c * 8), b = *(const u32x4*)(OG + (size_t)NTOK * 768 + (size_t)tok * 768 + c * 8), cc = *(const u32x4*)(OG + (size_t)2 * NTOK * 768 + (size_t)tok * 768 + c * 8);
                        const u32x4 g = *(const u32x4*)(QKV + (size_t)tok * EVEN_N + 5120 + c * 8);
                        u32x4 o;
#define CMB(f) cvt_pk_bf16((w0 * bflo(a.f) + w1 * bflo(b.f) + w2 * bflo(cc.f)) * bflo(g.f), (w0 * bfhi(a.f) + w1 * bfhi(b.f) + w2 * bfhi(cc.f)) * bfhi(g.f))
                        o.x = CMB(x); o.y = CMB(y); o.z = CMB(z); o.w = CMB(w);
#undef CMB
                        *(u32x4*)(Y + (size_t)tok * DM + c * 8) = o;
                    }
                }
            } else if (sub == 1 && (AN_MASK & 32)) {
                gu32* qctr = (gu32*)(ws + WS_CTL) + CW_Q + 64 * l;
                constexpr int NUNITS = 896;
                int it = 0;
                if (tid == 0) MISC[16] = __hip_atomic_fetch_add(qctr, 1u, RLX_AGENT);
                __syncthreads();
                int idx = (int)MISC[16];
                while (idx < NUNITS) {
                    if (tid == 0) MISC[16 + ((it + 1) & 1)] = __hip_atomic_fetch_add(qctr, 1u, RLX_AGENT);
                    idx = __builtin_amdgcn_readfirstlane(idx);
                    AU u; const bool d64 = decode_main(idx, l, wave, u);
                    float m_reg, l_reg;
                    if (d64) { f32x16 o[2]; attn_main<64>(u, ws, lds, tid, wave, lane, m_reg, l_reg, o);
                        int idx2 = idx; LAUNDER_S(idx2); AE e; decode_epi(idx2, l, wave, ka->odd_sinks, e); attn_epi<64>(e, u.qrow_w, ws, lds, wave, lane, m_reg, l_reg, o); }
                    else { f32x16 o[4]; attn_main<128>(u, ws, lds, tid, wave, lane, m_reg, l_reg, o);
                        int idx2 = idx; LAUNDER_S(idx2); AE e; decode_epi(idx2, l, wave, ka->odd_sinks, e); attn_epi<128>(e, u.qrow_w, ws, lds, wave, lane, m_reg, l_reg, o); }
                    __syncthreads();
                    idx = (int)MISC[16 + ((it + 1) & 1)]; ++it;
                }
            }
        }
        if (ph + 1 < ph_hi) { if (!(ph >= 1 && ph <= 16 && ((ph - 1) & 3) == 2 && (((ph - 1) >> 2) & 1))) xcd_barrier(bar); }
    }
}

extern "C" void kernel_launch(void* const* d_in, const int* in_sizes, int n_in, void* d_out, int out_size, void* d_ws, size_t ws_size, hipStream_t stream) {
    static int grid = 0;
    if (grid == 0) {
        if (n_in != 14 || in_sizes[0] != NTOK * DM || out_size != NTOK * DM || ws_size < WS_END) { fprintf(stderr, "kernel_launch: unexpected shapes (n_in %d, in0 %d, out %d, ws %zu)\n", n_in, n_in > 0 ? in_sizes[0] : -1, out_size, ws_size); grid = -1; return; }
        int dev = 0, cus = 0, per_cu = 0;
        if (hipGetDevice(&dev) != hipSuccess || hipDeviceGetAttribute(&cus, hipDeviceAttributeMultiprocessorCount, dev) != hipSuccess) { grid = -1; return; }
        if (hipFuncSetAttribute((const void*)fwd_kernel, hipFuncAttributeMaxDynamicSharedMemorySize, LDS_BYTES) != hipSuccess) { fprintf(stderr, "kernel_launch: hipFuncSetAttribute failed\n"); grid = -1; return; }
        if (hipOccupancyMaxActiveBlocksPerMultiprocessor(&per_cu, (const void*)fwd_kernel, NWAVES * 64, LDS_BYTES) != hipSuccess || per_cu < 1) { fprintf(stderr, "kernel_launch: occupancy query says %d blocks/CU\n", per_cu); }
        (void)hipGetLastError();
        grid = cus;
    }
    if (grid < 0) return;
    (void)hipMemsetAsync((char*)d_ws + WS_CTL, 0, CTL_ZERO_BYTES, stream);
    Args a{};
    a.x = (const float*)d_in[0]; a.mem = (const float*)d_in[1]; a.pos = (const int*)d_in[2];
    a.even_norm = (const float*)d_in[3]; a.even_w_in = (const float*)d_in[4]; a.even_w_mkv = (const float*)d_in[5]; a.even_w_out = (const float*)d_in[6];
    a.odd_norm = (const float*)d_in[7]; a.odd_w_in = (const float*)d_in[8]; a.odd_w_mkv = (const float*)d_in[9]; a.odd_w_out = (const float*)d_in[10]; a.odd_sinks = (const float*)d_in[11];
    a.mem_norm = (const float*)d_in[12]; a.final_norm = (const float*)d_in[13];
    a.out = (float*)d_out; a.ws = (unsigned char*)d_ws;
#if MK_PER_PHASE
    for (int ph = 0; ph < N_PHASES; ++ph) { a.ph_lo = ph; a.ph_hi = ph + 1; hipLaunchKernelGGL(fwd_kernel, dim3(grid), dim3(NWAVES * 64), LDS_BYTES, stream, a); }
#else
    a.ph_lo = 0; a.ph_hi = N_PHASES;
    hipLaunchKernelGGL(fwd_kernel, dim3(grid), dim3(NWAVES * 64), LDS_BYTES, stream, a);
#endif
    const hipError_t le = hipPeekAtLastError();
    if (le != hipSuccess) fprintf(stderr, "kernel_launch: launch failed: %s\n", hipGetErrorName(le));
}
```

```cpp
#include <hip/hip_runtime.h>
#include <cstdio>
#include <cstdint>

#ifndef AN_MASK
#define AN_MASK 63
#endif
#ifndef MK_PER_PHASE
#define MK_PER_PHASE 0
#endif

namespace {
#define LAS __attribute__((address_space(3)))
#define GAS __attribute__((address_space(1)))
typedef unsigned short bf16_t;
typedef short bf16x8 __attribute__((ext_vector_type(8)));
typedef short s16x4 __attribute__((ext_vector_type(4)));
typedef float f32x4 __attribute__((ext_vector_type(4)));
typedef float f32x16 __attribute__((ext_vector_type(16)));
typedef unsigned u32x4 __attribute__((ext_vector_type(4)));
typedef GAS unsigned gu32;
#define RLX_AGENT __ATOMIC_RELAXED, __HIP_MEMORY_SCOPE_AGENT
#define LDS_WAIT() asm volatile("s_waitcnt lgkmcnt(0)" ::: "memory")
#define VM_WAIT() asm volatile("s_waitcnt vmcnt(0)" ::: "memory")
#define SBAR() __builtin_amdgcn_sched_barrier(0)

constexpr int BATCH = 4, SEQ = 2048, DM = 2048, NTOK = BATCH * SEQ, MEML = 256, NMEM = BATCH * MEML;
constexpr int EVEN_N = 7168, ODD_N = 4480, ODD_NP = 4608;
constexpr int KDIM = 2048;
constexpr float EPS = 1e-6f;
constexpr int NWAVES = 8;

constexpr size_t MiB = 1u << 20;
constexpr size_t WS_CTL = 0, CTL_ZERO_BYTES = 1 * MiB;
constexpr size_t WS_WIN_E0 = 1 * MiB, WS_WIN_E1 = 29 * MiB, WS_WIN_O0 = 57 * MiB, WS_WIN_O1 = 75 * MiB;
constexpr size_t WS_WOUT = 93 * MiB;
constexpr size_t WS_WMKV = 125 * MiB;
constexpr size_t WS_XB = 141 * MiB;
constexpr size_t WS_QKV = 173 * MiB;
constexpr size_t WS_Y = 285 * MiB;
constexpr size_t WS_OG = 317 * MiB;
constexpr size_t WS_LSE = 353 * MiB;
constexpr size_t WS_MKV = 354 * MiB;
constexpr size_t WS_MEMN = 362 * MiB;
constexpr size_t WS_CS128 = 366 * MiB;
constexpr size_t WS_CS64 = 370 * MiB;
constexpr size_t WS_SSQ = 372 * MiB;
constexpr size_t WS_END = 374 * MiB;
constexpr int CW_BAR = 4096;
constexpr int CW_SSQ = 16384;
constexpr int CW_KM = 65536;
constexpr int CW_Q = 131072;
static_assert((CW_Q + 64 * 8) * 4 <= (int)CTL_ZERO_BYTES, "ctl");

constexpr int RING_BYTES = 131072;
constexpr int LDSCTL_OFF = RING_BYTES, MISC_OFF = LDSCTL_OFF + 320;
constexpr int LDS_BYTES = 147456;
constexpr int XTBL_OFF = LDSCTL_OFF + 1024;

__device__ __forceinline__ unsigned f2bf(float f) { unsigned u = __builtin_bit_cast(unsigned, f); return (u + 0x7fffu + ((u >> 16) & 1u)) >> 16; }
__device__ __forceinline__ unsigned pk2(float lo, float hi) { return f2bf(lo) | (f2bf(hi) << 16); }
__device__ __forceinline__ unsigned cvt_pk_bf16(float lo, float hi) { unsigned r; asm volatile("v_cvt_pk_bf16_f32 %0, %1, %2" : "=v"(r) : "v"(lo), "v"(hi)); return r; }
__device__ __forceinline__ float bflo(unsigned w) { return __builtin_bit_cast(float, w << 16); }
__device__ __forceinline__ float bfhi(unsigned w) { return __builtin_bit_cast(float, w & 0xffff0000u); }

constexpr int BM = 256, BK = 64, HALF = 128, HTB = HALF * BK * 2, NXCD = 8, WGM = 8;
__device__ __forceinline__ int lds_byte(int r, int c) { const int st = (r >> 4) * 2 + (c >> 5), rr = r & 15, cc = c & 31, ob = rr * 64 + cc * 2; return st * 1024 + (ob ^ (((ob >> 9) & 1) << 5)); }
__device__ __forceinline__ void stage_rc(int b, int& R, int& C) { const int st = b / 1024, sb = b % 1024, swz = sb ^ (((sb >> 9) & 1) << 5); R = (st >> 1) * 16 + swz / 64; C = (st & 1) * 32 + (swz % 64) / 2; }
__device__ __forceinline__ int perm32(int rho) { const int n = rho >> 4, i = rho & 15; return 8 * (i >> 2) + 4 * n + (i & 3); }

struct Unit { int pm, pn, s; };
enum { EM_PLAIN = 0, EM_INPROJ = 1, EM_OUTPROJ = 2 };
struct GemmP { const bf16_t* A; const bf16_t* Bt; int mode, l; unsigned char* ws; const float* xin; float* out; LAS unsigned char* lds; };
__device__ __forceinline__ void tile_of(int wgid, int nM, int nN, int& pm, int& pn) {
    const int nwg = nM * nN; { const int q = nwg / NXCD, r = nwg % NXCD, xcd = wgid % NXCD, off = wgid / NXCD; wgid = (xcd < r ? xcd * (q + 1) : r * (q + 1) + (xcd - r) * q) + off; }
    const int nig = WGM * nN, gid = wgid / nig, fm = gid * WGM, gsz = (nM - fm) < WGM ? (nM - fm) : WGM;
    pm = fm + ((wgid % nig) % gsz); pn = (wgid % nig) / gsz;
}
struct Order {
    int nwg0, nwg1, nM0, nN0, G, c;
    __device__ __forceinline__ bool next(int i, Unit& u) const {
        const int L = i * G + c; if (L >= nwg0 + nwg1) return false;
        if (L < nwg0) { u.s = 0; tile_of(L, nM0, nN0, u.pm, u.pn); } else { u.s = 1; tile_of(L - nwg0, 4, 16, u.pm, u.pn); }
        return true;
    }
};

__device__ __forceinline__ void epi_run(const GemmP& P, const f32x4 (&acc)[2][2][4][2], const Unit& u, int wr, int wc, int fr, int fq) {
    const int row0 = u.pm * BM + wr * 64 + fr;
    const int colt = u.pn * BM + wc * 32 + 8 * fq;
    const int mode = u.s ? EM_PLAIN : P.mode;
    unsigned char* ws = P.ws;
    if (mode == EM_PLAIN) {
        bf16_t* O = (bf16_t*)(ws + WS_MKV);
#pragma unroll
        for (int ai = 0; ai < 2; ++ai)
#pragma unroll
            for (int m = 0; m < 4; ++m) { bf16_t* rowp = O + (size_t)(row0 + ai * HALF + m * 16) * 4096 + colt;
#pragma unroll
                for (int bj = 0; bj < 2; ++bj) { const f32x4 v0 = acc[ai][bj][m][0], v1 = acc[ai][bj][m][1];
                    u32x4 w; w.x = cvt_pk_bf16(v0[0], v0[1]); w.y = cvt_pk_bf16(v0[2], v0[3]); w.z = cvt_pk_bf16(v1[0], v1[1]); w.w = cvt_pk_bf16(v1[2], v1[3]);
                    *(u32x4*)(rowp + bj * HALF) = w; } }
    } else if (mode == EM_INPROJ) {
        const int l = P.l, odd = l & 1, ldo = odd ? ODD_NP : EVEN_N;
        bf16_t* O = (bf16_t*)(ws + WS_QKV);
        const float* ssq = (const float*)(ws + WS_SSQ) + (size_t)l * 8 * NTOK;
        const float* cs128 = (const float*)(ws + WS_CS128); const float* cs64 = (const float*)(ws + WS_CS64);
        float* km = (float*)(ws + WS_CTL) + CW_KM + (size_t)(l >> 1) * (4 * 6 * 8 * 128);
        int kind; bool kmean = false;
        if (odd) { kind = (u.pn <= 6) ? 2 : (u.pn <= 9 ? 0 : 3); }
        else { kind = (u.pn < 6) ? 1 : (u.pn < 9 ? 0 : (u.pn < 15 ? 1 : (u.pn < 20 ? 0 : 3))); kmean = (u.pn >= 12 && u.pn < 15); }
        float ks[2][8];
#pragma unroll
        for (int bj = 0; bj < 2; ++bj)
#pragma unroll
            for (int e = 0; e < 8; ++e) ks[bj][e] = 0.f;
#pragma unroll
        for (int ai = 0; ai < 2; ++ai)
#pragma unroll
            for (int m = 0; m < 4; ++m) {
                const int row = row0 + ai * HALF + m * 16;
                float sq = 0.f;
#pragma unroll
                for (int j = 0; j < 8; ++j) sq += ssq[(size_t)j * NTOK + row];
                const float rs = __builtin_amdgcn_rsqf(sq * (1.0f / DM) + EPS);
                f32x4 cs = {1.f, 1.f, 1.f, 1.f}, sn = {0.f, 0.f, 0.f, 0.f};
                if (kind == 1) { const float* t = cs128 + (size_t)row * 128 + (16 * wc + 4 * fq); cs = *(const f32x4*)t; sn = *(const f32x4*)(t + 64); }
                else if (kind == 2) { const float* t = cs64 + (size_t)row * 64 + (16 * (wc & 1) + 4 * fq); cs = *(const f32x4*)t; sn = *(const f32x4*)(t + 32); }
                bf16_t* rowp = O + (size_t)row * ldo + colt;
#pragma unroll
                for (int bj = 0; bj < 2; ++bj) {
                    f32x4 v0 = acc[ai][bj][m][0] * rs, v1 = acc[ai][bj][m][1] * rs;
                    if (kind == 1 || kind == 2) { const f32x4 o0 = v0 * cs - v1 * sn, o1 = v1 * cs + v0 * sn; v0 = o0; v1 = o1; }
                    else if (kind == 3) {
#pragma unroll
                        for (int j = 0; j < 4; ++j) { v0[j] = v0[j] * __builtin_amdgcn_rcpf(1.0f + __builtin_amdgcn_exp2f(-1.4426950408889634f * v0[j]));
                                                      v1[j] = v1[j] * __builtin_amdgcn_rcpf(1.0f + __builtin_amdgcn_exp2f(-1.4426950408889634f * v1[j])); }
                    }
                    if (kmean) {
#pragma unroll
                        for (int j = 0; j < 4; ++j) { ks[bj][j] += v0[j]; ks[bj][4 + j] += v1[j]; }
                    }
                    u32x4 w; w.x = cvt_pk_bf16(v0[0], v0[1]); w.y = cvt_pk_bf16(v0[2], v0[3]); w.z = cvt_pk_bf16(v1[0], v1[1]); w.w = cvt_pk_bf16(v1[2], v1[3]);
                    *(u32x4*)(rowp + bj * HALF) = w;
                }
            }
        if (kmean) {
#pragma unroll
            for (int bj = 0; bj < 2; ++bj)
#pragma unroll
                for (int e = 0; e < 8; ++e) { float s = ks[bj][e]; s += __shfl_xor(s, 1); s += __shfl_xor(s, 2); s += __shfl_xor(s, 4); s += __shfl_xor(s, 8); ks[bj][e] = s; }
            if (fr == 0) {
                const int b = u.pm >> 3, n = u.pm & 7;
#pragma unroll
                for (int bj = 0; bj < 2; ++bj) { const int h = (u.pn - 12) * 2 + bj; float* dst = km + ((size_t)((b * 6 + h) * 8 + n)) * 128 + wc * 32 + 8 * fq;
#pragma unroll
                    for (int e = 0; e < 8; ++e) atomicAdd(dst + e, ks[bj][e]); }
            }
        }
    } else {
        const int l = P.l;
        const float* xres = (l == 0) ? P.xin : (const float*)P.out; float* xout = P.out;
        bf16_t* xb = (bf16_t*)(ws + WS_XB); const bool wxb = (l != 3);
        float* ssq_out = (float*)(ws + WS_SSQ) + (size_t)(l + 1) * 8 * NTOK + (size_t)u.pn * NTOK + u.pm * BM;
        LAS float* xt = (LAS float*)(P.lds + XTBL_OFF);
#pragma unroll
        for (int ai = 0; ai < 2; ++ai)
#pragma unroll
            for (int m = 0; m < 4; ++m) {
                const int row = row0 + ai * HALF + m * 16; float ss = 0.f;
#pragma unroll
                for (int bj = 0; bj < 2; ++bj) {
                    const size_t off = (size_t)row * DM + colt + bj * HALF;
                    const f32x4 a = *(const f32x4*)(xres + off), b = *(const f32x4*)(xres + off + 4);
                    const f32x4 v0 = acc[ai][bj][m][0] + a, v1 = acc[ai][bj][m][1] + b;
                    *(f32x4*)(xout + off) = v0; *(f32x4*)(xout + off + 4) = v1;
                    if (wxb) { u32x4 w; w.x = cvt_pk_bf16(v0[0], v0[1]); w.y = cvt_pk_bf16(v0[2], v0[3]); w.z = cvt_pk_bf16(v1[0], v1[1]); w.w = cvt_pk_bf16(v1[2], v1[3]); *(u32x4*)(xb + off) = w; }
                    ss += (v0[0] * v0[0] + v0[1] * v0[1]) + (v0[2] * v0[2] + v0[3] * v0[3]) + (v1[0] * v1[0] + v1[1] * v1[1]) + (v1[2] * v1[2] + v1[3] * v1[3]);
                }
                ss += __shfl_xor(ss, 16); ss += __shfl_xor(ss, 32);
                if (fq == 0) xt[(ai * HALF + wr * 64 + m * 16 + fr) * 4 + wc] = ss;
            }
        LDS_WAIT(); __builtin_amdgcn_s_barrier(); asm volatile("" ::: "memory");
        { const int lane = fq * 16 + fr, wid = wr * 4 + wc, r = wid * 32 + (lane & 31);
          if (lane < 32) { const f32x4 t = *(const LAS f32x4*)(xt + r * 4); ssq_out[r] = (t[0] + t[1]) + (t[2] + t[3]); } }
    }
}

__device__ __forceinline__ void gemm_phase(LAS unsigned char* lds, const GemmP& P, const Order& S, const int tid) {
    const int wid = __builtin_amdgcn_readfirstlane(tid >> 6), lane = tid & 63, wr = wid >> 2, wc = wid & 3, fr = lane & 15, fq = lane >> 4;
    constexpr int K = KDIM, nt = K / BK;
    unsigned voffA[2], voffB[2];
#pragma unroll
    for (int i = 0; i < 2; ++i) { int R, C; stage_rc(tid * 16 + i * 8192, R, C); const int Rb = (R & ~31) + perm32(R & 31);
        voffA[i] = (unsigned)(R * K + C) * 2u; voffB[i] = (unsigned)(Rb * K + C) * 2u; }
    constexpr size_t kstep = (size_t)(BK * 2);
    constexpr size_t hstep = (size_t)HALF * K * 2;
    constexpr size_t tstep = 2 * hstep;
    const unsigned ldsw = (unsigned)wid * 1024u;
    const int aoff = lds_byte(wr * 64 + fr, fq * 8), boff = lds_byte(wc * 32 + fr, fq * 8);
#define PG8_SA(b, h) (((b) * 2 + (h)) * HTB)
#define PG8_SB(b, h) ((4 + (b) * 2 + (h)) * HTB)
#define PG8_STAGE(bufoff, gbase, voff) do { _Pragma("unroll") for (int _i = 0; _i < 2; ++_i) \
        __builtin_amdgcn_global_load_lds((const unsigned*)((const char*)(gbase) + (voff)[_i]), (LAS unsigned*)(lds + (bufoff) + ldsw + _i * 8192), 16, 0, 0); } while (0)
#define PG8_LDA(dst, b, h) do { _Pragma("unroll") for (int m = 0; m < 4; ++m) _Pragma("unroll") for (int k = 0; k < 2; ++k) dst[m][k] = *(const LAS bf16x8*)(lds + PG8_SA(b, h) + aoff + m * 2048 + k * 1024); } while (0)
#define PG8_LDB(dst, b, h) do { _Pragma("unroll") for (int n = 0; n < 2; ++n) _Pragma("unroll") for (int k = 0; k < 2; ++k) dst[n][k] = *(const LAS bf16x8*)(lds + PG8_SB(b, h) + boff + n * 2048 + k * 1024); } while (0)
#define PG8_MMA(ai, bj, At, Bt) do { __builtin_amdgcn_s_setprio(1); _Pragma("unroll") for (int m = 0; m < 4; ++m) _Pragma("unroll") for (int n = 0; n < 2; ++n) _Pragma("unroll") for (int k = 0; k < 2; ++k) \
        acc[ai][bj][m][n] = __builtin_amdgcn_mfma_f32_16x16x32_bf16(Bt[n][k], At[m][k], acc[ai][bj][m][n], 0, 0, 0); __builtin_amdgcn_s_setprio(0); } while (0)
#define PG8_WAIT_V(n) asm volatile("s_waitcnt vmcnt(" #n ")" ::: "memory")
#define PG8_WAIT_L(n) asm volatile("s_waitcnt lgkmcnt(" #n ")" ::: "memory")
#define PG8_BAR __builtin_amdgcn_s_barrier()
#define PG8_SCHED __builtin_amdgcn_sched_barrier(0)
    Unit cur, nxt; int ui = 0;
    if (!S.next(0, cur)) return;
    f32x4 acc[2][2][4][2];
#pragma unroll
    for (int a = 0; a < 2; ++a)
#pragma unroll
        for (int b = 0; b < 2; ++b)
#pragma unroll
            for (int m = 0; m < 4; ++m)
#pragma unroll
                for (int n = 0; n < 2; ++n) acc[a][b][m][n] = (f32x4){0.f, 0.f, 0.f, 0.f};
    bf16x8 At[4][2], B0[2][2], B1[2][2];
    const char* cA = (cur.s ? (const char*)(P.ws + WS_MEMN) : (const char*)P.A) + (size_t)cur.pm * tstep; const char* cB = (cur.s ? (const char*)(P.ws + WS_WMKV) : (const char*)P.Bt) + (size_t)cur.pn * tstep;
    PG8_STAGE(PG8_SB(0, 0), cB, voffB); PG8_STAGE(PG8_SB(0, 1), cB + hstep, voffB); PG8_STAGE(PG8_SA(0, 0), cA, voffA); PG8_STAGE(PG8_SA(0, 1), cA + hstep, voffA);
    if (wr == 1) PG8_BAR;
    PG8_WAIT_V(2); PG8_BAR;
    PG8_STAGE(PG8_SB(1, 0), cB + kstep, voffB); PG8_STAGE(PG8_SA(1, 0), cA + kstep, voffA); PG8_STAGE(PG8_SB(1, 1), cB + hstep + kstep, voffB);
    PG8_WAIT_V(6); PG8_BAR;
    for (;;) {
        const bool has_next = S.next(ui + 1, nxt);
        const char* nA = has_next ? (nxt.s ? (const char*)(P.ws + WS_MEMN) : (const char*)P.A) + (size_t)nxt.pm * tstep : cA; const char* nB = has_next ? (nxt.s ? (const char*)(P.ws + WS_WMKV) : (const char*)P.Bt) + (size_t)nxt.pn * tstep : cB;
        for (int t = 0; t < nt; t += 2) {
            const bool last = (t == nt - 2);
            const char* a1 = cA + (size_t)(t + 1) * kstep;
            const char* a2 = last ? nA : cA + (size_t)(t + 2) * kstep; const char* b2 = last ? nB : cB + (size_t)(t + 2) * kstep;
            const char* a3 = a2 + kstep; const char* b3 = b2 + kstep;
            PG8_LDB(B0, 0, 0); PG8_LDB(B1, 0, 1); PG8_SCHED; PG8_LDA(At, 0, 0); PG8_STAGE(PG8_SA(1, 1), a1 + hstep, voffA);
            PG8_WAIT_V(8); PG8_WAIT_L(0); PG8_BAR; PG8_MMA(0, 0, At, B0); PG8_MMA(0, 1, At, B1); PG8_BAR; PG8_SCHED;
            PG8_LDA(At, 0, 1); PG8_STAGE(PG8_SB(0, 0), b2, voffB); PG8_STAGE(PG8_SB(0, 1), b2 + hstep, voffB); PG8_STAGE(PG8_SA(0, 0), a2, voffA);
            PG8_WAIT_V(8); PG8_WAIT_L(0); PG8_BAR; PG8_MMA(1, 0, At, B0); PG8_MMA(1, 1, At, B1); PG8_BAR; PG8_SCHED;
            PG8_LDB(B0, 1, 0); PG8_LDB(B1, 1, 1); PG8_SCHED; PG8_LDA(At, 1, 0); PG8_STAGE(PG8_SA(0, 1), a2 + hstep, voffA);
            PG8_WAIT_V(8); PG8_WAIT_L(0); PG8_BAR; PG8_MMA(0, 0, At, B0); PG8_MMA(0, 1, At, B1); PG8_BAR; PG8_SCHED;
            PG8_LDA(At, 1, 1); PG8_STAGE(PG8_SB(1, 0), b3, voffB); PG8_STAGE(PG8_SB(1, 1), b3 + hstep, voffB); PG8_STAGE(PG8_SA(1, 0), a3, voffA);
            PG8_WAIT_V(8); PG8_WAIT_L(0); PG8_BAR; PG8_MMA(1, 0, At, B0); PG8_MMA(1, 1, At, B1); PG8_BAR; PG8_SCHED;
        }
        if (wr == 0) PG8_BAR;
        epi_run(P, acc, cur, wr, wc, fr, fq);
        if (!has_next) break;
#pragma unroll
        for (int a = 0; a < 2; ++a)
#pragma unroll
            for (int b = 0; b < 2; ++b)
#pragma unroll
                for (int m = 0; m < 4; ++m)
#pragma unroll
                    for (int n = 0; n < 2; ++n) acc[a][b][m][n] = (f32x4){0.f, 0.f, 0.f, 0.f};
        cur = nxt; cA = nA; cB = nB; ++ui;
        if (wr == 1) PG8_BAR;
    }
    PG8_WAIT_V(0);
    PG8_BAR;
#undef PG8_SA
#undef PG8_SB
#undef PG8_STAGE
#undef PG8_LDA
#undef PG8_LDB
#undef PG8_MMA
#undef PG8_WAIT_V
#undef PG8_WAIT_L
#undef PG8_BAR
#undef PG8_SCHED
}

struct AU {
    int qoff, qs;
    int kvsel;
    int koff, voff, kd1, ks;
    int L, qrow_w, kt0, nsteps, kstep, koff1;
    int band, causal, pair, whalf, moba_n;
    int kmoff;
};
struct AE {
    int epi;
    int ooff, os, goff, gs, lseoff, lses, has_sink;
    float sink;
};
__device__ __forceinline__ int crow(int r, int hi) { return (r & 3) + 8 * (r >> 2) + 4 * hi; }
template <int OFF> __device__ __forceinline__ s16x4 tr_read(int vb) { s16x4 r; asm volatile("ds_read_b64_tr_b16 %0, %1 offset:%2" : "=&v"(r) : "v"(vb), "i"(OFF) : "memory"); return r; }
template <int D> __device__ __forceinline__ int kswz(int row, int colB) { if constexpr (D == 128) return row * 256 + (colB ^ ((row & 7) << 4)); else return row * 128 + (colB ^ (((row >> 1) & 7) << 4)); }
template <int D> __device__ __forceinline__ int v_st(int k, int c) { const int kk = (k & ~0xC) | ((k & 4) << 1) | ((k & 8) >> 1); return ((kk >> 3) * (D / 32) + (c >> 5)) * 512 + ((kk & 7) * 32 + (c & 31)) * 2; }
__device__ __forceinline__ int v_rd_base(int lane) { return ((lane & 3) << 3) | (((lane >> 2) & 3) << 6) | (((lane >> 4) & 1) << 5) | (((lane >> 5) & 1) << 8); }
template <int D> constexpr int v_rd_off(int d0, int ks, int half) { return d0 * 512 + (ks * 2 + half) * (D / 32) * 512; }

template <int D, int D0, int HF> __device__ __forceinline__ void pv_half(f32x16& od, int vb, bf16x8 pa, bf16x8 pb) {
    const s16x4 l0 = tr_read<v_rd_off<D>(D0, 2 * HF, 0)>(vb), h0 = tr_read<v_rd_off<D>(D0, 2 * HF, 1)>(vb), l1 = tr_read<v_rd_off<D>(D0, 2 * HF + 1, 0)>(vb), h1 = tr_read<v_rd_off<D>(D0, 2 * HF + 1, 1)>(vb);
    asm volatile("s_waitcnt lgkmcnt(0)" ::: "memory"); SBAR();
#define PKV(Lx, Hx) (bf16x8){Lx[0], Lx[1], Lx[2], Lx[3], Hx[0], Hx[1], Hx[2], Hx[3]}
    od = __builtin_amdgcn_mfma_f32_32x32x16_bf16(pa, PKV(l0, h0), od, 0, 0, 0);
    od = __builtin_amdgcn_mfma_f32_32x32x16_bf16(pb, PKV(l1, h1), od, 0, 0, 0);
#undef PKV
}
template <int D, int HF> __device__ __forceinline__ void pv_all(f32x16* o, int vb, bf16x8 pa, bf16x8 pb) {
    pv_half<D, 0, HF>(o[0], vb, pa, pb); pv_half<D, 1, HF>(o[1], vb, pa, pb);
    if constexpr (D == 128) { pv_half<D, 2, HF>(o[2], vb, pa, pb); pv_half<D, 3, HF>(o[3], vb, pa, pb); }
}

template <int D>
__device__ __forceinline__ void attn_main(const AU& u, unsigned char* ws, LAS unsigned char* lds, int tid, int wid, int lane, float& m_out, float& l_out, f32x16 (&o)[D / 32]) {
    constexpr int NQ = D / 16, NB = D / 32, KTB = 64 * D * 2;
    constexpr float SCALE = (D == 128) ? 0.088388347648318440f : 0.125f;
    constexpr float C = SCALE * 1.4426950408889634f;
    constexpr float THRS = 8.0f / SCALE;
    const int r32 = lane & 31, hi = lane >> 5;
    LAS unsigned char* Kl = lds; LAS unsigned char* Vl = lds + 2 * KTB;
    LAS float* wsf = (LAS float*)(lds + 65536 + wid * 8192);
    const bf16_t* QKVp = (const bf16_t*)(ws + WS_QKV);
    const bf16_t* KVp = u.kvsel ? (const bf16_t*)(ws + WS_MKV) : QKVp;
    bf16x8 qr[NQ];
    { const bf16_t* qrow = QKVp + (size_t)u.qoff + (size_t)(u.qrow_w + r32) * u.qs + hi * 8;
#pragma unroll
      for (int d0 = 0; d0 < NQ; ++d0) qr[d0] = *(const bf16x8*)(qrow + d0 * 16); }
    float m_reg = -1e30f, l_reg = 0.f;
#pragma unroll
    for (int d = 0; d < NB; ++d)
#pragma unroll
        for (int r = 0; r < 16; ++r) o[d][r] = 0.f;
    const int qidx = u.qrow_w + r32;
    unsigned selmask = 0;
    if constexpr (D == 128) {
        if (u.moba_n > 0) {
            const int n = u.moba_n; float g[7];
#pragma unroll
            for (int j = 0; j < 7; ++j) {
                g[j] = -INFINITY;
                if (j < n) {
                    const float* kmj = (const float*)(ws + WS_CTL) + CW_KM + u.kmoff + j * 128 + hi * 8; float s = 0.f;
#pragma unroll
                    for (int d0 = 0; d0 < NQ; ++d0) { const f32x4 a = *(const f32x4*)(kmj + d0 * 16), b = *(const f32x4*)(kmj + d0 * 16 + 4);
                        const u32x4 qw = __builtin_bit_cast(u32x4, qr[d0]);
                        s += bflo(qw.x) * a[0] + bfhi(qw.x) * a[1] + bflo(qw.y) * a[2] + bfhi(qw.y) * a[3] + bflo(qw.z) * b[0] + bfhi(qw.z) * b[1] + bflo(qw.w) * b[2] + bfhi(qw.w) * b[3]; }
                    auto rr = __builtin_amdgcn_permlane32_swap(__float_as_uint(s), __float_as_uint(s), false, false);
                    g[j] = __uint_as_float(rr[0]) + __uint_as_float(rr[1]);
                }
            }
#pragma unroll
            for (int j = 0; j < 7; ++j) { int cnt = 0;
#pragma unroll
                for (int i = 0; i < 7; ++i) if (i != j) cnt += (i < n && (g[i] > g[j] || (g[i] == g[j] && i < j))) ? 1 : 0;
                if (j < n && cnt < 3) selmask |= (1u << j); }
        }
    }
    const int sr = (D == 128) ? (tid >> 4) : (tid >> 3), sc = (D == 128) ? (tid & 15) * 8 : (tid & 7) * 8;
    bf16x8 sk0, sv0, sk1, sv1;
    auto clampk = [&](int kk) { return kk < 0 ? 0 : (kk > u.L - 1 ? u.L - 1 : kk); };
#define SLOAD(kb) do { if constexpr (D == 128) { const size_t i0 = (size_t)clampk((kb) + sr) * u.ks + sc, i1 = (size_t)clampk((kb) + sr + u.koff1) * u.ks + u.kd1 + sc; \
        sk0 = *(const bf16x8*)(KVp + u.koff + i0); sv0 = *(const bf16x8*)(KVp + u.voff + i0); sk1 = *(const bf16x8*)(KVp + u.koff + i1); sv1 = *(const bf16x8*)(KVp + u.voff + i1); } \
        else { const size_t i0 = (size_t)clampk((kb) + sr) * u.ks + sc; sk0 = *(const bf16x8*)(KVp + u.koff + i0); sv0 = *(const bf16x8*)(KVp + u.voff + i0); } } while (0)
#define SWRITE(buf) do { if constexpr (D == 128) { *(LAS bf16x8*)(Kl + (buf) * KTB + kswz<D>(sr, sc * 2)) = sk0; *(LAS bf16x8*)(Kl + (buf) * KTB + kswz<D>(32 + sr, sc * 2)) = sk1; \
        *(LAS bf16x8*)(Vl + (buf) * KTB + v_st<D>(sr, sc)) = sv0; *(LAS bf16x8*)(Vl + (buf) * KTB + v_st<D>(32 + sr, sc)) = sv1; } \
        else { *(LAS bf16x8*)(Kl + (buf) * KTB + kswz<D>(sr, sc * 2)) = sk0; *(LAS bf16x8*)(Vl + (buf) * KTB + v_st<D>(sr, sc)) = sv0; } } while (0)
    SLOAD(u.kt0); SWRITE(0); __syncthreads();
    const int vrb = (int)(uintptr_t)Vl + v_rd_base(lane);
    for (int t = 0; t < u.nsteps; ++t) {
        const int buf = t & 1;
        if (t + 1 < u.nsteps) SLOAD(u.kt0 + (t + 1) * u.kstep);
        {
            const int kb0 = u.kt0 + t * u.kstep, kb1 = kb0 + u.koff1;
            int lo_q, hi_q;
            if (u.moba_n >= 0 && t < 4 * u.moba_n) { const bool sel = (selmask >> (t >> 2)) & 1u; lo_q = sel ? -(1 << 28) : (1 << 28); hi_q = sel ? (1 << 28) : -(1 << 28); }
            else { lo_q = qidx - u.band; hi_q = u.causal ? qidx : (1 << 28); }
            bool any0 = __any(lo_q <= kb0 + 31 && hi_q >= kb0), any1 = __any(lo_q <= kb1 + 31 && hi_q >= kb1);
            if (u.pair) { any0 = any0 && (u.whalf == 0); any1 = any1 && (u.whalf == 1); }
            if (any0 || any1) {
                const bool all0 = __all(lo_q <= kb0 && hi_q >= kb0 + 31), all1 = __all(lo_q <= kb1 && hi_q >= kb1 + 31);
                f32x16 p0, p1;
#pragma unroll
                for (int r = 0; r < 16; ++r) { p0[r] = 0.f; p1[r] = 0.f; }
                LAS unsigned char* Kt = Kl + buf * KTB;
                if (any0) {
#pragma unroll
                    for (int d0 = 0; d0 < NQ; ++d0) { const bf16x8 b0 = *(const LAS bf16x8*)(Kt + kswz<D>(r32, (d0 * 16 + hi * 8) * 2)); p0 = __builtin_amdgcn_mfma_f32_32x32x16_bf16(b0, qr[d0], p0, 0, 0, 0); }
                    if (!all0) {
#pragma unroll
                        for (int r = 0; r < 16; ++r) { const int kk = kb0 + crow(r, hi); if (kk < lo_q || kk > hi_q) p0[r] = -INFINITY; }
                    }
                } else {
#pragma unroll
                    for (int r = 0; r < 16; ++r) p0[r] = -INFINITY;
                }
                if (any1) {
#pragma unroll
                    for (int d0 = 0; d0 < NQ; ++d0) { const bf16x8 b1 = *(const LAS bf16x8*)(Kt + kswz<D>(32 + r32, (d0 * 16 + hi * 8) * 2)); p1 = __builtin_amdgcn_mfma_f32_32x32x16_bf16(b1, qr[d0], p1, 0, 0, 0); }
                    if (!all1) {
#pragma unroll
                        for (int r = 0; r < 16; ++r) { const int kk = kb1 + crow(r, hi); if (kk < lo_q || kk > hi_q) p1[r] = -INFINITY; }
                    }
                } else {
#pragma unroll
                    for (int r = 0; r < 16; ++r) p1[r] = -INFINITY;
                }
                float pmax = p0[0];
#pragma unroll
                for (int r = 1; r < 16; ++r) pmax = fmaxf(pmax, p0[r]);
#pragma unroll
                for (int r = 0; r < 16; ++r) pmax = fmaxf(pmax, p1[r]);
                { auto rr = __builtin_amdgcn_permlane32_swap(__float_as_uint(pmax), __float_as_uint(pmax), false, false); pmax = fmaxf(__uint_as_float(rr[0]), __uint_as_float(rr[1])); }
                float alpha = 1.f;
                if (!__all(pmax - m_reg <= THRS)) { const float mn = fmaxf(m_reg, pmax); alpha = __builtin_amdgcn_exp2f((m_reg - mn) * C); m_reg = mn; }
                const float mnC = -m_reg * C;
                float ps = 0.f;
#pragma unroll
                for (int r = 0; r < 16; ++r) { p0[r] = __builtin_amdgcn_exp2f(fmaf(p0[r], C, mnC)); ps += p0[r]; }
#pragma unroll
                for (int r = 0; r < 16; ++r) { p1[r] = __builtin_amdgcn_exp2f(fmaf(p1[r], C, mnC)); ps += p1[r]; }
                { auto rr = __builtin_amdgcn_permlane32_swap(__float_as_uint(ps), __float_as_uint(ps), false, false); ps = __uint_as_float(rr[0]) + __uint_as_float(rr[1]); }
                l_reg = l_reg * alpha + ps;
                if (__any(alpha < 1.f)) {
                    if (hi == 0) wsf[r32] = alpha;
                    LDS_WAIT();
#pragma unroll
                    for (int d = 0; d < NB; ++d)
#pragma unroll
                        for (int r = 0; r < 16; ++r) o[d][r] *= wsf[crow(r, hi)];
                    LDS_WAIT();
                }
                bf16x8 pa0, pa1, pa2, pa3;
#define PK4(P, BASE, OUT) do { unsigned a0 = cvt_pk_bf16(P[BASE + 0], P[BASE + 1]), a1 = cvt_pk_bf16(P[BASE + 2], P[BASE + 3]);   \
    unsigned b0 = cvt_pk_bf16(P[BASE + 4], P[BASE + 5]), b1 = cvt_pk_bf16(P[BASE + 6], P[BASE + 7]);                              \
    auto r0 = __builtin_amdgcn_permlane32_swap(a0, b0, false, false); auto r1 = __builtin_amdgcn_permlane32_swap(a1, b1, false, false); \
    u32x4 w = {r0[0], r1[0], r0[1], r1[1]}; OUT = __builtin_bit_cast(bf16x8, w); } while (0)
                PK4(p0, 0, pa0); PK4(p0, 8, pa1); PK4(p1, 0, pa2); PK4(p1, 8, pa3);
#undef PK4
                const int vb = vrb + buf * KTB;
                SBAR();
                if (any0) pv_all<D, 0>(o, vb, pa0, pa1);
                if (any1) pv_all<D, 1>(o, vb, pa2, pa3);
            }
        }
        if (t + 1 < u.nsteps) SWRITE(buf ^ 1);
        __syncthreads();
    }
#undef SLOAD
#undef SWRITE
    m_out = m_reg; l_out = l_reg;
}

template <int D>
__device__ __forceinline__ void attn_epi(const AE& e, int qrow_w, unsigned char* ws, LAS unsigned char* lds, int wid, int lane, float m_reg, float l_reg, const f32x16 (&o)[D / 32]) {
    constexpr int NB = D / 32;
    constexpr float SCALE = (D == 128) ? 0.088388347648318440f : 0.125f;
    const int r32 = lane & 31, hi = lane >> 5;
    LAS float* wsf = (LAS float*)(lds + 65536 + wid * 8192);
    LAS bf16_t* stg = (LAS bf16_t*)(lds + 65536 + wid * 8192);
    float lt = l_reg;
    if (e.has_sink) lt += __builtin_amdgcn_exp2f((e.sink - m_reg * SCALE) * 1.4426950408889634f);
    if (hi == 0) wsf[r32] = lt;
    LDS_WAIT();
    float rli[16];
#pragma unroll
    for (int r = 0; r < 16; ++r) rli[r] = __builtin_amdgcn_rcpf(wsf[crow(r, hi)]);
    LDS_WAIT();
#pragma unroll
    for (int r = 0; r < 16; ++r) { const int orow = crow(r, hi);
#pragma unroll
        for (int d0 = 0; d0 < NB; ++d0) stg[orow * D + d0 * 32 + r32] = (bf16_t)f2bf(o[d0][r] * rli[r]); }
    LDS_WAIT();
    constexpr int CPR = D / 8, RPP = 64 / CPR;
    bf16_t* OB = (bf16_t*)(ws + (e.epi ? WS_Y : WS_OG));
    const bf16_t* GB = (const bf16_t*)(ws + WS_QKV);
#pragma unroll
    for (int i = 0; i < 32 / RPP; ++i) {
        const int row = i * RPP + lane / CPR, ch = lane % CPR;
        const u32x4 v = *(const LAS u32x4*)(stg + row * D + ch * 8);
        const size_t fidx = (size_t)(qrow_w + row);
        if (e.epi == 1) {
            const u32x4 g = *(const u32x4*)(GB + (size_t)e.goff + fidx * e.gs + ch * 8);
            u32x4 w;
            w.x = cvt_pk_bf16(bflo(v.x) * bflo(g.x), bfhi(v.x) * bfhi(g.x)); w.y = cvt_pk_bf16(bflo(v.y) * bflo(g.y), bfhi(v.y) * bfhi(g.y));
            w.z = cvt_pk_bf16(bflo(v.z) * bflo(g.z), bfhi(v.z) * bfhi(g.z)); w.w = cvt_pk_bf16(bflo(v.w) * bflo(g.w), bfhi(v.w) * bfhi(g.w));
            *(u32x4*)(OB + (size_t)e.ooff + fidx * e.os + ch * 8) = w;
        } else {
            *(u32x4*)(OB + (size_t)e.ooff + fidx * e.os + ch * 8) = v;
        }
    }
    if (e.epi == 0 && hi == 0) ((float*)(ws + WS_LSE))[(size_t)e.lseoff + (size_t)(qrow_w + r32) * e.lses] = m_reg * SCALE + __logf(l_reg);
    LDS_WAIT();
}

#define XB_TMO      128
#define XB_XCNT(j)  (256  + 64 * (j))
#define XB_XSUB(j)  (1280 + 64 * (j))
#define XB_XGEN(j)  (2304 + 64 * (j))
#define XB_TOP      3328
#define XB_TOPGEN   3392
#define XCD_BAR_WORDS 3456
#define XB_SPIN_CAP (1u << 18)
__device__ __forceinline__ unsigned xb_ld(unsigned* p)              { return __hip_atomic_load(p, __ATOMIC_RELAXED, __HIP_MEMORY_SCOPE_AGENT); }
__device__ __forceinline__ unsigned xb_add(unsigned* p, unsigned v) { return __hip_atomic_fetch_add(p, v, __ATOMIC_RELAXED, __HIP_MEMORY_SCOPE_AGENT); }
__device__ __forceinline__ unsigned xb_xcc_id() { return (unsigned)__builtin_amdgcn_s_getreg((3 << 11) | 20) & 0xFu; }
#define XB_SPIN(cond, bar) do { unsigned _sp = 0; while (cond) { __builtin_amdgcn_s_sleep(1); \
    if ((++_sp & 255u) == 0u) { if (xb_ld(&(bar)[XB_TMO])) break; if (_sp > XB_SPIN_CAP) { atomicAdd(&(bar)[XB_TMO], 1u); break; } } } } while (0)
struct XcdBarrier { unsigned* bar; unsigned x; volatile LAS unsigned* st; };
__device__ __forceinline__ XcdBarrier xcd_barrier_post(unsigned* bar, volatile LAS unsigned* st) {
    XcdBarrier b; b.bar = bar; b.x = xb_xcc_id(); b.st = st;
    if (threadIdx.x == 0) (void)xb_add(&bar[XB_XCNT(b.x)], 1u);
    return b;
}
__device__ __forceinline__ void xcd_barrier_complete(unsigned* bar, unsigned x, unsigned& nloc, unsigned& nx) {
    const unsigned G = gridDim.x * gridDim.y * gridDim.z;
    unsigned sum, cnt, mine, sp = 0u;
    for (;;) {
        sum = 0u; cnt = 0u; mine = 0u;
#pragma unroll
        for (unsigned j = 0; j < 16; ++j) { const unsigned c = xb_ld(&bar[XB_XCNT(j)]); sum += c; cnt += (c > 0u) ? 1u : 0u; mine = (j == x) ? c : mine; }
        if (sum == G) break;
        __builtin_amdgcn_s_sleep(1);
        if ((++sp & 255u) == 0u) { if (xb_ld(&bar[XB_TMO])) break; if (sp > XB_SPIN_CAP) { atomicAdd(&bar[XB_TMO], 1u); break; } }
    }
    nloc = mine > 0u ? mine : 1u; nx = cnt > 0u ? cnt : 1u;
}
__device__ __forceinline__ void xcd_barrier(const XcdBarrier& b) {
    asm volatile("s_waitcnt vmcnt(0)" ::: "memory");
    __syncthreads();
    if (threadIdx.x == 0) {
        unsigned* bar = b.bar;
        __builtin_amdgcn_s_waitcnt(0);
        unsigned nloc = b.st[0], nx = b.st[1];
        if (nloc == 0u) { xcd_barrier_complete(bar, b.x, nloc, nx); b.st[0] = nloc; b.st[1] = nx; }
        const unsigned old = xb_add(&bar[XB_XSUB(b.x)], 1u);
        const unsigned gen = old / nloc;
        if (old + 1u == (gen + 1u) * nloc) {
            __builtin_amdgcn_fence(__ATOMIC_RELEASE, "agent");
            asm volatile("s_waitcnt vmcnt(0)" ::: "memory");
            const unsigned og = xb_add(&bar[XB_TOP], 1u);
            const unsigned tg = og / nx;
            if (og + 1u == (tg + 1u) * nx) xb_add(&bar[XB_TOPGEN], 1u);
            else XB_SPIN(xb_ld(&bar[XB_TOPGEN]) == tg, bar);
            __builtin_amdgcn_fence(__ATOMIC_ACQUIRE, "agent");
            xb_add(&bar[XB_XGEN(b.x)], 1u);
            asm volatile("s_waitcnt vmcnt(0)" ::: "memory");
        } else {
            XB_SPIN(xb_ld(&bar[XB_XGEN(b.x)]) == gen, bar);
            __builtin_amdgcn_fence(__ATOMIC_ACQUIRE, "agent");
            asm volatile("s_waitcnt vmcnt(0)" ::: "memory");
        }
    }
    __syncthreads();
}

__device__ __forceinline__ float wave_sum(float v) {
#pragma unroll
    for (int o = 1; o < 64; o <<= 1) v += __shfl_xor(v, o);
    return v;
}
__device__ __forceinline__ int phys_even(int n) {
    if (n >= 4608) return n;
    const int seg = n / 768; if (seg == 2 || seg == 5) return n;
    const int i = n & 127, hb = n - i, ii = i & 63, g = ii >> 2, e = (ii & 3) + ((i >> 6) << 2);
    return hb + 8 * g + e;
}
__device__ __forceinline__ int phys_odd(int n) {
    if (n < 1728) { const int i = n & 63, hb = n - i, ii = i & 31, g = ii >> 2, e = (ii & 3) + ((i >> 5) << 2); return hb + 8 * g + e; }
    if (n < 1920) return n + 64;
    return n + 128;
}
__device__ __forceinline__ void convert_item(const float* W, int N, const float* gk, bf16_t* WT, int mapkind, int rowoff, int item, int lane) {
    const int nblk = N / 64, kb = item / nblk, nb = item % nblk, k0 = 64 * kb, n = 64 * nb + lane;
    const int p = (mapkind == 1 ? phys_even(n) : (mapkind == 2 ? phys_odd(n) : n)) + rowoff;
    const float* src = W + (size_t)k0 * N + n;
    bf16_t* dst = WT + (size_t)p * KDIM + k0;
    float v[64];
#pragma unroll
    for (int j = 0; j < 64; ++j) v[j] = src[(size_t)j * N];
    if (gk) {
#pragma unroll
        for (int j = 0; j < 64; ++j) v[j] *= gk[k0 + j];
    }
#pragma unroll
    for (int kk = 0; kk < 8; ++kk) { u32x4 o; o.x = pk2(v[8 * kk], v[8 * kk + 1]); o.y = pk2(v[8 * kk + 2], v[8 * kk + 3]); o.z = pk2(v[8 * kk + 4], v[8 * kk + 5]); o.w = pk2(v[8 * kk + 6], v[8 * kk + 7]);
        *(u32x4*)(dst + 8 * kk) = o; }
}

struct Args {
    const float* x; const float* mem; const int* pos;
    const float* even_norm; const float* even_w_in; const float* even_w_mkv; const float* even_w_out;
    const float* odd_norm; const float* odd_w_in; const float* odd_w_mkv; const float* odd_w_out; const float* odd_sinks;
    const float* mem_norm; const float* final_norm;
    float* out; unsigned char* ws;
    int ph_lo, ph_hi;
};
constexpr int N_PHASES = 18;

__device__ __forceinline__ bool decode_main(int idx, int l, int wave, AU& u) {
    const int odd = l & 1;
    u.koff1 = 32; u.kstep = 64; u.moba_n = -1; u.band = 1 << 28; u.causal = 1; u.kvsel = 0; u.kd1 = 0; u.pair = 0; u.whalf = 0; u.kmoff = 0;
    if (!odd) {
        if (idx < 192) {
            const int n = 7 - idx / 24, bh = idx % 24, b = bh / 6, h = bh % 6; const int tb = b * SEQ * EVEN_N;
            u.qoff = tb + 2304 + h * 128; u.qs = EVEN_N; u.koff = tb + 3072 + h * 128; u.voff = tb + 3840 + h * 128; u.ks = EVEN_N;
            u.L = SEQ; u.qrow_w = 256 * n + 32 * wave; u.kt0 = 0; u.nsteps = 4 * (n + 1); u.moba_n = n;
            u.kmoff = (l >> 1) * (4 * 6 * 8 * 128) + ((b * 6 + h) * 8) * 128;
        } else if (idx < 576) {
            const int i = idx - 192, pat = i / 192, j = i % 192, bh = j % 24, rr = j / 24, b = bh / 6, h = bh % 6;
            const int dil = pat ? 4 : 1, res = pat ? (rr & 3) : 0, kblk = pat ? (rr >> 2) : rr;
            const int tb = (b * SEQ + res) * EVEN_N;
            u.qoff = tb + h * 128; u.qs = dil * EVEN_N; u.koff = tb + 768 + h * 128; u.voff = tb + 1536 + h * 128; u.ks = dil * EVEN_N;
            u.L = SEQ / dil; u.qrow_w = 256 * kblk + 32 * wave; u.kt0 = (256 * kblk - 128) < 0 ? 0 : (256 * kblk - 128); u.nsteps = (256 * kblk + 256 - u.kt0) / 64; u.band = 128;
        } else if (idx < 704) {
            const int i = idx - 576, b = i / 32, hm = (i / 8) % 4, blk = i % 8;
            u.qoff = b * SEQ * EVEN_N + 4608 + hm * 128; u.qs = EVEN_N;
            u.kvsel = 1; u.koff = b * MEML * 4096 + l * 1024 + hm * 128; u.voff = u.koff + 512; u.ks = 4096;
            u.L = MEML; u.qrow_w = 256 * blk + 32 * wave; u.kt0 = 0; u.nsteps = 4; u.causal = 0;
        } else {
            const int i = idx - 704, bh = i % 24, u8 = i / 24, b = bh / 6, h = bh % 6; const int wh = wave >> 2;
            const int tp = (b * SEQ + 2 * u8) * EVEN_N;
            u.qoff = tp + wh * EVEN_N + h * 128; u.qs = 16 * EVEN_N; u.koff = tp + 768 + h * 128; u.voff = tp + 1536 + h * 128; u.kd1 = EVEN_N; u.ks = 16 * EVEN_N;
            u.L = 128; u.qrow_w = 32 * (wave & 3); u.kt0 = 0; u.nsteps = 4; u.kstep = 32; u.koff1 = 0; u.pair = 1; u.whalf = wh; u.band = 128;
        }
        return false;
    } else {
        if (idx < 128) {
            const int i = idx, b = i / 32, hm = (i / 8) % 4, blk = i % 8;
            u.qoff = b * SEQ * ODD_NP + 2048 + hm * 128; u.qs = ODD_NP;
            u.kvsel = 1; u.koff = b * MEML * 4096 + l * 1024 + hm * 128; u.voff = u.koff + 512; u.ks = 4096;
            u.L = MEML; u.qrow_w = 256 * blk + 32 * wave; u.kt0 = 0; u.nsteps = 4; u.causal = 0;
            return false;
        } else {
            const int i = idx - 128, b = i / 192, g = (i / 64) % 3, pblk = i % 64, hq = 8 * g + wave; const int tb = b * SEQ * ODD_NP;
            u.qoff = tb + hq * 64; u.qs = ODD_NP; u.koff = tb + 1536 + g * 64; u.voff = tb + 1792 + g * 64; u.ks = ODD_NP;
            u.L = SEQ; u.qrow_w = 32 * pblk; u.kt0 = (32 * pblk - 128) < 0 ? 0 : (32 * pblk - 128); u.nsteps = (32 * pblk + 32 - u.kt0 + 63) / 64; u.band = 127;
            return true;
        }
    }
}
__device__ __forceinline__ void decode_epi(int idx, int l, int wave, const float* sinks, AE& e) {
    const int odd = l & 1;
    e.has_sink = 0; e.sink = 0.f; e.lseoff = 0; e.lses = 0; e.goff = 0; e.gs = 0;
    if (!odd) {
        if (idx < 192) { const int bh = idx % 24, b = bh / 6, h = bh % 6;
            e.epi = 1; e.ooff = b * SEQ * DM + 768 + h * 128; e.os = DM; e.goff = b * SEQ * EVEN_N + 5120 + 768 + h * 128; e.gs = EVEN_N;
        } else if (idx < 576) { const int i = idx - 192, pat = i / 192, j = i % 192, bh = j % 24, rr = j / 24, b = bh / 6, h = bh % 6;
            const int dil = pat ? 4 : 1, res = pat ? (rr & 3) : 0; const int tok0 = b * SEQ + res;
            e.epi = 0; e.ooff = pat * NTOK * 768 + tok0 * 768 + h * 128; e.os = dil * 768; e.lseoff = pat * NTOK * 6 + tok0 * 6 + h; e.lses = dil * 6;
        } else if (idx < 704) { const int i = idx - 576, b = i / 32, hm = (i / 8) % 4;
            e.epi = 1; e.ooff = b * SEQ * DM + 1536 + hm * 128; e.os = DM; e.goff = b * SEQ * EVEN_N + 5120 + 1536 + hm * 128; e.gs = EVEN_N;
        } else { const int i = idx - 704, bh = i % 24, u8 = i / 24, b = bh / 6, h = bh % 6; const int tokw = b * SEQ + 2 * u8 + (wave >> 2);
            e.epi = 0; e.ooff = 2 * NTOK * 768 + tokw * 768 + h * 128; e.os = 16 * 768; e.lseoff = 2 * NTOK * 6 + tokw * 6 + h; e.lses = 16 * 6;
        }
    } else {
        if (idx < 128) { const int i = idx, b = i / 32, hm = (i / 8) % 4;
            e.epi = 1; e.ooff = b * SEQ * DM + 1536 + hm * 128; e.os = DM; e.goff = b * SEQ * ODD_NP + 2560 + 1536 + hm * 128; e.gs = ODD_NP;
        } else { const int i = idx - 128, b = i / 192, g = (i / 64) % 3, hq = 8 * g + wave;
            e.epi = 1; e.ooff = b * SEQ * DM + hq * 64; e.os = DM; e.goff = b * SEQ * ODD_NP + 2560 + hq * 64; e.gs = ODD_NP;
            e.has_sink = 1; e.sink = sinks[(l >> 1) * 24 + hq];
        }
    }
}

}

typedef __attribute__((address_space(4))) const Args* KArgs;
#define LAUNDER_S(p) asm volatile("" : "+s"(p))

__global__ void __launch_bounds__(NWAVES * 64, 2) fwd_kernel(Args args_unused) {
    extern __shared__ __attribute__((aligned(16))) unsigned char lds_raw[];
    LAS unsigned char* lds = (LAS unsigned char*)lds_raw;
    volatile LAS unsigned* MISC = (volatile LAS unsigned*)(lds + MISC_OFF);
    const int tid0 = threadIdx.x;
    const int G = gridDim.x; const int bx = blockIdx.x; const int vcu = (G % 8 == 0) ? (bx % 8) * (G / 8) + bx / 8 : bx;
    const KArgs ka0 = (KArgs)__builtin_amdgcn_kernarg_segment_ptr();
    for (int i = tid0; i < (LDS_BYTES - LDSCTL_OFF) / 4; i += NWAVES * 64) ((LAS unsigned*)(lds + LDSCTL_OFF))[i] = 0u;
    __syncthreads();
    XcdBarrier bar; { unsigned char* ws0 = ka0->ws; bar.bar = (unsigned*)(ws0 + WS_CTL) + CW_BAR; bar.x = 0; bar.st = nullptr;
        if (!MK_PER_PHASE) bar = xcd_barrier_post((unsigned*)(ws0 + WS_CTL) + CW_BAR, MISC + 8); }
    const int ph_lo = ka0->ph_lo, ph_hi = ka0->ph_hi;

    for (int ph = ph_lo; ph < ph_hi; ++ph) {
        int tid = tid0; asm volatile("" : "+v"(tid));
        const int lane = tid & 63, wave = __builtin_amdgcn_readfirstlane(tid >> 6);
        KArgs ka = ka0; LAUNDER_S(ka);
        unsigned char* ws = ka->ws;
        if (ph == 0 && (AN_MASK & 1)) {
            const int gw = vcu * NWAVES + wave, NGW = G * NWAVES;
            constexpr int I_E = 32 * (EVEN_N / 64), I_O = 32 * (ODD_N / 64), I_W = 32 * (DM / 64), I_M = 32 * (1024 / 64);
            constexpr int NITEMS = 2 * I_E + 2 * I_O + 4 * I_W + 4 * I_M;
            for (int it = gw; it < NITEMS; it += NGW) {
                int r = it;
                if (r < 2 * I_E) { const int i = r / I_E; r -= i * I_E; convert_item(ka->even_w_in + (size_t)i * DM * EVEN_N, EVEN_N, ka->even_norm + i * DM, (bf16_t*)(ws + (i ? WS_WIN_E1 : WS_WIN_E0)), 1, 0, r, lane); continue; } r -= 2 * I_E;
                if (r < 2 * I_O) { const int i = r / I_O; r -= i * I_O; convert_item(ka->odd_w_in + (size_t)i * DM * ODD_N, ODD_N, ka->odd_norm + i * DM, (bf16_t*)(ws + (i ? WS_WIN_O1 : WS_WIN_O0)), 2, 0, r, lane); continue; } r -= 2 * I_O;
                if (r < 4 * I_W) { const int l = r / I_W; r -= l * I_W; const float* W = ((l & 1) ? ka->odd_w_out : ka->even_w_out) + (size_t)(l >> 1) * DM * DM;
                    convert_item(W, DM, nullptr, (bf16_t*)(ws + WS_WOUT + (size_t)l * 8 * MiB), 0, 0, r, lane); continue; } r -= 4 * I_W;
                { const int l = r / I_M; r -= l * I_M; const float* W = ((l & 1) ? ka->odd_w_mkv : ka->even_w_mkv) + (size_t)(l >> 1) * DM * 1024;
                    convert_item(W, 1024, nullptr, (bf16_t*)(ws + WS_WMKV), 0, l * 1024, r, lane); }
            }
            bf16_t* XB = (bf16_t*)(ws + WS_XB); bf16_t* MEMN = (bf16_t*)(ws + WS_MEMN); float* SSQ = (float*)(ws + WS_SSQ);
            const float* xin = ka->x; const float* memin = ka->mem; const float* mnorm = ka->mem_norm;
            for (int m = gw; m < NTOK + NMEM; m += NGW) {
                const bool isx = m < NTOK; const int row = isx ? m : m - NTOK;
                const f32x4* xr = (const f32x4*)((isx ? xin : memin) + (size_t)row * DM) + lane;
                f32x4 v[8]; float s = 0.f;
#pragma unroll
                for (int j = 0; j < 8; ++j) { v[j] = xr[64 * j]; s += (v[j].x * v[j].x + v[j].y * v[j].y) + (v[j].z * v[j].z + v[j].w * v[j].w); }
                s = wave_sum(s);
                unsigned long long* o8 = (unsigned long long*)((isx ? XB : MEMN) + (size_t)row * DM) + lane;
                if (isx) {
                    if (lane < 8) SSQ[(size_t)lane * NTOK + row] = lane == 0 ? s : 0.f;
#pragma unroll
                    for (int j = 0; j < 8; ++j) o8[64 * j] = (unsigned long long)pk2(v[j].x, v[j].y) | ((unsigned long long)pk2(v[j].z, v[j].w) << 32);
                } else {
                    const float rs = 1.0f / sqrtf(s * (1.0f / DM) + EPS);
                    const f32x4* gr = (const f32x4*)mnorm + lane;
#pragma unroll
                    for (int j = 0; j < 8; ++j) { const f32x4 g = gr[64 * j]; o8[64 * j] = (unsigned long long)pk2(v[j].x * rs * g.x, v[j].y * rs * g.y) | ((unsigned long long)pk2(v[j].z * rs * g.z, v[j].w * rs * g.w) << 32); }
                }
            }
            float* CS128 = (float*)(ws + WS_CS128); float* CS64 = (float*)(ws + WS_CS64); const int* posp = ka->pos;
            for (int tk = gw; tk < NTOK; tk += NGW) {
                const float pf = (float)posp[tk];
                { const float inv = expf((float)lane * (float)(-2.0 * 9.210340371976184 / 128.0)); const float ang = pf * inv;
                  const double rev = (double)ang * 0.15915494309189535; const float fr = (float)(rev - rint(rev));
                  CS128[(size_t)tk * 128 + lane] = __builtin_amdgcn_cosf(fr); CS128[(size_t)tk * 128 + 64 + lane] = __builtin_amdgcn_sinf(fr); }
                if (lane < 32) { const float inv = expf((float)lane * (float)(-2.0 * 9.210340371976184 / 64.0)); const float ang = pf * inv;
                  const double rev = (double)ang * 0.15915494309189535; const float fr = (float)(rev - rint(rev));
                  CS64[(size_t)tk * 64 + lane] = __builtin_amdgcn_cosf(fr); CS64[(size_t)tk * 64 + 32 + lane] = __builtin_amdgcn_sinf(fr); }
            }
        } else if (ph == 17 && (AN_MASK & 2)) {
            const int gw = vcu * NWAVES + wave, NGW = G * NWAVES;
            const float* ssq = (const float*)(ws + WS_SSQ) + (size_t)4 * 8 * NTOK; float* outp = ka->out; const float* fnorm = ka->final_norm;
            for (int m = gw; m < NTOK; m += NGW) {
                float sq = 0.f;
#pragma unroll
                for (int j = 0; j < 8; ++j) sq += ssq[(size_t)j * NTOK + m];
                const float rs = 1.0f / sqrtf(sq * (1.0f / DM) + EPS);
                f32x4* xr = (f32x4*)(outp + (size_t)m * DM) + lane; const f32x4* gr = (const f32x4*)fnorm + lane;
#pragma unroll
                for (int j = 0; j < 8; ++j) { f32x4 v = xr[64 * j]; const f32x4 g = gr[64 * j]; v = v * rs * g; xr[64 * j] = v; }
            }
        } else if (ph >= 1 && ph <= 16) {
            const int l = (ph - 1) >> 2, sub = (ph - 1) & 3, odd = l & 1, li = l >> 1;
            if ((sub == 0 && (AN_MASK & 4)) || (sub == 3 && (AN_MASK & 8))) {
                GemmP P; P.ws = ws; P.l = l; P.xin = ka->x; P.out = ka->out; P.lds = lds;
                Order S; S.G = G; S.c = bx; S.nM0 = NTOK / 256;
                if (sub == 0) { P.mode = EM_INPROJ; P.A = (const bf16_t*)(ws + WS_XB); P.Bt = (const bf16_t*)(ws + (odd ? (li ? WS_WIN_O1 : WS_WIN_O0) : (li ? WS_WIN_E1 : WS_WIN_E0)));
                    S.nN0 = (odd ? ODD_NP : EVEN_N) / 256; S.nwg1 = (l == 0) ? 64 : 0; }
                else { P.mode = EM_OUTPROJ; P.A = (const bf16_t*)(ws + WS_Y); P.Bt = (const bf16_t*)(ws + WS_WOUT + (size_t)l * 8 * MiB); S.nN0 = DM / 256; S.nwg1 = 0; }
                S.nwg0 = S.nM0 * S.nN0;
                gemm_phase(lds, P, S, tid);
            } else if (sub == 2 && (AN_MASK & 16)) {
                if (!odd) {
                    const float* LSE = (const float*)(ws + WS_LSE); const bf16_t* OG = (const bf16_t*)(ws + WS_OG); const bf16_t* QKV = (const bf16_t*)(ws + WS_QKV); bf16_t* Y = (bf16_t*)(ws + WS_Y);
                    const long NIT = (long)NTOK * 96;
                    for (long it = (long)bx * 512 + tid; it < NIT; it += (long)G * 512) {
                        const int tok = (int)(it / 96), c = (int)(it % 96), h = c >> 4;
                        const float l0 = LSE[(size_t)tok * 6 + h], l1 = LSE[(size_t)NTOK * 6 + (size_t)tok * 6 + h], l2 = LSE[(size_t)2 * NTOK * 6 + (size_t)tok * 6 + h];
                        const float mx = fmaxf(l0, fmaxf(l1, l2));
                        float w0 = __expf(l0 - mx), w1 = __expf(l1 - mx), w2 = __expf(l2 - mx); const float inv = 1.0f / (w0 + w1 + w2); w0 *= inv; w1 *= inv; w2 *= inv;
                        const u32x4 a = *(const u32x4*)(OG + (size_t)tok * 768 + c * 8), b = *(const u32x4*)(OG + (size_t)NTOK * 768 + (size_t)tok * 768 + c * 8), cc = *(const u32x4*)(OG + (size_t)2 * NTOK * 768 + (size_t)tok * 768 + c * 8);
                        const u32x4 g = *(const u32x4*)(QKV + (size_t)tok * EVEN_N + 5120 + c * 8);
                        u32x4 o;
#define CMB(f) cvt_pk_bf16((w0 * bflo(a.f) + w1 * bflo(b.f) + w2 * bflo(cc.f)) * bflo(g.f), (w0 * bfhi(a.f) + w1 * bfhi(b.f) + w2 * bfhi(cc.f)) * bfhi(g.f))
                        o.x = CMB(x); o.y = CMB(y); o.z = CMB(z); o.w = CMB(w);
#undef CMB
                        *(u32x4*)(Y + (size_t)tok * DM + c * 8) = o;
                    }
                }
            } else if (sub == 1 && (AN_MASK & 32)) {
                gu32* qctr = (gu32*)(ws + WS_CTL) + CW_Q + 64 * l;
                constexpr int NUNITS = 896;
                int it = 0;
                if (tid == 0) MISC[16] = __hip_atomic_fetch_add(qctr, 1u, RLX_AGENT);
                __syncthreads();
                int idx = (int)MISC[16];
                while (idx < NUNITS) {
                    if (tid == 0) MISC[16 + ((it + 1) & 1)] = __hip_atomic_fetch_add(qctr, 1u, RLX_AGENT);
                    idx = __builtin_amdgcn_readfirstlane(idx);
                    AU u; const bool d64 = decode_main(idx, l, wave, u);
                    float m_reg, l_reg;
                    if (d64) { f32x16 o[2]; attn_main<64>(u, ws, lds, tid, wave, lane, m_reg, l_reg, o);
                        int idx2 = idx; LAUNDER_S(idx2); AE e; decode_epi(idx2, l, wave, ka->odd_sinks, e); attn_epi<64>(e, u.qrow_w, ws, lds, wave, lane, m_reg, l_reg, o); }
                    else { f32x16 o[4]; attn_main<128>(u, ws, lds, tid, wave, lane, m_reg, l_reg, o);
                        int idx2 = idx; LAUNDER_S(idx2); AE e; decode_epi(idx2, l, wave, ka->odd_sinks, e); attn_epi<128>(e, u.qrow_w, ws, lds, wave, lane, m_reg, l_reg, o); }
                    __syncthreads();
                    idx = (int)MISC[16 + ((it + 1) & 1)]; ++it;
                }
            }
        }
        if (ph + 1 < ph_hi) { if (!(ph >= 1 && ph <= 16 && ((ph - 1) & 3) == 2 && (((ph - 1) >> 2) & 1))) xcd_barrier(bar); }
    }
}

extern "C" void kernel_launch(void* const* d_in, const int* in_sizes, int n_in, void* d_out, int out_size, void* d_ws, size_t ws_size, hipStream_t stream) {
    static int grid = 0;
    if (grid == 0) {
        if (n_in != 14 || in_sizes[0] != NTOK * DM || out_size != NTOK * DM || ws_size < WS_END) { fprintf(stderr, "kernel_launch: unexpected shapes (n_in %d, in0 %d, out %d, ws %zu)\n", n_in, n_in > 0 ? in_sizes[0] : -1, out_size, ws_size); grid = -1; return; }
        int dev = 0, cus = 0, per_cu = 0;
        if (hipGetDevice(&dev) != hipSuccess || hipDeviceGetAttribute(&cus, hipDeviceAttributeMultiprocessorCount, dev) != hipSuccess) { grid = -1; return; }
        if (hipFuncSetAttribute((const void*)fwd_kernel, hipFuncAttributeMaxDynamicSharedMemorySize, LDS_BYTES) != hipSuccess) { fprintf(stderr, "kernel_launch: hipFuncSetAttribute failed\n"); grid = -1; return; }
        if (hipOccupancyMaxActiveBlocksPerMultiprocessor(&per_cu, (const void*)fwd_kernel, NWAVES * 64, LDS_BYTES) != hipSuccess || per_cu < 1) { fprintf(stderr, "kernel_launch: occupancy query says %d blocks/CU\n", per_cu); }
        (void)hipGetLastError();
        grid = cus;
    }
    if (grid < 0) return;
    (void)hipMemsetAsync((char*)d_ws + WS_CTL, 0, CTL_ZERO_BYTES, stream);
    Args a{};
    a.x = (const float*)d_in[0]; a.mem = (const float*)d_in[1]; a.pos = (const int*)d_in[2];
    a.even_norm = (const float*)d_in[3]; a.even_w_in = (const float*)d_in[4]; a.even_w_mkv = (const float*)d_in[5]; a.even_w_out = (const float*)d_in[6];
    a.odd_norm = (const float*)d_in[7]; a.odd_w_in = (const float*)d_in[8]; a.odd_w_mkv = (const float*)d_in[9]; a.odd_w_out = (const float*)d_in[10]; a.odd_sinks = (const float*)d_in[11];
    a.mem_norm = (const float*)d_in[12]; a.final_norm = (const float*)d_in[13];
    a.out = (float*)d_out; a.ws = (unsigned char*)d_ws;
#if MK_PER_PHASE
    for (int ph = 0; ph < N_PHASES; ++ph) { a.ph_lo = ph; a.ph_hi = ph + 1; hipLaunchKernelGGL(fwd_kernel, dim3(grid), dim3(NWAVES * 64), LDS_BYTES, stream, a); }
#else
    a.ph_lo = 0; a.ph_hi = N_PHASES;
    hipLaunchKernelGGL(fwd_kernel, dim3(grid), dim3(NWAVES * 64), LDS_BYTES, stream, a);
#ifdef PROBE_PHASES
    {
        const int pp[] = PROBE_PHASES;
        (void)hipMemsetAsync((char*)d_ws + WS_CTL + (size_t)CW_Q * 4, 0, 64 * 8 * 4, stream);
        for (unsigned i = 0; i < sizeof(pp) / sizeof(pp[0]); ++i) { a.ph_lo = pp[i]; a.ph_hi = pp[i] + 1; hipLaunchKernelGGL(fwd_kernel, dim3(grid), dim3(NWAVES * 64), LDS_BYTES, stream, a); }
    }
#endif
#endif
    const hipError_t le = hipPeekAtLastError();
    if (le != hipSuccess) fprintf(stderr, "kernel_launch: launch failed: %s\n", hipGetErrorName(le));
}
```

```cpp
#include <hip/hip_runtime.h>
#include <cstdio>
#include <cstdint>

#ifndef TPROBE_MASK
#define TPROBE_MASK 0
#endif
#ifndef AN_MASK
#define AN_MASK 63
#endif
#ifndef MK_PER_PHASE
#define MK_PER_PHASE 0
#endif

namespace {
#define LAS __attribute__((address_space(3)))
#define GAS __attribute__((address_space(1)))
typedef unsigned short bf16_t;
typedef short bf16x8 __attribute__((ext_vector_type(8)));
typedef short s16x4 __attribute__((ext_vector_type(4)));
typedef float f32x4 __attribute__((ext_vector_type(4)));
typedef float f32x16 __attribute__((ext_vector_type(16)));
typedef unsigned u32x4 __attribute__((ext_vector_type(4)));
typedef GAS unsigned gu32;
#define RLX_AGENT __ATOMIC_RELAXED, __HIP_MEMORY_SCOPE_AGENT
#define LDS_WAIT() asm volatile("s_waitcnt lgkmcnt(0)" ::: "memory")
#define VM_WAIT() asm volatile("s_waitcnt vmcnt(0)" ::: "memory")
#define SBAR() __builtin_amdgcn_sched_barrier(0)

constexpr int BATCH = 4, SEQ = 2048, DM = 2048, NTOK = BATCH * SEQ, MEML = 256, NMEM = BATCH * MEML;
constexpr int EVEN_N = 7168, ODD_N = 4480, ODD_NP = 4608;
constexpr int KDIM = 2048;
constexpr float EPS = 1e-6f;
constexpr int NWAVES = 8;

constexpr size_t MiB = 1u << 20;
constexpr size_t WS_CTL = 0, CTL_ZERO_BYTES = 1 * MiB;
constexpr size_t WS_WIN_E0 = 1 * MiB, WS_WIN_E1 = 29 * MiB, WS_WIN_O0 = 57 * MiB, WS_WIN_O1 = 75 * MiB;
constexpr size_t WS_WOUT = 93 * MiB;
constexpr size_t WS_WMKV = 125 * MiB;
constexpr size_t WS_XB = 141 * MiB;
constexpr size_t WS_QKV = 173 * MiB;
constexpr size_t WS_Y = 285 * MiB;
constexpr size_t WS_OG = 374 * MiB;
constexpr size_t WS_LSE = 353 * MiB;
constexpr size_t WS_MKV = 354 * MiB;
constexpr size_t WS_MEMN = 362 * MiB;
constexpr size_t WS_CS128 = 366 * MiB;
constexpr size_t WS_CS64 = 370 * MiB;
constexpr size_t WS_SSQ = 372 * MiB;
constexpr size_t WS_END = 438 * MiB;
constexpr int CW_BAR = 4096;
constexpr int CW_SSQ = 16384;
constexpr int CW_KM = 65536;
constexpr int CW_Q = 131072;
static_assert((CW_Q + 64 * 8) * 4 <= (int)CTL_ZERO_BYTES, "ctl");

constexpr int RING_BYTES = 131072;
constexpr int LDSCTL_OFF = RING_BYTES, MISC_OFF = LDSCTL_OFF + 320;
constexpr int LDS_BYTES = 147456;
constexpr int XTBL_OFF = LDSCTL_OFF + 1024;

__device__ __forceinline__ unsigned f2bf(float f) { unsigned u = __builtin_bit_cast(unsigned, f); return (u + 0x7fffu + ((u >> 16) & 1u)) >> 16; }
typedef float f32x2_t __attribute__((ext_vector_type(2))); typedef __bf16 bf16x2_t __attribute__((ext_vector_type(2)));
__device__ __forceinline__ unsigned pk2(float lo, float hi) { f32x2_t v = {lo, hi}; bf16x2_t b = __builtin_convertvector(v, bf16x2_t); return __builtin_bit_cast(unsigned, b); }
__device__ __forceinline__ unsigned cvt_pk_bf16(float lo, float hi) { unsigned r; asm volatile("v_cvt_pk_bf16_f32 %0, %1, %2" : "=v"(r) : "v"(lo), "v"(hi)); return r; }
__device__ __forceinline__ float bflo(unsigned w) { return __builtin_bit_cast(float, w << 16); }
__device__ __forceinline__ float bfhi(unsigned w) { return __builtin_bit_cast(float, w & 0xffff0000u); }

constexpr int BM = 256, BK = 64, HALF = 128, HTB = HALF * BK * 2, NXCD = 8, WGM = 8;
__device__ __forceinline__ int lds_byte(int r, int c) { const int st = (r >> 4) * 2 + (c >> 5), rr = r & 15, cc = c & 31, ob = rr * 64 + cc * 2; return st * 1024 + (ob ^ (((ob >> 9) & 1) << 5)); }
__device__ __forceinline__ void stage_rc(int b, int& R, int& C) { const int st = b / 1024, sb = b % 1024, swz = sb ^ (((sb >> 9) & 1) << 5); R = (st >> 1) * 16 + swz / 64; C = (st & 1) * 32 + (swz % 64) / 2; }
__device__ __forceinline__ int perm32(int rho) { const int n = rho >> 4, i = rho & 15; return 8 * (i >> 2) + 4 * n + (i & 3); }

struct Unit { int pm, pn, s; };
enum { EM_PLAIN = 0, EM_INPROJ = 1, EM_OUTPROJ = 2 };
struct GemmP { const bf16_t* A; const bf16_t* Bt; int mode, l; unsigned char* ws; const float* xin; float* out; LAS unsigned char* lds; };
__device__ __forceinline__ void tile_of(int wgid, int nM, int nN, int& pm, int& pn) {
    const int nwg = nM * nN; { const int q = nwg / NXCD, r = nwg % NXCD, xcd = wgid % NXCD, off = wgid / NXCD; wgid = (xcd < r ? xcd * (q + 1) : r * (q + 1) + (xcd - r) * q) + off; }
    const int nig = WGM * nN, gid = wgid / nig, fm = gid * WGM, gsz = (nM - fm) < WGM ? (nM - fm) : WGM;
    pm = fm + ((wgid % nig) % gsz); pn = (wgid % nig) / gsz;
}
struct Order {
    int nwg0, nwg1, nM0, nN0, G, c;
    __device__ __forceinline__ bool next(int i, Unit& u) const {
        const int L = i * G + c; if (L >= nwg0 + nwg1) return false;
        if (L < nwg0) { u.s = 0; tile_of(L, nM0, nN0, u.pm, u.pn); } else { u.s = 1; tile_of(L - nwg0, 4, 16, u.pm, u.pn); }
        return true;
    }
};

__device__ __forceinline__ void epi_run(const GemmP& P, const f32x4 (&acc)[2][2][4][2], const Unit& u, int wr, int wc, int fr, int fq) {
    const int row0 = u.pm * BM + wr * 64 + fr;
    const int colt = u.pn * BM + wc * 32 + 8 * fq;
    const int mode = u.s ? EM_PLAIN : P.mode;
    unsigned char* ws = P.ws;
    if (mode == EM_PLAIN) {
        bf16_t* O = (bf16_t*)(ws + WS_MKV);
#pragma unroll
        for (int ai = 0; ai < 2; ++ai)
#pragma unroll
            for (int m = 0; m < 4; ++m) { bf16_t* rowp = O + (size_t)(row0 + ai * HALF + m * 16) * 4096 + colt;
#pragma unroll
                for (int bj = 0; bj < 2; ++bj) { const f32x4 v0 = acc[ai][bj][m][0], v1 = acc[ai][bj][m][1];
                    u32x4 w; w.x = cvt_pk_bf16(v0[0], v0[1]); w.y = cvt_pk_bf16(v0[2], v0[3]); w.z = cvt_pk_bf16(v1[0], v1[1]); w.w = cvt_pk_bf16(v1[2], v1[3]);
                    *(u32x4*)(rowp + bj * HALF) = w; } }
    } else if (mode == EM_INPROJ) {
        const int l = P.l, odd = l & 1, ldo = odd ? ODD_NP : EVEN_N;
        bf16_t* O = (bf16_t*)(ws + WS_QKV);
        const float* ssq = (const float*)(ws + WS_SSQ) + (size_t)l * 8 * NTOK;
        const float* cs128 = (const float*)(ws + WS_CS128); const float* cs64 = (const float*)(ws + WS_CS64);
        float* km = (float*)(ws + WS_CTL) + CW_KM + (size_t)(l >> 1) * (4 * 6 * 8 * 128);
        int kind; bool kmean = false;
        if (odd) { kind = (u.pn <= 6) ? 2 : (u.pn <= 9 ? 0 : 3); }
        else { kind = (u.pn < 6) ? 1 : (u.pn < 9 ? 0 : (u.pn < 15 ? 1 : (u.pn < 20 ? 0 : 3))); kmean = (u.pn >= 12 && u.pn < 15); }
        float ks[2][8];
#pragma unroll
        for (int bj = 0; bj < 2; ++bj)
#pragma unroll
            for (int e = 0; e < 8; ++e) ks[bj][e] = 0.f;
#pragma unroll
        for (int ai = 0; ai < 2; ++ai)
#pragma unroll
            for (int m = 0; m < 4; ++m) {
                const int row = row0 + ai * HALF + m * 16;
                float sq = 0.f;
#pragma unroll
                for (int j = 0; j < 8; ++j) sq += ssq[(size_t)j * NTOK + row];
                const float rs = __builtin_amdgcn_rsqf(sq * (1.0f / DM) + EPS);
                f32x4 cs = {1.f, 1.f, 1.f, 1.f}, sn = {0.f, 0.f, 0.f, 0.f};
                if (kind == 1) { const float* t = cs128 + (size_t)row * 128 + (16 * wc + 4 * fq); cs = *(const f32x4*)t; sn = *(const f32x4*)(t + 64); }
                else if (kind == 2) { const float* t = cs64 + (size_t)row * 64 + (16 * (wc & 1) + 4 * fq); cs = *(const f32x4*)t; sn = *(const f32x4*)(t + 32); }
                bf16_t* rowp = O + (size_t)row * ldo + colt;
#pragma unroll
                for (int bj = 0; bj < 2; ++bj) {
                    f32x4 v0 = acc[ai][bj][m][0] * rs, v1 = acc[ai][bj][m][1] * rs;
                    if (kind == 1 || kind == 2) { const f32x4 o0 = v0 * cs - v1 * sn, o1 = v1 * cs + v0 * sn; v0 = o0; v1 = o1; }
                    else if (kind == 3) {
#pragma unroll
                        for (int j = 0; j < 4; ++j) { v0[j] = v0[j] * __builtin_amdgcn_rcpf(1.0f + __builtin_amdgcn_exp2f(-1.4426950408889634f * v0[j]));
                                                      v1[j] = v1[j] * __builtin_amdgcn_rcpf(1.0f + __builtin_amdgcn_exp2f(-1.4426950408889634f * v1[j])); }
                    }
                    if (kmean) {
#pragma unroll
                        for (int j = 0; j < 4; ++j) { ks[bj][j] += v0[j]; ks[bj][4 + j] += v1[j]; }
                    }
                    u32x4 w; w.x = cvt_pk_bf16(v0[0], v0[1]); w.y = cvt_pk_bf16(v0[2], v0[3]); w.z = cvt_pk_bf16(v1[0], v1[1]); w.w = cvt_pk_bf16(v1[2], v1[3]);
                    *(u32x4*)(rowp + bj * HALF) = w;
                }
            }
        if (kmean) {
#pragma unroll
            for (int bj = 0; bj < 2; ++bj)
#pragma unroll
                for (int e = 0; e < 8; ++e) { float s = ks[bj][e]; s += __shfl_xor(s, 1); s += __shfl_xor(s, 2); s += __shfl_xor(s, 4); s += __shfl_xor(s, 8); ks[bj][e] = s; }
            if (fr == 0) {
                const int b = u.pm >> 3, n = u.pm & 7;
#pragma unroll
                for (int bj = 0; bj < 2; ++bj) { const int h = (u.pn - 12) * 2 + bj; float* dst = km + ((size_t)((b * 6 + h) * 8 + n)) * 128 + wc * 32 + 8 * fq;
#pragma unroll
                    for (int e = 0; e < 8; ++e) atomicAdd(dst + e, ks[bj][e]); }
            }
        }
    } else {
        const int l = P.l;
        float* xout = P.out;
        bf16_t* xb = (bf16_t*)(ws + WS_XB); const bool wxb = (l != 3);
        float* ssq_out = (float*)(ws + WS_SSQ) + (size_t)(l + 1) * 8 * NTOK + (size_t)u.pn * NTOK + u.pm * BM;
        LAS float* xt = (LAS float*)(P.lds + XTBL_OFF);
#pragma unroll
        for (int ai = 0; ai < 2; ++ai)
#pragma unroll
            for (int m = 0; m < 4; ++m) {
                const int row = row0 + ai * HALF + m * 16; float ss = 0.f;
#pragma unroll
                for (int bj = 0; bj < 2; ++bj) {
                    const size_t off = (size_t)row * DM + colt + bj * HALF;
                    const f32x4 v0 = acc[ai][bj][m][0], v1 = acc[ai][bj][m][1];
                    *(f32x4*)(xout + off) = v0; *(f32x4*)(xout + off + 4) = v1;
                    if (wxb) { u32x4 w; w.x = cvt_pk_bf16(v0[0], v0[1]); w.y = cvt_pk_bf16(v0[2], v0[3]); w.z = cvt_pk_bf16(v1[0], v1[1]); w.w = cvt_pk_bf16(v1[2], v1[3]); *(u32x4*)(xb + off) = w; }
                    ss += (v0[0] * v0[0] + v0[1] * v0[1]) + (v0[2] * v0[2] + v0[3] * v0[3]) + (v1[0] * v1[0] + v1[1] * v1[1]) + (v1[2] * v1[2] + v1[3] * v1[3]);
                }
                ss += __shfl_xor(ss, 16); ss += __shfl_xor(ss, 32);
                if (fq == 0) xt[(ai * HALF + wr * 64 + m * 16 + fr) * 4 + wc] = ss;
            }
        LDS_WAIT(); __builtin_amdgcn_s_barrier(); asm volatile("" ::: "memory");
        { const int lane = fq * 16 + fr, wid = wr * 4 + wc, r = wid * 32 + (lane & 31);
          if (lane < 32) { const f32x4 t = *(const LAS f32x4*)(xt + r * 4); ssq_out[r] = (t[0] + t[1]) + (t[2] + t[3]); } }
    }
}

__device__ __forceinline__ void gemm_phase(LAS unsigned char* lds, const GemmP& P, const Order& S, const int tid) {
    const int wid = __builtin_amdgcn_readfirstlane(tid >> 6), lane = tid & 63, wr = wid >> 2, wc = wid & 3, fr = lane & 15, fq = lane >> 4;
    constexpr int K = KDIM, nt = K / BK;
    unsigned voffA[2], voffB[2];
#pragma unroll
    for (int i = 0; i < 2; ++i) { int R, C; stage_rc(tid * 16 + i * 8192, R, C); const int Rb = (R & ~31) + perm32(R & 31);
        voffA[i] = (unsigned)(R * K + C) * 2u; voffB[i] = (unsigned)(Rb * K + C) * 2u; }
    constexpr size_t kstep = (size_t)(BK * 2);
    constexpr size_t hstep = (size_t)HALF * K * 2;
    constexpr size_t tstep = 2 * hstep;
    const unsigned ldsw = (unsigned)wid * 1024u;
    const int aoff = lds_byte(wr * 64 + fr, fq * 8), boff = lds_byte(wc * 32 + fr, fq * 8);
#define PG8_SA(b, h) (((b) * 2 + (h)) * HTB)
#define PG8_SB(b, h) ((4 + (b) * 2 + (h)) * HTB)
#define PG8_STAGE(bufoff, gbase, voff) do { _Pragma("unroll") for (int _i = 0; _i < 2; ++_i) \
        __builtin_amdgcn_global_load_lds((const unsigned*)((const char*)(gbase) + (voff)[_i]), (LAS unsigned*)(lds + (bufoff) + ldsw + _i * 8192), 16, 0, 0); } while (0)
#define PG8_LDA(dst, b, h) do { _Pragma("unroll") for (int m = 0; m < 4; ++m) _Pragma("unroll") for (int k = 0; k < 2; ++k) dst[m][k] = *(const LAS bf16x8*)(lds + PG8_SA(b, h) + aoff + m * 2048 + k * 1024); } while (0)
#define PG8_LDB(dst, b, h) do { _Pragma("unroll") for (int n = 0; n < 2; ++n) _Pragma("unroll") for (int k = 0; k < 2; ++k) dst[n][k] = *(const LAS bf16x8*)(lds + PG8_SB(b, h) + boff + n * 2048 + k * 1024); } while (0)
#define PG8_MMA(ai, bj, At, Bt) do { __builtin_amdgcn_s_setprio(1); _Pragma("unroll") for (int m = 0; m < 4; ++m) _Pragma("unroll") for (int n = 0; n < 2; ++n) _Pragma("unroll") for (int k = 0; k < 2; ++k) \
        acc[ai][bj][m][n] = __builtin_amdgcn_mfma_f32_16x16x32_bf16(Bt[n][k], At[m][k], acc[ai][bj][m][n], 0, 0, 0); __builtin_amdgcn_s_setprio(0); } while (0)
#define PG8_WAIT_V(n) asm volatile("s_waitcnt vmcnt(" #n ")" ::: "memory")
#define PG8_WAIT_L(n) asm volatile("s_waitcnt lgkmcnt(" #n ")" ::: "memory")
#define PG8_BAR __builtin_amdgcn_s_barrier()
#define PG8_SCHED __builtin_amdgcn_sched_barrier(0)
    Unit cur, nxt; int ui = 0;
    if (!S.next(0, cur)) return;
    f32x4 acc[2][2][4][2];
#define PG8_ACC_INIT(U) do { if (P.mode == EM_OUTPROJ && (U).s == 0) { \
        const char* rp = (const char*)(P.l == 0 ? P.xin : (const float*)P.out) + ((size_t)((U).pm * BM + wr * 64 + fr) * DM + (U).pn * BM + wc * 32 + 8 * fq) * 4; \
        _Pragma("unroll") for (int a = 0; a < 2; ++a) _Pragma("unroll") for (int m = 0; m < 4; ++m) { asm volatile("" : "+v"(rp)); \
            _Pragma("unroll") for (int b = 0; b < 2; ++b) _Pragma("unroll") for (int n = 0; n < 2; ++n) acc[a][b][m][n] = *(const f32x4*)(rp + b * 512 + n * 16); \
            rp += (m == 3 ? (size_t)(HALF - 48) : (size_t)16) * DM * 4; } \
    } else { _Pragma("unroll") for (int a = 0; a < 2; ++a) _Pragma("unroll") for (int b = 0; b < 2; ++b) _Pragma("unroll") for (int m = 0; m < 4; ++m) _Pragma("unroll") for (int n = 0; n < 2; ++n) acc[a][b][m][n] = (f32x4){0.f, 0.f, 0.f, 0.f}; } } while (0)
    PG8_ACC_INIT(cur);
    bf16x8 At[4][2], B0[2][2], B1[2][2];
    const char* cA = (cur.s ? (const char*)(P.ws + WS_MEMN) : (const char*)P.A) + (size_t)cur.pm * tstep; const char* cB = (cur.s ? (const char*)(P.ws + WS_WMKV) : (const char*)P.Bt) + (size_t)cur.pn * tstep;
    PG8_STAGE(PG8_SB(0, 0), cB, voffB); PG8_STAGE(PG8_SB(0, 1), cB + hstep, voffB); PG8_STAGE(PG8_SA(0, 0), cA, voffA); PG8_STAGE(PG8_SA(0, 1), cA + hstep, voffA);
    if (wr == 1) PG8_BAR;
    PG8_WAIT_V(2); PG8_BAR;
    PG8_STAGE(PG8_SB(1, 0), cB + kstep, voffB); PG8_STAGE(PG8_SA(1, 0), cA + kstep, voffA); PG8_STAGE(PG8_SB(1, 1), cB + hstep + kstep, voffB);
    PG8_WAIT_V(6); PG8_BAR;
    for (;;) {
        const bool has_next = S.next(ui + 1, nxt);
        const char* nA = has_next ? (nxt.s ? (const char*)(P.ws + WS_MEMN) : (const char*)P.A) + (size_t)nxt.pm * tstep : cA; const char* nB = has_next ? (nxt.s ? (const char*)(P.ws + WS_WMKV) : (const char*)P.Bt) + (size_t)nxt.pn * tstep : cB;
        for (int t = 0; t < nt; t += 2) {
            const bool last = (t == nt - 2);
            const char* a1 = cA + (size_t)(t + 1) * kstep;
            const char* a2 = last ? nA : cA + (size_t)(t + 2) * kstep; const char* b2 = last ? nB : cB + (size_t)(t + 2) * kstep;
            const char* a3 = a2 + kstep; const char* b3 = b2 + kstep;
            PG8_LDB(B0, 0, 0); PG8_LDB(B1, 0, 1); PG8_SCHED; PG8_LDA(At, 0, 0); PG8_STAGE(PG8_SA(1, 1), a1 + hstep, voffA);
            PG8_WAIT_V(8); PG8_WAIT_L(0); PG8_BAR; PG8_MMA(0, 0, At, B0); PG8_MMA(0, 1, At, B1); PG8_BAR; PG8_SCHED;
            PG8_LDA(At, 0, 1); PG8_STAGE(PG8_SB(0, 0), b2, voffB); PG8_STAGE(PG8_SB(0, 1), b2 + hstep, voffB); PG8_STAGE(PG8_SA(0, 0), a2, voffA);
            PG8_WAIT_V(8); PG8_WAIT_L(0); PG8_BAR; PG8_MMA(1, 0, At, B0); PG8_MMA(1, 1, At, B1); PG8_BAR; PG8_SCHED;
            PG8_LDB(B0, 1, 0); PG8_LDB(B1, 1, 1); PG8_SCHED; PG8_LDA(At, 1, 0); PG8_STAGE(PG8_SA(0, 1), a2 + hstep, voffA);
            PG8_WAIT_V(8); PG8_WAIT_L(0); PG8_BAR; PG8_MMA(0, 0, At, B0); PG8_MMA(0, 1, At, B1); PG8_BAR; PG8_SCHED;
            PG8_LDA(At, 1, 1); PG8_STAGE(PG8_SB(1, 0), b3, voffB); PG8_STAGE(PG8_SB(1, 1), b3 + hstep, voffB); PG8_STAGE(PG8_SA(1, 0), a3, voffA);
            PG8_WAIT_V(8); PG8_WAIT_L(0); PG8_BAR; PG8_MMA(1, 0, At, B0); PG8_MMA(1, 1, At, B1); PG8_BAR; PG8_SCHED;
        }
        if (wr == 0) PG8_BAR;
        { int lane_e = lane; asm volatile("" : "+v"(lane_e));
          epi_run(P, acc, cur, wr, wc, lane_e & 15, lane_e >> 4); }
        if (!has_next) break;
        PG8_ACC_INIT(nxt);
        cur = nxt; cA = nA; cB = nB; ++ui;
        if (wr == 1) PG8_BAR;
    }
    PG8_WAIT_V(0);
    PG8_BAR;
#undef PG8_ACC_INIT
#undef PG8_SA
#undef PG8_SB
#undef PG8_STAGE
#undef PG8_LDA
#undef PG8_LDB
#undef PG8_MMA
#undef PG8_WAIT_V
#undef PG8_WAIT_L
#undef PG8_BAR
#undef PG8_SCHED
}

struct KVD { int kvsel, koff, voff, kd1, ks, L, kt0, ksub, koff1, nst; };
struct AU { int qoff, qs, qrow_w, band, causal, pair, whalf, moba_n, tbase, kmoff; };
struct AE { int epi, ooff, os, goff, gs, lseoff, lses, has_sink; float sink; };
__device__ __forceinline__ int crow(int r, int hi) { return (r & 3) + 8 * (r >> 2) + 4 * hi; }
typedef short v4i16_t __attribute__((ext_vector_type(4)));
template <int OFF> __device__ __forceinline__ s16x4 tr_read(int vb) { return __builtin_bit_cast(s16x4, __builtin_amdgcn_ds_read_tr16_b64_v4i16((LAS v4i16_t*)(uintptr_t)(unsigned)(vb + OFF))); }
template <int D> __device__ __forceinline__ int kswz(int row, int colB) { if constexpr (D == 128) return row * 256 + (colB ^ ((row & 7) << 4)); else return row * 128 + (colB ^ (((row >> 1) & 7) << 4)); }
template <int D> __device__ __forceinline__ int v_st(int k, int c) { const int kk = (k & ~0xC) | ((k & 4) << 1) | ((k & 8) >> 1); return ((kk >> 3) * (D / 32) + (c >> 5)) * 512 + ((kk & 7) * 32 + (c & 31)) * 2; }
__device__ __forceinline__ int v_rd_base(int lane) { return ((lane & 3) << 3) | (((lane >> 2) & 3) << 6) | (((lane >> 4) & 1) << 5) | (((lane >> 5) & 1) << 8); }
template <int D> constexpr int v_rd_off(int d0, int ks, int half) { return d0 * 512 + (ks * 2 + half) * (D / 32) * 512; }

template <int D, int D0, int HF> __device__ __forceinline__ void pv_half(f32x16& od, int vb, bf16x8 pa, bf16x8 pb) {
    const s16x4 l0 = tr_read<v_rd_off<D>(D0, 2 * HF, 0)>(vb), h0 = tr_read<v_rd_off<D>(D0, 2 * HF, 1)>(vb), l1 = tr_read<v_rd_off<D>(D0, 2 * HF + 1, 0)>(vb), h1 = tr_read<v_rd_off<D>(D0, 2 * HF + 1, 1)>(vb);
#define PKV(Lx, Hx) (bf16x8){Lx[0], Lx[1], Lx[2], Lx[3], Hx[0], Hx[1], Hx[2], Hx[3]}
    od = __builtin_amdgcn_mfma_f32_32x32x16_bf16(pa, PKV(l0, h0), od, 0, 0, 0);
    od = __builtin_amdgcn_mfma_f32_32x32x16_bf16(pb, PKV(l1, h1), od, 0, 0, 0);
#undef PKV
}
template <int D, int HF> __device__ __forceinline__ void pv_all(f32x16* o, int vb, bf16x8 pa, bf16x8 pb) {
    pv_half<D, 0, HF>(o[0], vb, pa, pb); pv_half<D, 1, HF>(o[1], vb, pa, pb);
    if constexpr (D == 128) { pv_half<D, 2, HF>(o[2], vb, pa, pb); pv_half<D, 3, HF>(o[3], vb, pa, pb); }
}
template <int D> struct ACfg { static constexpr int NSUB = (D == 128) ? 2 : 3, KTB = 64 * D * 2; };
constexpr int ABUF = 65536;
struct StageR { bf16x8 k0, v0, k1, v1; };
template <int D> __device__ __forceinline__ void sload(StageR& r, const KVD& d, const unsigned char* ws, int sub, int tid) {
    const bf16_t* KVp = (const bf16_t*)(ws + (d.kvsel ? WS_MKV : WS_QKV));
    const int kb = d.kt0 + sub * d.ksub;
    if constexpr (D == 128) {
        const int sr = tid >> 4, sc = (tid & 15) * 8;
        int a0 = kb + sr, a1 = kb + sr + d.koff1; a0 = a0 < 0 ? 0 : (a0 > d.L - 1 ? d.L - 1 : a0); a1 = a1 < 0 ? 0 : (a1 > d.L - 1 ? d.L - 1 : a1);
        const size_t i0 = (size_t)a0 * d.ks + sc, i1 = (size_t)a1 * d.ks + d.kd1 + sc;
        r.k0 = *(const bf16x8*)(KVp + d.koff + i0); r.v0 = *(const bf16x8*)(KVp + d.voff + i0); r.k1 = *(const bf16x8*)(KVp + d.koff + i1); r.v1 = *(const bf16x8*)(KVp + d.voff + i1);
    } else {
        const int sr = tid >> 3, sc = (tid & 7) * 8;
        int a0 = kb + sr; a0 = a0 < 0 ? 0 : (a0 > d.L - 1 ? d.L - 1 : a0);
        const size_t i0 = (size_t)a0 * d.ks + sc;
        r.k0 = *(const bf16x8*)(KVp + d.koff + i0); r.v0 = *(const bf16x8*)(KVp + d.voff + i0);
    }
}
template <int D> __device__ __forceinline__ void swrite(const StageR& r, LAS unsigned char* buf, int slot, int tid) {
    constexpr int NSUB = ACfg<D>::NSUB, KTB = ACfg<D>::KTB;
    LAS unsigned char* Kt = buf + slot * KTB; LAS unsigned char* Vt = buf + NSUB * KTB + slot * KTB;
    if constexpr (D == 128) {
        const int sr = tid >> 4, sc = (tid & 15) * 8;
        *(LAS bf16x8*)(Kt + kswz<D>(sr, sc * 2)) = r.k0; *(LAS bf16x8*)(Kt + kswz<D>(32 + sr, sc * 2)) = r.k1;
        *(LAS bf16x8*)(Vt + v_st<D>(sr, sc)) = r.v0; *(LAS bf16x8*)(Vt + v_st<D>(32 + sr, sc)) = r.v1;
    } else {
        const int sr = tid >> 3, sc = (tid & 7) * 8;
        *(LAS bf16x8*)(Kt + kswz<D>(sr, sc * 2)) = r.k0; *(LAS bf16x8*)(Vt + v_st<D>(sr, sc)) = r.v0;
    }
}
template <int D> __device__ __forceinline__ void cold_start(const KVD& d, const unsigned char* ws, LAS unsigned char* buf, int tid) {
#pragma unroll
    for (int sl = 0; sl < ACfg<D>::NSUB; ++sl) if (sl < d.nst) { StageR r; sload<D>(r, d, ws, sl, tid); swrite<D>(r, buf, sl, tid); }
    __syncthreads();
}

template <int D>
__device__ __forceinline__ void attn_main(const AU& u, const KVD& d, const KVD& dn, const int pre, int& pb, unsigned char* ws, LAS unsigned char* lds, int tid, int wid, int lane,
                                          float& m_out, float& l_out, f32x16 (&o)[D / 32]) {
    constexpr int NQ = D / 16, NB = D / 32, NSUB = ACfg<D>::NSUB, KTB = ACfg<D>::KTB;
    constexpr float SCALE = (D == 128) ? 0.088388347648318440f : 0.125f;
    constexpr float C = SCALE * 1.4426950408889634f;
    constexpr float THRS = 8.0f / SCALE;
    const int r32 = lane & 31, hi = lane >> 5;
    LAS float* wsf = (LAS float*)(lds + XTBL_OFF + wid * 256);
    bf16x8 qr[NQ];
    { const bf16_t* qrow = (const bf16_t*)(ws + WS_QKV) + (size_t)u.qoff + (size_t)(u.qrow_w + r32) * u.qs + hi * 8;
#pragma unroll
      for (int d0 = 0; d0 < NQ; ++d0) qr[d0] = *(const bf16x8*)(qrow + d0 * 16); }
    float m_reg = -1e30f, l_reg = 0.f;
#pragma unroll
    for (int dd = 0; dd < NB; ++dd)
#pragma unroll
        for (int r = 0; r < 16; ++r) o[dd][r] = 0.f;
    const int qidx = u.qrow_w + r32;
    unsigned selmask = 0;
    if constexpr (D == 128) {
        if (u.moba_n > 0) {
            const int n = u.moba_n; float g[7];
#pragma unroll
            for (int j = 0; j < 7; ++j) {
                g[j] = -INFINITY;
                if (j < n) {
                    const float* kmj = (const float*)(ws + WS_CTL) + CW_KM + u.kmoff + j * 128 + hi * 8; float s = 0.f;
#pragma unroll
                    for (int d0 = 0; d0 < NQ; ++d0) { const f32x4 a = *(const f32x4*)(kmj + d0 * 16), b = *(const f32x4*)(kmj + d0 * 16 + 4);
                        const u32x4 qw = __builtin_bit_cast(u32x4, qr[d0]);
                        s += bflo(qw.x) * a[0] + bfhi(qw.x) * a[1] + bflo(qw.y) * a[2] + bfhi(qw.y) * a[3] + bflo(qw.z) * b[0] + bfhi(qw.z) * b[1] + bflo(qw.w) * b[2] + bfhi(qw.w) * b[3]; }
                    auto rr = __builtin_amdgcn_permlane32_swap(__float_as_uint(s), __float_as_uint(s), false, false);
                    g[j] = __uint_as_float(rr[0]) + __uint_as_float(rr[1]);
                }
            }
#pragma unroll
            for (int j = 0; j < 7; ++j) { int cnt = 0;
#pragma unroll
                for (int i = 0; i < 7; ++i) if (i != j) cnt += (i < n && (g[i] > g[j] || (g[i] == g[j] && i < j))) ? 1 : 0;
                if (j < n && cnt < 3) selmask |= (1u << j); }
        }
    }
    const int nsteps = (d.nst + NSUB - 1) / NSUB;
    for (int st = 0; st < nsteps; ++st) {
        LAS unsigned char* bufc = lds + pb * ABUF; LAS unsigned char* bufn = lds + (pb ^ 1) * ABUF;
        const bool lastst = (st + 1 == nsteps);
#pragma unroll 1
        for (int sl = 0; sl < NSUB; ++sl) {
            const int sub = st * NSUB + sl;
            StageR sr_; int wr_next = 0;
            if (!lastst) { if (sub + NSUB < d.nst) { sload<D>(sr_, d, ws, sub + NSUB, tid); wr_next = 1; } }
            else if (pre) { if (sl < dn.nst) { sload<D>(sr_, dn, ws, sl, tid); wr_next = 1; } }
            if (sub < d.nst) {
                const int kb0 = d.kt0 + sub * d.ksub, kb1 = kb0 + d.koff1;
                int lo_q, hi_q;
                const int tabs = u.tbase + sub;
                if (u.moba_n >= 0 && tabs < 4 * u.moba_n) { const bool sel = (selmask >> (tabs >> 2)) & 1u; lo_q = sel ? -(1 << 28) : (1 << 28); hi_q = sel ? (1 << 28) : -(1 << 28); }
                else { lo_q = qidx - u.band; hi_q = u.causal ? qidx : (1 << 28); }
                bool any0 = __any(lo_q <= kb0 + 31 && hi_q >= kb0), any1 = __any(lo_q <= kb1 + 31 && hi_q >= kb1);
                if (u.pair) { any0 = any0 && (u.whalf == 0); any1 = any1 && (u.whalf == 1); }
#define HALF_STEP(HF, ANY, KBH) do { if (ANY) { \
                    const bool allv = __all(lo_q <= (KBH) && hi_q >= (KBH) + 31); \
                    f32x16 p; _Pragma("unroll") for (int r = 0; r < 16; ++r) p[r] = 0.f; \
                    LAS unsigned char* Kt = bufc + sl * KTB; \
                    _Pragma("unroll") for (int d0 = 0; d0 < NQ; ++d0) { const bf16x8 bk = *(const LAS bf16x8*)(Kt + kswz<D>(32 * (HF) + r32, (d0 * 16 + hi * 8) * 2)); p = __builtin_amdgcn_mfma_f32_32x32x16_bf16(bk, qr[d0], p, 0, 0, 0); } \
                    if (!allv) { _Pragma("unroll") for (int r = 0; r < 16; ++r) { const int kk = (KBH) + crow(r, hi); if (kk < lo_q || kk > hi_q) p[r] = -INFINITY; } } \
                    float pmax = p[0]; _Pragma("unroll") for (int r = 1; r < 16; ++r) pmax = fmaxf(pmax, p[r]); \
                    { auto rr = __builtin_amdgcn_permlane32_swap(__float_as_uint(pmax), __float_as_uint(pmax), false, false); pmax = fmaxf(__uint_as_float(rr[0]), __uint_as_float(rr[1])); } \
                    float alpha = 1.f; \
                    if (!__all(pmax - m_reg <= THRS)) { const float mn = fmaxf(m_reg, pmax); alpha = __builtin_amdgcn_exp2f((m_reg - mn) * C); m_reg = mn; } \
                    const float mnC = -m_reg * C; float ps = 0.f; \
                    _Pragma("unroll") for (int r = 0; r < 16; ++r) { p[r] = __builtin_amdgcn_exp2f(fmaf(p[r], C, mnC)); ps += p[r]; } \
                    { auto rr = __builtin_amdgcn_permlane32_swap(__float_as_uint(ps), __float_as_uint(ps), false, false); ps = __uint_as_float(rr[0]) + __uint_as_float(rr[1]); } \
                    l_reg = l_reg * alpha + ps; \
                    if (__any(alpha < 1.f)) { if (hi == 0) wsf[r32] = alpha; LDS_WAIT(); \
                        _Pragma("unroll") for (int dd = 0; dd < NB; ++dd) _Pragma("unroll") for (int r = 0; r < 16; ++r) o[dd][r] *= wsf[crow(r, hi)]; \
                        LDS_WAIT(); } \
                    bf16x8 paA, paB; PK4(p, 0, paA); PK4(p, 8, paB); \
                    const int vb = (int)(uintptr_t)(bufc + NSUB * KTB + sl * KTB) + v_rd_base(lane); \
                    pv_all<D, HF>(o, vb, paA, paB); } } while (0)
#define PK4(P, BASE, OUT) do { unsigned a0 = cvt_pk_bf16(P[BASE + 0], P[BASE + 1]), a1 = cvt_pk_bf16(P[BASE + 2], P[BASE + 3]);   \
    unsigned b0 = cvt_pk_bf16(P[BASE + 4], P[BASE + 5]), b1 = cvt_pk_bf16(P[BASE + 6], P[BASE + 7]);                              \
    auto r0 = __builtin_amdgcn_permlane32_swap(a0, b0, false, false); auto r1 = __builtin_amdgcn_permlane32_swap(a1, b1, false, false); \
    u32x4 w = {r0[0], r1[0], r0[1], r1[1]}; OUT = __builtin_bit_cast(bf16x8, w); } while (0)
                HALF_STEP(0, any0, kb0);
                HALF_STEP(1, any1, kb1);
#undef PK4
#undef HALF_STEP
            }
            if (wr_next) swrite<D>(sr_, bufn, sl, tid);
        }
        __syncthreads();
        pb ^= 1;
    }
    m_out = m_reg; l_out = l_reg;
}

template <int D>
__device__ __forceinline__ void attn_epi(const AE& e, int qrow_w, int pbl, unsigned char* ws, LAS unsigned char* lds, int wid, int lane, float m_reg, float l_reg, const f32x16 (&o)[D / 32]) {
    constexpr int NB = D / 32;
    constexpr float SCALE = (D == 128) ? 0.088388347648318440f : 0.125f;
    const int r32 = lane & 31, hi = lane >> 5;
    LAS float* wsf = (LAS float*)(lds + XTBL_OFF + wid * 256);
    LAS bf16_t* stg = (LAS bf16_t*)(lds + pbl * ABUF + wid * 8192);
    float lt = l_reg;
    if (e.has_sink) lt += __builtin_amdgcn_exp2f((e.sink - m_reg * SCALE) * 1.4426950408889634f);
    if (hi == 0) wsf[r32] = lt > 0.f ? __builtin_amdgcn_rcpf(lt) : 0.f;
    LDS_WAIT();
    float rli[16];
#pragma unroll
    for (int r = 0; r < 16; ++r) rli[r] = wsf[crow(r, hi)];
    LDS_WAIT();
#pragma unroll
    for (int r = 0; r < 16; ++r) { const int orow = crow(r, hi);
#pragma unroll
        for (int d0 = 0; d0 < NB; ++d0) stg[orow * D + d0 * 32 + r32] = (bf16_t)f2bf(o[d0][r] * rli[r]); }
    LDS_WAIT();
    constexpr int CPR = D / 8, RPP = 64 / CPR;
    bf16_t* OB = (bf16_t*)(ws + (e.epi ? WS_Y : WS_OG));
    const bf16_t* GB = (const bf16_t*)(ws + WS_QKV);
#pragma unroll
    for (int i = 0; i < 32 / RPP; ++i) {
        const int row = i * RPP + lane / CPR, ch = lane % CPR;
        const u32x4 v = *(const LAS u32x4*)(stg + row * D + ch * 8);
        const size_t fidx = (size_t)(qrow_w + row);
        if (e.epi == 1) {
            const u32x4 g = *(const u32x4*)(GB + (size_t)e.goff + fidx * e.gs + ch * 8);
            u32x4 w;
            w.x = cvt_pk_bf16(bflo(v.x) * bflo(g.x), bfhi(v.x) * bfhi(g.x)); w.y = cvt_pk_bf16(bflo(v.y) * bflo(g.y), bfhi(v.y) * bfhi(g.y));
            w.z = cvt_pk_bf16(bflo(v.z) * bflo(g.z), bfhi(v.z) * bfhi(g.z)); w.w = cvt_pk_bf16(bflo(v.w) * bflo(g.w), bfhi(v.w) * bfhi(g.w));
            *(u32x4*)(OB + (size_t)e.ooff + fidx * e.os + ch * 8) = w;
        } else {
            *(u32x4*)(OB + (size_t)e.ooff + fidx * e.os + ch * 8) = v;
        }
    }
    if (e.epi == 0 && hi == 0) ((float*)(ws + WS_LSE))[(size_t)e.lseoff + (size_t)(qrow_w + r32) * e.lses] = l_reg > 0.f ? m_reg * SCALE + __logf(l_reg) : -1e30f;
    LDS_WAIT();
}

#define XB_TMO      128
#define XB_XCNT(j)  (256  + 64 * (j))
#define XB_XSUB(j)  (1280 + 64 * (j))
#define XB_XGEN(j)  (2304 + 64 * (j))
#define XB_TOP      3328
#define XB_TOPGEN   3392
#define XCD_BAR_WORDS 3456
#define XB_SPIN_CAP (1u << 18)
__device__ __forceinline__ unsigned xb_ld(unsigned* p)              { return __hip_atomic_load(p, __ATOMIC_RELAXED, __HIP_MEMORY_SCOPE_AGENT); }
__device__ __forceinline__ unsigned xb_add(unsigned* p, unsigned v) { return __hip_atomic_fetch_add(p, v, __ATOMIC_RELAXED, __HIP_MEMORY_SCOPE_AGENT); }
__device__ __forceinline__ unsigned xb_xcc_id() { return (unsigned)__builtin_amdgcn_s_getreg((3 << 11) | 20) & 0xFu; }
#define XB_SPIN(cond, bar) do { unsigned _sp = 0; while (cond) { __builtin_amdgcn_s_sleep(1); \
    if ((++_sp & 255u) == 0u) { if (xb_ld(&(bar)[XB_TMO])) break; if (_sp > XB_SPIN_CAP) { atomicAdd(&(bar)[XB_TMO], 1u); break; } } } } while (0)
struct XcdBarrier { unsigned* bar; unsigned x; volatile LAS unsigned* st; };
__device__ __forceinline__ XcdBarrier xcd_barrier_post(unsigned* bar, volatile LAS unsigned* st) {
    XcdBarrier b; b.bar = bar; b.x = xb_xcc_id(); b.st = st;
    if (threadIdx.x == 0) (void)xb_add(&bar[XB_XCNT(b.x)], 1u);
    return b;
}
__device__ __forceinline__ void xcd_barrier_complete(unsigned* bar, unsigned x, unsigned& nloc, unsigned& nx) {
    const unsigned G = gridDim.x * gridDim.y * gridDim.z;
    unsigned sum, cnt, mine, sp = 0u;
    for (;;) {
        sum = 0u; cnt = 0u; mine = 0u;
#pragma unroll
        for (unsigned j = 0; j < 16; ++j) { const unsigned c = xb_ld(&bar[XB_XCNT(j)]); sum += c; cnt += (c > 0u) ? 1u : 0u; mine = (j == x) ? c : mine; }
        if (sum == G) break;
        __builtin_amdgcn_s_sleep(1);
        if ((++sp & 255u) == 0u) { if (xb_ld(&bar[XB_TMO])) break; if (sp > XB_SPIN_CAP) { atomicAdd(&bar[XB_TMO], 1u); break; } }
    }
    nloc = mine > 0u ? mine : 1u; nx = cnt > 0u ? cnt : 1u;
}
__device__ __forceinline__ void xcd_barrier(const XcdBarrier& b) {
    asm volatile("s_waitcnt vmcnt(0)" ::: "memory");
    __syncthreads();
    if (threadIdx.x == 0) {
        unsigned* bar = b.bar;
        __builtin_amdgcn_s_waitcnt(0);
        unsigned nloc = b.st[0], nx = b.st[1];
        if (nloc == 0u) { xcd_barrier_complete(bar, b.x, nloc, nx); b.st[0] = nloc; b.st[1] = nx; }
        const unsigned old = xb_add(&bar[XB_XSUB(b.x)], 1u);
        const unsigned gen = old / nloc;
        if (old + 1u == (gen + 1u) * nloc) {
            __builtin_amdgcn_fence(__ATOMIC_RELEASE, "agent");
            asm volatile("s_waitcnt vmcnt(0)" ::: "memory");
            const unsigned og = xb_add(&bar[XB_TOP], 1u);
            const unsigned tg = og / nx;
            if (og + 1u == (tg + 1u) * nx) xb_add(&bar[XB_TOPGEN], 1u);
            else XB_SPIN(xb_ld(&bar[XB_TOPGEN]) == tg, bar);
            __builtin_amdgcn_fence(__ATOMIC_ACQUIRE, "agent");
            xb_add(&bar[XB_XGEN(b.x)], 1u);
            asm volatile("s_waitcnt vmcnt(0)" ::: "memory");
        } else {
            XB_SPIN(xb_ld(&bar[XB_XGEN(b.x)]) == gen, bar);
            __builtin_amdgcn_fence(__ATOMIC_ACQUIRE, "agent");
            asm volatile("s_waitcnt vmcnt(0)" ::: "memory");
        }
    }
    __syncthreads();
}

__device__ __forceinline__ float wave_sum(float v) {
#pragma unroll
    for (int o = 1; o < 64; o <<= 1) v += __shfl_xor(v, o);
    return v;
}
__device__ __forceinline__ int phys_even(int n) {
    if (n >= 4608) return n;
    const int seg = n / 768; if (seg == 2 || seg == 5) return n;
    const int i = n & 127, hb = n - i, ii = i & 63, g = ii >> 2, e = (ii & 3) + ((i >> 6) << 2);
    return hb + 8 * g + e;
}
__device__ __forceinline__ int phys_odd(int n) {
    if (n < 1728) { const int i = n & 63, hb = n - i, ii = i & 31, g = ii >> 2, e = (ii & 3) + ((i >> 5) << 2); return hb + 8 * g + e; }
    if (n < 1920) return n + 64;
    return n + 128;
}
__device__ __forceinline__ void convert_item(const float* W, int N, const float* gk, bf16_t* WT, int mapkind, int rowoff, int item, int lane) {
    const int nblk = N / 64, kb = item / nblk, nb = item % nblk, k0 = 64 * kb, n = 64 * nb + lane;
    const int p = (mapkind == 1 ? phys_even(n) : (mapkind == 2 ? phys_odd(n) : n)) + rowoff;
    const float* src = W + (size_t)k0 * N + n;
    bf16_t* dst = WT + (size_t)p * KDIM + k0;
    float v[64];
#pragma unroll
    for (int j = 0; j < 64; ++j) v[j] = src[(size_t)j * N];
    if (gk) {
#pragma unroll
        for (int j = 0; j < 64; ++j) v[j] *= gk[k0 + j];
    }
#pragma unroll
    for (int kk = 0; kk < 8; ++kk) { u32x4 o; o.x = pk2(v[8 * kk], v[8 * kk + 1]); o.y = pk2(v[8 * kk + 2], v[8 * kk + 3]); o.z = pk2(v[8 * kk + 4], v[8 * kk + 5]); o.w = pk2(v[8 * kk + 6], v[8 * kk + 7]);
        *(u32x4*)(dst + 8 * kk) = o; }
}

struct Args {
    const float* x; const float* mem; const int* pos;
    const float* even_norm; const float* even_w_in; const float* even_w_mkv; const float* even_w_out;
    const float* odd_norm; const float* odd_w_in; const float* odd_w_mkv; const float* odd_w_out; const float* odd_sinks;
    const float* mem_norm; const float* final_norm;
    float* out; unsigned char* ws;
    int ph_lo, ph_hi;
};
constexpr int N_PHASES = 18;

constexpr int NUNITS_EVEN = 1088, NUNITS_ODD = 896;
__device__ __forceinline__ bool unit_d64(int idx, int l) { return (l & 1) && idx >= 128; }
__device__ __forceinline__ void decode_kv(int idx, int l, KVD& d) {
    d.kvsel = 0; d.kd1 = 0; d.ksub = 64; d.koff1 = 32;
    if (!(l & 1)) {
        if (idx < 384) { const int n = 7 - idx / 48, rem = idx % 48, s = rem / 24, bh = rem % 24, b = bh / 6, h = bh % 6; const int tb = b * SEQ * EVEN_N;
            d.koff = tb + 3072 + h * 128; d.voff = tb + 3840 + h * 128; d.ks = EVEN_N; d.L = SEQ; d.kt0 = 128 * (n + 1) * s; d.nst = 2 * (n + 1);
        } else if (idx < 768) { const int i = idx - 384, pat = i / 192, j = i % 192, bh = j % 24, rr = j / 24, b = bh / 6, h = bh % 6;
            const int dil = pat ? 4 : 1, res = pat ? (rr & 3) : 0, kblk = pat ? (rr >> 2) : rr; const int tb = (b * SEQ + res) * EVEN_N;
            d.koff = tb + 768 + h * 128; d.voff = tb + 1536 + h * 128; d.ks = dil * EVEN_N; d.L = SEQ / dil; d.kt0 = (256 * kblk - 128) < 0 ? 0 : (256 * kblk - 128); d.nst = (256 * kblk + 256 - d.kt0) / 64;
        } else if (idx < 896) { const int i = idx - 768, b = i / 32, hm = (i / 8) % 4;
            d.kvsel = 1; d.koff = b * MEML * 4096 + l * 1024 + hm * 128; d.voff = d.koff + 512; d.ks = 4096; d.L = MEML; d.kt0 = 0; d.nst = 4;
        } else { const int i = idx - 896, bh = i % 24, u8 = i / 24, b = bh / 6, h = bh % 6; const int tp = (b * SEQ + 2 * u8) * EVEN_N;
            d.koff = tp + 768 + h * 128; d.voff = tp + 1536 + h * 128; d.kd1 = EVEN_N; d.ks = 16 * EVEN_N; d.L = 128; d.kt0 = 0; d.nst = 4; d.ksub = 32; d.koff1 = 0;
        }
    } else {
        if (idx < 128) { const int i = idx, b = i / 32, hm = (i / 8) % 4;
            d.kvsel = 1; d.koff = b * MEML * 4096 + l * 1024 + hm * 128; d.voff = d.koff + 512; d.ks = 4096; d.L = MEML; d.kt0 = 0; d.nst = 4;
        } else { const int i = idx - 128, b = i / 192, g = (i / 64) % 3, pblk = i % 64; const int tb = b * SEQ * ODD_NP;
            d.koff = tb + 1536 + g * 64; d.voff = tb + 1792 + g * 64; d.ks = ODD_NP; d.L = SEQ; d.kt0 = (32 * pblk - 128) < 0 ? 0 : (32 * pblk - 128); d.nst = (32 * pblk + 32 - d.kt0 + 63) / 64;
        }
    }
}
__device__ __forceinline__ void decode_q(int idx, int l, int wave, AU& u) {
    u.moba_n = -1; u.band = 1 << 28; u.causal = 1; u.pair = 0; u.whalf = 0; u.kmoff = 0; u.tbase = 0;
    if (!(l & 1)) {
        if (idx < 384) { const int n = 7 - idx / 48, rem = idx % 48, s = rem / 24, bh = rem % 24, b = bh / 6, h = bh % 6;
            u.qoff = b * SEQ * EVEN_N + 2304 + h * 128; u.qs = EVEN_N; u.qrow_w = 256 * n + 32 * wave; u.moba_n = n; u.tbase = 2 * (n + 1) * s;
            u.kmoff = (l >> 1) * (4 * 6 * 8 * 128) + ((b * 6 + h) * 8) * 128;
        } else if (idx < 768) { const int i = idx - 384, pat = i / 192, j = i % 192, bh = j % 24, rr = j / 24, b = bh / 6, h = bh % 6;
            const int dil = pat ? 4 : 1, res = pat ? (rr & 3) : 0, kblk = pat ? (rr >> 2) : rr;
            u.qoff = (b * SEQ + res) * EVEN_N + h * 128; u.qs = dil * EVEN_N; u.qrow_w = 256 * kblk + 32 * wave; u.band = 128;
        } else if (idx < 896) { const int i = idx - 768, b = i / 32, hm = (i / 8) % 4, blk = i % 8;
            u.qoff = b * SEQ * EVEN_N + 4608 + hm * 128; u.qs = EVEN_N; u.qrow_w = 256 * blk + 32 * wave; u.causal = 0;
        } else { const int i = idx - 896, bh = i % 24, u8 = i / 24, b = bh / 6, h = bh % 6; const int wh = wave >> 2;
            u.qoff = (b * SEQ + 2 * u8 + wh) * EVEN_N + h * 128; u.qs = 16 * EVEN_N; u.qrow_w = 32 * (wave & 3); u.pair = 1; u.whalf = wh; u.band = 128;
        }
    } else {
        if (idx < 128) { const int i = idx, b = i / 32, hm = (i / 8) % 4, blk = i % 8;
            u.qoff = b * SEQ * ODD_NP + 2048 + hm * 128; u.qs = ODD_NP; u.qrow_w = 256 * blk + 32 * wave; u.causal = 0;
        } else { const int i = idx - 128, b = i / 192, g = (i / 64) % 3, pblk = i % 64, hq = 8 * g + wave;
            u.qoff = b * SEQ * ODD_NP + hq * 64; u.qs = ODD_NP; u.qrow_w = 32 * pblk; u.band = 127;
        }
    }
}
__device__ __forceinline__ void decode_epi(int idx, int l, int wave, const float* sinks, AE& e) {
    e.has_sink = 0; e.sink = 0.f; e.lseoff = 0; e.lses = 0; e.goff = 0; e.gs = 0;
    if (!(l & 1)) {
        if (idx < 384) { const int rem = idx % 48, s = rem / 24, bh = rem % 24, b = bh / 6, h = bh % 6; const int tok0 = b * SEQ;
            e.epi = 0; e.ooff = (3 + s) * NTOK * 768 + tok0 * 768 + h * 128; e.os = 768; e.lseoff = (3 + s) * NTOK * 6 + tok0 * 6 + h; e.lses = 6;
        } else if (idx < 768) { const int i = idx - 384, pat = i / 192, j = i % 192, bh = j % 24, rr = j / 24, b = bh / 6, h = bh % 6;
            const int dil = pat ? 4 : 1, res = pat ? (rr & 3) : 0; const int tok0 = b * SEQ + res;
            e.epi = 0; e.ooff = pat * NTOK * 768 + tok0 * 768 + h * 128; e.os = dil * 768; e.lseoff = pat * NTOK * 6 + tok0 * 6 + h; e.lses = dil * 6;
        } else if (idx < 896) { const int i = idx - 768, b = i / 32, hm = (i / 8) % 4;
            e.epi = 1; e.ooff = b * SEQ * DM + 1536 + hm * 128; e.os = DM; e.goff = b * SEQ * EVEN_N + 5120 + 1536 + hm * 128; e.gs = EVEN_N;
        } else { const int i = idx - 896, bh = i % 24, u8 = i / 24, b = bh / 6, h = bh % 6; const int tokw = b * SEQ + 2 * u8 + (wave >> 2);
            e.epi = 0; e.ooff = 2 * NTOK * 768 + tokw * 768 + h * 128; e.os = 16 * 768; e.lseoff = 2 * NTOK * 6 + tokw * 6 + h; e.lses = 16 * 6;
        }
    } else {
        if (idx < 128) { const int i = idx, b = i / 32, hm = (i / 8) % 4;
            e.epi = 1; e.ooff = b * SEQ * DM + 1536 + hm * 128; e.os = DM; e.goff = b * SEQ * ODD_NP + 2560 + 1536 + hm * 128; e.gs = ODD_NP;
        } else { const int i = idx - 128, b = i / 192, g = (i / 64) % 3, hq = 8 * g + wave;
            e.epi = 1; e.ooff = b * SEQ * DM + hq * 64; e.os = DM; e.goff = b * SEQ * ODD_NP + 2560 + hq * 64; e.gs = ODD_NP;
            e.has_sink = 1; e.sink = sinks[(l >> 1) * 24 + hq];
        }
    }
}


constexpr int I_E = 32 * (EVEN_N / 64), I_O = 32 * (ODD_N / 64), I_W = 32 * (DM / 64), I_M = 32 * (1024 / 64);
constexpr int CV_A = I_E + 4 * I_M + I_W, CV_B = CV_A + I_O, CV_C = CV_B + I_E + I_W, CV_D = CV_C + I_O + 2 * I_W;
typedef __attribute__((address_space(4))) const Args* KArgsC;
__device__ __forceinline__ void convert_stage(KArgsC ka, unsigned char* ws, int lo, int hi, int worker, int nworkers, int lane) {
    for (int it = lo + worker; it < hi; it += nworkers) {
        int r = it;
        if (r < I_E) { convert_item(ka->even_w_in, EVEN_N, ka->even_norm, (bf16_t*)(ws + WS_WIN_E0), 1, 0, r, lane); continue; } r -= I_E;
        if (r < 4 * I_M) { const int l = r / I_M; r -= l * I_M; const float* W = ((l & 1) ? ka->odd_w_mkv : ka->even_w_mkv) + (size_t)(l >> 1) * DM * 1024;
            convert_item(W, 1024, nullptr, (bf16_t*)(ws + WS_WMKV), 0, l * 1024, r, lane); continue; } r -= 4 * I_M;
        if (r < I_W) { convert_item(ka->even_w_out, DM, nullptr, (bf16_t*)(ws + WS_WOUT), 0, 0, r, lane); continue; } r -= I_W;
        if (r < I_O) { convert_item(ka->odd_w_in, ODD_N, ka->odd_norm, (bf16_t*)(ws + WS_WIN_O0), 2, 0, r, lane); continue; } r -= I_O;
        if (r < I_E) { convert_item(ka->even_w_in + (size_t)DM * EVEN_N, EVEN_N, ka->even_norm + DM, (bf16_t*)(ws + WS_WIN_E1), 1, 0, r, lane); continue; } r -= I_E;
        if (r < I_W) { convert_item(ka->odd_w_out, DM, nullptr, (bf16_t*)(ws + WS_WOUT + (size_t)1 * 8 * MiB), 0, 0, r, lane); continue; } r -= I_W;
        if (r < I_O) { convert_item(ka->odd_w_in + (size_t)DM * ODD_N, ODD_N, ka->odd_norm + DM, (bf16_t*)(ws + WS_WIN_O1), 2, 0, r, lane); continue; } r -= I_O;
        { const int l = 2 + r / I_W; r -= (l - 2) * I_W; const float* W = ((l & 1) ? ka->odd_w_out : ka->even_w_out) + (size_t)(l >> 1) * DM * DM;
          convert_item(W, DM, nullptr, (bf16_t*)(ws + WS_WOUT + (size_t)l * 8 * MiB), 0, 0, r, lane); }
    }
}

}

typedef __attribute__((address_space(4))) const Args* KArgs;
#define LAUNDER_S(p) asm volatile("" : "+s"(p))

__global__ void __launch_bounds__(NWAVES * 64, 2) fwd_kernel(Args args_unused) {
    extern __shared__ __attribute__((aligned(16))) unsigned char lds_raw[];
    LAS unsigned char* lds = (LAS unsigned char*)lds_raw;
    volatile LAS unsigned* MISC = (volatile LAS unsigned*)(lds + MISC_OFF);
    const int tid0 = threadIdx.x;
    const int G = gridDim.x; const int bx = blockIdx.x; const int vcu = (G % 8 == 0) ? (bx % 8) * (G / 8) + bx / 8 : bx;
    const KArgs ka0 = (KArgs)__builtin_amdgcn_kernarg_segment_ptr();
    for (int i = tid0; i < (LDS_BYTES - LDSCTL_OFF) / 4; i += NWAVES * 64) ((LAS unsigned*)(lds + LDSCTL_OFF))[i] = 0u;
    __syncthreads();
    XcdBarrier bar; { unsigned char* ws0 = ka0->ws; bar.bar = (unsigned*)(ws0 + WS_CTL) + CW_BAR; bar.x = 0; bar.st = nullptr;
        if (!MK_PER_PHASE) bar = xcd_barrier_post((unsigned*)(ws0 + WS_CTL) + CW_BAR, MISC + 8); }
    const int ph_lo = ka0->ph_lo, ph_hi = ka0->ph_hi;

    unsigned long long tp_acc = 0ull;
    for (int ph = ph_lo; ph < ph_hi; ++ph) {
        unsigned long long tp_t0 = 0ull; if (TPROBE_MASK) tp_t0 = __builtin_amdgcn_s_memrealtime();
        int tid = tid0; asm volatile("" : "+v"(tid));
        const int lane = tid & 63, wave = __builtin_amdgcn_readfirstlane(tid >> 6);
        KArgs ka = ka0; LAUNDER_S(ka);
        unsigned char* ws = ka->ws;
        if (ph == 0 && (AN_MASK & 1)) {
            const int gw = vcu * NWAVES + wave, NGW = G * NWAVES;
            convert_stage(ka, ws, 0, CV_A, gw, NGW, lane);
            bf16_t* XB = (bf16_t*)(ws + WS_XB); bf16_t* MEMN = (bf16_t*)(ws + WS_MEMN); float* SSQ = (float*)(ws + WS_SSQ);
            const float* xin = ka->x; const float* memin = ka->mem; const float* mnorm = ka->mem_norm;
            for (int m = gw; m < NTOK + NMEM; m += NGW) {
                const bool isx = m < NTOK; const int row = isx ? m : m - NTOK;
                const f32x4* xr = (const f32x4*)((isx ? xin : memin) + (size_t)row * DM) + lane;
                f32x4 v[8]; float s = 0.f;
#pragma unroll
                for (int j = 0; j < 8; ++j) { v[j] = xr[64 * j]; s += (v[j].x * v[j].x + v[j].y * v[j].y) + (v[j].z * v[j].z + v[j].w * v[j].w); }
                s = wave_sum(s);
                unsigned long long* o8 = (unsigned long long*)((isx ? XB : MEMN) + (size_t)row * DM) + lane;
                if (isx) {
                    if (lane < 8) SSQ[(size_t)lane * NTOK + row] = lane == 0 ? s : 0.f;
#pragma unroll
                    for (int j = 0; j < 8; ++j) o8[64 * j] = (unsigned long long)pk2(v[j].x, v[j].y) | ((unsigned long long)pk2(v[j].z, v[j].w) << 32);
                } else {
                    const float rs = 1.0f / sqrtf(s * (1.0f / DM) + EPS);
                    const f32x4* gr = (const f32x4*)mnorm + lane;
#pragma unroll
                    for (int j = 0; j < 8; ++j) { const f32x4 g = gr[64 * j]; o8[64 * j] = (unsigned long long)pk2(v[j].x * rs * g.x, v[j].y * rs * g.y) | ((unsigned long long)pk2(v[j].z * rs * g.z, v[j].w * rs * g.w) << 32); }
                }
            }
            float* CS128 = (float*)(ws + WS_CS128); float* CS64 = (float*)(ws + WS_CS64); const int* posp = ka->pos;
            for (int tk = gw; tk < NTOK; tk += NGW) {
                const float pf = (float)posp[tk];
                { const float inv = expf((float)lane * (float)(-2.0 * 9.210340371976184 / 128.0)); const float ang = pf * inv;
                  const double rev = (double)ang * 0.15915494309189535; const float fr = (float)(rev - rint(rev));
                  CS128[(size_t)tk * 128 + lane] = __builtin_amdgcn_cosf(fr); CS128[(size_t)tk * 128 + 64 + lane] = __builtin_amdgcn_sinf(fr); }
                if (lane < 32) { const float inv = expf((float)lane * (float)(-2.0 * 9.210340371976184 / 64.0)); const float ang = pf * inv;
                  const double rev = (double)ang * 0.15915494309189535; const float fr = (float)(rev - rint(rev));
                  CS64[(size_t)tk * 64 + lane] = __builtin_amdgcn_cosf(fr); CS64[(size_t)tk * 64 + 32 + lane] = __builtin_amdgcn_sinf(fr); }
            }
        } else if (ph == 17 && (AN_MASK & 2)) {
            const int gw = vcu * NWAVES + wave, NGW = G * NWAVES;
            const float* ssq = (const float*)(ws + WS_SSQ) + (size_t)4 * 8 * NTOK; float* outp = ka->out; const float* fnorm = ka->final_norm;
            for (int m = gw; m < NTOK; m += NGW) {
                float sq = 0.f;
#pragma unroll
                for (int j = 0; j < 8; ++j) sq += ssq[(size_t)j * NTOK + m];
                const float rs = 1.0f / sqrtf(sq * (1.0f / DM) + EPS);
                f32x4* xr = (f32x4*)(outp + (size_t)m * DM) + lane; const f32x4* gr = (const f32x4*)fnorm + lane;
#pragma unroll
                for (int j = 0; j < 8; ++j) { f32x4 v = xr[64 * j]; const f32x4 g = gr[64 * j]; v = v * rs * g; xr[64 * j] = v; }
            }
        } else if (ph >= 1 && ph <= 16) {
            const int l = (ph - 1) >> 2, sub = (ph - 1) & 3, odd = l & 1, li = l >> 1;
            if ((sub == 0 && (AN_MASK & 4)) || (sub == 3 && (AN_MASK & 8))) {
                GemmP P; P.ws = ws; P.l = l; P.xin = ka->x; P.out = ka->out; P.lds = lds;
                Order S; S.G = G; S.c = bx; S.nM0 = NTOK / 256;
                if (sub == 0) { P.mode = EM_INPROJ; P.A = (const bf16_t*)(ws + WS_XB); P.Bt = (const bf16_t*)(ws + (odd ? (li ? WS_WIN_O1 : WS_WIN_O0) : (li ? WS_WIN_E1 : WS_WIN_E0)));
                    S.nN0 = (odd ? ODD_NP : EVEN_N) / 256; S.nwg1 = (l == 0) ? 64 : 0; }
                else { P.mode = EM_OUTPROJ; P.A = (const bf16_t*)(ws + WS_Y); P.Bt = (const bf16_t*)(ws + WS_WOUT + (size_t)l * 8 * MiB); S.nN0 = DM / 256; S.nwg1 = 0; }
                S.nwg0 = S.nM0 * S.nN0;
                gemm_phase(lds, P, S, tid);
                if (sub == 0 && l < 3) {
                    const int nwg = S.nwg0 + S.nwg1, TT = nwg % G, lo = l == 0 ? CV_A : (l == 1 ? CV_B : CV_C), hi = l == 0 ? CV_B : (l == 1 ? CV_C : CV_D);
                    if (TT == 0) convert_stage(ka, ws, lo, hi, bx * NWAVES + wave, G * NWAVES, lane);
                    else if (bx >= TT) convert_stage(ka, ws, lo, hi, (bx - TT) * NWAVES + wave, (G - TT) * NWAVES, lane);
                }
            } else if (sub == 2 && (AN_MASK & 16)) {
                if (!odd) {
                    const float* LSE = (const float*)(ws + WS_LSE); const bf16_t* OG = (const bf16_t*)(ws + WS_OG); const bf16_t* QKV = (const bf16_t*)(ws + WS_QKV); bf16_t* Y = (bf16_t*)(ws + WS_Y);
                    const long NIT = (long)NTOK * 192;
                    for (long it = (long)bx * 512 + tid; it < NIT; it += (long)G * 512) {
                        const int tok = (int)(it / 192), c = (int)(it % 192), isb = c >= 96, cc8 = (isb ? c - 96 : c), h = cc8 >> 4;
                        const int g0 = isb ? 3 : 0;
                        const size_t lb = (size_t)tok * 6 + h, ob = (size_t)tok * 768 + cc8 * 8;
                        const float l0 = LSE[(size_t)g0 * NTOK * 6 + lb], l1 = LSE[(size_t)(g0 + 1) * NTOK * 6 + lb], l2 = isb ? -1e30f : LSE[(size_t)2 * NTOK * 6 + lb];
                        const float mx = fmaxf(l0, fmaxf(l1, l2));
                        float w0 = __expf(l0 - mx), w1 = __expf(l1 - mx), w2 = isb ? 0.f : __expf(l2 - mx); const float inv = 1.0f / (w0 + w1 + w2); w0 *= inv; w1 *= inv; w2 *= inv;
                        const u32x4 a = *(const u32x4*)(OG + (size_t)g0 * NTOK * 768 + ob), b = *(const u32x4*)(OG + (size_t)(g0 + 1) * NTOK * 768 + ob);
                        u32x4 cc = {0u, 0u, 0u, 0u}; if (!isb) cc = *(const u32x4*)(OG + (size_t)2 * NTOK * 768 + ob);
                        const u32x4 g = *(const u32x4*)(QKV + (size_t)tok * EVEN_N + 5120 + c * 8);
                        u32x4 o;
#define CMB(f) cvt_pk_bf16((w0 * bflo(a.f) + w1 * bflo(b.f) + w2 * bflo(cc.f)) * bflo(g.f), (w0 * bfhi(a.f) + w1 * bfhi(b.f) + w2 * bfhi(cc.f)) * bfhi(g.f))
                        o.x = CMB(x); o.y = CMB(y); o.z = CMB(z); o.w = CMB(w);
#undef CMB
                        *(u32x4*)(Y + (size_t)tok * DM + c * 8) = o;
                    }
                }
            } else if (sub == 1 && (AN_MASK & 32)) {
                gu32* qctr = (gu32*)(ws + WS_CTL) + CW_Q + 64 * l;
                const int NUNITS = odd ? NUNITS_ODD : NUNITS_EVEN;
                if (tid == 0) { MISC[16] = __hip_atomic_fetch_add(qctr, 1u, RLX_AGENT); MISC[17] = __hip_atomic_fetch_add(qctr, 1u, RLX_AGENT); }
                __syncthreads();
                int idx = (int)MISC[16], idx1 = (int)MISC[17];
                int it = 0, pb = 0; bool warm = false;
                while (idx < NUNITS) {
                    idx = __builtin_amdgcn_readfirstlane(idx); idx1 = __builtin_amdgcn_readfirstlane(idx1);
                    int tid_u = tid; asm volatile("" : "+v"(tid_u)); const int lane_u = tid_u & 63;
                    unsigned nx2 = 0; if (tid == 0) nx2 = __hip_atomic_fetch_add(qctr, 1u, RLX_AGENT);
                    const bool d64 = unit_d64(idx, l);
                    const int pre = (idx1 < NUNITS && unit_d64(idx1, l) == d64) ? 1 : 0;
                    KVD d, dn; decode_kv(idx, l, d); decode_kv(pre ? idx1 : idx, l, dn);
                    AU u; decode_q(idx, l, wave, u);
                    float m_reg, l_reg;
                    if (d64) { if (!warm) cold_start<64>(d, ws, lds + pb * ABUF, tid_u);
                        f32x16 o[2]; attn_main<64>(u, d, dn, pre, pb, ws, lds, tid_u, wave, lane_u, m_reg, l_reg, o);
                        int idx2 = idx; LAUNDER_S(idx2); AE e; decode_epi(idx2, l, wave, ka->odd_sinks, e); attn_epi<64>(e, u.qrow_w, pb ^ 1, ws, lds, wave, lane_u, m_reg, l_reg, o); }
                    else { if (!warm) cold_start<128>(d, ws, lds + pb * ABUF, tid_u);
                        f32x16 o[4]; attn_main<128>(u, d, dn, pre, pb, ws, lds, tid_u, wave, lane_u, m_reg, l_reg, o);
                        int idx2 = idx; LAUNDER_S(idx2); AE e; decode_epi(idx2, l, wave, ka->odd_sinks, e); attn_epi<128>(e, u.qrow_w, pb ^ 1, ws, lds, wave, lane_u, m_reg, l_reg, o); }
                    warm = pre != 0;
                    if (tid == 0) MISC[18 + (it & 1)] = nx2;
                    __syncthreads();
                    idx = idx1; idx1 = (int)MISC[18 + (it & 1)]; ++it;
                }
            }
        }
        if (ph + 1 < ph_hi) { if (!(ph >= 1 && ph <= 16 && ((ph - 1) & 3) == 2 && (((ph - 1) >> 2) & 1))) xcd_barrier(bar); }
        if (TPROBE_MASK) { if ((TPROBE_MASK >> ph) & 1) tp_acc += __builtin_amdgcn_s_memrealtime() - tp_t0; }
    }
    if (TPROBE_MASK) { if (bx == 0) { const unsigned long long te = __builtin_amdgcn_s_memrealtime(); while (__builtin_amdgcn_s_memrealtime() - te < 4ull * tp_acc) __builtin_amdgcn_s_sleep(8); } }
}

extern "C" void kernel_launch(void* const* d_in, const int* in_sizes, int n_in, void* d_out, int out_size, void* d_ws, size_t ws_size, hipStream_t stream) {
    static int grid = 0;
    if (grid == 0) {
        if (n_in != 14 || in_sizes[0] != NTOK * DM || out_size != NTOK * DM || ws_size < WS_END) { fprintf(stderr, "kernel_launch: unexpected shapes (n_in %d, in0 %d, out %d, ws %zu)\n", n_in, n_in > 0 ? in_sizes[0] : -1, out_size, ws_size); grid = -1; return; }
        int dev = 0, cus = 0, per_cu = 0;
        if (hipGetDevice(&dev) != hipSuccess || hipDeviceGetAttribute(&cus, hipDeviceAttributeMultiprocessorCount, dev) != hipSuccess) { grid = -1; return; }
        if (hipFuncSetAttribute((const void*)fwd_kernel, hipFuncAttributeMaxDynamicSharedMemorySize, LDS_BYTES) != hipSuccess) { fprintf(stderr, "kernel_launch: hipFuncSetAttribute failed\n"); grid = -1; return; }
        if (hipOccupancyMaxActiveBlocksPerMultiprocessor(&per_cu, (const void*)fwd_kernel, NWAVES * 64, LDS_BYTES) != hipSuccess || per_cu < 1) { fprintf(stderr, "kernel_launch: occupancy query says %d blocks/CU\n", per_cu); }
        (void)hipGetLastError();
        grid = cus;
    }
    if (grid < 0) return;
    (void)hipMemsetAsync((char*)d_ws + WS_CTL, 0, CTL_ZERO_BYTES, stream);
    Args a{};
    a.x = (const float*)d_in[0]; a.mem = (const float*)d_in[1]; a.pos = (const int*)d_in[2];
    a.even_norm = (const float*)d_in[3]; a.even_w_in = (const float*)d_in[4]; a.even_w_mkv = (const float*)d_in[5]; a.even_w_out = (const float*)d_in[6];
    a.odd_norm = (const float*)d_in[7]; a.odd_w_in = (const float*)d_in[8]; a.odd_w_mkv = (const float*)d_in[9]; a.odd_w_out = (const float*)d_in[10]; a.odd_sinks = (const float*)d_in[11];
    a.mem_norm = (const float*)d_in[12]; a.final_norm = (const float*)d_in[13];
    a.out = (float*)d_out; a.ws = (unsigned char*)d_ws;
#if MK_PER_PHASE
    for (int ph = 0; ph < N_PHASES; ++ph) { a.ph_lo = ph; a.ph_hi = ph + 1; hipLaunchKernelGGL(fwd_kernel, dim3(grid), dim3(NWAVES * 64), LDS_BYTES, stream, a); }
#else
    a.ph_lo = 0; a.ph_hi = N_PHASES;
    hipLaunchKernelGGL(fwd_kernel, dim3(grid), dim3(NWAVES * 64), LDS_BYTES, stream, a);
#ifdef PROBE_PHASES
    {
        const int pp[] = PROBE_PHASES;
        (void)hipMemsetAsync((char*)d_ws + WS_CTL + (size_t)CW_Q * 4, 0, 64 * 8 * 4, stream);
        for (unsigned i = 0; i < sizeof(pp) / sizeof(pp[0]); ++i) { a.ph_lo = pp[i]; a.ph_hi = pp[i] + 1; hipLaunchKernelGGL(fwd_kernel, dim3(grid), dim3(NWAVES * 64), LDS_BYTES, stream, a); }
    }
#endif
#endif
    const hipError_t le = hipPeekAtLastError();
    if (le != hipSuccess) fprintf(stderr, "kernel_launch: launch failed: %s\n", hipGetErrorName(le));
}
```

```cpp
#include <hip/hip_runtime.h>
#include <cstdio>
#include <cstdint>

#ifndef TPROBE_MASK
#define TPROBE_MASK 0
#endif
#ifndef AN_MASK
#define AN_MASK 63
#endif
#ifndef MK_PER_PHASE
#define MK_PER_PHASE 0
#endif

namespace {
#define LAS __attribute__((address_space(3)))
#define GAS __attribute__((address_space(1)))
typedef unsigned short bf16_t;
typedef short bf16x8 __attribute__((ext_vector_type(8)));
typedef short s16x4 __attribute__((ext_vector_type(4)));
typedef float f32x4 __attribute__((ext_vector_type(4)));
typedef float f32x16 __attribute__((ext_vector_type(16)));
typedef unsigned u32x4 __attribute__((ext_vector_type(4)));
typedef GAS unsigned gu32;
#define RLX_AGENT __ATOMIC_RELAXED, __HIP_MEMORY_SCOPE_AGENT
#define LDS_WAIT() asm volatile("s_waitcnt lgkmcnt(0)" ::: "memory")
#define VM_WAIT() asm volatile("s_waitcnt vmcnt(0)" ::: "memory")
#define SBAR() __builtin_amdgcn_sched_barrier(0)

constexpr int BATCH = 4, SEQ = 2048, DM = 2048, NTOK = BATCH * SEQ, MEML = 256, NMEM = BATCH * MEML;
constexpr int EVEN_N = 7168, ODD_N = 4480, ODD_NP = 4608;
constexpr int KDIM = 2048;
constexpr float EPS = 1e-6f;
constexpr int NWAVES = 8;

constexpr size_t MiB = 1u << 20;
constexpr size_t WS_CTL = 0, CTL_ZERO_BYTES = 1 * MiB;
constexpr size_t WS_WIN_E0 = 1 * MiB, WS_WIN_E1 = 29 * MiB, WS_WIN_O0 = 57 * MiB, WS_WIN_O1 = 75 * MiB;
constexpr size_t WS_WOUT = 93 * MiB;
constexpr size_t WS_WMKV = 125 * MiB;
constexpr size_t WS_XB = 141 * MiB;
constexpr size_t WS_QKV = 173 * MiB;
constexpr size_t WS_Y = 285 * MiB;
constexpr size_t WS_OG = 374 * MiB;
constexpr size_t WS_LSE = 353 * MiB;
constexpr size_t WS_MKV = 354 * MiB;
constexpr size_t WS_MEMN = 362 * MiB;
constexpr size_t WS_CS128 = 366 * MiB;
constexpr size_t WS_CS64 = 370 * MiB;
constexpr size_t WS_SSQ = 372 * MiB;
constexpr size_t WS_END = 438 * MiB;
constexpr int CW_BAR = 4096;
constexpr int CW_SSQ = 16384;
constexpr int CW_KM = 65536;
constexpr int CW_Q = 131072;
static_assert((CW_Q + 64 * 8) * 4 <= (int)CTL_ZERO_BYTES, "ctl");

constexpr int RING_BYTES = 131072;
constexpr int LDSCTL_OFF = RING_BYTES, MISC_OFF = LDSCTL_OFF + 320;
constexpr int LDS_BYTES = 147456;
constexpr int XTBL_OFF = LDSCTL_OFF + 1024;

__device__ __forceinline__ unsigned f2bf(float f) { unsigned u = __builtin_bit_cast(unsigned, f); return (u + 0x7fffu + ((u >> 16) & 1u)) >> 16; }
typedef float f32x2_t __attribute__((ext_vector_type(2))); typedef __bf16 bf16x2_t __attribute__((ext_vector_type(2)));
__device__ __forceinline__ unsigned pk2(float lo, float hi) { f32x2_t v = {lo, hi}; bf16x2_t b = __builtin_convertvector(v, bf16x2_t); return __builtin_bit_cast(unsigned, b); }
__device__ __forceinline__ unsigned cvt_pk_bf16(float lo, float hi) { unsigned r; asm volatile("v_cvt_pk_bf16_f32 %0, %1, %2" : "=v"(r) : "v"(lo), "v"(hi)); return r; }
__device__ __forceinline__ float bflo(unsigned w) { return __builtin_bit_cast(float, w << 16); }
__device__ __forceinline__ float bfhi(unsigned w) { return __builtin_bit_cast(float, w & 0xffff0000u); }

constexpr int BM = 256, BK = 64, HALF = 128, HTB = HALF * BK * 2, NXCD = 8, WGM = 8;
__device__ __forceinline__ int lds_byte(int r, int c) { const int st = (r >> 4) * 2 + (c >> 5), rr = r & 15, cc = c & 31, ob = rr * 64 + cc * 2; return st * 1024 + (ob ^ (((ob >> 9) & 1) << 5)); }
__device__ __forceinline__ void stage_rc(int b, int& R, int& C) { const int st = b / 1024, sb = b % 1024, swz = sb ^ (((sb >> 9) & 1) << 5); R = (st >> 1) * 16 + swz / 64; C = (st & 1) * 32 + (swz % 64) / 2; }
__device__ __forceinline__ int perm32(int rho) { const int n = rho >> 4, i = rho & 15; return 8 * (i >> 2) + 4 * n + (i & 3); }

struct Unit { int pm, pn, s; };
enum { EM_PLAIN = 0, EM_INPROJ = 1, EM_OUTPROJ = 2 };
struct GemmP { const bf16_t* A; const bf16_t* Bt; int mode, l; unsigned char* ws; const float* xin; float* out; LAS unsigned char* lds; };
__device__ __forceinline__ void tile_of(int wgid, int nM, int nN, int& pm, int& pn) {
    const int nwg = nM * nN; { const int q = nwg / NXCD, r = nwg % NXCD, xcd = wgid % NXCD, off = wgid / NXCD; wgid = (xcd < r ? xcd * (q + 1) : r * (q + 1) + (xcd - r) * q) + off; }
    const int nig = WGM * nN, gid = wgid / nig, fm = gid * WGM, gsz = (nM - fm) < WGM ? (nM - fm) : WGM;
    pm = fm + ((wgid % nig) % gsz); pn = (wgid % nig) / gsz;
}
struct Order {
    int nwg0, nwg1, nM0, nN0, G, c;
    __device__ __forceinline__ bool next(int i, Unit& u) const {
        const int L = i * G + c; if (L >= nwg0 + nwg1) return false;
        if (L < nwg0) { u.s = 0; tile_of(L, nM0, nN0, u.pm, u.pn); } else { u.s = 1; tile_of(L - nwg0, 4, 16, u.pm, u.pn); }
        return true;
    }
};

__device__ __forceinline__ void epi_run(const GemmP& P, const f32x4 (&acc)[2][2][4][2], const Unit& u, int wr, int wc, int fr, int fq) {
    const int row0 = u.pm * BM + wr * 64 + fr;
    const int colt = u.pn * BM + wc * 32 + 8 * fq;
    const int mode = u.s ? EM_PLAIN : P.mode;
    unsigned char* ws = P.ws;
    if (mode == EM_PLAIN) {
        bf16_t* O = (bf16_t*)(ws + WS_MKV);
#pragma unroll
        for (int ai = 0; ai < 2; ++ai)
#pragma unroll
            for (int m = 0; m < 4; ++m) { bf16_t* rowp = O + (size_t)(row0 + ai * HALF + m * 16) * 4096 + colt;
#pragma unroll
                for (int bj = 0; bj < 2; ++bj) { const f32x4 v0 = acc[ai][bj][m][0], v1 = acc[ai][bj][m][1];
                    u32x4 w; w.x = cvt_pk_bf16(v0[0], v0[1]); w.y = cvt_pk_bf16(v0[2], v0[3]); w.z = cvt_pk_bf16(v1[0], v1[1]); w.w = cvt_pk_bf16(v1[2], v1[3]);
                    *(u32x4*)(rowp + bj * HALF) = w; } }
    } else if (mode == EM_INPROJ) {
        const int l = P.l, odd = l & 1, ldo = odd ? ODD_NP : EVEN_N;
        bf16_t* O = (bf16_t*)(ws + WS_QKV);
        const float* cs128 = (const float*)(ws + WS_CS128); const float* cs64 = (const float*)(ws + WS_CS64);
        float* km = (float*)(ws + WS_CTL) + CW_KM + (size_t)(l >> 1) * (4 * 6 * 8 * 128);
        int kind; bool kmean = false;
        if (odd) { kind = (u.pn <= 6) ? 2 : (u.pn <= 9 ? 0 : 3); }
        else { kind = (u.pn < 6) ? 1 : (u.pn < 9 ? 0 : (u.pn < 15 ? 1 : (u.pn < 20 ? 0 : 3))); kmean = (u.pn >= 12 && u.pn < 15); }
        float ks[2][8];
#pragma unroll
        for (int bj = 0; bj < 2; ++bj)
#pragma unroll
            for (int e = 0; e < 8; ++e) ks[bj][e] = 0.f;
        f32x4 csA[8], snA[8];
#define EPI_TLOAD(I0) do { if (kind == 1) { _Pragma("unroll") for (int i = (I0); i < (I0) + 4; ++i) { const float* t = cs128 + (size_t)(row0 + (i >> 2) * HALF + (i & 3) * 16) * 128 + (16 * wc + 4 * fq); csA[i] = *(const f32x4*)t; snA[i] = *(const f32x4*)(t + 64); } } \
        else if (kind == 2) { _Pragma("unroll") for (int i = (I0); i < (I0) + 4; ++i) { const float* t = cs64 + (size_t)(row0 + (i >> 2) * HALF + (i & 3) * 16) * 64 + (16 * (wc & 1) + 4 * fq); csA[i] = *(const f32x4*)t; snA[i] = *(const f32x4*)(t + 32); } } \
        else { _Pragma("unroll") for (int i = (I0); i < (I0) + 4; ++i) { csA[i] = (f32x4){1.f, 1.f, 1.f, 1.f}; snA[i] = (f32x4){0.f, 0.f, 0.f, 0.f}; } } } while (0)
        EPI_TLOAD(0);
        { const int te = (wr * 4 + wc) * 64 + fq * 16 + fr;
          if (te < 256) { const float* sb = (const float*)(ws + WS_SSQ) + (size_t)l * 8 * NTOK + u.pm * BM; float t8[8];
#pragma unroll
              for (int j = 0; j < 8; ++j) { const float* sj = sb + (size_t)j * NTOK; t8[j] = sj[te]; }
              const float sq = ((t8[0] + t8[1]) + (t8[2] + t8[3])) + ((t8[4] + t8[5]) + (t8[6] + t8[7]));
              ((LAS float*)(P.lds + XTBL_OFF))[te] = __builtin_amdgcn_rsqf(sq * (1.0f / DM) + EPS); }
          LDS_WAIT(); __builtin_amdgcn_s_barrier(); asm volatile("" ::: "memory"); }
        const LAS float* rst = (const LAS float*)(P.lds + XTBL_OFF);
#pragma unroll
        for (int ai = 0; ai < 2; ++ai) {
#pragma unroll
            for (int m = 0; m < 4; ++m) {
                if (ai == 0 && m == 3) { asm volatile("" ::: "memory"); EPI_TLOAD(4); }
                const int row = row0 + ai * HALF + m * 16;
                const float rs = rst[ai * HALF + wr * 64 + m * 16 + fr];
                const f32x4 cs = csA[ai * 4 + m], sn = snA[ai * 4 + m];
                bf16_t* rowp = O + (size_t)row * ldo + colt;
#pragma unroll
                for (int bj = 0; bj < 2; ++bj) {
                    f32x4 v0 = acc[ai][bj][m][0] * rs, v1 = acc[ai][bj][m][1] * rs;
                    if (kind == 1 || kind == 2) { const f32x4 o0 = v0 * cs - v1 * sn, o1 = v1 * cs + v0 * sn; v0 = o0; v1 = o1; }
                    else if (kind == 3) {
#pragma unroll
                        for (int j = 0; j < 4; ++j) { v0[j] = v0[j] * __builtin_amdgcn_rcpf(1.0f + __builtin_amdgcn_exp2f(-1.4426950408889634f * v0[j]));
                                                      v1[j] = v1[j] * __builtin_amdgcn_rcpf(1.0f + __builtin_amdgcn_exp2f(-1.4426950408889634f * v1[j])); }
                    }
                    if (kmean) {
#pragma unroll
                        for (int j = 0; j < 4; ++j) { ks[bj][j] += v0[j]; ks[bj][4 + j] += v1[j]; }
                    }
                    u32x4 w; w.x = cvt_pk_bf16(v0[0], v0[1]); w.y = cvt_pk_bf16(v0[2], v0[3]); w.z = cvt_pk_bf16(v1[0], v1[1]); w.w = cvt_pk_bf16(v1[2], v1[3]);
                    *(u32x4*)(rowp + bj * HALF) = w;
                }
            }
        }
#undef EPI_TLOAD
        if (kmean) {
#pragma unroll
            for (int bj = 0; bj < 2; ++bj)
#pragma unroll
                for (int e = 0; e < 8; ++e) { float s = ks[bj][e]; s += __shfl_xor(s, 1); s += __shfl_xor(s, 2); s += __shfl_xor(s, 4); s += __shfl_xor(s, 8); ks[bj][e] = s; }
            if (fr == 0) {
                const int b = u.pm >> 3, n = u.pm & 7;
#pragma unroll
                for (int bj = 0; bj < 2; ++bj) { const int h = (u.pn - 12) * 2 + bj; float* dst = km + ((size_t)((b * 6 + h) * 8 + n)) * 128 + wc * 32 + 8 * fq;
#pragma unroll
                    for (int e = 0; e < 8; ++e) atomicAdd(dst + e, ks[bj][e]); }
            }
        }
    } else {
        const int l = P.l;
        float* xout = P.out;
        bf16_t* xb = (bf16_t*)(ws + WS_XB); const bool wxb = (l != 3);
        float* ssq_out = (float*)(ws + WS_SSQ) + (size_t)(l + 1) * 8 * NTOK + (size_t)u.pn * NTOK + u.pm * BM;
        LAS float* xt = (LAS float*)(P.lds + XTBL_OFF);
#pragma unroll
        for (int ai = 0; ai < 2; ++ai)
#pragma unroll
            for (int m = 0; m < 4; ++m) {
                const int row = row0 + ai * HALF + m * 16; float ss = 0.f;
#pragma unroll
                for (int bj = 0; bj < 2; ++bj) {
                    const size_t off = (size_t)row * DM + colt + bj * HALF;
                    const f32x4 v0 = acc[ai][bj][m][0], v1 = acc[ai][bj][m][1];
                    *(f32x4*)(xout + off) = v0; *(f32x4*)(xout + off + 4) = v1;
                    if (wxb) { u32x4 w; w.x = cvt_pk_bf16(v0[0], v0[1]); w.y = cvt_pk_bf16(v0[2], v0[3]); w.z = cvt_pk_bf16(v1[0], v1[1]); w.w = cvt_pk_bf16(v1[2], v1[3]); *(u32x4*)(xb + off) = w; }
                    ss += (v0[0] * v0[0] + v0[1] * v0[1]) + (v0[2] * v0[2] + v0[3] * v0[3]) + (v1[0] * v1[0] + v1[1] * v1[1]) + (v1[2] * v1[2] + v1[3] * v1[3]);
                }
                ss += __shfl_xor(ss, 16); ss += __shfl_xor(ss, 32);
                if (fq == 0) xt[(ai * HALF + wr * 64 + m * 16 + fr) * 4 + wc] = ss;
            }
        LDS_WAIT(); __builtin_amdgcn_s_barrier(); asm volatile("" ::: "memory");
        { const int lane = fq * 16 + fr, wid = wr * 4 + wc, r = wid * 32 + (lane & 31);
          if (lane < 32) { const f32x4 t = *(const LAS f32x4*)(xt + r * 4); ssq_out[r] = (t[0] + t[1]) + (t[2] + t[3]); } }
    }
}

__device__ __forceinline__ void gemm_phase(LAS unsigned char* lds, const GemmP& P, const Order& S, const int tid) {
    const int wid = __builtin_amdgcn_readfirstlane(tid >> 6), lane = tid & 63, wr = wid >> 2, wc = wid & 3, fr = lane & 15, fq = lane >> 4;
    constexpr int K = KDIM, nt = K / BK;
    unsigned voffA[2], voffB[2];
#pragma unroll
    for (int i = 0; i < 2; ++i) { int R, C; stage_rc(tid * 16 + i * 8192, R, C); const int Rb = (R & ~31) + perm32(R & 31);
        voffA[i] = (unsigned)(R * K + C) * 2u; voffB[i] = (unsigned)(Rb * K + C) * 2u; }
    constexpr size_t kstep = (size_t)(BK * 2);
    constexpr size_t hstep = (size_t)HALF * K * 2;
    constexpr size_t tstep = 2 * hstep;
    const unsigned ldsw = (unsigned)wid * 1024u;
    const int aoff = lds_byte(wr * 64 + fr, fq * 8), boff = lds_byte(wc * 32 + fr, fq * 8);
#define PG8_SA(b, h) (((b) * 2 + (h)) * HTB)
#define PG8_SB(b, h) ((4 + (b) * 2 + (h)) * HTB)
#define PG8_STAGE(bufoff, gbase, voff) do { _Pragma("unroll") for (int _i = 0; _i < 2; ++_i) \
        __builtin_amdgcn_global_load_lds((const unsigned*)((const char*)(gbase) + (voff)[_i]), (LAS unsigned*)(lds + (bufoff) + ldsw + _i * 8192), 16, 0, 0); } while (0)
#define PG8_LDA(dst, b, h) do { _Pragma("unroll") for (int m = 0; m < 4; ++m) _Pragma("unroll") for (int k = 0; k < 2; ++k) dst[m][k] = *(const LAS bf16x8*)(lds + PG8_SA(b, h) + aoff + m * 2048 + k * 1024); } while (0)
#define PG8_LDB(dst, b, h) do { _Pragma("unroll") for (int n = 0; n < 2; ++n) _Pragma("unroll") for (int k = 0; k < 2; ++k) dst[n][k] = *(const LAS bf16x8*)(lds + PG8_SB(b, h) + boff + n * 2048 + k * 1024); } while (0)
#define PG8_MMA(ai, bj, At, Bt) do { __builtin_amdgcn_s_setprio(1); _Pragma("unroll") for (int m = 0; m < 4; ++m) _Pragma("unroll") for (int n = 0; n < 2; ++n) _Pragma("unroll") for (int k = 0; k < 2; ++k) \
        acc[ai][bj][m][n] = __builtin_amdgcn_mfma_f32_16x16x32_bf16(Bt[n][k], At[m][k], acc[ai][bj][m][n], 0, 0, 0); __builtin_amdgcn_s_setprio(0); } while (0)
#define PG8_WAIT_V(n) asm volatile("s_waitcnt vmcnt(" #n ")" ::: "memory")
#define PG8_WAIT_L(n) asm volatile("s_waitcnt lgkmcnt(" #n ")" ::: "memory")
#define PG8_BAR __builtin_amdgcn_s_barrier()
#define PG8_SCHED __builtin_amdgcn_sched_barrier(0)
    Unit cur, nxt; int ui = 0;
    if (!S.next(0, cur)) return;
    f32x4 acc[2][2][4][2];
#define PG8_ACC_INIT(U) do { if (P.mode == EM_OUTPROJ && (U).s == 0) { \
        const char* rp = (const char*)(P.l == 0 ? P.xin : (const float*)P.out) + ((size_t)((U).pm * BM + wr * 64 + fr) * DM + (U).pn * BM + wc * 32 + 8 * fq) * 4; \
        _Pragma("unroll") for (int a = 0; a < 2; ++a) _Pragma("unroll") for (int m = 0; m < 4; ++m) { asm volatile("" : "+v"(rp)); \
            _Pragma("unroll") for (int b = 0; b < 2; ++b) _Pragma("unroll") for (int n = 0; n < 2; ++n) acc[a][b][m][n] = *(const f32x4*)(rp + b * 512 + n * 16); \
            rp += (m == 3 ? (size_t)(HALF - 48) : (size_t)16) * DM * 4; } \
    } else { _Pragma("unroll") for (int a = 0; a < 2; ++a) _Pragma("unroll") for (int b = 0; b < 2; ++b) _Pragma("unroll") for (int m = 0; m < 4; ++m) _Pragma("unroll") for (int n = 0; n < 2; ++n) acc[a][b][m][n] = (f32x4){0.f, 0.f, 0.f, 0.f}; } } while (0)
    PG8_ACC_INIT(cur);
    bf16x8 At[4][2], B0[2][2], B1[2][2];
    const char* cA = (cur.s ? (const char*)(P.ws + WS_MEMN) : (const char*)P.A) + (size_t)cur.pm * tstep; const char* cB = (cur.s ? (const char*)(P.ws + WS_WMKV) : (const char*)P.Bt) + (size_t)cur.pn * tstep;
    PG8_STAGE(PG8_SB(0, 0), cB, voffB); PG8_STAGE(PG8_SB(0, 1), cB + hstep, voffB); PG8_STAGE(PG8_SA(0, 0), cA, voffA); PG8_STAGE(PG8_SA(0, 1), cA + hstep, voffA);
    if (wr == 1) PG8_BAR;
    PG8_WAIT_V(2); PG8_BAR;
    PG8_STAGE(PG8_SB(1, 0), cB + kstep, voffB); PG8_STAGE(PG8_SA(1, 0), cA + kstep, voffA); PG8_STAGE(PG8_SB(1, 1), cB + hstep + kstep, voffB);
    PG8_WAIT_V(6); PG8_BAR;
    for (;;) {
        const bool has_next = S.next(ui + 1, nxt);
        const char* nA = has_next ? (nxt.s ? (const char*)(P.ws + WS_MEMN) : (const char*)P.A) + (size_t)nxt.pm * tstep : cA; const char* nB = has_next ? (nxt.s ? (const char*)(P.ws + WS_WMKV) : (const char*)P.Bt) + (size_t)nxt.pn * tstep : cB;
        for (int t = 0; t < nt; t += 2) {
            const bool last = (t == nt - 2);
            const char* a1 = cA + (size_t)(t + 1) * kstep;
            const char* a2 = last ? nA : cA + (size_t)(t + 2) * kstep; const char* b2 = last ? nB : cB + (size_t)(t + 2) * kstep;
            const char* a3 = a2 + kstep; const char* b3 = b2 + kstep;
            PG8_LDB(B0, 0, 0); PG8_LDB(B1, 0, 1); PG8_SCHED; PG8_LDA(At, 0, 0); PG8_STAGE(PG8_SA(1, 1), a1 + hstep, voffA);
            PG8_WAIT_V(8); PG8_WAIT_L(0); PG8_BAR; PG8_MMA(0, 0, At, B0); PG8_MMA(0, 1, At, B1); PG8_BAR; PG8_SCHED;
            PG8_LDA(At, 0, 1); PG8_STAGE(PG8_SB(0, 0), b2, voffB); PG8_STAGE(PG8_SB(0, 1), b2 + hstep, voffB); PG8_STAGE(PG8_SA(0, 0), a2, voffA);
            PG8_WAIT_V(8); PG8_WAIT_L(0); PG8_BAR; PG8_MMA(1, 0, At, B0); PG8_MMA(1, 1, At, B1); PG8_BAR; PG8_SCHED;
            PG8_LDB(B0, 1, 0); PG8_LDB(B1, 1, 1); PG8_SCHED; PG8_LDA(At, 1, 0); PG8_STAGE(PG8_SA(0, 1), a2 + hstep, voffA);
            PG8_WAIT_V(8); PG8_WAIT_L(0); PG8_BAR; PG8_MMA(0, 0, At, B0); PG8_MMA(0, 1, At, B1); PG8_BAR; PG8_SCHED;
            PG8_LDA(At, 1, 1); PG8_STAGE(PG8_SB(1, 0), b3, voffB); PG8_STAGE(PG8_SB(1, 1), b3 + hstep, voffB); PG8_STAGE(PG8_SA(1, 0), a3, voffA);
            PG8_WAIT_V(8); PG8_WAIT_L(0); PG8_BAR; PG8_MMA(1, 0, At, B0); PG8_MMA(1, 1, At, B1); PG8_BAR; PG8_SCHED;
        }
        if (wr == 0) PG8_BAR;
        { int lane_e = lane; asm volatile("" : "+v"(lane_e));
          epi_run(P, acc, cur, wr, wc, lane_e & 15, lane_e >> 4); }
        if (!has_next) break;
        PG8_ACC_INIT(nxt);
        cur = nxt; cA = nA; cB = nB; ++ui;
        if (wr == 1) PG8_BAR;
    }
    PG8_WAIT_V(0);
    PG8_BAR;
#undef PG8_ACC_INIT
#undef PG8_SA
#undef PG8_SB
#undef PG8_STAGE
#undef PG8_LDA
#undef PG8_LDB
#undef PG8_MMA
#undef PG8_WAIT_V
#undef PG8_WAIT_L
#undef PG8_BAR
#undef PG8_SCHED
}

struct KVD { int kvsel, koff, voff, kd1, ks, L, kt0, ksub, koff1, nst; };
struct AU { int qoff, qs, qrow_w, band, causal, pair, whalf, moba_n, tbase, kmoff; };
struct AE { int epi, ooff, os, goff, gs, lseoff, lses, has_sink; float sink; };
__device__ __forceinline__ int crow(int r, int hi) { return (r & 3) + 8 * (r >> 2) + 4 * hi; }
typedef short v4i16_t __attribute__((ext_vector_type(4)));
template <int OFF> __device__ __forceinline__ s16x4 tr_read(int vb) { return __builtin_bit_cast(s16x4, __builtin_amdgcn_ds_read_tr16_b64_v4i16((LAS v4i16_t*)(uintptr_t)(unsigned)(vb + OFF))); }
template <int D> __device__ __forceinline__ int kswz(int row, int colB) { if constexpr (D == 128) return row * 256 + (colB ^ ((row & 7) << 4)); else return row * 128 + (colB ^ (((row >> 1) & 7) << 4)); }
template <int D> __device__ __forceinline__ int v_st(int k, int c) { const int kk = (k & ~0xC) | ((k & 4) << 1) | ((k & 8) >> 1); return ((kk >> 3) * (D / 32) + (c >> 5)) * 512 + ((kk & 7) * 32 + (c & 31)) * 2; }
__device__ __forceinline__ int v_rd_base(int lane) { return ((lane & 3) << 3) | (((lane >> 2) & 3) << 6) | (((lane >> 4) & 1) << 5) | (((lane >> 5) & 1) << 8); }
template <int D> constexpr int v_rd_off(int d0, int ks, int half) { return d0 * 512 + (ks * 2 + half) * (D / 32) * 512; }

template <int D, int D0, int HF> __device__ __forceinline__ void pv_half(f32x16& od, int vb, bf16x8 pa, bf16x8 pb) {
    const s16x4 l0 = tr_read<v_rd_off<D>(D0, 2 * HF, 0)>(vb), h0 = tr_read<v_rd_off<D>(D0, 2 * HF, 1)>(vb), l1 = tr_read<v_rd_off<D>(D0, 2 * HF + 1, 0)>(vb), h1 = tr_read<v_rd_off<D>(D0, 2 * HF + 1, 1)>(vb);
#define PKV(Lx, Hx) (bf16x8){Lx[0], Lx[1], Lx[2], Lx[3], Hx[0], Hx[1], Hx[2], Hx[3]}
    od = __builtin_amdgcn_mfma_f32_32x32x16_bf16(pa, PKV(l0, h0), od, 0, 0, 0);
    od = __builtin_amdgcn_mfma_f32_32x32x16_bf16(pb, PKV(l1, h1), od, 0, 0, 0);
#undef PKV
}
template <int D, int HF> __device__ __forceinline__ void pv_all(f32x16* o, int vb, bf16x8 pa, bf16x8 pb) {
    pv_half<D, 0, HF>(o[0], vb, pa, pb); pv_half<D, 1, HF>(o[1], vb, pa, pb);
    if constexpr (D == 128) { pv_half<D, 2, HF>(o[2], vb, pa, pb); pv_half<D, 3, HF>(o[3], vb, pa, pb); }
}
template <int D> struct ACfg { static constexpr int NSUB = (D == 128) ? 2 : 3, KTB = 64 * D * 2; };
constexpr int ABUF = 65536;
struct StageR { bf16x8 k0, v0, k1, v1; };
template <int D> __device__ __forceinline__ void sload(StageR& r, const KVD& d, const unsigned char* ws, int sub, int tid) {
    const bf16_t* KVp = (const bf16_t*)(ws + (d.kvsel ? WS_MKV : WS_QKV));
    const int kb = d.kt0 + sub * d.ksub;
    if constexpr (D == 128) {
        const int sr = tid >> 4, sc = (tid & 15) * 8;
        int a0 = kb + sr, a1 = kb + sr + d.koff1; a0 = a0 < 0 ? 0 : (a0 > d.L - 1 ? d.L - 1 : a0); a1 = a1 < 0 ? 0 : (a1 > d.L - 1 ? d.L - 1 : a1);
        const size_t i0 = (size_t)a0 * d.ks + sc, i1 = (size_t)a1 * d.ks + d.kd1 + sc;
        r.k0 = *(const bf16x8*)(KVp + d.koff + i0); r.v0 = *(const bf16x8*)(KVp + d.voff + i0); r.k1 = *(const bf16x8*)(KVp + d.koff + i1); r.v1 = *(const bf16x8*)(KVp + d.voff + i1);
    } else {
        const int sr = tid >> 3, sc = (tid & 7) * 8;
        int a0 = kb + sr; a0 = a0 < 0 ? 0 : (a0 > d.L - 1 ? d.L - 1 : a0);
        const size_t i0 = (size_t)a0 * d.ks + sc;
        r.k0 = *(const bf16x8*)(KVp + d.koff + i0); r.v0 = *(const bf16x8*)(KVp + d.voff + i0);
    }
}
template <int D> __device__ __forceinline__ void swrite(const StageR& r, LAS unsigned char* buf, int slot, int tid) {
    constexpr int NSUB = ACfg<D>::NSUB, KTB = ACfg<D>::KTB;
    LAS unsigned char* Kt = buf + slot * KTB; LAS unsigned char* Vt = buf + NSUB * KTB + slot * KTB;
    if constexpr (D == 128) {
        const int sr = tid >> 4, sc = (tid & 15) * 8;
        *(LAS bf16x8*)(Kt + kswz<D>(sr, sc * 2)) = r.k0; *(LAS bf16x8*)(Kt + kswz<D>(32 + sr, sc * 2)) = r.k1;
        *(LAS bf16x8*)(Vt + v_st<D>(sr, sc)) = r.v0; *(LAS bf16x8*)(Vt + v_st<D>(32 + sr, sc)) = r.v1;
    } else {
        const int sr = tid >> 3, sc = (tid & 7) * 8;
        *(LAS bf16x8*)(Kt + kswz<D>(sr, sc * 2)) = r.k0; *(LAS bf16x8*)(Vt + v_st<D>(sr, sc)) = r.v0;
    }
}
template <int D> __device__ __forceinline__ void cold_start(const KVD& d, const unsigned char* ws, LAS unsigned char* buf, int tid) {
#pragma unroll
    for (int sl = 0; sl < ACfg<D>::NSUB; ++sl) if (sl < d.nst) { StageR r; sload<D>(r, d, ws, sl, tid); swrite<D>(r, buf, sl, tid); }
    __syncthreads();
}

template <int D>
__device__ __forceinline__ void attn_main(const AU& u, const KVD& d, const KVD& dn, const int pre, int& pb, unsigned char* ws, LAS unsigned char* lds, int tid, int wid, int lane,
                                          float& m_out, float& l_out, f32x16 (&o)[D / 32]) {
    constexpr int NQ = D / 16, NB = D / 32, NSUB = ACfg<D>::NSUB, KTB = ACfg<D>::KTB;
    constexpr float SCALE = (D == 128) ? 0.088388347648318440f : 0.125f;
    constexpr float C = SCALE * 1.4426950408889634f;
    constexpr float THRS = 8.0f / SCALE;
    const int r32 = lane & 31, hi = lane >> 5;
    LAS float* wsf = (LAS float*)(lds + XTBL_OFF + wid * 256);
    bf16x8 qr[NQ];
    { const bf16_t* qrow = (const bf16_t*)(ws + WS_QKV) + (size_t)u.qoff + (size_t)(u.qrow_w + r32) * u.qs + hi * 8;
#pragma unroll
      for (int d0 = 0; d0 < NQ; ++d0) qr[d0] = *(const bf16x8*)(qrow + d0 * 16); }
    float m_reg = -1e30f, l_reg = 0.f;
#pragma unroll
    for (int dd = 0; dd < NB; ++dd)
#pragma unroll
        for (int r = 0; r < 16; ++r) o[dd][r] = 0.f;
    const int qidx = u.qrow_w + r32;
    unsigned selmask = 0;
    if constexpr (D == 128) {
        if (u.moba_n > 0) {
            const int n = u.moba_n; float g[7];
#pragma unroll
            for (int j = 0; j < 7; ++j) {
                g[j] = -INFINITY;
                if (j < n) {
                    const float* kmj = (const float*)(ws + WS_CTL) + CW_KM + u.kmoff + j * 128 + hi * 8; float s = 0.f;
#pragma unroll
                    for (int d0 = 0; d0 < NQ; ++d0) { const f32x4 a = *(const f32x4*)(kmj + d0 * 16), b = *(const f32x4*)(kmj + d0 * 16 + 4);
                        const u32x4 qw = __builtin_bit_cast(u32x4, qr[d0]);
                        s += bflo(qw.x) * a[0] + bfhi(qw.x) * a[1] + bflo(qw.y) * a[2] + bfhi(qw.y) * a[3] + bflo(qw.z) * b[0] + bfhi(qw.z) * b[1] + bflo(qw.w) * b[2] + bfhi(qw.w) * b[3]; }
                    auto rr = __builtin_amdgcn_permlane32_swap(__float_as_uint(s), __float_as_uint(s), false, false);
                    g[j] = __uint_as_float(rr[0]) + __uint_as_float(rr[1]);
                }
            }
#pragma unroll
            for (int j = 0; j < 7; ++j) { int cnt = 0;
#pragma unroll
                for (int i = 0; i < 7; ++i) if (i != j) cnt += (i < n && (g[i] > g[j] || (g[i] == g[j] && i < j))) ? 1 : 0;
                if (j < n && cnt < 3) selmask |= (1u << j); }
        }
    }
    const int nsteps = (d.nst + NSUB - 1) / NSUB;
    for (int st = 0; st < nsteps; ++st) {
        LAS unsigned char* bufc = lds + pb * ABUF; LAS unsigned char* bufn = lds + (pb ^ 1) * ABUF;
        const bool lastst = (st + 1 == nsteps);
#pragma unroll 1
        for (int sl = 0; sl < NSUB; ++sl) {
            const int sub = st * NSUB + sl;
            StageR sr_; int wr_next = 0;
            if (!lastst) { if (sub + NSUB < d.nst) { sload<D>(sr_, d, ws, sub + NSUB, tid); wr_next = 1; } }
            else if (pre) { if (sl < dn.nst) { sload<D>(sr_, dn, ws, sl, tid); wr_next = 1; } }
            if (sub < d.nst) {
                const int kb0 = d.kt0 + sub * d.ksub, kb1 = kb0 + d.koff1;
                int lo_q, hi_q;
                const int tabs = u.tbase + sub;
                if (u.moba_n >= 0 && tabs < 4 * u.moba_n) { const bool sel = (selmask >> (tabs >> 2)) & 1u; lo_q = sel ? -(1 << 28) : (1 << 28); hi_q = sel ? (1 << 28) : -(1 << 28); }
                else { lo_q = qidx - u.band; hi_q = u.causal ? qidx : (1 << 28); }
                bool any0 = __any(lo_q <= kb0 + 31 && hi_q >= kb0), any1 = __any(lo_q <= kb1 + 31 && hi_q >= kb1);
                if (u.pair) { any0 = any0 && (u.whalf == 0); any1 = any1 && (u.whalf == 1); }
#define HALF_STEP(HF, ANY, KBH) do { if (ANY) { \
                    const bool allv = __all(lo_q <= (KBH) && hi_q >= (KBH) + 31); \
                    f32x16 p; _Pragma("unroll") for (int r = 0; r < 16; ++r) p[r] = 0.f; \
                    LAS unsigned char* Kt = bufc + sl * KTB; \
                    _Pragma("unroll") for (int d0 = 0; d0 < NQ; ++d0) { const bf16x8 bk = *(const LAS bf16x8*)(Kt + kswz<D>(32 * (HF) + r32, (d0 * 16 + hi * 8) * 2)); p = __builtin_amdgcn_mfma_f32_32x32x16_bf16(bk, qr[d0], p, 0, 0, 0); } \
                    if (!allv) { _Pragma("unroll") for (int r = 0; r < 16; ++r) { const int kk = (KBH) + crow(r, hi); if (kk < lo_q || kk > hi_q) p[r] = -INFINITY; } } \
                    float pmax = p[0]; _Pragma("unroll") for (int r = 1; r < 16; ++r) pmax = fmaxf(pmax, p[r]); \
                    { auto rr = __builtin_amdgcn_permlane32_swap(__float_as_uint(pmax), __float_as_uint(pmax), false, false); pmax = fmaxf(__uint_as_float(rr[0]), __uint_as_float(rr[1])); } \
                    float alpha = 1.f; \
                    if (!__all(pmax - m_reg <= THRS)) { const float mn = fmaxf(m_reg, pmax); alpha = __builtin_amdgcn_exp2f((m_reg - mn) * C); m_reg = mn; } \
                    const float mnC = -m_reg * C; float ps = 0.f; \
                    _Pragma("unroll") for (int r = 0; r < 16; ++r) { p[r] = __builtin_amdgcn_exp2f(fmaf(p[r], C, mnC)); ps += p[r]; } \
                    { auto rr = __builtin_amdgcn_permlane32_swap(__float_as_uint(ps), __float_as_uint(ps), false, false); ps = __uint_as_float(rr[0]) + __uint_as_float(rr[1]); } \
                    l_reg = l_reg * alpha + ps; \
                    if (__any(alpha < 1.f)) { if (hi == 0) wsf[r32] = alpha; LDS_WAIT(); \
                        _Pragma("unroll") for (int dd = 0; dd < NB; ++dd) _Pragma("unroll") for (int r = 0; r < 16; ++r) o[dd][r] *= wsf[crow(r, hi)]; \
                        LDS_WAIT(); } \
                    bf16x8 paA, paB; PK4(p, 0, paA); PK4(p, 8, paB); \
                    const int vb = (int)(uintptr_t)(bufc + NSUB * KTB + sl * KTB) + v_rd_base(lane); \
                    pv_all<D, HF>(o, vb, paA, paB); } } while (0)
#define PK4(P, BASE, OUT) do { unsigned a0 = cvt_pk_bf16(P[BASE + 0], P[BASE + 1]), a1 = cvt_pk_bf16(P[BASE + 2], P[BASE + 3]);   \
    unsigned b0 = cvt_pk_bf16(P[BASE + 4], P[BASE + 5]), b1 = cvt_pk_bf16(P[BASE + 6], P[BASE + 7]);                              \
    auto r0 = __builtin_amdgcn_permlane32_swap(a0, b0, false, false); auto r1 = __builtin_amdgcn_permlane32_swap(a1, b1, false, false); \
    u32x4 w = {r0[0], r1[0], r0[1], r1[1]}; OUT = __builtin_bit_cast(bf16x8, w); } while (0)
                HALF_STEP(0, any0, kb0);
                HALF_STEP(1, any1, kb1);
#undef PK4
#undef HALF_STEP
            }
            if (wr_next) swrite<D>(sr_, bufn, sl, tid);
        }
        __syncthreads();
        pb ^= 1;
    }
    m_out = m_reg; l_out = l_reg;
}

template <int D>
__device__ __forceinline__ void attn_epi(const AE& e, int qrow_w, int pbl, unsigned char* ws, LAS unsigned char* lds, int wid, int lane, float m_reg, float l_reg, const f32x16 (&o)[D / 32]) {
    constexpr int NB = D / 32;
    constexpr float SCALE = (D == 128) ? 0.088388347648318440f : 0.125f;
    const int r32 = lane & 31, hi = lane >> 5;
    LAS float* wsf = (LAS float*)(lds + XTBL_OFF + wid * 256);
    LAS bf16_t* stg = (LAS bf16_t*)(lds + pbl * ABUF + wid * 8192);
    float lt = l_reg;
    if (e.has_sink) lt += __builtin_amdgcn_exp2f((e.sink - m_reg * SCALE) * 1.4426950408889634f);
    if (hi == 0) wsf[r32] = lt > 0.f ? __builtin_amdgcn_rcpf(lt) : 0.f;
    LDS_WAIT();
    float rli[16];
#pragma unroll
    for (int r = 0; r < 16; ++r) rli[r] = wsf[crow(r, hi)];
    LDS_WAIT();
#pragma unroll
    for (int r = 0; r < 16; ++r) { const int orow = crow(r, hi);
#pragma unroll
        for (int d0 = 0; d0 < NB; ++d0) stg[orow * D + d0 * 32 + r32] = (bf16_t)f2bf(o[d0][r] * rli[r]); }
    LDS_WAIT();
    constexpr int CPR = D / 8, RPP = 64 / CPR;
    bf16_t* OB = (bf16_t*)(ws + (e.epi ? WS_Y : WS_OG));
    const bf16_t* GB = (const bf16_t*)(ws + WS_QKV);
#pragma unroll
    for (int i = 0; i < 32 / RPP; ++i) {
        const int row = i * RPP + lane / CPR, ch = lane % CPR;
        const u32x4 v = *(const LAS u32x4*)(stg + row * D + ch * 8);
        const size_t fidx = (size_t)(qrow_w + row);
        if (e.epi == 1) {
            const u32x4 g = *(const u32x4*)(GB + (size_t)e.goff + fidx * e.gs + ch * 8);
            u32x4 w;
            w.x = cvt_pk_bf16(bflo(v.x) * bflo(g.x), bfhi(v.x) * bfhi(g.x)); w.y = cvt_pk_bf16(bflo(v.y) * bflo(g.y), bfhi(v.y) * bfhi(g.y));
            w.z = cvt_pk_bf16(bflo(v.z) * bflo(g.z), bfhi(v.z) * bfhi(g.z)); w.w = cvt_pk_bf16(bflo(v.w) * bflo(g.w), bfhi(v.w) * bfhi(g.w));
            *(u32x4*)(OB + (size_t)e.ooff + fidx * e.os + ch * 8) = w;
        } else {
            *(u32x4*)(OB + (size_t)e.ooff + fidx * e.os + ch * 8) = v;
        }
    }
    if (e.epi == 0 && hi == 0) ((float*)(ws + WS_LSE))[(size_t)e.lseoff + (size_t)(qrow_w + r32) * e.lses] = l_reg > 0.f ? m_reg * SCALE + __logf(l_reg) : -1e30f;
    LDS_WAIT();
}

#define XB_TMO      128
#define XB_XCNT(j)  (256  + 64 * (j))
#define XB_XSUB(j)  (1280 + 64 * (j))
#define XB_XGEN(j)  (2304 + 64 * (j))
#define XB_TOP      3328
#define XB_TOPGEN   3392
#define XCD_BAR_WORDS 3456
#define XB_SPIN_CAP (1u << 18)
__device__ __forceinline__ unsigned xb_ld(unsigned* p)              { return __hip_atomic_load(p, __ATOMIC_RELAXED, __HIP_MEMORY_SCOPE_AGENT); }
__device__ __forceinline__ unsigned xb_add(unsigned* p, unsigned v) { return __hip_atomic_fetch_add(p, v, __ATOMIC_RELAXED, __HIP_MEMORY_SCOPE_AGENT); }
__device__ __forceinline__ unsigned xb_xcc_id() { return (unsigned)__builtin_amdgcn_s_getreg((3 << 11) | 20) & 0xFu; }
#define XB_SPIN(cond, bar) do { unsigned _sp = 0; while (cond) { __builtin_amdgcn_s_sleep(1); \
    if ((++_sp & 255u) == 0u) { if (xb_ld(&(bar)[XB_TMO])) break; if (_sp > XB_SPIN_CAP) { atomicAdd(&(bar)[XB_TMO], 1u); break; } } } } while (0)
struct XcdBarrier { unsigned* bar; unsigned x; volatile LAS unsigned* st; };
__device__ __forceinline__ XcdBarrier xcd_barrier_post(unsigned* bar, volatile LAS unsigned* st) {
    XcdBarrier b; b.bar = bar; b.x = xb_xcc_id(); b.st = st;
    if (threadIdx.x == 0) (void)xb_add(&bar[XB_XCNT(b.x)], 1u);
    return b;
}
__device__ __forceinline__ void xcd_barrier_complete(unsigned* bar, unsigned x, unsigned& nloc, unsigned& nx) {
    const unsigned G = gridDim.x * gridDim.y * gridDim.z;
    unsigned sum, cnt, mine, sp = 0u;
    for (;;) {
        sum = 0u; cnt = 0u; mine = 0u;
#pragma unroll
        for (unsigned j = 0; j < 16; ++j) { const unsigned c = xb_ld(&bar[XB_XCNT(j)]); sum += c; cnt += (c > 0u) ? 1u : 0u; mine = (j == x) ? c : mine; }
        if (sum == G) break;
        __builtin_amdgcn_s_sleep(1);
        if ((++sp & 255u) == 0u) { if (xb_ld(&bar[XB_TMO])) break; if (sp > XB_SPIN_CAP) { atomicAdd(&bar[XB_TMO], 1u); break; } }
    }
    nloc = mine > 0u ? mine : 1u; nx = cnt > 0u ? cnt : 1u;
}
__device__ __forceinline__ void xcd_barrier(const XcdBarrier& b) {
    asm volatile("s_waitcnt vmcnt(0)" ::: "memory");
    __syncthreads();
    if (threadIdx.x == 0) {
        unsigned* bar = b.bar;
        __builtin_amdgcn_s_waitcnt(0);
        unsigned nloc = b.st[0], nx = b.st[1];
        if (nloc == 0u) { xcd_barrier_complete(bar, b.x, nloc, nx); b.st[0] = nloc; b.st[1] = nx; }
        const unsigned old = xb_add(&bar[XB_XSUB(b.x)], 1u);
        const unsigned gen = old / nloc;
        if (old + 1u == (gen + 1u) * nloc) {
            __builtin_amdgcn_fence(__ATOMIC_RELEASE, "agent");
            asm volatile("s_waitcnt vmcnt(0)" ::: "memory");
            const unsigned og = xb_add(&bar[XB_TOP], 1u);
            const unsigned tg = og / nx;
            if (og + 1u == (tg + 1u) * nx) xb_add(&bar[XB_TOPGEN], 1u);
            else XB_SPIN(xb_ld(&bar[XB_TOPGEN]) == tg, bar);
            __builtin_amdgcn_fence(__ATOMIC_ACQUIRE, "agent");
            xb_add(&bar[XB_XGEN(b.x)], 1u);
            asm volatile("s_waitcnt vmcnt(0)" ::: "memory");
        } else {
            XB_SPIN(xb_ld(&bar[XB_XGEN(b.x)]) == gen, bar);
            __builtin_amdgcn_fence(__ATOMIC_ACQUIRE, "agent");
            asm volatile("s_waitcnt vmcnt(0)" ::: "memory");
        }
    }
    __syncthreads();
}

__device__ __forceinline__ float wave_sum(float v) {
#pragma unroll
    for (int o = 1; o < 64; o <<= 1) v += __shfl_xor(v, o);
    return v;
}
__device__ __forceinline__ int phys_even(int n) {
    if (n >= 4608) return n;
    const int seg = n / 768; if (seg == 2 || seg == 5) return n;
    const int i = n & 127, hb = n - i, ii = i & 63, g = ii >> 2, e = (ii & 3) + ((i >> 6) << 2);
    return hb + 8 * g + e;
}
__device__ __forceinline__ int phys_odd(int n) {
    if (n < 1728) { const int i = n & 63, hb = n - i, ii = i & 31, g = ii >> 2, e = (ii & 3) + ((i >> 5) << 2); return hb + 8 * g + e; }
    if (n < 1920) return n + 64;
    return n + 128;
}
__device__ __forceinline__ void convert_item(const float* W, int N, const float* gk, bf16_t* WT, int mapkind, int rowoff, int item, int lane) {
    const int nblk = N / 64, kb = item / nblk, nb = item % nblk, k0 = 64 * kb, n = 64 * nb + lane;
    const int p = (mapkind == 1 ? phys_even(n) : (mapkind == 2 ? phys_odd(n) : n)) + rowoff;
    const float* src = W + (size_t)k0 * N + n;
    bf16_t* dst = WT + (size_t)p * KDIM + k0;
    float v[64];
#pragma unroll
    for (int j = 0; j < 64; ++j) v[j] = src[(size_t)j * N];
    if (gk) {
#pragma unroll
        for (int j = 0; j < 64; ++j) v[j] *= gk[k0 + j];
    }
#pragma unroll
    for (int kk = 0; kk < 8; ++kk) { u32x4 o; o.x = pk2(v[8 * kk], v[8 * kk + 1]); o.y = pk2(v[8 * kk + 2], v[8 * kk + 3]); o.z = pk2(v[8 * kk + 4], v[8 * kk + 5]); o.w = pk2(v[8 * kk + 6], v[8 * kk + 7]);
        *(u32x4*)(dst + 8 * kk) = o; }
}

struct Args {
    const float* x; const float* mem; const int* pos;
    const float* even_norm; const float* even_w_in; const float* even_w_mkv; const float* even_w_out;
    const float* odd_norm; const float* odd_w_in; const float* odd_w_mkv; const float* odd_w_out; const float* odd_sinks;
    const float* mem_norm; const float* final_norm;
    float* out; unsigned char* ws;
    int ph_lo, ph_hi;
};
constexpr int N_PHASES = 18;

constexpr int NUNITS_EVEN = 1088, NUNITS_ODD = 896;
__device__ __forceinline__ bool unit_d64(int idx, int l) { return (l & 1) && idx >= 128; }
__device__ __forceinline__ void decode_kv(int idx, int l, KVD& d) {
    d.kvsel = 0; d.kd1 = 0; d.ksub = 64; d.koff1 = 32;
    if (!(l & 1)) {
        if (idx < 384) { const int n = 7 - idx / 48, rem = idx % 48, s = rem / 24, bh = rem % 24, b = bh / 6, h = bh % 6; const int tb = b * SEQ * EVEN_N;
            d.koff = tb + 3072 + h * 128; d.voff = tb + 3840 + h * 128; d.ks = EVEN_N; d.L = SEQ; d.kt0 = 128 * (n + 1) * s; d.nst = 2 * (n + 1);
        } else if (idx < 768) { const int i = idx - 384, pat = i / 192, j = i % 192, bh = j % 24, rr = j / 24, b = bh / 6, h = bh % 6;
            const int dil = pat ? 4 : 1, res = pat ? (rr & 3) : 0, kblk = pat ? (rr >> 2) : rr; const int tb = (b * SEQ + res) * EVEN_N;
            d.koff = tb + 768 + h * 128; d.voff = tb + 1536 + h * 128; d.ks = dil * EVEN_N; d.L = SEQ / dil; d.kt0 = (256 * kblk - 128) < 0 ? 0 : (256 * kblk - 128); d.nst = (256 * kblk + 256 - d.kt0) / 64;
        } else if (idx < 896) { const int i = idx - 768, b = i / 32, hm = (i / 8) % 4;
            d.kvsel = 1; d.koff = b * MEML * 4096 + l * 1024 + hm * 128; d.voff = d.koff + 512; d.ks = 4096; d.L = MEML; d.kt0 = 0; d.nst = 4;
        } else { const int i = idx - 896, bh = i % 24, u8 = i / 24, b = bh / 6, h = bh % 6; const int tp = (b * SEQ + 2 * u8) * EVEN_N;
            d.koff = tp + 768 + h * 128; d.voff = tp + 1536 + h * 128; d.kd1 = EVEN_N; d.ks = 16 * EVEN_N; d.L = 128; d.kt0 = 0; d.nst = 4; d.ksub = 32; d.koff1 = 0;
        }
    } else {
        if (idx < 128) { const int i = idx, b = i / 32, hm = (i / 8) % 4;
            d.kvsel = 1; d.koff = b * MEML * 4096 + l * 1024 + hm * 128; d.voff = d.koff + 512; d.ks = 4096; d.L = MEML; d.kt0 = 0; d.nst = 4;
        } else { const int i = idx - 128, b = i / 192, g = (i / 64) % 3, pblk = i % 64; const int tb = b * SEQ * ODD_NP;
            d.koff = tb + 1536 + g * 64; d.voff = tb + 1792 + g * 64; d.ks = ODD_NP; d.L = SEQ; d.kt0 = (32 * pblk - 128) < 0 ? 0 : (32 * pblk - 128); d.nst = (32 * pblk + 32 - d.kt0 + 63) / 64;
        }
    }
}
__device__ __forceinline__ void decode_q(int idx, int l, int wave, AU& u) {
    u.moba_n = -1; u.band = 1 << 28; u.causal = 1; u.pair = 0; u.whalf = 0; u.kmoff = 0; u.tbase = 0;
    if (!(l & 1)) {
        if (idx < 384) { const int n = 7 - idx / 48, rem = idx % 48, s = rem / 24, bh = rem % 24, b = bh / 6, h = bh % 6;
            u.qoff = b * SEQ * EVEN_N + 2304 + h * 128; u.qs = EVEN_N; u.qrow_w = 256 * n + 32 * wave; u.moba_n = n; u.tbase = 2 * (n + 1) * s;
            u.kmoff = (l >> 1) * (4 * 6 * 8 * 128) + ((b * 6 + h) * 8) * 128;
        } else if (idx < 768) { const int i = idx - 384, pat = i / 192, j = i % 192, bh = j % 24, rr = j / 24, b = bh / 6, h = bh % 6;
            const int dil = pat ? 4 : 1, res = pat ? (rr & 3) : 0, kblk = pat ? (rr >> 2) : rr;
            u.qoff = (b * SEQ + res) * EVEN_N + h * 128; u.qs = dil * EVEN_N; u.qrow_w = 256 * kblk + 32 * wave; u.band = 128;
        } else if (idx < 896) { const int i = idx - 768, b = i / 32, hm = (i / 8) % 4, blk = i % 8;
            u.qoff = b * SEQ * EVEN_N + 4608 + hm * 128; u.qs = EVEN_N; u.qrow_w = 256 * blk + 32 * wave; u.causal = 0;
        } else { const int i = idx - 896, bh = i % 24, u8 = i / 24, b = bh / 6, h = bh % 6; const int wh = wave >> 2;
            u.qoff = (b * SEQ + 2 * u8 + wh) * EVEN_N + h * 128; u.qs = 16 * EVEN_N; u.qrow_w = 32 * (wave & 3); u.pair = 1; u.whalf = wh; u.band = 128;
        }
    } else {
        if (idx < 128) { const int i = idx, b = i / 32, hm = (i / 8) % 4, blk = i % 8;
            u.qoff = b * SEQ * ODD_NP + 2048 + hm * 128; u.qs = ODD_NP; u.qrow_w = 256 * blk + 32 * wave; u.causal = 0;
        } else { const int i = idx - 128, b = i / 192, g = (i / 64) % 3, pblk = i % 64, hq = 8 * g + wave;
            u.qoff = b * SEQ * ODD_NP + hq * 64; u.qs = ODD_NP; u.qrow_w = 32 * pblk; u.band = 127;
        }
    }
}
__device__ __forceinline__ void decode_epi(int idx, int l, int wave, const float* sinks, AE& e) {
    e.has_sink = 0; e.sink = 0.f; e.lseoff = 0; e.lses = 0; e.goff = 0; e.gs = 0;
    if (!(l & 1)) {
        if (idx < 384) { const int rem = idx % 48, s = rem / 24, bh = rem % 24, b = bh / 6, h = bh % 6; const int tok0 = b * SEQ;
            e.epi = 0; e.ooff = (3 + s) * NTOK * 768 + tok0 * 768 + h * 128; e.os = 768; e.lseoff = (3 + s) * NTOK * 6 + tok0 * 6 + h; e.lses = 6;
        } else if (idx < 768) { const int i = idx - 384, pat = i / 192, j = i % 192, bh = j % 24, rr = j / 24, b = bh / 6, h = bh % 6;
            const int dil = pat ? 4 : 1, res = pat ? (rr & 3) : 0; const int tok0 = b * SEQ + res;
            e.epi = 0; e.ooff = pat * NTOK * 768 + tok0 * 768 + h * 128; e.os = dil * 768; e.lseoff = pat * NTOK * 6 + tok0 * 6 + h; e.lses = dil * 6;
        } else if (idx < 896) { const int i = idx - 768, b = i / 32, hm = (i / 8) % 4;
            e.epi = 1; e.ooff = b * SEQ * DM + 1536 + hm * 128; e.os = DM; e.goff = b * SEQ * EVEN_N + 5120 + 1536 + hm * 128; e.gs = EVEN_N;
        } else { const int i = idx - 896, bh = i % 24, u8 = i / 24, b = bh / 6, h = bh % 6; const int tokw = b * SEQ + 2 * u8 + (wave >> 2);
            e.epi = 0; e.ooff = 2 * NTOK * 768 + tokw * 768 + h * 128; e.os = 16 * 768; e.lseoff = 2 * NTOK * 6 + tokw * 6 + h; e.lses = 16 * 6;
        }
    } else {
        if (idx < 128) { const int i = idx, b = i / 32, hm = (i / 8) % 4;
            e.epi = 1; e.ooff = b * SEQ * DM + 1536 + hm * 128; e.os = DM; e.goff = b * SEQ * ODD_NP + 2560 + 1536 + hm * 128; e.gs = ODD_NP;
        } else { const int i = idx - 128, b = i / 192, g = (i / 64) % 3, hq = 8 * g + wave;
            e.epi = 1; e.ooff = b * SEQ * DM + hq * 64; e.os = DM; e.goff = b * SEQ * ODD_NP + 2560 + hq * 64; e.gs = ODD_NP;
            e.has_sink = 1; e.sink = sinks[(l >> 1) * 24 + hq];
        }
    }
}


constexpr int I_E = 32 * (EVEN_N / 64), I_O = 32 * (ODD_N / 64), I_W = 32 * (DM / 64), I_M = 32 * (1024 / 64);
constexpr int CV_A = I_E + 4 * I_M + I_W, CV_B = CV_A + I_O, CV_C = CV_B + I_E + I_W, CV_D = CV_C + I_O + 2 * I_W;
typedef __attribute__((address_space(4))) const Args* KArgsC;
__device__ __forceinline__ void convert_stage(KArgsC ka, unsigned char* ws, int lo, int hi, int worker, int nworkers, int lane) {
    for (int it = lo + worker; it < hi; it += nworkers) {
        int r = it;
        if (r < I_E) { convert_item(ka->even_w_in, EVEN_N, ka->even_norm, (bf16_t*)(ws + WS_WIN_E0), 1, 0, r, lane); continue; } r -= I_E;
        if (r < 4 * I_M) { const int l = r / I_M; r -= l * I_M; const float* W = ((l & 1) ? ka->odd_w_mkv : ka->even_w_mkv) + (size_t)(l >> 1) * DM * 1024;
            convert_item(W, 1024, nullptr, (bf16_t*)(ws + WS_WMKV), 0, l * 1024, r, lane); continue; } r -= 4 * I_M;
        if (r < I_W) { convert_item(ka->even_w_out, DM, nullptr, (bf16_t*)(ws + WS_WOUT), 0, 0, r, lane); continue; } r -= I_W;
        if (r < I_O) { convert_item(ka->odd_w_in, ODD_N, ka->odd_norm, (bf16_t*)(ws + WS_WIN_O0), 2, 0, r, lane); continue; } r -= I_O;
        if (r < I_E) { convert_item(ka->even_w_in + (size_t)DM * EVEN_N, EVEN_N, ka->even_norm + DM, (bf16_t*)(ws + WS_WIN_E1), 1, 0, r, lane); continue; } r -= I_E;
        if (r < I_W) { convert_item(ka->odd_w_out, DM, nullptr, (bf16_t*)(ws + WS_WOUT + (size_t)1 * 8 * MiB), 0, 0, r, lane); continue; } r -= I_W;
        if (r < I_O) { convert_item(ka->odd_w_in + (size_t)DM * ODD_N, ODD_N, ka->odd_norm + DM, (bf16_t*)(ws + WS_WIN_O1), 2, 0, r, lane); continue; } r -= I_O;
        { const int l = 2 + r / I_W; r -= (l - 2) * I_W; const float* W = ((l & 1) ? ka->odd_w_out : ka->even_w_out) + (size_t)(l >> 1) * DM * DM;
          convert_item(W, DM, nullptr, (bf16_t*)(ws + WS_WOUT + (size_t)l * 8 * MiB), 0, 0, r, lane); }
    }
}

}

typedef __attribute__((address_space(4))) const Args* KArgs;
#define LAUNDER_S(p) asm volatile("" : "+s"(p))

__global__ void __launch_bounds__(NWAVES * 64, 2) fwd_kernel(Args args_unused) {
    extern __shared__ __attribute__((aligned(16))) unsigned char lds_raw[];
    LAS unsigned char* lds = (LAS unsigned char*)lds_raw;
    volatile LAS unsigned* MISC = (volatile LAS unsigned*)(lds + MISC_OFF);
    const int tid0 = threadIdx.x;
    const int G = gridDim.x; const int bx = blockIdx.x; const int vcu = (G % 8 == 0) ? (bx % 8) * (G / 8) + bx / 8 : bx;
    const KArgs ka0 = (KArgs)__builtin_amdgcn_kernarg_segment_ptr();
    for (int i = tid0; i < (LDS_BYTES - LDSCTL_OFF) / 4; i += NWAVES * 64) ((LAS unsigned*)(lds + LDSCTL_OFF))[i] = 0u;
    __syncthreads();
    XcdBarrier bar; { unsigned char* ws0 = ka0->ws; bar.bar = (unsigned*)(ws0 + WS_CTL) + CW_BAR; bar.x = 0; bar.st = nullptr;
        if (!MK_PER_PHASE) bar = xcd_barrier_post((unsigned*)(ws0 + WS_CTL) + CW_BAR, MISC + 8); }
    const int ph_lo = ka0->ph_lo, ph_hi = ka0->ph_hi;

    unsigned long long tp_acc = 0ull;
    for (int ph = ph_lo; ph < ph_hi; ++ph) {
        unsigned long long tp_t0 = 0ull; if (TPROBE_MASK) tp_t0 = __builtin_amdgcn_s_memrealtime();
        int tid = tid0; asm volatile("" : "+v"(tid));
        const int lane = tid & 63, wave = __builtin_amdgcn_readfirstlane(tid >> 6);
        KArgs ka = ka0; LAUNDER_S(ka);
        unsigned char* ws = ka->ws;
        if (ph == 0 && (AN_MASK & 1)) {
            const int gw = vcu * NWAVES + wave, NGW = G * NWAVES;
            convert_stage(ka, ws, 0, CV_A, gw, NGW, lane);
            bf16_t* XB = (bf16_t*)(ws + WS_XB); bf16_t* MEMN = (bf16_t*)(ws + WS_MEMN); float* SSQ = (float*)(ws + WS_SSQ);
            const float* xin = ka->x; const float* memin = ka->mem; const float* mnorm = ka->mem_norm;
            for (int m = gw; m < NTOK + NMEM; m += NGW) {
                const bool isx = m < NTOK; const int row = isx ? m : m - NTOK;
                const f32x4* xr = (const f32x4*)((isx ? xin : memin) + (size_t)row * DM) + lane;
                f32x4 v[8]; float s = 0.f;
#pragma unroll
                for (int j = 0; j < 8; ++j) { v[j] = xr[64 * j]; s += (v[j].x * v[j].x + v[j].y * v[j].y) + (v[j].z * v[j].z + v[j].w * v[j].w); }
                s = wave_sum(s);
                unsigned long long* o8 = (unsigned long long*)((isx ? XB : MEMN) + (size_t)row * DM) + lane;
                if (isx) {
                    if (lane < 8) SSQ[(size_t)lane * NTOK + row] = lane == 0 ? s : 0.f;
#pragma unroll
                    for (int j = 0; j < 8; ++j) o8[64 * j] = (unsigned long long)pk2(v[j].x, v[j].y) | ((unsigned long long)pk2(v[j].z, v[j].w) << 32);
                } else {
                    const float rs = 1.0f / sqrtf(s * (1.0f / DM) + EPS);
                    const f32x4* gr = (const f32x4*)mnorm + lane;
#pragma unroll
                    for (int j = 0; j < 8; ++j) { const f32x4 g = gr[64 * j]; o8[64 * j] = (unsigned long long)pk2(v[j].x * rs * g.x, v[j].y * rs * g.y) | ((unsigned long long)pk2(v[j].z * rs * g.z, v[j].w * rs * g.w) << 32); }
                }
            }
            float* CS128 = (float*)(ws + WS_CS128); float* CS64 = (float*)(ws + WS_CS64); const int* posp = ka->pos;
            for (int tk = gw; tk < NTOK; tk += NGW) {
                const float pf = (float)posp[tk];
                { const float inv = expf((float)lane * (float)(-2.0 * 9.210340371976184 / 128.0)); const float ang = pf * inv;
                  const double rev = (double)ang * 0.15915494309189535; const float fr = (float)(rev - rint(rev));
                  CS128[(size_t)tk * 128 + lane] = __builtin_amdgcn_cosf(fr); CS128[(size_t)tk * 128 + 64 + lane] = __builtin_amdgcn_sinf(fr); }
                if (lane < 32) { const float inv = expf((float)lane * (float)(-2.0 * 9.210340371976184 / 64.0)); const float ang = pf * inv;
                  const double rev = (double)ang * 0.15915494309189535; const float fr = (float)(rev - rint(rev));
                  CS64[(size_t)tk * 64 + lane] = __builtin_amdgcn_cosf(fr); CS64[(size_t)tk * 64 + 32 + lane] = __builtin_amdgcn_sinf(fr); }
            }
        } else if (ph == 17 && (AN_MASK & 2)) {
            const int gw = vcu * NWAVES + wave, NGW = G * NWAVES;
            const float* ssq = (const float*)(ws + WS_SSQ) + (size_t)4 * 8 * NTOK; float* outp = ka->out; const float* fnorm = ka->final_norm;
            for (int m = gw; m < NTOK; m += NGW) {
                float sq = 0.f;
#pragma unroll
                for (int j = 0; j < 8; ++j) sq += ssq[(size_t)j * NTOK + m];
                const float rs = 1.0f / sqrtf(sq * (1.0f / DM) + EPS);
                f32x4* xr = (f32x4*)(outp + (size_t)m * DM) + lane; const f32x4* gr = (const f32x4*)fnorm + lane;
#pragma unroll
                for (int j = 0; j < 8; ++j) { f32x4 v = xr[64 * j]; const f32x4 g = gr[64 * j]; v = v * rs * g; xr[64 * j] = v; }
            }
        } else if (ph >= 1 && ph <= 16) {
            const int l = (ph - 1) >> 2, sub = (ph - 1) & 3, odd = l & 1, li = l >> 1;
            if ((sub == 0 && (AN_MASK & 4)) || (sub == 3 && (AN_MASK & 8))) {
                GemmP P; P.ws = ws; P.l = l; P.xin = ka->x; P.out = ka->out; P.lds = lds;
                Order S; S.G = G; S.c = bx; S.nM0 = NTOK / 256;
                if (sub == 0) { P.mode = EM_INPROJ; P.A = (const bf16_t*)(ws + WS_XB); P.Bt = (const bf16_t*)(ws + (odd ? (li ? WS_WIN_O1 : WS_WIN_O0) : (li ? WS_WIN_E1 : WS_WIN_E0)));
                    S.nN0 = (odd ? ODD_NP : EVEN_N) / 256; S.nwg1 = (l == 0) ? 64 : 0; }
                else { P.mode = EM_OUTPROJ; P.A = (const bf16_t*)(ws + WS_Y); P.Bt = (const bf16_t*)(ws + WS_WOUT + (size_t)l * 8 * MiB); S.nN0 = DM / 256; S.nwg1 = 0; }
                S.nwg0 = S.nM0 * S.nN0;
                gemm_phase(lds, P, S, tid);
                if (sub == 0 && l < 3) {
                    const int nwg = S.nwg0 + S.nwg1, TT = nwg % G, lo = l == 0 ? CV_A : (l == 1 ? CV_B : CV_C), hi = l == 0 ? CV_B : (l == 1 ? CV_C : CV_D);
                    if (TT == 0) convert_stage(ka, ws, lo, hi, bx * NWAVES + wave, G * NWAVES, lane);
                    else if (bx >= TT) convert_stage(ka, ws, lo, hi, (bx - TT) * NWAVES + wave, (G - TT) * NWAVES, lane);
                }
            } else if (sub == 2 && (AN_MASK & 16)) {
                if (!odd) {
                    const float* LSE = (const float*)(ws + WS_LSE); const bf16_t* OG = (const bf16_t*)(ws + WS_OG); const bf16_t* QKV = (const bf16_t*)(ws + WS_QKV); bf16_t* Y = (bf16_t*)(ws + WS_Y);
                    const long NIT = (long)NTOK * 192;
                    for (long it = (long)bx * 512 + tid; it < NIT; it += (long)G * 512) {
                        const int tok = (int)(it / 192), c = (int)(it % 192), isb = c >= 96, cc8 = (isb ? c - 96 : c), h = cc8 >> 4;
                        const int g0 = isb ? 3 : 0;
                        const size_t lb = (size_t)tok * 6 + h, ob = (size_t)tok * 768 + cc8 * 8;
                        const float l0 = LSE[(size_t)g0 * NTOK * 6 + lb], l1 = LSE[(size_t)(g0 + 1) * NTOK * 6 + lb], l2 = isb ? -1e30f : LSE[(size_t)2 * NTOK * 6 + lb];
                        const float mx = fmaxf(l0, fmaxf(l1, l2));
                        float w0 = __expf(l0 - mx), w1 = __expf(l1 - mx), w2 = isb ? 0.f : __expf(l2 - mx); const float inv = 1.0f / (w0 + w1 + w2); w0 *= inv; w1 *= inv; w2 *= inv;
                        const u32x4 a = *(const u32x4*)(OG + (size_t)g0 * NTOK * 768 + ob), b = *(const u32x4*)(OG + (size_t)(g0 + 1) * NTOK * 768 + ob);
                        u32x4 cc = {0u, 0u, 0u, 0u}; if (!isb) cc = *(const u32x4*)(OG + (size_t)2 * NTOK * 768 + ob);
                        const u32x4 g = *(const u32x4*)(QKV + (size_t)tok * EVEN_N + 5120 + c * 8);
                        u32x4 o;
#define CMB(f) cvt_pk_bf16((w0 * bflo(a.f) + w1 * bflo(b.f) + w2 * bflo(cc.f)) * bflo(g.f), (w0 * bfhi(a.f) + w1 * bfhi(b.f) + w2 * bfhi(cc.f)) * bfhi(g.f))
                        o.x = CMB(x); o.y = CMB(y); o.z = CMB(z); o.w = CMB(w);
#undef CMB
                        *(u32x4*)(Y + (size_t)tok * DM + c * 8) = o;
                    }
                }
            } else if (sub == 1 && (AN_MASK & 32)) {
                gu32* qctr = (gu32*)(ws + WS_CTL) + CW_Q + 64 * l;
                const int NUNITS = odd ? NUNITS_ODD : NUNITS_EVEN;
                if (tid == 0) { MISC[16] = __hip_atomic_fetch_add(qctr, 1u, RLX_AGENT); MISC[17] = __hip_atomic_fetch_add(qctr, 1u, RLX_AGENT); }
                __syncthreads();
                int idx = (int)MISC[16], idx1 = (int)MISC[17];
                int it = 0, pb = 0; bool warm = false;
                while (idx < NUNITS) {
                    idx = __builtin_amdgcn_readfirstlane(idx); idx1 = __builtin_amdgcn_readfirstlane(idx1);
                    int tid_u = tid; asm volatile("" : "+v"(tid_u)); const int lane_u = tid_u & 63;
                    unsigned nx2 = 0; if (tid == 0) nx2 = __hip_atomic_fetch_add(qctr, 1u, RLX_AGENT);
                    const bool d64 = unit_d64(idx, l);
                    const int pre = (idx1 < NUNITS && unit_d64(idx1, l) == d64) ? 1 : 0;
                    KVD d, dn; decode_kv(idx, l, d); decode_kv(pre ? idx1 : idx, l, dn);
                    AU u; decode_q(idx, l, wave, u);
                    float m_reg, l_reg;
                    if (d64) { if (!warm) cold_start<64>(d, ws, lds + pb * ABUF, tid_u);
                        f32x16 o[2]; attn_main<64>(u, d, dn, pre, pb, ws, lds, tid_u, wave, lane_u, m_reg, l_reg, o);
                        int idx2 = idx; LAUNDER_S(idx2); AE e; decode_epi(idx2, l, wave, ka->odd_sinks, e); attn_epi<64>(e, u.qrow_w, pb ^ 1, ws, lds, wave, lane_u, m_reg, l_reg, o); }
                    else { if (!warm) cold_start<128>(d, ws, lds + pb * ABUF, tid_u);
                        f32x16 o[4]; attn_main<128>(u, d, dn, pre, pb, ws, lds, tid_u, wave, lane_u, m_reg, l_reg, o);
                        int idx2 = idx; LAUNDER_S(idx2); AE e; decode_epi(idx2, l, wave, ka->odd_sinks, e); attn_epi<128>(e, u.qrow_w, pb ^ 1, ws, lds, wave, lane_u, m_reg, l_reg, o); }
                    warm = pre != 0;
                    if (tid == 0) MISC[18 + (it & 1)] = nx2;
                    __syncthreads();
                    idx = idx1; idx1 = (int)MISC[18 + (it & 1)]; ++it;
                }
            }
        }
        if (ph + 1 < ph_hi) { if (!(ph >= 1 && ph <= 16 && ((ph - 1) & 3) == 2 && (((ph - 1) >> 2) & 1))) xcd_barrier(bar); }
        if (TPROBE_MASK) { if ((TPROBE_MASK >> ph) & 1) tp_acc += __builtin_amdgcn_s_memrealtime() - tp_t0; }
    }
    if (TPROBE_MASK) { if (bx == 0) { const unsigned long long te = __builtin_amdgcn_s_memrealtime(); while (__builtin_amdgcn_s_memrealtime() - te < 4ull * tp_acc) __builtin_amdgcn_s_sleep(8); } }
}

extern "C" void kernel_launch(void* const* d_in, const int* in_sizes, int n_in, void* d_out, int out_size, void* d_ws, size_t ws_size, hipStream_t stream) {
    static int grid = 0;
    if (grid == 0) {
        if (n_in != 14 || in_sizes[0] != NTOK * DM || out_size != NTOK * DM || ws_size < WS_END) { fprintf(stderr, "kernel_launch: unexpected shapes (n_in %d, in0 %d, out %d, ws %zu)\n", n_in, n_in > 0 ? in_sizes[0] : -1, out_size, ws_size); grid = -1; return; }
        int dev = 0, cus = 0, per_cu = 0;
        if (hipGetDevice(&dev) != hipSuccess || hipDeviceGetAttribute(&cus, hipDeviceAttributeMultiprocessorCount, dev) != hipSuccess) { grid = -1; return; }
        if (hipFuncSetAttribute((const void*)fwd_kernel, hipFuncAttributeMaxDynamicSharedMemorySize, LDS_BYTES) != hipSuccess) { fprintf(stderr, "kernel_launch: hipFuncSetAttribute failed\n"); grid = -1; return; }
        if (hipOccupancyMaxActiveBlocksPerMultiprocessor(&per_cu, (const void*)fwd_kernel, NWAVES * 64, LDS_BYTES) != hipSuccess || per_cu < 1) { fprintf(stderr, "kernel_launch: occupancy query says %d blocks/CU\n", per_cu); }
        (void)hipGetLastError();
        grid = cus;
    }
    if (grid < 0) return;
    (void)hipMemsetAsync((char*)d_ws + WS_CTL, 0, CTL_ZERO_BYTES, stream);
    Args a{};
    a.x = (const float*)d_in[0]; a.mem = (const float*)d_in[1]; a.pos = (const int*)d_in[2];
    a.even_norm = (const float*)d_in[3]; a.even_w_in = (const float*)d_in[4]; a.even_w_mkv = (const float*)d_in[5]; a.even_w_out = (const float*)d_in[6];
    a.odd_norm = (const float*)d_in[7]; a.odd_w_in = (const float*)d_in[8]; a.odd_w_mkv = (const float*)d_in[9]; a.odd_w_out = (const float*)d_in[10]; a.odd_sinks = (const float*)d_in[11];
    a.mem_norm = (const float*)d_in[12]; a.final_norm = (const float*)d_in[13];
    a.out = (float*)d_out; a.ws = (unsigned char*)d_ws;
#if MK_PER_PHASE
    for (int ph = 0; ph < N_PHASES; ++ph) { a.ph_lo = ph; a.ph_hi = ph + 1; hipLaunchKernelGGL(fwd_kernel, dim3(grid), dim3(NWAVES * 64), LDS_BYTES, stream, a); }
#else
    a.ph_lo = 0; a.ph_hi = N_PHASES;
    hipLaunchKernelGGL(fwd_kernel, dim3(grid), dim3(NWAVES * 64), LDS_BYTES, stream, a);
#ifdef PROBE_PHASES
    {
        const int pp[] = PROBE_PHASES;
        (void)hipMemsetAsync((char*)d_ws + WS_CTL + (size_t)CW_Q * 4, 0, 64 * 8 * 4, stream);
        for (unsigned i = 0; i < sizeof(pp) / sizeof(pp[0]); ++i) { a.ph_lo = pp[i]; a.ph_hi = pp[i] + 1; hipLaunchKernelGGL(fwd_kernel, dim3(grid), dim3(NWAVES * 64), LDS_BYTES, stream, a); }
    }
#endif
#endif
    const hipError_t le = hipPeekAtLastError();
    if (le != hipSuccess) fprintf(stderr, "kernel_launch: launch failed: %s\n", hipGetErrorName(le));
}
```

```cpp
#include <hip/hip_runtime.h>
#include <cstdio>
#include <cstdint>

#ifndef TPROBE_MASK
#define TPROBE_MASK 0
#endif
#ifndef AN_MASK
#define AN_MASK 63
#endif
#ifndef MK_PER_PHASE
#define MK_PER_PHASE 0
#endif

namespace {
#define LAS __attribute__((address_space(3)))
#define GAS __attribute__((address_space(1)))
typedef unsigned short bf16_t;
typedef short bf16x8 __attribute__((ext_vector_type(8)));
typedef short s16x4 __attribute__((ext_vector_type(4)));
typedef float f32x4 __attribute__((ext_vector_type(4)));
typedef float f32x16 __attribute__((ext_vector_type(16)));
typedef unsigned u32x4 __attribute__((ext_vector_type(4)));
typedef GAS unsigned gu32;
#define RLX_AGENT __ATOMIC_RELAXED, __HIP_MEMORY_SCOPE_AGENT
#define LDS_WAIT() asm volatile("s_waitcnt lgkmcnt(0)" ::: "memory")
#define VM_WAIT() asm volatile("s_waitcnt vmcnt(0)" ::: "memory")
#define SBAR() __builtin_amdgcn_sched_barrier(0)

constexpr int BATCH = 4, SEQ = 2048, DM = 2048, NTOK = BATCH * SEQ, MEML = 256, NMEM = BATCH * MEML;
constexpr int EVEN_N = 7168, ODD_N = 4480, ODD_NP = 4608;
constexpr int KDIM = 2048;
constexpr float EPS = 1e-6f;
constexpr int NWAVES = 8;

constexpr size_t MiB = 1u << 20;
constexpr size_t WS_CTL = 0, CTL_ZERO_BYTES = 1 * MiB;
constexpr size_t WS_WIN_E0 = 1 * MiB, WS_WIN_E1 = 29 * MiB, WS_WIN_O0 = 57 * MiB, WS_WIN_O1 = 75 * MiB;
constexpr size_t WS_WOUT = 93 * MiB;
constexpr size_t WS_WMKV = 125 * MiB;
constexpr size_t WS_XB = 141 * MiB;
constexpr size_t WS_QKV = 173 * MiB;
constexpr size_t WS_Y = 285 * MiB;
constexpr size_t WS_OG = 374 * MiB;
constexpr size_t WS_LSE = 353 * MiB;
constexpr size_t WS_MKV = 354 * MiB;
constexpr size_t WS_MEMN = 362 * MiB;
constexpr size_t WS_CS128 = 366 * MiB;
constexpr size_t WS_CS64 = 370 * MiB;
constexpr size_t WS_SSQ = 372 * MiB;
constexpr size_t WS_END = 438 * MiB;
constexpr int CW_BAR = 4096;
constexpr int CW_SSQ = 16384;
constexpr int CW_KM = 65536;
constexpr int CW_Q = 131072;
constexpr int CW_PAN = 135168;
static_assert((CW_PAN + 64 * 32) * 4 <= (int)CTL_ZERO_BYTES, "ctl");

constexpr int RING_BYTES = 131072;
constexpr int LDSCTL_OFF = RING_BYTES, MISC_OFF = LDSCTL_OFF + 320;
constexpr int LDS_BYTES = 147456;
constexpr int XTBL_OFF = LDSCTL_OFF + 1024;

__device__ __forceinline__ unsigned f2bf(float f) { unsigned u = __builtin_bit_cast(unsigned, f); return (u + 0x7fffu + ((u >> 16) & 1u)) >> 16; }
typedef float f32x2_t __attribute__((ext_vector_type(2))); typedef __bf16 bf16x2_t __attribute__((ext_vector_type(2)));
__device__ __forceinline__ unsigned pk2(float lo, float hi) { f32x2_t v = {lo, hi}; bf16x2_t b = __builtin_convertvector(v, bf16x2_t); return __builtin_bit_cast(unsigned, b); }
__device__ __forceinline__ unsigned cvt_pk_bf16(float lo, float hi) { unsigned r; asm volatile("v_cvt_pk_bf16_f32 %0, %1, %2" : "=v"(r) : "v"(lo), "v"(hi)); return r; }
__device__ __forceinline__ float bflo(unsigned w) { return __builtin_bit_cast(float, w << 16); }
__device__ __forceinline__ float bfhi(unsigned w) { return __builtin_bit_cast(float, w & 0xffff0000u); }

constexpr int BM = 256, BK = 64, HALF = 128, HTB = HALF * BK * 2, NXCD = 8, WGM = 8;
__device__ __forceinline__ int lds_byte(int r, int c) { const int st = (r >> 4) * 2 + (c >> 5), rr = r & 15, cc = c & 31, ob = rr * 64 + cc * 2; return st * 1024 + (ob ^ (((ob >> 9) & 1) << 5)); }
__device__ __forceinline__ void stage_rc(int b, int& R, int& C) { const int st = b / 1024, sb = b % 1024, swz = sb ^ (((sb >> 9) & 1) << 5); R = (st >> 1) * 16 + swz / 64; C = (st & 1) * 32 + (swz % 64) / 2; }
__device__ __forceinline__ int perm32(int rho) { const int n = rho >> 4, i = rho & 15; return 8 * (i >> 2) + 4 * n + (i & 3); }

struct Unit { int pm, pn, s; };
enum { EM_PLAIN = 0, EM_INPROJ = 1, EM_OUTPROJ = 2 };
struct GemmP { const bf16_t* A; const bf16_t* Bt; int mode, l; unsigned char* ws; const float* xin; float* out; LAS unsigned char* lds; const float* fnorm; int fuse_final; };
__device__ __forceinline__ void tile_of(int wgid, int nM, int nN, int& pm, int& pn) {
    const int nwg = nM * nN; { const int q = nwg / NXCD, r = nwg % NXCD, xcd = wgid % NXCD, off = wgid / NXCD; wgid = (xcd < r ? xcd * (q + 1) : r * (q + 1) + (xcd - r) * q) + off; }
    const int nig = WGM * nN, gid = wgid / nig, fm = gid * WGM, gsz = (nM - fm) < WGM ? (nM - fm) : WGM;
    pm = fm + ((wgid % nig) % gsz); pn = (wgid % nig) / gsz;
}
struct Order {
    int nwg0, nwg1, nM0, nN0, G, c;
    __device__ __forceinline__ bool next(int i, Unit& u) const {
        const int L = i * G + c; if (L >= nwg0 + nwg1) return false;
        if (L < nwg0) { u.s = 0; tile_of(L, nM0, nN0, u.pm, u.pn); } else { u.s = 1; tile_of(L - nwg0, 4, 16, u.pm, u.pn); }
        return true;
    }
};

__device__ __forceinline__ void epi_run(const GemmP& P, const f32x4 (&acc)[2][2][4][2], const Unit& u, int wr, int wc, int fr, int fq) {
    const int row0 = u.pm * BM + wr * 64 + fr;
    const int colt = u.pn * BM + wc * 32 + 8 * fq;
    const int mode = u.s ? EM_PLAIN : P.mode;
    unsigned char* ws = P.ws;
    if (mode == EM_PLAIN) {
        bf16_t* O = (bf16_t*)(ws + WS_MKV);
#pragma unroll
        for (int ai = 0; ai < 2; ++ai)
#pragma unroll
            for (int m = 0; m < 4; ++m) { bf16_t* rowp = O + (size_t)(row0 + ai * HALF + m * 16) * 4096 + colt;
#pragma unroll
                for (int bj = 0; bj < 2; ++bj) { const f32x4 v0 = acc[ai][bj][m][0], v1 = acc[ai][bj][m][1];
                    u32x4 w; w.x = cvt_pk_bf16(v0[0], v0[1]); w.y = cvt_pk_bf16(v0[2], v0[3]); w.z = cvt_pk_bf16(v1[0], v1[1]); w.w = cvt_pk_bf16(v1[2], v1[3]);
                    *(u32x4*)(rowp + bj * HALF) = w; } }
    } else if (mode == EM_INPROJ) {
        const int l = P.l, odd = l & 1, ldo = odd ? ODD_NP : EVEN_N;
        bf16_t* O = (bf16_t*)(ws + WS_QKV);
        const float* cs128 = (const float*)(ws + WS_CS128); const float* cs64 = (const float*)(ws + WS_CS64);
        float* km = (float*)(ws + WS_CTL) + CW_KM + (size_t)(l >> 1) * (4 * 6 * 8 * 128);
        int kind; bool kmean = false;
        if (odd) { kind = (u.pn <= 6) ? 2 : (u.pn <= 9 ? 0 : 3); }
        else { kind = (u.pn < 6) ? 1 : (u.pn < 9 ? 0 : (u.pn < 15 ? 1 : (u.pn < 20 ? 0 : 3))); kmean = (u.pn >= 12 && u.pn < 15); }
        float ks[2][8];
#pragma unroll
        for (int bj = 0; bj < 2; ++bj)
#pragma unroll
            for (int e = 0; e < 8; ++e) ks[bj][e] = 0.f;
        f32x4 csA[8], snA[8];
#define EPI_TLOAD(I0) do { if (kind == 1) { _Pragma("unroll") for (int i = (I0); i < (I0) + 4; ++i) { const float* t = cs128 + (size_t)(row0 + (i >> 2) * HALF + (i & 3) * 16) * 128 + (16 * wc + 4 * fq); csA[i] = *(const f32x4*)t; snA[i] = *(const f32x4*)(t + 64); } } \
        else if (kind == 2) { _Pragma("unroll") for (int i = (I0); i < (I0) + 4; ++i) { const float* t = cs64 + (size_t)(row0 + (i >> 2) * HALF + (i & 3) * 16) * 64 + (16 * (wc & 1) + 4 * fq); csA[i] = *(const f32x4*)t; snA[i] = *(const f32x4*)(t + 32); } } \
        else { _Pragma("unroll") for (int i = (I0); i < (I0) + 4; ++i) { csA[i] = (f32x4){1.f, 1.f, 1.f, 1.f}; snA[i] = (f32x4){0.f, 0.f, 0.f, 0.f}; } } } while (0)
        EPI_TLOAD(0);
        { const int te = (wr * 4 + wc) * 64 + fq * 16 + fr;
          if (te < 256) { const float* sb = (const float*)(ws + WS_SSQ) + (size_t)l * 8 * NTOK + u.pm * BM; float t8[8];
#pragma unroll
              for (int j = 0; j < 8; ++j) { const float* sj = sb + (size_t)j * NTOK; t8[j] = sj[te]; }
              const float sq = ((t8[0] + t8[1]) + (t8[2] + t8[3])) + ((t8[4] + t8[5]) + (t8[6] + t8[7]));
              ((LAS float*)(P.lds + XTBL_OFF))[te] = __builtin_amdgcn_rsqf(sq * (1.0f / DM) + EPS); }
          LDS_WAIT(); __builtin_amdgcn_s_barrier(); asm volatile("" ::: "memory"); }
        const LAS float* rst = (const LAS float*)(P.lds + XTBL_OFF);
#pragma unroll
        for (int ai = 0; ai < 2; ++ai) {
#pragma unroll
            for (int m = 0; m < 4; ++m) {
                if (ai == 0 && m == 3) { asm volatile("" ::: "memory"); EPI_TLOAD(4); }
                const int row = row0 + ai * HALF + m * 16;
                const float rs = rst[ai * HALF + wr * 64 + m * 16 + fr];
                const f32x4 cs = csA[ai * 4 + m], sn = snA[ai * 4 + m];
                bf16_t* rowp = O + (size_t)row * ldo + colt;
#pragma unroll
                for (int bj = 0; bj < 2; ++bj) {
                    f32x4 v0 = acc[ai][bj][m][0] * rs, v1 = acc[ai][bj][m][1] * rs;
                    if (kind == 1 || kind == 2) { const f32x4 o0 = v0 * cs - v1 * sn, o1 = v1 * cs + v0 * sn; v0 = o0; v1 = o1; }
                    else if (kind == 3) {
#pragma unroll
                        for (int j = 0; j < 4; ++j) { v0[j] = v0[j] * __builtin_amdgcn_rcpf(1.0f + __builtin_amdgcn_exp2f(-1.4426950408889634f * v0[j]));
                                                      v1[j] = v1[j] * __builtin_amdgcn_rcpf(1.0f + __builtin_amdgcn_exp2f(-1.4426950408889634f * v1[j])); }
                    }
                    if (kmean) {
#pragma unroll
                        for (int j = 0; j < 4; ++j) { ks[bj][j] += v0[j]; ks[bj][4 + j] += v1[j]; }
                    }
                    u32x4 w; w.x = cvt_pk_bf16(v0[0], v0[1]); w.y = cvt_pk_bf16(v0[2], v0[3]); w.z = cvt_pk_bf16(v1[0], v1[1]); w.w = cvt_pk_bf16(v1[2], v1[3]);
                    *(u32x4*)(rowp + bj * HALF) = w;
                }
            }
        }
#undef EPI_TLOAD
        if (kmean) {
#pragma unroll
            for (int bj = 0; bj < 2; ++bj)
#pragma unroll
                for (int e = 0; e < 8; ++e) { float s = ks[bj][e]; s += __shfl_xor(s, 1); s += __shfl_xor(s, 2); s += __shfl_xor(s, 4); s += __shfl_xor(s, 8); ks[bj][e] = s; }
            if (fr == 0) {
                const int b = u.pm >> 3, n = u.pm & 7;
#pragma unroll
                for (int bj = 0; bj < 2; ++bj) { const int h = (u.pn - 12) * 2 + bj; float* dst = km + ((size_t)((b * 6 + h) * 8 + n)) * 128 + wc * 32 + 8 * fq;
#pragma unroll
                    for (int e = 0; e < 8; ++e) atomicAdd(dst + e, ks[bj][e]); }
            }
        }
    } else {
        const int l = P.l;
        float* xout = P.out;
        bf16_t* xb = (bf16_t*)(ws + WS_XB); const bool wxb = (l != 3);
        const bool fuse = (l == 3) && P.fuse_final;
        float* ssq_out = (float*)(ws + WS_SSQ) + (size_t)(l + 1) * 8 * NTOK + (size_t)u.pn * NTOK + u.pm * BM;
        LAS float* xt = (LAS float*)(P.lds + XTBL_OFF);
#pragma unroll
        for (int ai = 0; ai < 2; ++ai)
#pragma unroll
            for (int m = 0; m < 4; ++m) {
                const int row = row0 + ai * HALF + m * 16; float ss = 0.f;
#pragma unroll
                for (int bj = 0; bj < 2; ++bj) {
                    const size_t off = (size_t)row * DM + colt + bj * HALF;
                    const f32x4 v0 = acc[ai][bj][m][0], v1 = acc[ai][bj][m][1];
                    if (!fuse) { *(f32x4*)(xout + off) = v0; *(f32x4*)(xout + off + 4) = v1; }
                    if (wxb) { u32x4 w; w.x = cvt_pk_bf16(v0[0], v0[1]); w.y = cvt_pk_bf16(v0[2], v0[3]); w.z = cvt_pk_bf16(v1[0], v1[1]); w.w = cvt_pk_bf16(v1[2], v1[3]); *(u32x4*)(xb + off) = w; }
                    ss += (v0[0] * v0[0] + v0[1] * v0[1]) + (v0[2] * v0[2] + v0[3] * v0[3]) + (v1[0] * v1[0] + v1[1] * v1[1]) + (v1[2] * v1[2] + v1[3] * v1[3]);
                }
                ss += __shfl_xor(ss, 16); ss += __shfl_xor(ss, 32);
                if (fq == 0) xt[(ai * HALF + wr * 64 + m * 16 + fr) * 4 + wc] = ss;
            }
        LDS_WAIT(); __builtin_amdgcn_s_barrier(); asm volatile("" ::: "memory");
        const int lane = fq * 16 + fr, wid = wr * 4 + wc, r = wid * 32 + (lane & 31);
        if (!fuse) {
            if (lane < 32) { const f32x4 t = *(const LAS f32x4*)(xt + r * 4); ssq_out[r] = (t[0] + t[1]) + (t[2] + t[3]); }
        } else {
            if (lane < 32) { const f32x4 t = *(const LAS f32x4*)(xt + r * 4); __hip_atomic_store((unsigned*)(ssq_out + r), __float_as_uint((t[0] + t[1]) + (t[2] + t[3])), __ATOMIC_RELAXED, __HIP_MEMORY_SCOPE_AGENT); }
            asm volatile("s_waitcnt vmcnt(0)" ::: "memory"); LDS_WAIT();
            __builtin_amdgcn_s_barrier(); asm volatile("" ::: "memory");
            unsigned* pcnt = (unsigned*)(ws + WS_CTL) + CW_PAN + 64 * u.pm;
            if (wid == 0 && lane == 0) {
                __hip_atomic_fetch_add(pcnt, 1u, __ATOMIC_RELAXED, __HIP_MEMORY_SCOPE_AGENT);
                unsigned sp = 0; while (__hip_atomic_load(pcnt, __ATOMIC_RELAXED, __HIP_MEMORY_SCOPE_AGENT) < 8u) { __builtin_amdgcn_s_sleep(2); if (++sp > (1u << 22)) break; }
                __builtin_amdgcn_fence(__ATOMIC_ACQUIRE, "agent"); asm volatile("s_waitcnt vmcnt(0)" ::: "memory");
            }
            __builtin_amdgcn_s_barrier(); asm volatile("" ::: "memory");
            { const int te = wid * 64 + lane;
              if (te < 256) { const unsigned* sb = (const unsigned*)((const float*)(ws + WS_SSQ) + (size_t)4 * 8 * NTOK + u.pm * BM + te); float sq = 0.f;
#pragma unroll
                  for (int j = 0; j < 8; ++j) sq += __uint_as_float(__hip_atomic_load(sb + (size_t)j * NTOK, __ATOMIC_RELAXED, __HIP_MEMORY_SCOPE_AGENT));
                  xt[te] = 1.0f / sqrtf(sq * (1.0f / DM) + EPS); }
              LDS_WAIT(); __builtin_amdgcn_s_barrier(); asm volatile("" ::: "memory"); }
#pragma unroll
            for (int bj = 0; bj < 2; ++bj) {
                const f32x4 g0 = *(const f32x4*)(P.fnorm + colt + bj * HALF), g1 = *(const f32x4*)(P.fnorm + colt + bj * HALF + 4);
#pragma unroll
                for (int ai = 0; ai < 2; ++ai)
#pragma unroll
                    for (int m = 0; m < 4; ++m) {
                        const float rs = xt[ai * HALF + wr * 64 + m * 16 + fr];
                        const size_t off = (size_t)(row0 + ai * HALF + m * 16) * DM + colt + bj * HALF;
                        *(f32x4*)(xout + off) = acc[ai][bj][m][0] * rs * g0; *(f32x4*)(xout + off + 4) = acc[ai][bj][m][1] * rs * g1;
                    }
            }
        }
    }
}

__device__ __forceinline__ void gemm_phase(LAS unsigned char* lds, const GemmP& P, const Order& S, const int tid) {
    const int wid = __builtin_amdgcn_readfirstlane(tid >> 6), lane = tid & 63, wr = wid >> 2, wc = wid & 3, fr = lane & 15, fq = lane >> 4;
    constexpr int K = KDIM, nt = K / BK;
    unsigned voffA[2], voffB[2];
#pragma unroll
    for (int i = 0; i < 2; ++i) { int R, C; stage_rc(tid * 16 + i * 8192, R, C); const int Rb = (R & ~31) + perm32(R & 31);
        voffA[i] = (unsigned)(R * K + C) * 2u; voffB[i] = (unsigned)(Rb * K + C) * 2u; }
    constexpr size_t kstep = (size_t)(BK * 2);
    constexpr size_t hstep = (size_t)HALF * K * 2;
    constexpr size_t tstep = 2 * hstep;
    const unsigned ldsw = (unsigned)wid * 1024u;
    const int aoff = lds_byte(wr * 64 + fr, fq * 8), boff = lds_byte(wc * 32 + fr, fq * 8);
#define PG8_SA(b, h) (((b) * 2 + (h)) * HTB)
#define PG8_SB(b, h) ((4 + (b) * 2 + (h)) * HTB)
#define PG8_STAGE(bufoff, gbase, voff) do { _Pragma("unroll") for (int _i = 0; _i < 2; ++_i) \
        __builtin_amdgcn_global_load_lds((const unsigned*)((const char*)(gbase) + (voff)[_i]), (LAS unsigned*)(lds + (bufoff) + ldsw + _i * 8192), 16, 0, 0); } while (0)
#define PG8_LDA(dst, b, h) do { _Pragma("unroll") for (int m = 0; m < 4; ++m) _Pragma("unroll") for (int k = 0; k < 2; ++k) dst[m][k] = *(const LAS bf16x8*)(lds + PG8_SA(b, h) + aoff + m * 2048 + k * 1024); } while (0)
#define PG8_LDB(dst, b, h) do { _Pragma("unroll") for (int n = 0; n < 2; ++n) _Pragma("unroll") for (int k = 0; k < 2; ++k) dst[n][k] = *(const LAS bf16x8*)(lds + PG8_SB(b, h) + boff + n * 2048 + k * 1024); } while (0)
#define PG8_MMA(ai, bj, At, Bt) do { __builtin_amdgcn_s_setprio(1); _Pragma("unroll") for (int m = 0; m < 4; ++m) _Pragma("unroll") for (int n = 0; n < 2; ++n) _Pragma("unroll") for (int k = 0; k < 2; ++k) \
        acc[ai][bj][m][n] = __builtin_amdgcn_mfma_f32_16x16x32_bf16(Bt[n][k], At[m][k], acc[ai][bj][m][n], 0, 0, 0); __builtin_amdgcn_s_setprio(0); } while (0)
#define PG8_WAIT_V(n) asm volatile("s_waitcnt vmcnt(" #n ")" ::: "memory")
#define PG8_WAIT_L(n) asm volatile("s_waitcnt lgkmcnt(" #n ")" ::: "memory")
#define PG8_BAR __builtin_amdgcn_s_barrier()
#define PG8_SCHED __builtin_amdgcn_sched_barrier(0)
    Unit cur, nxt; int ui = 0;
    if (!S.next(0, cur)) return;
    f32x4 acc[2][2][4][2];
#define PG8_ACC_INIT(U) do { if (P.mode == EM_OUTPROJ && (U).s == 0) { \
        const char* rp = (const char*)(P.l == 0 ? P.xin : (const float*)P.out) + ((size_t)((U).pm * BM + wr * 64 + fr) * DM + (U).pn * BM + wc * 32 + 8 * fq) * 4; \
        _Pragma("unroll") for (int a = 0; a < 2; ++a) _Pragma("unroll") for (int m = 0; m < 4; ++m) { asm volatile("" : "+v"(rp)); \
            _Pragma("unroll") for (int b = 0; b < 2; ++b) _Pragma("unroll") for (int n = 0; n < 2; ++n) acc[a][b][m][n] = *(const f32x4*)(rp + b * 512 + n * 16); \
            rp += (m == 3 ? (size_t)(HALF - 48) : (size_t)16) * DM * 4; } \
    } else { _Pragma("unroll") for (int a = 0; a < 2; ++a) _Pragma("unroll") for (int b = 0; b < 2; ++b) _Pragma("unroll") for (int m = 0; m < 4; ++m) _Pragma("unroll") for (int n = 0; n < 2; ++n) acc[a][b][m][n] = (f32x4){0.f, 0.f, 0.f, 0.f}; } } while (0)
    PG8_ACC_INIT(cur);
    bf16x8 At[4][2], B0[2][2], B1[2][2];
    const char* cA = (cur.s ? (const char*)(P.ws + WS_MEMN) : (const char*)P.A) + (size_t)cur.pm * tstep; const char* cB = (cur.s ? (const char*)(P.ws + WS_WMKV) : (const char*)P.Bt) + (size_t)cur.pn * tstep;
    PG8_STAGE(PG8_SB(0, 0), cB, voffB); PG8_STAGE(PG8_SB(0, 1), cB + hstep, voffB); PG8_STAGE(PG8_SA(0, 0), cA, voffA); PG8_STAGE(PG8_SA(0, 1), cA + hstep, voffA);
    if (wr == 1) PG8_BAR;
    PG8_WAIT_V(2); PG8_BAR;
    PG8_STAGE(PG8_SB(1, 0), cB + kstep, voffB); PG8_STAGE(PG8_SA(1, 0), cA + kstep, voffA); PG8_STAGE(PG8_SB(1, 1), cB + hstep + kstep, voffB);
    PG8_WAIT_V(6); PG8_BAR;
    for (;;) {
        const bool has_next = S.next(ui + 1, nxt);
        const char* nA = has_next ? (nxt.s ? (const char*)(P.ws + WS_MEMN) : (const char*)P.A) + (size_t)nxt.pm * tstep : cA; const char* nB = has_next ? (nxt.s ? (const char*)(P.ws + WS_WMKV) : (const char*)P.Bt) + (size_t)nxt.pn * tstep : cB;
        for (int t = 0; t < nt; t += 2) {
            const bool last = (t == nt - 2);
            const char* a1 = cA + (size_t)(t + 1) * kstep;
            const char* a2 = last ? nA : cA + (size_t)(t + 2) * kstep; const char* b2 = last ? nB : cB + (size_t)(t + 2) * kstep;
            const char* a3 = a2 + kstep; const char* b3 = b2 + kstep;
            PG8_LDB(B0, 0, 0); PG8_LDB(B1, 0, 1); PG8_SCHED; PG8_LDA(At, 0, 0); PG8_STAGE(PG8_SA(1, 1), a1 + hstep, voffA);
            PG8_WAIT_V(8); PG8_WAIT_L(0); PG8_BAR; PG8_MMA(0, 0, At, B0); PG8_MMA(0, 1, At, B1); PG8_BAR; PG8_SCHED;
            PG8_LDA(At, 0, 1); PG8_STAGE(PG8_SB(0, 0), b2, voffB); PG8_STAGE(PG8_SB(0, 1), b2 + hstep, voffB); PG8_STAGE(PG8_SA(0, 0), a2, voffA);
            PG8_WAIT_V(8); PG8_WAIT_L(0); PG8_BAR; PG8_MMA(1, 0, At, B0); PG8_MMA(1, 1, At, B1); PG8_BAR; PG8_SCHED;
            PG8_LDB(B0, 1, 0); PG8_LDB(B1, 1, 1); PG8_SCHED; PG8_LDA(At, 1, 0); PG8_STAGE(PG8_SA(0, 1), a2 + hstep, voffA);
            PG8_WAIT_V(8); PG8_WAIT_L(0); PG8_BAR; PG8_MMA(0, 0, At, B0); PG8_MMA(0, 1, At, B1); PG8_BAR; PG8_SCHED;
            PG8_LDA(At, 1, 1); PG8_STAGE(PG8_SB(1, 0), b3, voffB); PG8_STAGE(PG8_SB(1, 1), b3 + hstep, voffB); PG8_STAGE(PG8_SA(1, 0), a3, voffA);
            PG8_WAIT_V(8); PG8_WAIT_L(0); PG8_BAR; PG8_MMA(1, 0, At, B0); PG8_MMA(1, 1, At, B1); PG8_BAR; PG8_SCHED;
        }
        if (wr == 0) PG8_BAR;
        { int lane_e = lane; asm volatile("" : "+v"(lane_e));
          epi_run(P, acc, cur, wr, wc, lane_e & 15, lane_e >> 4); }
        if (!has_next) break;
        PG8_ACC_INIT(nxt);
        cur = nxt; cA = nA; cB = nB; ++ui;
        if (wr == 1) PG8_BAR;
    }
    PG8_WAIT_V(0);
    PG8_BAR;
#undef PG8_ACC_INIT
#undef PG8_SA
#undef PG8_SB
#undef PG8_STAGE
#undef PG8_LDA
#undef PG8_LDB
#undef PG8_MMA
#undef PG8_WAIT_V
#undef PG8_WAIT_L
#undef PG8_BAR
#undef PG8_SCHED
}

struct KVD { int kvsel, koff, voff, kd1, ks, L, kt0, ksub, koff1, nst; };
struct AU { int qoff, qs, qrow_w, band, causal, pair, whalf, moba_n, tbase, kmoff; };
struct AE { int epi, ooff, os, goff, gs, lseoff, lses, has_sink; float sink; };
__device__ __forceinline__ int crow(int r, int hi) { return (r & 3) + 8 * (r >> 2) + 4 * hi; }
typedef short v4i16_t __attribute__((ext_vector_type(4)));
template <int OFF> __device__ __forceinline__ s16x4 tr_read(int vb) { return __builtin_bit_cast(s16x4, __builtin_amdgcn_ds_read_tr16_b64_v4i16((LAS v4i16_t*)(uintptr_t)(unsigned)(vb + OFF))); }
template <int D> __device__ __forceinline__ int kswz(int row, int colB) { if constexpr (D == 128) return row * 256 + (colB ^ ((row & 7) << 4)); else return row * 128 + (colB ^ (((row >> 1) & 7) << 4)); }
template <int D> __device__ __forceinline__ int v_st(int k, int c) { const int kk = (k & ~0xC) | ((k & 4) << 1) | ((k & 8) >> 1); return ((kk >> 3) * (D / 32) + (c >> 5)) * 512 + ((kk & 7) * 32 + (c & 31)) * 2; }
__device__ __forceinline__ int v_rd_base(int lane) { return ((lane & 3) << 3) | (((lane >> 2) & 3) << 6) | (((lane >> 4) & 1) << 5) | (((lane >> 5) & 1) << 8); }
template <int D> constexpr int v_rd_off(int d0, int ks, int half) { return d0 * 512 + (ks * 2 + half) * (D / 32) * 512; }

template <int D, int D0, int HF> __device__ __forceinline__ void pv_half(f32x16& od, int vb, bf16x8 pa, bf16x8 pb) {
    const s16x4 l0 = tr_read<v_rd_off<D>(D0, 2 * HF, 0)>(vb), h0 = tr_read<v_rd_off<D>(D0, 2 * HF, 1)>(vb), l1 = tr_read<v_rd_off<D>(D0, 2 * HF + 1, 0)>(vb), h1 = tr_read<v_rd_off<D>(D0, 2 * HF + 1, 1)>(vb);
#define PKV(Lx, Hx) (bf16x8){Lx[0], Lx[1], Lx[2], Lx[3], Hx[0], Hx[1], Hx[2], Hx[3]}
    od = __builtin_amdgcn_mfma_f32_32x32x16_bf16(pa, PKV(l0, h0), od, 0, 0, 0);
    od = __builtin_amdgcn_mfma_f32_32x32x16_bf16(pb, PKV(l1, h1), od, 0, 0, 0);
#undef PKV
}
template <int D, int HF> __device__ __forceinline__ void pv_all(f32x16* o, int vb, bf16x8 pa, bf16x8 pb) {
    pv_half<D, 0, HF>(o[0], vb, pa, pb); pv_half<D, 1, HF>(o[1], vb, pa, pb);
    if constexpr (D == 128) { pv_half<D, 2, HF>(o[2], vb, pa, pb); pv_half<D, 3, HF>(o[3], vb, pa, pb); }
}
template <int D> struct ACfg { static constexpr int NSUB = (D == 128) ? 2 : 3, KTB = 64 * D * 2; };
constexpr int ABUF = 65536;
struct StageR { bf16x8 k0, v0, k1, v1; };
template <int D> __device__ __forceinline__ void sload(StageR& r, const KVD& d, const unsigned char* ws, int sub, int tid) {
    const bf16_t* KVp = (const bf16_t*)(ws + (d.kvsel ? WS_MKV : WS_QKV));
    const int kb = d.kt0 + sub * d.ksub;
    if constexpr (D == 128) {
        const int sr = tid >> 4, sc = (tid & 15) * 8;
        int a0 = kb + sr, a1 = kb + sr + d.koff1; a0 = a0 < 0 ? 0 : (a0 > d.L - 1 ? d.L - 1 : a0); a1 = a1 < 0 ? 0 : (a1 > d.L - 1 ? d.L - 1 : a1);
        const size_t i0 = (size_t)a0 * d.ks + sc, i1 = (size_t)a1 * d.ks + d.kd1 + sc;
        r.k0 = *(const bf16x8*)(KVp + d.koff + i0); r.v0 = *(const bf16x8*)(KVp + d.voff + i0); r.k1 = *(const bf16x8*)(KVp + d.koff + i1); r.v1 = *(const bf16x8*)(KVp + d.voff + i1);
    } else {
        const int sr = tid >> 3, sc = (tid & 7) * 8;
        int a0 = kb + sr; a0 = a0 < 0 ? 0 : (a0 > d.L - 1 ? d.L - 1 : a0);
        const size_t i0 = (size_t)a0 * d.ks + sc;
        r.k0 = *(const bf16x8*)(KVp + d.koff + i0); r.v0 = *(const bf16x8*)(KVp + d.voff + i0);
    }
}
template <int D> __device__ __forceinline__ void swrite(const StageR& r, LAS unsigned char* buf, int slot, int tid) {
    constexpr int NSUB = ACfg<D>::NSUB, KTB = ACfg<D>::KTB;
    LAS unsigned char* Kt = buf + slot * KTB; LAS unsigned char* Vt = buf + NSUB * KTB + slot * KTB;
    if constexpr (D == 128) {
        const int sr = tid >> 4, sc = (tid & 15) * 8;
        *(LAS bf16x8*)(Kt + kswz<D>(sr, sc * 2)) = r.k0; *(LAS bf16x8*)(Kt + kswz<D>(32 + sr, sc * 2)) = r.k1;
        *(LAS bf16x8*)(Vt + v_st<D>(sr, sc)) = r.v0; *(LAS bf16x8*)(Vt + v_st<D>(32 + sr, sc)) = r.v1;
    } else {
        const int sr = tid >> 3, sc = (tid & 7) * 8;
        *(LAS bf16x8*)(Kt + kswz<D>(sr, sc * 2)) = r.k0; *(LAS bf16x8*)(Vt + v_st<D>(sr, sc)) = r.v0;
    }
}
template <int D> __device__ __forceinline__ void cold_start(const KVD& d, const unsigned char* ws, LAS unsigned char* buf, int tid) {
#pragma unroll
    for (int sl = 0; sl < ACfg<D>::NSUB; ++sl) if (sl < d.nst) { StageR r; sload<D>(r, d, ws, sl, tid); swrite<D>(r, buf, sl, tid); }
    __syncthreads();
}

template <int D>
__device__ __forceinline__ void attn_main(const AU& u, const KVD& d, const KVD& dn, const int pre, int& pb, unsigned char* ws, LAS unsigned char* lds, int tid, int wid, int lane,
                                          float& m_out, float& l_out, f32x16 (&o)[D / 32]) {
    constexpr int NQ = D / 16, NB = D / 32, NSUB = ACfg<D>::NSUB, KTB = ACfg<D>::KTB;
    constexpr float SCALE = (D == 128) ? 0.088388347648318440f : 0.125f;
    constexpr float C = SCALE * 1.4426950408889634f;
    constexpr float THRS = 8.0f / SCALE;
    const int r32 = lane & 31, hi = lane >> 5;
    LAS float* wsf = (LAS float*)(lds + XTBL_OFF + wid * 256);
    bf16x8 qr[NQ];
    { const bf16_t* qrow = (const bf16_t*)(ws + WS_QKV) + (size_t)u.qoff + (size_t)(u.qrow_w + r32) * u.qs + hi * 8;
#pragma unroll
      for (int d0 = 0; d0 < NQ; ++d0) qr[d0] = *(const bf16x8*)(qrow + d0 * 16); }
    float m_reg = -1e30f, l_reg = 0.f;
#pragma unroll
    for (int dd = 0; dd < NB; ++dd)
#pragma unroll
        for (int r = 0; r < 16; ++r) o[dd][r] = 0.f;
    const int qidx = u.qrow_w + r32;
    unsigned selmask = 0;
    if constexpr (D == 128) {
        if (u.moba_n > 0) {
            const int n = u.moba_n; float g[7];
#pragma unroll
            for (int j = 0; j < 7; ++j) {
                g[j] = -INFINITY;
                if (j < n) {
                    const float* kmj = (const float*)(ws + WS_CTL) + CW_KM + u.kmoff + j * 128 + hi * 8; float s = 0.f;
#pragma unroll
                    for (int d0 = 0; d0 < NQ; ++d0) { const f32x4 a = *(const f32x4*)(kmj + d0 * 16), b = *(const f32x4*)(kmj + d0 * 16 + 4);
                        const u32x4 qw = __builtin_bit_cast(u32x4, qr[d0]);
                        s += bflo(qw.x) * a[0] + bfhi(qw.x) * a[1] + bflo(qw.y) * a[2] + bfhi(qw.y) * a[3] + bflo(qw.z) * b[0] + bfhi(qw.z) * b[1] + bflo(qw.w) * b[2] + bfhi(qw.w) * b[3]; }
                    auto rr = __builtin_amdgcn_permlane32_swap(__float_as_uint(s), __float_as_uint(s), false, false);
                    g[j] = __uint_as_float(rr[0]) + __uint_as_float(rr[1]);
                }
            }
#pragma unroll
            for (int j = 0; j < 7; ++j) { int cnt = 0;
#pragma unroll
                for (int i = 0; i < 7; ++i) if (i != j) cnt += (i < n && (g[i] > g[j] || (g[i] == g[j] && i < j))) ? 1 : 0;
                if (j < n && cnt < 3) selmask |= (1u << j); }
        }
    }
    const int nsteps = (d.nst + NSUB - 1) / NSUB;
    for (int st = 0; st < nsteps; ++st) {
        LAS unsigned char* bufc = lds + pb * ABUF; LAS unsigned char* bufn = lds + (pb ^ 1) * ABUF;
        const bool lastst = (st + 1 == nsteps);
#pragma unroll 1
        for (int sl = 0; sl < NSUB; ++sl) {
            const int sub = st * NSUB + sl;
            StageR sr_; int wr_next = 0;
            if (!lastst) { if (sub + NSUB < d.nst) { sload<D>(sr_, d, ws, sub + NSUB, tid); wr_next = 1; } }
            else if (pre) { if (sl < dn.nst) { sload<D>(sr_, dn, ws, sl, tid); wr_next = 1; } }
            if (sub < d.nst) {
                const int kb0 = d.kt0 + sub * d.ksub, kb1 = kb0 + d.koff1;
                int lo_q, hi_q;
                const int tabs = u.tbase + sub;
                if (u.moba_n >= 0 && tabs < 4 * u.moba_n) { const bool sel = (selmask >> (tabs >> 2)) & 1u; lo_q = sel ? -(1 << 28) : (1 << 28); hi_q = sel ? (1 << 28) : -(1 << 28); }
                else { lo_q = qidx - u.band; hi_q = u.causal ? qidx : (1 << 28); }
                bool any0 = __any(lo_q <= kb0 + 31 && hi_q >= kb0), any1 = __any(lo_q <= kb1 + 31 && hi_q >= kb1);
                if (u.pair) { any0 = any0 && (u.whalf == 0); any1 = any1 && (u.whalf == 1); }
#define HALF_STEP(HF, ANY, KBH) do { if (ANY) { \
                    const bool allv = __all(lo_q <= (KBH) && hi_q >= (KBH) + 31); \
                    f32x16 p; _Pragma("unroll") for (int r = 0; r < 16; ++r) p[r] = 0.f; \
                    LAS unsigned char* Kt = bufc + sl * KTB; \
                    _Pragma("unroll") for (int d0 = 0; d0 < NQ; ++d0) { const bf16x8 bk = *(const LAS bf16x8*)(Kt + kswz<D>(32 * (HF) + r32, (d0 * 16 + hi * 8) * 2)); p = __builtin_amdgcn_mfma_f32_32x32x16_bf16(bk, qr[d0], p, 0, 0, 0); } \
                    if (!allv) { _Pragma("unroll") for (int r = 0; r < 16; ++r) { const int kk = (KBH) + crow(r, hi); if (kk < lo_q || kk > hi_q) p[r] = -INFINITY; } } \
                    float pmax = p[0]; _Pragma("unroll") for (int r = 1; r < 16; ++r) pmax = fmaxf(pmax, p[r]); \
                    { auto rr = __builtin_amdgcn_permlane32_swap(__float_as_uint(pmax), __float_as_uint(pmax), false, false); pmax = fmaxf(__uint_as_float(rr[0]), __uint_as_float(rr[1])); } \
                    float alpha = 1.f; \
                    if (!__all(pmax - m_reg <= THRS)) { const float mn = fmaxf(m_reg, pmax); alpha = __builtin_amdgcn_exp2f((m_reg - mn) * C); m_reg = mn; } \
                    const float mnC = -m_reg * C; float ps = 0.f; \
                    _Pragma("unroll") for (int r = 0; r < 16; ++r) { p[r] = __builtin_amdgcn_exp2f(fmaf(p[r], C, mnC)); ps += p[r]; } \
                    { auto rr = __builtin_amdgcn_permlane32_swap(__float_as_uint(ps), __float_as_uint(ps), false, false); ps = __uint_as_float(rr[0]) + __uint_as_float(rr[1]); } \
                    l_reg = l_reg * alpha + ps; \
                    if (__any(alpha < 1.f)) { if (hi == 0) wsf[r32] = alpha; LDS_WAIT(); \
                        _Pragma("unroll") for (int dd = 0; dd < NB; ++dd) _Pragma("unroll") for (int r = 0; r < 16; ++r) o[dd][r] *= wsf[crow(r, hi)]; \
                        LDS_WAIT(); } \
                    bf16x8 paA, paB; PK4(p, 0, paA); PK4(p, 8, paB); \
                    const int vb = (int)(uintptr_t)(bufc + NSUB * KTB + sl * KTB) + v_rd_base(lane); \
                    pv_all<D, HF>(o, vb, paA, paB); } } while (0)
#define PK4(P, BASE, OUT) do { unsigned a0 = cvt_pk_bf16(P[BASE + 0], P[BASE + 1]), a1 = cvt_pk_bf16(P[BASE + 2], P[BASE + 3]);   \
    unsigned b0 = cvt_pk_bf16(P[BASE + 4], P[BASE + 5]), b1 = cvt_pk_bf16(P[BASE + 6], P[BASE + 7]);                              \
    auto r0 = __builtin_amdgcn_permlane32_swap(a0, b0, false, false); auto r1 = __builtin_amdgcn_permlane32_swap(a1, b1, false, false); \
    u32x4 w = {r0[0], r1[0], r0[1], r1[1]}; OUT = __builtin_bit_cast(bf16x8, w); } while (0)
                HALF_STEP(0, any0, kb0);
                HALF_STEP(1, any1, kb1);
#undef PK4
#undef HALF_STEP
            }
            if (wr_next) swrite<D>(sr_, bufn, sl, tid);
        }
        __syncthreads();
        pb ^= 1;
    }
    m_out = m_reg; l_out = l_reg;
}

template <int D>
__device__ __forceinline__ void attn_epi(const AE& e, int qrow_w, int pbl, unsigned char* ws, LAS unsigned char* lds, int wid, int lane, float m_reg, float l_reg, const f32x16 (&o)[D / 32]) {
    constexpr int NB = D / 32;
    constexpr float SCALE = (D == 128) ? 0.088388347648318440f : 0.125f;
    const int r32 = lane & 31, hi = lane >> 5;
    LAS float* wsf = (LAS float*)(lds + XTBL_OFF + wid * 256);
    LAS bf16_t* stg = (LAS bf16_t*)(lds + pbl * ABUF + wid * 8192);
    float lt = l_reg;
    if (e.has_sink) lt += __builtin_amdgcn_exp2f((e.sink - m_reg * SCALE) * 1.4426950408889634f);
    if (hi == 0) wsf[r32] = lt > 0.f ? __builtin_amdgcn_rcpf(lt) : 0.f;
    LDS_WAIT();
    float rli[16];
#pragma unroll
    for (int r = 0; r < 16; ++r) rli[r] = wsf[crow(r, hi)];
    LDS_WAIT();
#pragma unroll
    for (int r = 0; r < 16; ++r) { const int orow = crow(r, hi);
#pragma unroll
        for (int d0 = 0; d0 < NB; ++d0) stg[orow * D + d0 * 32 + r32] = (bf16_t)f2bf(o[d0][r] * rli[r]); }
    LDS_WAIT();
    constexpr int CPR = D / 8, RPP = 64 / CPR;
    bf16_t* OB = (bf16_t*)(ws + (e.epi ? WS_Y : WS_OG));
    const bf16_t* GB = (const bf16_t*)(ws + WS_QKV);
#pragma unroll
    for (int i = 0; i < 32 / RPP; ++i) {
        const int row = i * RPP + lane / CPR, ch = lane % CPR;
        const u32x4 v = *(const LAS u32x4*)(stg + row * D + ch * 8);
        const size_t fidx = (size_t)(qrow_w + row);
        if (e.epi == 1) {
            const u32x4 g = *(const u32x4*)(GB + (size_t)e.goff + fidx * e.gs + ch * 8);
            u32x4 w;
            w.x = cvt_pk_bf16(bflo(v.x) * bflo(g.x), bfhi(v.x) * bfhi(g.x)); w.y = cvt_pk_bf16(bflo(v.y) * bflo(g.y), bfhi(v.y) * bfhi(g.y));
            w.z = cvt_pk_bf16(bflo(v.z) * bflo(g.z), bfhi(v.z) * bfhi(g.z)); w.w = cvt_pk_bf16(bflo(v.w) * bflo(g.w), bfhi(v.w) * bfhi(g.w));
            *(u32x4*)(OB + (size_t)e.ooff + fidx * e.os + ch * 8) = w;
        } else {
            *(u32x4*)(OB + (size_t)e.ooff + fidx * e.os + ch * 8) = v;
        }
    }
    if (e.epi == 0 && hi == 0) ((float*)(ws + WS_LSE))[(size_t)e.lseoff + (size_t)(qrow_w + r32) * e.lses] = l_reg > 0.f ? m_reg * SCALE + __logf(l_reg) : -1e30f;
    LDS_WAIT();
}

#define XB_TMO      128
#define XB_XCNT(j)  (256  + 64 * (j))
#define XB_XSUB(j)  (1280 + 64 * (j))
#define XB_XGEN(j)  (2304 + 64 * (j))
#define XB_TOP      3328
#define XB_TOPGEN   3392
#define XCD_BAR_WORDS 3456
#define XB_SPIN_CAP (1u << 18)
__device__ __forceinline__ unsigned xb_ld(unsigned* p)              { return __hip_atomic_load(p, __ATOMIC_RELAXED, __HIP_MEMORY_SCOPE_AGENT); }
__device__ __forceinline__ unsigned xb_add(unsigned* p, unsigned v) { return __hip_atomic_fetch_add(p, v, __ATOMIC_RELAXED, __HIP_MEMORY_SCOPE_AGENT); }
__device__ __forceinline__ unsigned xb_xcc_id() { return (unsigned)__builtin_amdgcn_s_getreg((3 << 11) | 20) & 0xFu; }
#define XB_SPIN(cond, bar) do { unsigned _sp = 0; while (cond) { __builtin_amdgcn_s_sleep(1); \
    if ((++_sp & 255u) == 0u) { if (xb_ld(&(bar)[XB_TMO])) break; if (_sp > XB_SPIN_CAP) { atomicAdd(&(bar)[XB_TMO], 1u); break; } } } } while (0)
struct XcdBarrier { unsigned* bar; unsigned x; volatile LAS unsigned* st; };
__device__ __forceinline__ XcdBarrier xcd_barrier_post(unsigned* bar, volatile LAS unsigned* st) {
    XcdBarrier b; b.bar = bar; b.x = xb_xcc_id(); b.st = st;
    if (threadIdx.x == 0) (void)xb_add(&bar[XB_XCNT(b.x)], 1u);
    return b;
}
__device__ __forceinline__ void xcd_barrier_complete(unsigned* bar, unsigned x, unsigned& nloc, unsigned& nx) {
    const unsigned G = gridDim.x * gridDim.y * gridDim.z;
    unsigned sum, cnt, mine, sp = 0u;
    for (;;) {
        sum = 0u; cnt = 0u; mine = 0u;
#pragma unroll
        for (unsigned j = 0; j < 16; ++j) { const unsigned c = xb_ld(&bar[XB_XCNT(j)]); sum += c; cnt += (c > 0u) ? 1u : 0u; mine = (j == x) ? c : mine; }
        if (sum == G) break;
        __builtin_amdgcn_s_sleep(1);
        if ((++sp & 255u) == 0u) { if (xb_ld(&bar[XB_TMO])) break; if (sp > XB_SPIN_CAP) { atomicAdd(&bar[XB_TMO], 1u); break; } }
    }
    nloc = mine > 0u ? mine : 1u; nx = cnt > 0u ? cnt : 1u;
}
__device__ __forceinline__ void xcd_barrier(const XcdBarrier& b) {
    asm volatile("s_waitcnt vmcnt(0)" ::: "memory");
    __syncthreads();
    if (threadIdx.x == 0) {
        unsigned* bar = b.bar;
        __builtin_amdgcn_s_waitcnt(0);
        unsigned nloc = b.st[0], nx = b.st[1];
        if (nloc == 0u) { xcd_barrier_complete(bar, b.x, nloc, nx); b.st[0] = nloc; b.st[1] = nx; }
        const unsigned old = xb_add(&bar[XB_XSUB(b.x)], 1u);
        const unsigned gen = old / nloc;
        if (old + 1u == (gen + 1u) * nloc) {
            __builtin_amdgcn_fence(__ATOMIC_RELEASE, "agent");
            asm volatile("s_waitcnt vmcnt(0)" ::: "memory");
            const unsigned og = xb_add(&bar[XB_TOP], 1u);
            const unsigned tg = og / nx;
            if (og + 1u == (tg + 1u) * nx) xb_add(&bar[XB_TOPGEN], 1u);
            else XB_SPIN(xb_ld(&bar[XB_TOPGEN]) == tg, bar);
            __builtin_amdgcn_fence(__ATOMIC_ACQUIRE, "agent");
            xb_add(&bar[XB_XGEN(b.x)], 1u);
            asm volatile("s_waitcnt vmcnt(0)" ::: "memory");
        } else {
            XB_SPIN(xb_ld(&bar[XB_XGEN(b.x)]) == gen, bar);
            __builtin_amdgcn_fence(__ATOMIC_ACQUIRE, "agent");
            asm volatile("s_waitcnt vmcnt(0)" ::: "memory");
        }
    }
    __syncthreads();
}

__device__ __forceinline__ float wave_sum(float v) {
#pragma unroll
    for (int o = 1; o < 64; o <<= 1) v += __shfl_xor(v, o);
    return v;
}
__device__ __forceinline__ int phys_even(int n) {
    if (n >= 4608) return n;
    const int seg = n / 768; if (seg == 2 || seg == 5) return n;
    const int i = n & 127, hb = n - i, ii = i & 63, g = ii >> 2, e = (ii & 3) + ((i >> 6) << 2);
    return hb + 8 * g + e;
}
__device__ __forceinline__ int phys_odd(int n) {
    if (n < 1728) { const int i = n & 63, hb = n - i, ii = i & 31, g = ii >> 2, e = (ii & 3) + ((i >> 5) << 2); return hb + 8 * g + e; }
    if (n < 1920) return n + 64;
    return n + 128;
}
__device__ __forceinline__ void convert_item(const float* W, int N, const float* gk, bf16_t* WT, int mapkind, int rowoff, int item, int lane) {
    const int nblk = N / 64, kb = item / nblk, nb = item % nblk, k0 = 64 * kb, n = 64 * nb + lane;
    const int p = (mapkind == 1 ? phys_even(n) : (mapkind == 2 ? phys_odd(n) : n)) + rowoff;
    const float* src = W + (size_t)k0 * N + n;
    bf16_t* dst = WT + (size_t)p * KDIM + k0;
    float v[64];
#pragma unroll
    for (int j = 0; j < 64; ++j) v[j] = src[(size_t)j * N];
    if (gk) {
#pragma unroll
        for (int j = 0; j < 64; ++j) v[j] *= gk[k0 + j];
    }
#pragma unroll
    for (int kk = 0; kk < 8; ++kk) { u32x4 o; o.x = pk2(v[8 * kk], v[8 * kk + 1]); o.y = pk2(v[8 * kk + 2], v[8 * kk + 3]); o.z = pk2(v[8 * kk + 4], v[8 * kk + 5]); o.w = pk2(v[8 * kk + 6], v[8 * kk + 7]);
        *(u32x4*)(dst + 8 * kk) = o; }
}

struct Args {
    const float* x; const float* mem; const int* pos;
    const float* even_norm; const float* even_w_in; const float* even_w_mkv; const float* even_w_out;
    const float* odd_norm; const float* odd_w_in; const float* odd_w_mkv; const float* odd_w_out; const float* odd_sinks;
    const float* mem_norm; const float* final_norm;
    float* out; unsigned char* ws;
    int ph_lo, ph_hi;
};
constexpr int N_PHASES = 18;

constexpr int NUNITS_EVEN = 1088, NUNITS_ODD = 896;
__device__ __forceinline__ bool unit_d64(int idx, int l) { return (l & 1) && idx >= 128; }
__device__ __forceinline__ void decode_kv(int idx, int l, KVD& d) {
    d.kvsel = 0; d.kd1 = 0; d.ksub = 64; d.koff1 = 32;
    if (!(l & 1)) {
        if (idx < 384) { const int n = 7 - idx / 48, rem = idx % 48, s = rem / 24, bh = rem % 24, b = bh / 6, h = bh % 6; const int tb = b * SEQ * EVEN_N;
            d.koff = tb + 3072 + h * 128; d.voff = tb + 3840 + h * 128; d.ks = EVEN_N; d.L = SEQ; d.kt0 = 128 * (n + 1) * s; d.nst = 2 * (n + 1);
        } else if (idx < 768) { const int i = idx - 384, pat = i / 192, j = i % 192, bh = j % 24, rr = j / 24, b = bh / 6, h = bh % 6;
            const int dil = pat ? 4 : 1, res = pat ? (rr & 3) : 0, kblk = pat ? (rr >> 2) : rr; const int tb = (b * SEQ + res) * EVEN_N;
            d.koff = tb + 768 + h * 128; d.voff = tb + 1536 + h * 128; d.ks = dil * EVEN_N; d.L = SEQ / dil; d.kt0 = (256 * kblk - 128) < 0 ? 0 : (256 * kblk - 128); d.nst = (256 * kblk + 256 - d.kt0) / 64;
        } else if (idx < 896) { const int i = idx - 768, b = i / 32, hm = (i / 8) % 4;
            d.kvsel = 1; d.koff = b * MEML * 4096 + l * 1024 + hm * 128; d.voff = d.koff + 512; d.ks = 4096; d.L = MEML; d.kt0 = 0; d.nst = 4;
        } else { const int i = idx - 896, bh = i % 24, u8 = i / 24, b = bh / 6, h = bh % 6; const int tp = (b * SEQ + 2 * u8) * EVEN_N;
            d.koff = tp + 768 + h * 128; d.voff = tp + 1536 + h * 128; d.kd1 = EVEN_N; d.ks = 16 * EVEN_N; d.L = 128; d.kt0 = 0; d.nst = 4; d.ksub = 32; d.koff1 = 0;
        }
    } else {
        if (idx < 128) { const int i = idx, b = i / 32, hm = (i / 8) % 4;
            d.kvsel = 1; d.koff = b * MEML * 4096 + l * 1024 + hm * 128; d.voff = d.koff + 512; d.ks = 4096; d.L = MEML; d.kt0 = 0; d.nst = 4;
        } else { const int i = idx - 128, b = i / 192, g = (i / 64) % 3, pblk = i % 64; const int tb = b * SEQ * ODD_NP;
            d.koff = tb + 1536 + g * 64; d.voff = tb + 1792 + g * 64; d.ks = ODD_NP; d.L = SEQ; d.kt0 = (32 * pblk - 128) < 0 ? 0 : (32 * pblk - 128); d.nst = (32 * pblk + 32 - d.kt0 + 63) / 64;
        }
    }
}
__device__ __forceinline__ void decode_q(int idx, int l, int wave, AU& u) {
    u.moba_n = -1; u.band = 1 << 28; u.causal = 1; u.pair = 0; u.whalf = 0; u.kmoff = 0; u.tbase = 0;
    if (!(l & 1)) {
        if (idx < 384) { const int n = 7 - idx / 48, rem = idx % 48, s = rem / 24, bh = rem % 24, b = bh / 6, h = bh % 6;
            u.qoff = b * SEQ * EVEN_N + 2304 + h * 128; u.qs = EVEN_N; u.qrow_w = 256 * n + 32 * wave; u.moba_n = n; u.tbase = 2 * (n + 1) * s;
            u.kmoff = (l >> 1) * (4 * 6 * 8 * 128) + ((b * 6 + h) * 8) * 128;
        } else if (idx < 768) { const int i = idx - 384, pat = i / 192, j = i % 192, bh = j % 24, rr = j / 24, b = bh / 6, h = bh % 6;
            const int dil = pat ? 4 : 1, res = pat ? (rr & 3) : 0, kblk = pat ? (rr >> 2) : rr;
            u.qoff = (b * SEQ + res) * EVEN_N + h * 128; u.qs = dil * EVEN_N; u.qrow_w = 256 * kblk + 32 * wave; u.band = 128;
        } else if (idx < 896) { const int i = idx - 768, b = i / 32, hm = (i / 8) % 4, blk = i % 8;
            u.qoff = b * SEQ * EVEN_N + 4608 + hm * 128; u.qs = EVEN_N; u.qrow_w = 256 * blk + 32 * wave; u.causal = 0;
        } else { const int i = idx - 896, bh = i % 24, u8 = i / 24, b = bh / 6, h = bh % 6; const int wh = wave >> 2;
            u.qoff = (b * SEQ + 2 * u8 + wh) * EVEN_N + h * 128; u.qs = 16 * EVEN_N; u.qrow_w = 32 * (wave & 3); u.pair = 1; u.whalf = wh; u.band = 128;
        }
    } else {
        if (idx < 128) { const int i = idx, b = i / 32, hm = (i / 8) % 4, blk = i % 8;
            u.qoff = b * SEQ * ODD_NP + 2048 + hm * 128; u.qs = ODD_NP; u.qrow_w = 256 * blk + 32 * wave; u.causal = 0;
        } else { const int i = idx - 128, b = i / 192, g = (i / 64) % 3, pblk = i % 64, hq = 8 * g + wave;
            u.qoff = b * SEQ * ODD_NP + hq * 64; u.qs = ODD_NP; u.qrow_w = 32 * pblk; u.band = 127;
        }
    }
}
__device__ __forceinline__ void decode_epi(int idx, int l, int wave, const float* sinks, AE& e) {
    e.has_sink = 0; e.sink = 0.f; e.lseoff = 0; e.lses = 0; e.goff = 0; e.gs = 0;
    if (!(l & 1)) {
        if (idx < 384) { const int rem = idx % 48, s = rem / 24, bh = rem % 24, b = bh / 6, h = bh % 6; const int tok0 = b * SEQ;
            e.epi = 0; e.ooff = (3 + s) * NTOK * 768 + tok0 * 768 + h * 128; e.os = 768; e.lseoff = (3 + s) * NTOK * 6 + tok0 * 6 + h; e.lses = 6;
        } else if (idx < 768) { const int i = idx - 384, pat = i / 192, j = i % 192, bh = j % 24, rr = j / 24, b = bh / 6, h = bh % 6;
            const int dil = pat ? 4 : 1, res = pat ? (rr & 3) : 0; const int tok0 = b * SEQ + res;
            e.epi = 0; e.ooff = pat * NTOK * 768 + tok0 * 768 + h * 128; e.os = dil * 768; e.lseoff = pat * NTOK * 6 + tok0 * 6 + h; e.lses = dil * 6;
        } else if (idx < 896) { const int i = idx - 768, b = i / 32, hm = (i / 8) % 4;
            e.epi = 1; e.ooff = b * SEQ * DM + 1536 + hm * 128; e.os = DM; e.goff = b * SEQ * EVEN_N + 5120 + 1536 + hm * 128; e.gs = EVEN_N;
        } else { const int i = idx - 896, bh = i % 24, u8 = i / 24, b = bh / 6, h = bh % 6; const int tokw = b * SEQ + 2 * u8 + (wave >> 2);
            e.epi = 0; e.ooff = 2 * NTOK * 768 + tokw * 768 + h * 128; e.os = 16 * 768; e.lseoff = 2 * NTOK * 6 + tokw * 6 + h; e.lses = 16 * 6;
        }
    } else {
        if (idx < 128) { const int i = idx, b = i / 32, hm = (i / 8) % 4;
            e.epi = 1; e.ooff = b * SEQ * DM + 1536 + hm * 128; e.os = DM; e.goff = b * SEQ * ODD_NP + 2560 + 1536 + hm * 128; e.gs = ODD_NP;
        } else { const int i = idx - 128, b = i / 192, g = (i / 64) % 3, hq = 8 * g + wave;
            e.epi = 1; e.ooff = b * SEQ * DM + hq * 64; e.os = DM; e.goff = b * SEQ * ODD_NP + 2560 + hq * 64; e.gs = ODD_NP;
            e.has_sink = 1; e.sink = sinks[(l >> 1) * 24 + hq];
        }
    }
}


constexpr int I_E = 32 * (EVEN_N / 64), I_O = 32 * (ODD_N / 64), I_W = 32 * (DM / 64), I_M = 32 * (1024 / 64);
constexpr int CV_A = I_E + 4 * I_M + I_W, CV_B = CV_A + I_O, CV_C = CV_B + I_E + I_W, CV_D = CV_C + I_O + 2 * I_W;
typedef __attribute__((address_space(4))) const Args* KArgsC;
__device__ __forceinline__ void convert_stage(KArgsC ka, unsigned char* ws, int lo, int hi, int worker, int nworkers, int lane) {
    for (int it = lo + worker; it < hi; it += nworkers) {
        int r = it;
        if (r < I_E) { convert_item(ka->even_w_in, EVEN_N, ka->even_norm, (bf16_t*)(ws + WS_WIN_E0), 1, 0, r, lane); continue; } r -= I_E;
        if (r < 4 * I_M) { const int l = r / I_M; r -= l * I_M; const float* W = ((l & 1) ? ka->odd_w_mkv : ka->even_w_mkv) + (size_t)(l >> 1) * DM * 1024;
            convert_item(W, 1024, nullptr, (bf16_t*)(ws + WS_WMKV), 0, l * 1024, r, lane); continue; } r -= 4 * I_M;
        if (r < I_W) { convert_item(ka->even_w_out, DM, nullptr, (bf16_t*)(ws + WS_WOUT), 0, 0, r, lane); continue; } r -= I_W;
        if (r < I_O) { convert_item(ka->odd_w_in, ODD_N, ka->odd_norm, (bf16_t*)(ws + WS_WIN_O0), 2, 0, r, lane); continue; } r -= I_O;
        if (r < I_E) { convert_item(ka->even_w_in + (size_t)DM * EVEN_N, EVEN_N, ka->even_norm + DM, (bf16_t*)(ws + WS_WIN_E1), 1, 0, r, lane); continue; } r -= I_E;
        if (r < I_W) { convert_item(ka->odd_w_out, DM, nullptr, (bf16_t*)(ws + WS_WOUT + (size_t)1 * 8 * MiB), 0, 0, r, lane); continue; } r -= I_W;
        if (r < I_O) { convert_item(ka->odd_w_in + (size_t)DM * ODD_N, ODD_N, ka->odd_norm + DM, (bf16_t*)(ws + WS_WIN_O1), 2, 0, r, lane); continue; } r -= I_O;
        { const int l = 2 + r / I_W; r -= (l - 2) * I_W; const float* W = ((l & 1) ? ka->odd_w_out : ka->even_w_out) + (size_t)(l >> 1) * DM * DM;
          convert_item(W, DM, nullptr, (bf16_t*)(ws + WS_WOUT + (size_t)l * 8 * MiB), 0, 0, r, lane); }
    }
}

}

typedef __attribute__((address_space(4))) const Args* KArgs;
#define LAUNDER_S(p) asm volatile("" : "+s"(p))

__global__ void __launch_bounds__(NWAVES * 64, 2) fwd_kernel(Args args_unused) {
    extern __shared__ __attribute__((aligned(16))) unsigned char lds_raw[];
    LAS unsigned char* lds = (LAS unsigned char*)lds_raw;
    volatile LAS unsigned* MISC = (volatile LAS unsigned*)(lds + MISC_OFF);
    const int tid0 = threadIdx.x;
    const int G = gridDim.x; const int bx = blockIdx.x; const int vcu = (G % 8 == 0) ? (bx % 8) * (G / 8) + bx / 8 : bx;
    const KArgs ka0 = (KArgs)__builtin_amdgcn_kernarg_segment_ptr();
    for (int i = tid0; i < (LDS_BYTES - LDSCTL_OFF) / 4; i += NWAVES * 64) ((LAS unsigned*)(lds + LDSCTL_OFF))[i] = 0u;
    __syncthreads();
    XcdBarrier bar; { unsigned char* ws0 = ka0->ws; bar.bar = (unsigned*)(ws0 + WS_CTL) + CW_BAR; bar.x = 0; bar.st = nullptr;
        if (!MK_PER_PHASE) bar = xcd_barrier_post((unsigned*)(ws0 + WS_CTL) + CW_BAR, MISC + 8); }
    const int ph_lo = ka0->ph_lo, ph_hi = ka0->ph_hi;

    unsigned long long tp_acc = 0ull;
    for (int ph = ph_lo; ph < ph_hi; ++ph) {
        unsigned long long tp_t0 = 0ull; if (TPROBE_MASK) tp_t0 = __builtin_amdgcn_s_memrealtime();
        int tid = tid0; asm volatile("" : "+v"(tid));
        const int lane = tid & 63, wave = __builtin_amdgcn_readfirstlane(tid >> 6);
        KArgs ka = ka0; LAUNDER_S(ka);
        unsigned char* ws = ka->ws;
        if (ph == 0 && (AN_MASK & 1)) {
            const int gw = vcu * NWAVES + wave, NGW = G * NWAVES;
            convert_stage(ka, ws, 0, CV_A, gw, NGW, lane);
            bf16_t* XB = (bf16_t*)(ws + WS_XB); bf16_t* MEMN = (bf16_t*)(ws + WS_MEMN); float* SSQ = (float*)(ws + WS_SSQ);
            const float* xin = ka->x; const float* memin = ka->mem; const float* mnorm = ka->mem_norm;
            for (int m = gw; m < NTOK + NMEM; m += NGW) {
                const bool isx = m < NTOK; const int row = isx ? m : m - NTOK;
                const f32x4* xr = (const f32x4*)((isx ? xin : memin) + (size_t)row * DM) + lane;
                f32x4 v[8]; float s = 0.f;
#pragma unroll
                for (int j = 0; j < 8; ++j) { v[j] = xr[64 * j]; s += (v[j].x * v[j].x + v[j].y * v[j].y) + (v[j].z * v[j].z + v[j].w * v[j].w); }
                s = wave_sum(s);
                unsigned long long* o8 = (unsigned long long*)((isx ? XB : MEMN) + (size_t)row * DM) + lane;
                if (isx) {
                    if (lane < 8) SSQ[(size_t)lane * NTOK + row] = lane == 0 ? s : 0.f;
#pragma unroll
                    for (int j = 0; j < 8; ++j) o8[64 * j] = (unsigned long long)pk2(v[j].x, v[j].y) | ((unsigned long long)pk2(v[j].z, v[j].w) << 32);
                } else {
                    const float rs = 1.0f / sqrtf(s * (1.0f / DM) + EPS);
                    const f32x4* gr = (const f32x4*)mnorm + lane;
#pragma unroll
                    for (int j = 0; j < 8; ++j) { const f32x4 g = gr[64 * j]; o8[64 * j] = (unsigned long long)pk2(v[j].x * rs * g.x, v[j].y * rs * g.y) | ((unsigned long long)pk2(v[j].z * rs * g.z, v[j].w * rs * g.w) << 32); }
                }
            }
            float* CS128 = (float*)(ws + WS_CS128); float* CS64 = (float*)(ws + WS_CS64); const int* posp = ka->pos;
            for (int tk = gw; tk < NTOK; tk += NGW) {
                const float pf = (float)posp[tk];
                { const float inv = expf((float)lane * (float)(-2.0 * 9.210340371976184 / 128.0)); const float ang = pf * inv;
                  const double rev = (double)ang * 0.15915494309189535; const float fr = (float)(rev - rint(rev));
                  CS128[(size_t)tk * 128 + lane] = __builtin_amdgcn_cosf(fr); CS128[(size_t)tk * 128 + 64 + lane] = __builtin_amdgcn_sinf(fr); }
                if (lane < 32) { const float inv = expf((float)lane * (float)(-2.0 * 9.210340371976184 / 64.0)); const float ang = pf * inv;
                  const double rev = (double)ang * 0.15915494309189535; const float fr = (float)(rev - rint(rev));
                  CS64[(size_t)tk * 64 + lane] = __builtin_amdgcn_cosf(fr); CS64[(size_t)tk * 64 + 32 + lane] = __builtin_amdgcn_sinf(fr); }
            }
        } else if (ph == 17 && (AN_MASK & 2) && G != 256) {
            const int gw = vcu * NWAVES + wave, NGW = G * NWAVES;
            const float* ssq = (const float*)(ws + WS_SSQ) + (size_t)4 * 8 * NTOK; float* outp = ka->out; const float* fnorm = ka->final_norm;
            for (int m = gw; m < NTOK; m += NGW) {
                float sq = 0.f;
#pragma unroll
                for (int j = 0; j < 8; ++j) sq += ssq[(size_t)j * NTOK + m];
                const float rs = 1.0f / sqrtf(sq * (1.0f / DM) + EPS);
                f32x4* xr = (f32x4*)(outp + (size_t)m * DM) + lane; const f32x4* gr = (const f32x4*)fnorm + lane;
#pragma unroll
                for (int j = 0; j < 8; ++j) { f32x4 v = xr[64 * j]; const f32x4 g = gr[64 * j]; v = v * rs * g; xr[64 * j] = v; }
            }
        } else if (ph >= 1 && ph <= 16) {
            const int l = (ph - 1) >> 2, sub = (ph - 1) & 3, odd = l & 1, li = l >> 1;
            if ((sub == 0 && (AN_MASK & 4)) || (sub == 3 && (AN_MASK & 8))) {
                GemmP P; P.ws = ws; P.l = l; P.xin = ka->x; P.out = ka->out; P.lds = lds; P.fnorm = ka->final_norm; P.fuse_final = (G == 256) ? 1 : 0;
                Order S; S.G = G; S.c = bx; S.nM0 = NTOK / 256;
                if (sub == 0) { P.mode = EM_INPROJ; P.A = (const bf16_t*)(ws + WS_XB); P.Bt = (const bf16_t*)(ws + (odd ? (li ? WS_WIN_O1 : WS_WIN_O0) : (li ? WS_WIN_E1 : WS_WIN_E0)));
                    S.nN0 = (odd ? ODD_NP : EVEN_N) / 256; S.nwg1 = (l == 0) ? 64 : 0; }
                else { P.mode = EM_OUTPROJ; P.A = (const bf16_t*)(ws + WS_Y); P.Bt = (const bf16_t*)(ws + WS_WOUT + (size_t)l * 8 * MiB); S.nN0 = DM / 256; S.nwg1 = 0; }
                S.nwg0 = S.nM0 * S.nN0;
                gemm_phase(lds, P, S, tid);
                if (sub == 0 && l < 3) {
                    const int nwg = S.nwg0 + S.nwg1, TT = nwg % G, lo = l == 0 ? CV_A : (l == 1 ? CV_B : CV_C), hi = l == 0 ? CV_B : (l == 1 ? CV_C : CV_D);
                    if (TT == 0) convert_stage(ka, ws, lo, hi, bx * NWAVES + wave, G * NWAVES, lane);
                    else if (bx >= TT) convert_stage(ka, ws, lo, hi, (bx - TT) * NWAVES + wave, (G - TT) * NWAVES, lane);
                }
            } else if (sub == 2 && (AN_MASK & 16)) {
                if (!odd) {
                    const float* LSE = (const float*)(ws + WS_LSE); const bf16_t* OG = (const bf16_t*)(ws + WS_OG); const bf16_t* QKV = (const bf16_t*)(ws + WS_QKV); bf16_t* Y = (bf16_t*)(ws + WS_Y);
                    const long NIT = (long)NTOK * 192;
                    for (long it = (long)bx * 512 + tid; it < NIT; it += (long)G * 512) {
                        const int tok = (int)(it / 192), c = (int)(it % 192), isb = c >= 96, cc8 = (isb ? c - 96 : c), h = cc8 >> 4;
                        const int g0 = isb ? 3 : 0;
                        const size_t lb = (size_t)tok * 6 + h, ob = (size_t)tok * 768 + cc8 * 8;
                        const float l0 = LSE[(size_t)g0 * NTOK * 6 + lb], l1 = LSE[(size_t)(g0 + 1) * NTOK * 6 + lb], l2 = isb ? -1e30f : LSE[(size_t)2 * NTOK * 6 + lb];
                        const float mx = fmaxf(l0, fmaxf(l1, l2));
                        float w0 = __expf(l0 - mx), w1 = __expf(l1 - mx), w2 = isb ? 0.f : __expf(l2 - mx); const float inv = 1.0f / (w0 + w1 + w2); w0 *= inv; w1 *= inv; w2 *= inv;
                        const u32x4 a = *(const u32x4*)(OG + (size_t)g0 * NTOK * 768 + ob), b = *(const u32x4*)(OG + (size_t)(g0 + 1) * NTOK * 768 + ob);
                        u32x4 cc = {0u, 0u, 0u, 0u}; if (!isb) cc = *(const u32x4*)(OG + (size_t)2 * NTOK * 768 + ob);
                        const u32x4 g = *(const u32x4*)(QKV + (size_t)tok * EVEN_N + 5120 + c * 8);
                        u32x4 o;
#define CMB(f) cvt_pk_bf16((w0 * bflo(a.f) + w1 * bflo(b.f) + w2 * bflo(cc.f)) * bflo(g.f), (w0 * bfhi(a.f) + w1 * bfhi(b.f) + w2 * bfhi(cc.f)) * bfhi(g.f))
                        o.x = CMB(x); o.y = CMB(y); o.z = CMB(z); o.w = CMB(w);
#undef CMB
                        *(u32x4*)(Y + (size_t)tok * DM + c * 8) = o;
                    }
                }
            } else if (sub == 1 && (AN_MASK & 32)) {
                gu32* qctr = (gu32*)(ws + WS_CTL) + CW_Q + 64 * l;
                const int NUNITS = odd ? NUNITS_ODD : NUNITS_EVEN;
                if (tid == 0) { MISC[16] = __hip_atomic_fetch_add(qctr, 1u, RLX_AGENT); MISC[17] = __hip_atomic_fetch_add(qctr, 1u, RLX_AGENT); }
                __syncthreads();
                int idx = (int)MISC[16], idx1 = (int)MISC[17];
                int it = 0, pb = 0; bool warm = false;
                while (idx < NUNITS) {
                    idx = __builtin_amdgcn_readfirstlane(idx); idx1 = __builtin_amdgcn_readfirstlane(idx1);
                    int tid_u = tid; asm volatile("" : "+v"(tid_u)); const int lane_u = tid_u & 63;
                    unsigned nx2 = 0; if (tid == 0) nx2 = __hip_atomic_fetch_add(qctr, 1u, RLX_AGENT);
                    const bool d64 = unit_d64(idx, l);
                    const int pre = (idx1 < NUNITS && unit_d64(idx1, l) == d64) ? 1 : 0;
                    KVD d, dn; decode_kv(idx, l, d); decode_kv(pre ? idx1 : idx, l, dn);
                    AU u; decode_q(idx, l, wave, u);
                    float m_reg, l_reg;
                    if (d64) { if (!warm) cold_start<64>(d, ws, lds + pb * ABUF, tid_u);
                        f32x16 o[2]; attn_main<64>(u, d, dn, pre, pb, ws, lds, tid_u, wave, lane_u, m_reg, l_reg, o);
                        int idx2 = idx; LAUNDER_S(idx2); AE e; decode_epi(idx2, l, wave, ka->odd_sinks, e); attn_epi<64>(e, u.qrow_w, pb ^ 1, ws, lds, wave, lane_u, m_reg, l_reg, o); }
                    else { if (!warm) cold_start<128>(d, ws, lds + pb * ABUF, tid_u);
                        f32x16 o[4]; attn_main<128>(u, d, dn, pre, pb, ws, lds, tid_u, wave, lane_u, m_reg, l_reg, o);
                        int idx2 = idx; LAUNDER_S(idx2); AE e; decode_epi(idx2, l, wave, ka->odd_sinks, e); attn_epi<128>(e, u.qrow_w, pb ^ 1, ws, lds, wave, lane_u, m_reg, l_reg, o); }
                    warm = pre != 0;
                    if (tid == 0) MISC[18 + (it & 1)] = nx2;
                    __syncthreads();
                    idx = idx1; idx1 = (int)MISC[18 + (it & 1)]; ++it;
                }
            }
        }
        if (ph + 1 < ph_hi && !(ph == 16 && G == 256)) { if (!(ph >= 1 && ph <= 16 && ((ph - 1) & 3) == 2 && (((ph - 1) >> 2) & 1))) xcd_barrier(bar); }
        if (TPROBE_MASK) { if ((TPROBE_MASK >> ph) & 1) tp_acc += __builtin_amdgcn_s_memrealtime() - tp_t0; }
    }
    if (TPROBE_MASK) { if (bx == 0) { const unsigned long long te = __builtin_amdgcn_s_memrealtime(); while (__builtin_amdgcn_s_memrealtime() - te < 4ull * tp_acc) __builtin_amdgcn_s_sleep(8); } }
}

extern "C" void kernel_launch(void* const* d_in, const int* in_sizes, int n_in, void* d_out, int out_size, void* d_ws, size_t ws_size, hipStream_t stream) {
    static int grid = 0;
    if (grid == 0) {
        if (n_in != 14 || in_sizes[0] != NTOK * DM || out_size != NTOK * DM || ws_size < WS_END) { fprintf(stderr, "kernel_launch: unexpected shapes (n_in %d, in0 %d, out %d, ws %zu)\n", n_in, n_in > 0 ? in_sizes[0] : -1, out_size, ws_size); grid = -1; return; }
        int dev = 0, cus = 0, per_cu = 0;
        if (hipGetDevice(&dev) != hipSuccess || hipDeviceGetAttribute(&cus, hipDeviceAttributeMultiprocessorCount, dev) != hipSuccess) { grid = -1; return; }
        if (hipFuncSetAttribute((const void*)fwd_kernel, hipFuncAttributeMaxDynamicSharedMemorySize, LDS_BYTES) != hipSuccess) { fprintf(stderr, "kernel_launch: hipFuncSetAttribute failed\n"); grid = -1; return; }
        if (hipOccupancyMaxActiveBlocksPerMultiprocessor(&per_cu, (const void*)fwd_kernel, NWAVES * 64, LDS_BYTES) != hipSuccess || per_cu < 1) { fprintf(stderr, "kernel_launch: occupancy query says %d blocks/CU\n", per_cu); }
        (void)hipGetLastError();
        grid = cus;
    }
    if (grid < 0) return;
    (void)hipMemsetAsync((char*)d_ws + WS_CTL, 0, CTL_ZERO_BYTES, stream);
    Args a{};
    a.x = (const float*)d_in[0]; a.mem = (const float*)d_in[1]; a.pos = (const int*)d_in[2];
    a.even_norm = (const float*)d_in[3]; a.even_w_in = (const float*)d_in[4]; a.even_w_mkv = (const float*)d_in[5]; a.even_w_out = (const float*)d_in[6];
    a.odd_norm = (const float*)d_in[7]; a.odd_w_in = (const float*)d_in[8]; a.odd_w_mkv = (const float*)d_in[9]; a.odd_w_out = (const float*)d_in[10]; a.odd_sinks = (const float*)d_in[11];
    a.mem_norm = (const float*)d_in[12]; a.final_norm = (const float*)d_in[13];
    a.out = (float*)d_out; a.ws = (unsigned char*)d_ws;
#if MK_PER_PHASE
    for (int ph = 0; ph < N_PHASES; ++ph) { a.ph_lo = ph; a.ph_hi = ph + 1; hipLaunchKernelGGL(fwd_kernel, dim3(grid), dim3(NWAVES * 64), LDS_BYTES, stream, a); }
#else
    a.ph_lo = 0; a.ph_hi = N_PHASES;
    hipLaunchKernelGGL(fwd_kernel, dim3(grid), dim3(NWAVES * 64), LDS_BYTES, stream, a);
#ifdef PROBE_PHASES
    {
        const int pp[] = PROBE_PHASES;
        (void)hipMemsetAsync((char*)d_ws + WS_CTL + (size_t)CW_Q * 4, 0, 64 * 8 * 4, stream);
        for (unsigned i = 0; i < sizeof(pp) / sizeof(pp[0]); ++i) { a.ph_lo = pp[i]; a.ph_hi = pp[i] + 1; hipLaunchKernelGGL(fwd_kernel, dim3(grid), dim3(NWAVES * 64), LDS_BYTES, stream, a); }
    }
#endif
#endif
    const hipError_t le = hipPeekAtLastError();
    if (le != hipSuccess) fprintf(stderr, "kernel_launch: launch failed: %s\n", hipGetErrorName(le));
}
```

```cpp
#include <hip/hip_runtime.h>
#include <cstdio>
#include <cstdint>

#ifndef TPROBE_MASK
#define TPROBE_MASK 0
#endif
#ifndef AN_MASK
#define AN_MASK 63
#endif
#ifndef MK_PER_PHASE
#define MK_PER_PHASE 0
#endif

namespace {
#define LAS __attribute__((address_space(3)))
#define GAS __attribute__((address_space(1)))
typedef unsigned short bf16_t;
typedef short bf16x8 __attribute__((ext_vector_type(8)));
typedef short s16x4 __attribute__((ext_vector_type(4)));
typedef float f32x4 __attribute__((ext_vector_type(4)));
typedef float f32x16 __attribute__((ext_vector_type(16)));
typedef unsigned u32x4 __attribute__((ext_vector_type(4)));
typedef GAS unsigned gu32;
#define RLX_AGENT __ATOMIC_RELAXED, __HIP_MEMORY_SCOPE_AGENT
#define LDS_WAIT() asm volatile("s_waitcnt lgkmcnt(0)" ::: "memory")
#define VM_WAIT() asm volatile("s_waitcnt vmcnt(0)" ::: "memory")
#define SBAR() __builtin_amdgcn_sched_barrier(0)

constexpr int BATCH = 4, SEQ = 2048, DM = 2048, NTOK = BATCH * SEQ, MEML = 256, NMEM = BATCH * MEML;
constexpr int EVEN_N = 7168, ODD_N = 4480, ODD_NP = 4608;
constexpr int KDIM = 2048;
constexpr float EPS = 1e-6f;
constexpr int NWAVES = 8;

constexpr size_t MiB = 1u << 20;
constexpr size_t WS_CTL = 0, CTL_ZERO_BYTES = 1 * MiB;
constexpr size_t WS_WIN_E0 = 1 * MiB, WS_WIN_E1 = 29 * MiB, WS_WIN_O0 = 57 * MiB, WS_WIN_O1 = 75 * MiB;
constexpr size_t WS_WOUT = 93 * MiB;
constexpr size_t WS_WMKV = 125 * MiB;
constexpr size_t WS_XB = 141 * MiB;
constexpr size_t WS_QKV = 173 * MiB;
constexpr size_t WS_Y = 285 * MiB;
constexpr size_t WS_OG = 374 * MiB;
constexpr size_t WS_LSE = 353 * MiB;
constexpr size_t WS_MKV = 354 * MiB;
constexpr size_t WS_MEMN = 362 * MiB;
constexpr size_t WS_CS128 = 366 * MiB;
constexpr size_t WS_CS64 = 370 * MiB;
constexpr size_t WS_SSQ = 372 * MiB;
constexpr size_t WS_END = 438 * MiB;
constexpr int CW_BAR = 4096;
constexpr int CW_SSQ = 16384;
constexpr int CW_KM = 65536;
constexpr int CW_Q = 131072;
constexpr int CW_PAN = 135168;
static_assert((CW_PAN + 64 * 32) * 4 <= (int)CTL_ZERO_BYTES, "ctl");

constexpr int RING_BYTES = 131072;
constexpr int LDSCTL_OFF = RING_BYTES, MISC_OFF = LDSCTL_OFF + 320;
constexpr int LDS_BYTES = 147456;
constexpr int XTBL_OFF = LDSCTL_OFF + 1024;

__device__ __forceinline__ unsigned f2bf(float f) { unsigned u = __builtin_bit_cast(unsigned, f); return (u + 0x7fffu + ((u >> 16) & 1u)) >> 16; }
typedef float f32x2_t __attribute__((ext_vector_type(2))); typedef __bf16 bf16x2_t __attribute__((ext_vector_type(2)));
__device__ __forceinline__ unsigned pk2(float lo, float hi) { f32x2_t v = {lo, hi}; bf16x2_t b = __builtin_convertvector(v, bf16x2_t); return __builtin_bit_cast(unsigned, b); }
__device__ __forceinline__ unsigned cvt_pk_bf16(float lo, float hi) { unsigned r; asm volatile("v_cvt_pk_bf16_f32 %0, %1, %2" : "=v"(r) : "v"(lo), "v"(hi)); return r; }
__device__ __forceinline__ float bflo(unsigned w) { return __builtin_bit_cast(float, w << 16); }
__device__ __forceinline__ float bfhi(unsigned w) { return __builtin_bit_cast(float, w & 0xffff0000u); }

constexpr int BM = 256, BK = 64, HALF = 128, HTB = HALF * BK * 2, NXCD = 8, WGM = 8;
__device__ __forceinline__ int lds_byte(int r, int c) { const int st = (r >> 4) * 2 + (c >> 5), rr = r & 15, cc = c & 31, ob = rr * 64 + cc * 2; return st * 1024 + (ob ^ (((ob >> 9) & 1) << 5)); }
__device__ __forceinline__ void stage_rc(int b, int& R, int& C) { const int st = b / 1024, sb = b % 1024, swz = sb ^ (((sb >> 9) & 1) << 5); R = (st >> 1) * 16 + swz / 64; C = (st & 1) * 32 + (swz % 64) / 2; }
__device__ __forceinline__ int perm32(int rho) { const int n = rho >> 4, i = rho & 15; return 8 * (i >> 2) + 4 * n + (i & 3); }

struct Unit { int pm, pn, s; };
enum { EM_PLAIN = 0, EM_INPROJ = 1, EM_OUTPROJ = 2 };
struct GemmP { const bf16_t* A; const bf16_t* Bt; int mode, l; unsigned char* ws; const float* xin; float* out; LAS unsigned char* lds; const float* fnorm; int fuse_final; };
__device__ __forceinline__ void tile_of(int wgid, int nM, int nN, int& pm, int& pn) {
    const int nwg = nM * nN; { const int q = nwg / NXCD, r = nwg % NXCD, xcd = wgid % NXCD, off = wgid / NXCD; wgid = (xcd < r ? xcd * (q + 1) : r * (q + 1) + (xcd - r) * q) + off; }
    const int nig = WGM * nN, gid = wgid / nig, fm = gid * WGM, gsz = (nM - fm) < WGM ? (nM - fm) : WGM;
    pm = fm + ((wgid % nig) % gsz); pn = (wgid % nig) / gsz;
}
struct Order {
    int nwg0, nwg1, nM0, nN0, G, c;
    __device__ __forceinline__ bool next(int i, Unit& u) const {
        const int L = i * G + c; if (L >= nwg0 + nwg1) return false;
        if (L < nwg0) { u.s = 0; tile_of(L, nM0, nN0, u.pm, u.pn); } else { u.s = 1; tile_of(L - nwg0, 4, 16, u.pm, u.pn); }
        return true;
    }
};

__device__ __forceinline__ void epi_run(const GemmP& P, const f32x4 (&acc)[2][2][4][2], const Unit& u, int wr, int wc, int fr, int fq) {
    const int row0 = u.pm * BM + wr * 64 + fr;
    const int colt = u.pn * BM + wc * 32 + 8 * fq;
    const int mode = u.s ? EM_PLAIN : P.mode;
    unsigned char* ws = P.ws;
    if (mode == EM_PLAIN) {
        bf16_t* O = (bf16_t*)(ws + WS_MKV);
#pragma unroll
        for (int ai = 0; ai < 2; ++ai)
#pragma unroll
            for (int m = 0; m < 4; ++m) { bf16_t* rowp = O + (size_t)(row0 + ai * HALF + m * 16) * 4096 + colt;
#pragma unroll
                for (int bj = 0; bj < 2; ++bj) { const f32x4 v0 = acc[ai][bj][m][0], v1 = acc[ai][bj][m][1];
                    u32x4 w; w.x = cvt_pk_bf16(v0[0], v0[1]); w.y = cvt_pk_bf16(v0[2], v0[3]); w.z = cvt_pk_bf16(v1[0], v1[1]); w.w = cvt_pk_bf16(v1[2], v1[3]);
                    *(u32x4*)(rowp + bj * HALF) = w; } }
    } else if (mode == EM_INPROJ) {
        const int l = P.l, odd = l & 1, ldo = odd ? ODD_NP : EVEN_N;
        bf16_t* O = (bf16_t*)(ws + WS_QKV);
        const float* cs128 = (const float*)(ws + WS_CS128); const float* cs64 = (const float*)(ws + WS_CS64);
        float* km = (float*)(ws + WS_CTL) + CW_KM + (size_t)(l >> 1) * (4 * 6 * 8 * 128);
        int kind; bool kmean = false;
        if (odd) { kind = (u.pn <= 6) ? 2 : (u.pn <= 9 ? 0 : 3); }
        else { kind = (u.pn < 6) ? 1 : (u.pn < 9 ? 0 : (u.pn < 15 ? 1 : (u.pn < 20 ? 0 : 3))); kmean = (u.pn >= 12 && u.pn < 15); }
        float ks[2][8];
#pragma unroll
        for (int bj = 0; bj < 2; ++bj)
#pragma unroll
            for (int e = 0; e < 8; ++e) ks[bj][e] = 0.f;
        f32x4 csA[8], snA[8];
#define EPI_TLOAD(I0) do { if (kind == 1) { _Pragma("unroll") for (int i = (I0); i < (I0) + 4; ++i) { const float* t = cs128 + (size_t)(row0 + (i >> 2) * HALF + (i & 3) * 16) * 128 + (16 * wc + 4 * fq); csA[i] = *(const f32x4*)t; snA[i] = *(const f32x4*)(t + 64); } } \
        else if (kind == 2) { _Pragma("unroll") for (int i = (I0); i < (I0) + 4; ++i) { const float* t = cs64 + (size_t)(row0 + (i >> 2) * HALF + (i & 3) * 16) * 64 + (16 * (wc & 1) + 4 * fq); csA[i] = *(const f32x4*)t; snA[i] = *(const f32x4*)(t + 32); } } \
        else { _Pragma("unroll") for (int i = (I0); i < (I0) + 4; ++i) { csA[i] = (f32x4){1.f, 1.f, 1.f, 1.f}; snA[i] = (f32x4){0.f, 0.f, 0.f, 0.f}; } } } while (0)
        EPI_TLOAD(0);
        { const int te = (wr * 4 + wc) * 64 + fq * 16 + fr;
          if (te < 256) { const float* sb = (const float*)(ws + WS_SSQ) + (size_t)l * 8 * NTOK + u.pm * BM; float t8[8];
#pragma unroll
              for (int j = 0; j < 8; ++j) { const float* sj = sb + (size_t)j * NTOK; t8[j] = sj[te]; }
              const float sq = ((t8[0] + t8[1]) + (t8[2] + t8[3])) + ((t8[4] + t8[5]) + (t8[6] + t8[7]));
              ((LAS float*)(P.lds + XTBL_OFF))[te] = __builtin_amdgcn_rsqf(sq * (1.0f / DM) + EPS); }
          LDS_WAIT(); __builtin_amdgcn_s_barrier(); asm volatile("" ::: "memory"); }
        const LAS float* rst = (const LAS float*)(P.lds + XTBL_OFF);
#pragma unroll
        for (int ai = 0; ai < 2; ++ai) {
#pragma unroll
            for (int m = 0; m < 4; ++m) {
                if (ai == 0 && m == 3) { asm volatile("" ::: "memory"); EPI_TLOAD(4); }
                const int row = row0 + ai * HALF + m * 16;
                const float rs = rst[ai * HALF + wr * 64 + m * 16 + fr];
                const f32x4 cs = csA[ai * 4 + m], sn = snA[ai * 4 + m];
                bf16_t* rowp = O + (size_t)row * ldo + colt;
#pragma unroll
                for (int bj = 0; bj < 2; ++bj) {
                    f32x4 v0 = acc[ai][bj][m][0] * rs, v1 = acc[ai][bj][m][1] * rs;
                    if (kind == 1 || kind == 2) { const f32x4 o0 = v0 * cs - v1 * sn, o1 = v1 * cs + v0 * sn; v0 = o0; v1 = o1; }
                    else if (kind == 3) {
#pragma unroll
                        for (int j = 0; j < 4; ++j) { v0[j] = v0[j] * __builtin_amdgcn_rcpf(1.0f + __builtin_amdgcn_exp2f(-1.4426950408889634f * v0[j]));
                                                      v1[j] = v1[j] * __builtin_amdgcn_rcpf(1.0f + __builtin_amdgcn_exp2f(-1.4426950408889634f * v1[j])); }
                    }
                    if (kmean) {
#pragma unroll
                        for (int j = 0; j < 4; ++j) { ks[bj][j] += v0[j]; ks[bj][4 + j] += v1[j]; }
                    }
                    u32x4 w; w.x = cvt_pk_bf16(v0[0], v0[1]); w.y = cvt_pk_bf16(v0[2], v0[3]); w.z = cvt_pk_bf16(v1[0], v1[1]); w.w = cvt_pk_bf16(v1[2], v1[3]);
                    *(u32x4*)(rowp + bj * HALF) = w;
                }
            }
        }
#undef EPI_TLOAD
        if (kmean) {
#pragma unroll
            for (int bj = 0; bj < 2; ++bj)
#pragma unroll
                for (int e = 0; e < 8; ++e) { float s = ks[bj][e]; s += __shfl_xor(s, 1); s += __shfl_xor(s, 2); s += __shfl_xor(s, 4); s += __shfl_xor(s, 8); ks[bj][e] = s; }
            if (fr == 0) {
                const int b = u.pm >> 3, n = u.pm & 7;
#pragma unroll
                for (int bj = 0; bj < 2; ++bj) { const int h = (u.pn - 12) * 2 + bj; float* dst = km + ((size_t)((b * 6 + h) * 8 + n)) * 128 + wc * 32 + 8 * fq;
#pragma unroll
                    for (int e = 0; e < 8; ++e) atomicAdd(dst + e, ks[bj][e]); }
            }
        }
    } else {
        const int l = P.l;
        float* xout = P.out;
        bf16_t* xb = (bf16_t*)(ws + WS_XB); const bool wxb = (l != 3);
        const bool fuse = (l == 3) && P.fuse_final;
        float* ssq_out = (float*)(ws + WS_SSQ) + (size_t)(l + 1) * 8 * NTOK + (size_t)u.pn * NTOK + u.pm * BM;
        LAS float* xt = (LAS float*)(P.lds + XTBL_OFF);
#pragma unroll
        for (int ai = 0; ai < 2; ++ai)
#pragma unroll
            for (int m = 0; m < 4; ++m) {
                const int row = row0 + ai * HALF + m * 16; float ss = 0.f;
#pragma unroll
                for (int bj = 0; bj < 2; ++bj) {
                    const size_t off = (size_t)row * DM + colt + bj * HALF;
                    const f32x4 v0 = acc[ai][bj][m][0], v1 = acc[ai][bj][m][1];
                    if (!fuse) { *(f32x4*)(xout + off) = v0; *(f32x4*)(xout + off + 4) = v1; }
                    if (wxb) { u32x4 w; w.x = cvt_pk_bf16(v0[0], v0[1]); w.y = cvt_pk_bf16(v0[2], v0[3]); w.z = cvt_pk_bf16(v1[0], v1[1]); w.w = cvt_pk_bf16(v1[2], v1[3]); *(u32x4*)(xb + off) = w; }
                    ss += (v0[0] * v0[0] + v0[1] * v0[1]) + (v0[2] * v0[2] + v0[3] * v0[3]) + (v1[0] * v1[0] + v1[1] * v1[1]) + (v1[2] * v1[2] + v1[3] * v1[3]);
                }
                ss += __shfl_xor(ss, 16); ss += __shfl_xor(ss, 32);
                if (fq == 0) xt[(ai * HALF + wr * 64 + m * 16 + fr) * 4 + wc] = ss;
            }
        LDS_WAIT(); __builtin_amdgcn_s_barrier(); asm volatile("" ::: "memory");
        const int lane = fq * 16 + fr, wid = wr * 4 + wc, r = wid * 32 + (lane & 31);
        if (!fuse) {
            if (lane < 32) { const f32x4 t = *(const LAS f32x4*)(xt + r * 4); ssq_out[r] = (t[0] + t[1]) + (t[2] + t[3]); }
        } else {
            if (lane < 32) { const f32x4 t = *(const LAS f32x4*)(xt + r * 4); __hip_atomic_store((unsigned*)(ssq_out + r), __float_as_uint((t[0] + t[1]) + (t[2] + t[3])), __ATOMIC_RELAXED, __HIP_MEMORY_SCOPE_AGENT); }
            asm volatile("s_waitcnt vmcnt(0)" ::: "memory"); LDS_WAIT();
            __builtin_amdgcn_s_barrier(); asm volatile("" ::: "memory");
            unsigned* pcnt = (unsigned*)(ws + WS_CTL) + CW_PAN + 64 * u.pm;
            if (wid == 0 && lane == 0) {
                __hip_atomic_fetch_add(pcnt, 1u, __ATOMIC_RELAXED, __HIP_MEMORY_SCOPE_AGENT);
                unsigned sp = 0; while (__hip_atomic_load(pcnt, __ATOMIC_RELAXED, __HIP_MEMORY_SCOPE_AGENT) < 8u) { __builtin_amdgcn_s_sleep(2); if (++sp > (1u << 22)) break; }
                __builtin_amdgcn_fence(__ATOMIC_ACQUIRE, "agent"); asm volatile("s_waitcnt vmcnt(0)" ::: "memory");
            }
            __builtin_amdgcn_s_barrier(); asm volatile("" ::: "memory");
            { const int te = wid * 64 + lane;
              if (te < 256) { const unsigned* sb = (const unsigned*)((const float*)(ws + WS_SSQ) + (size_t)4 * 8 * NTOK + u.pm * BM + te); float sq = 0.f;
#pragma unroll
                  for (int j = 0; j < 8; ++j) sq += __uint_as_float(__hip_atomic_load(sb + (size_t)j * NTOK, __ATOMIC_RELAXED, __HIP_MEMORY_SCOPE_AGENT));
                  xt[te] = 1.0f / sqrtf(sq * (1.0f / DM) + EPS); }
              LDS_WAIT(); __builtin_amdgcn_s_barrier(); asm volatile("" ::: "memory"); }
#pragma unroll
            for (int bj = 0; bj < 2; ++bj) {
                const f32x4 g0 = *(const f32x4*)(P.fnorm + colt + bj * HALF), g1 = *(const f32x4*)(P.fnorm + colt + bj * HALF + 4);
#pragma unroll
                for (int ai = 0; ai < 2; ++ai)
#pragma unroll
                    for (int m = 0; m < 4; ++m) {
                        const float rs = xt[ai * HALF + wr * 64 + m * 16 + fr];
                        const size_t off = (size_t)(row0 + ai * HALF + m * 16) * DM + colt + bj * HALF;
                        *(f32x4*)(xout + off) = acc[ai][bj][m][0] * rs * g0; *(f32x4*)(xout + off + 4) = acc[ai][bj][m][1] * rs * g1;
                    }
            }
        }
    }
}

__device__ __forceinline__ void gemm_phase(LAS unsigned char* lds, const GemmP& P, const Order& S, const int tid) {
    const int wid = __builtin_amdgcn_readfirstlane(tid >> 6), lane = tid & 63, wr = wid >> 2, wc = wid & 3, fr = lane & 15, fq = lane >> 4;
    constexpr int K = KDIM, nt = K / BK;
    unsigned voffA[2], voffB[2];
#pragma unroll
    for (int i = 0; i < 2; ++i) { int R, C; stage_rc(tid * 16 + i * 8192, R, C); const int Rb = (R & ~31) + perm32(R & 31);
        voffA[i] = (unsigned)(R * K + C) * 2u; voffB[i] = (unsigned)(Rb * K + C) * 2u; }
    constexpr size_t kstep = (size_t)(BK * 2);
    constexpr size_t hstep = (size_t)HALF * K * 2;
    constexpr size_t tstep = 2 * hstep;
    const unsigned ldsw = (unsigned)wid * 1024u;
    const int aoff = lds_byte(wr * 64 + fr, fq * 8), boff = lds_byte(wc * 32 + fr, fq * 8);
#define PG8_SA(b, h) (((b) * 2 + (h)) * HTB)
#define PG8_SB(b, h) ((4 + (b) * 2 + (h)) * HTB)
#define PG8_STAGE(bufoff, gbase, voff) do { _Pragma("unroll") for (int _i = 0; _i < 2; ++_i) \
        __builtin_amdgcn_global_load_lds((const unsigned*)((const char*)(gbase) + (voff)[_i]), (LAS unsigned*)(lds + (bufoff) + ldsw + _i * 8192), 16, 0, 0); } while (0)
#define PG8_LDA(dst, b, h) do { _Pragma("unroll") for (int m = 0; m < 4; ++m) _Pragma("unroll") for (int k = 0; k < 2; ++k) dst[m][k] = *(const LAS bf16x8*)(lds + PG8_SA(b, h) + aoff + m * 2048 + k * 1024); } while (0)
#define PG8_LDB(dst, b, h) do { _Pragma("unroll") for (int n = 0; n < 2; ++n) _Pragma("unroll") for (int k = 0; k < 2; ++k) dst[n][k] = *(const LAS bf16x8*)(lds + PG8_SB(b, h) + boff + n * 2048 + k * 1024); } while (0)
#define PG8_MMA(ai, bj, At, Bt) do { __builtin_amdgcn_s_setprio(1); _Pragma("unroll") for (int m = 0; m < 4; ++m) _Pragma("unroll") for (int n = 0; n < 2; ++n) _Pragma("unroll") for (int k = 0; k < 2; ++k) \
        acc[ai][bj][m][n] = __builtin_amdgcn_mfma_f32_16x16x32_bf16(Bt[n][k], At[m][k], acc[ai][bj][m][n], 0, 0, 0); __builtin_amdgcn_s_setprio(0); } while (0)
#define PG8_WAIT_V(n) asm volatile("s_waitcnt vmcnt(" #n ")" ::: "memory")
#define PG8_WAIT_L(n) asm volatile("s_waitcnt lgkmcnt(" #n ")" ::: "memory")
#define PG8_BAR __builtin_amdgcn_s_barrier()
#define PG8_SCHED __builtin_amdgcn_sched_barrier(0)
    Unit cur, nxt; int ui = 0;
    if (!S.next(0, cur)) return;
    f32x4 acc[2][2][4][2];
#define PG8_ACC_INIT(U) do { if (P.mode == EM_OUTPROJ && (U).s == 0) { \
        const char* rp = (const char*)(P.l == 0 ? P.xin : (const float*)P.out) + ((size_t)((U).pm * BM + wr * 64 + fr) * DM + (U).pn * BM + wc * 32 + 8 * fq) * 4; \
        _Pragma("unroll") for (int a = 0; a < 2; ++a) _Pragma("unroll") for (int m = 0; m < 4; ++m) { asm volatile("" : "+v"(rp)); \
            _Pragma("unroll") for (int b = 0; b < 2; ++b) _Pragma("unroll") for (int n = 0; n < 2; ++n) acc[a][b][m][n] = *(const f32x4*)(rp + b * 512 + n * 16); \
            rp += (m == 3 ? (size_t)(HALF - 48) : (size_t)16) * DM * 4; } \
    } else { _Pragma("unroll") for (int a = 0; a < 2; ++a) _Pragma("unroll") for (int b = 0; b < 2; ++b) _Pragma("unroll") for (int m = 0; m < 4; ++m) _Pragma("unroll") for (int n = 0; n < 2; ++n) acc[a][b][m][n] = (f32x4){0.f, 0.f, 0.f, 0.f}; } } while (0)
    PG8_ACC_INIT(cur);
    bf16x8 At[4][2], B0[2][2], B1[2][2];
    const char* cA = (cur.s ? (const char*)(P.ws + WS_MEMN) : (const char*)P.A) + (size_t)cur.pm * tstep; const char* cB = (cur.s ? (const char*)(P.ws + WS_WMKV) : (const char*)P.Bt) + (size_t)cur.pn * tstep;
    PG8_STAGE(PG8_SB(0, 0), cB, voffB); PG8_STAGE(PG8_SB(0, 1), cB + hstep, voffB); PG8_STAGE(PG8_SA(0, 0), cA, voffA); PG8_STAGE(PG8_SA(0, 1), cA + hstep, voffA);
    if (wr == 1) PG8_BAR;
    PG8_WAIT_V(2); PG8_BAR;
    PG8_STAGE(PG8_SB(1, 0), cB + kstep, voffB); PG8_STAGE(PG8_SA(1, 0), cA + kstep, voffA); PG8_STAGE(PG8_SB(1, 1), cB + hstep + kstep, voffB);
    PG8_WAIT_V(6); PG8_BAR;
    for (;;) {
        const bool has_next = S.next(ui + 1, nxt);
        const char* nA = has_next ? (nxt.s ? (const char*)(P.ws + WS_MEMN) : (const char*)P.A) + (size_t)nxt.pm * tstep : cA; const char* nB = has_next ? (nxt.s ? (const char*)(P.ws + WS_WMKV) : (const char*)P.Bt) + (size_t)nxt.pn * tstep : cB;
        for (int t = 0; t < nt; t += 2) {
            const bool last = (t == nt - 2);
            const char* a1 = cA + (size_t)(t + 1) * kstep;
            const char* a2 = last ? nA : cA + (size_t)(t + 2) * kstep; const char* b2 = last ? nB : cB + (size_t)(t + 2) * kstep;
            const char* a3 = a2 + kstep; const char* b3 = b2 + kstep;
            PG8_LDB(B0, 0, 0); PG8_LDB(B1, 0, 1); PG8_SCHED; PG8_LDA(At, 0, 0); PG8_STAGE(PG8_SA(1, 1), a1 + hstep, voffA);
            PG8_WAIT_V(8); PG8_WAIT_L(0); PG8_BAR; PG8_MMA(0, 0, At, B0); PG8_MMA(0, 1, At, B1); PG8_BAR; PG8_SCHED;
            PG8_LDA(At, 0, 1); PG8_STAGE(PG8_SB(0, 0), b2, voffB); PG8_STAGE(PG8_SB(0, 1), b2 + hstep, voffB); PG8_STAGE(PG8_SA(0, 0), a2, voffA);
            PG8_WAIT_V(8); PG8_WAIT_L(0); PG8_BAR; PG8_MMA(1, 0, At, B0); PG8_MMA(1, 1, At, B1); PG8_BAR; PG8_SCHED;
            PG8_LDB(B0, 1, 0); PG8_LDB(B1, 1, 1); PG8_SCHED; PG8_LDA(At, 1, 0); PG8_STAGE(PG8_SA(0, 1), a2 + hstep, voffA);
            PG8_WAIT_V(8); PG8_WAIT_L(0); PG8_BAR; PG8_MMA(0, 0, At, B0); PG8_MMA(0, 1, At, B1); PG8_BAR; PG8_SCHED;
            PG8_LDA(At, 1, 1); PG8_STAGE(PG8_SB(1, 0), b3, voffB); PG8_STAGE(PG8_SB(1, 1), b3 + hstep, voffB); PG8_STAGE(PG8_SA(1, 0), a3, voffA);
            PG8_WAIT_V(8); PG8_WAIT_L(0); PG8_BAR; PG8_MMA(1, 0, At, B0); PG8_MMA(1, 1, At, B1); PG8_BAR; PG8_SCHED;
        }
        if (wr == 0) PG8_BAR;
        { int lane_e = lane; asm volatile("" : "+v"(lane_e));
          epi_run(P, acc, cur, wr, wc, lane_e & 15, lane_e >> 4); }
        if (!has_next) break;
        PG8_ACC_INIT(nxt);
        cur = nxt; cA = nA; cB = nB; ++ui;
        if (wr == 1) PG8_BAR;
    }
    PG8_WAIT_V(0);
    PG8_BAR;
#undef PG8_ACC_INIT
#undef PG8_SA
#undef PG8_SB
#undef PG8_STAGE
#undef PG8_LDA
#undef PG8_LDB
#undef PG8_MMA
#undef PG8_WAIT_V
#undef PG8_WAIT_L
#undef PG8_BAR
#undef PG8_SCHED
}

struct KVD { int kvsel, koff, voff, kd1, ks, L, kt0, ksub, koff1, nst; };
struct AU { int qoff, qs, qrow_w, band, causal, pair, whalf, moba_n, tbase, kmoff; };
struct AE { int epi, ooff, os, goff, gs, lseoff, lses, has_sink; float sink; };
__device__ __forceinline__ int crow(int r, int hi) { return (r & 3) + 8 * (r >> 2) + 4 * hi; }
typedef short v4i16_t __attribute__((ext_vector_type(4)));
template <int OFF> __device__ __forceinline__ s16x4 tr_read(int vb) { return __builtin_bit_cast(s16x4, __builtin_amdgcn_ds_read_tr16_b64_v4i16((LAS v4i16_t*)(uintptr_t)(unsigned)(vb + OFF))); }
template <int D> __device__ __forceinline__ int kswz(int row, int colB) { if constexpr (D == 128) return row * 256 + (colB ^ ((row & 7) << 4)); else return row * 128 + (colB ^ (((row >> 1) & 7) << 4)); }
template <int D> __device__ __forceinline__ int v_st(int k, int c) { const int kk = (k & ~0xC) | ((k & 4) << 1) | ((k & 8) >> 1); return ((kk >> 3) * (D / 32) + (c >> 5)) * 512 + ((kk & 7) * 32 + (c & 31)) * 2; }
__device__ __forceinline__ int v_rd_base(int lane) { return ((lane & 3) << 3) | (((lane >> 2) & 3) << 6) | (((lane >> 4) & 1) << 5) | (((lane >> 5) & 1) << 8); }
template <int D> constexpr int v_rd_off(int d0, int ks, int half) { return d0 * 512 + (ks * 2 + half) * (D / 32) * 512; }

template <int D, int D0, int HF> __device__ __forceinline__ void pv_half(f32x16& od, int vb, bf16x8 pa, bf16x8 pb) {
    const s16x4 l0 = tr_read<v_rd_off<D>(D0, 2 * HF, 0)>(vb), h0 = tr_read<v_rd_off<D>(D0, 2 * HF, 1)>(vb), l1 = tr_read<v_rd_off<D>(D0, 2 * HF + 1, 0)>(vb), h1 = tr_read<v_rd_off<D>(D0, 2 * HF + 1, 1)>(vb);
#define PKV(Lx, Hx) (bf16x8){Lx[0], Lx[1], Lx[2], Lx[3], Hx[0], Hx[1], Hx[2], Hx[3]}
    od = __builtin_amdgcn_mfma_f32_32x32x16_bf16(pa, PKV(l0, h0), od, 0, 0, 0);
    od = __builtin_amdgcn_mfma_f32_32x32x16_bf16(pb, PKV(l1, h1), od, 0, 0, 0);
#undef PKV
}
template <int D, int HF> __device__ __forceinline__ void pv_all(f32x16* o, int vb, bf16x8 pa, bf16x8 pb) {
    pv_half<D, 0, HF>(o[0], vb, pa, pb); pv_half<D, 1, HF>(o[1], vb, pa, pb);
    if constexpr (D == 128) { pv_half<D, 2, HF>(o[2], vb, pa, pb); pv_half<D, 3, HF>(o[3], vb, pa, pb); }
}
template <int D> struct ACfg { static constexpr int NSUB = (D == 128) ? 2 : 3, KTB = 64 * D * 2; };
constexpr int ABUF = 65536;
__device__ __forceinline__ int swap23(int k) { return (k & ~0xC) | ((k & 4) << 1) | ((k & 8) >> 1); }
template <int D> __device__ __forceinline__ void stage_dma(const KVD& d, const unsigned char* ws, int sub, LAS unsigned char* buf, int slot, int wid, int lane) {
    constexpr int NSUB = ACfg<D>::NSUB, KTB = ACfg<D>::KTB, NBLK = D / 32, NP = KTB / 8192;
    const bf16_t* KVp = (const bf16_t*)(ws + (d.kvsel ? WS_MKV : WS_QKV));
    const int kb = d.kt0 + sub * d.ksub;
    LAS unsigned char* Kt = buf + slot * KTB; LAS unsigned char* Vt = buf + NSUB * KTB + slot * KTB;
#pragma unroll
    for (int i = 0; i < NP; ++i) {
        const int piece = wid + 8 * i;
        int row, c;
        if constexpr (D == 128) { row = piece * 4 + (lane >> 4); c = (lane & 15) ^ (row & 7); } else { row = piece * 8 + (lane >> 3); c = (lane & 7) ^ ((row >> 1) & 7); }
        { const int half = row >> 5; int a = kb + (row & 31) + half * d.koff1; a = a < 0 ? 0 : (a > d.L - 1 ? d.L - 1 : a);
          const bf16_t* src = KVp + d.koff + (size_t)a * d.ks + half * d.kd1 + c * 8;
          __builtin_amdgcn_global_load_lds((const unsigned*)src, (LAS unsigned*)(Kt + piece * 1024), 16, 0, 0); }
        { const int p = piece * 1024 + lane * 16, st = p >> 9, q = (p & 511) >> 1, kk = (st / NBLK) * 8 + (q >> 5), k = swap23(kk), col = (st % NBLK) * 32 + (q & 31);
          const int half = k >> 5; int a = kb + (k & 31) + half * d.koff1; a = a < 0 ? 0 : (a > d.L - 1 ? d.L - 1 : a);
          const bf16_t* src = KVp + d.voff + (size_t)a * d.ks + half * d.kd1 + col;
          __builtin_amdgcn_global_load_lds((const unsigned*)src, (LAS unsigned*)(Vt + piece * 1024), 16, 0, 0); }
    }
}
template <int D> __device__ __forceinline__ void cold_start(const KVD& d, const unsigned char* ws, LAS unsigned char* buf, int wid, int lane) {
#pragma unroll
    for (int sl = 0; sl < ACfg<D>::NSUB; ++sl) if (sl < d.nst) stage_dma<D>(d, ws, sl, buf, sl, wid, lane);
    asm volatile("s_waitcnt vmcnt(0)" ::: "memory");
    __syncthreads();
}

template <int D>
__device__ __forceinline__ void attn_main(const AU& u, const KVD& d, const KVD& dn, const int pre, int& pb, unsigned char* ws, LAS unsigned char* lds, int tid, int wid, int lane,
                                          float& m_out, float& l_out, f32x16 (&o)[D / 32]) {
    constexpr int NQ = D / 16, NB = D / 32, NSUB = ACfg<D>::NSUB, KTB = ACfg<D>::KTB;
    constexpr float SCALE = (D == 128) ? 0.088388347648318440f : 0.125f;
    constexpr float C = SCALE * 1.4426950408889634f;
    constexpr float THRS = 8.0f / SCALE;
    const int r32 = lane & 31, hi = lane >> 5;
    LAS float* wsf = (LAS float*)(lds + XTBL_OFF + wid * 256);
    bf16x8 qr[NQ];
    { const bf16_t* qrow = (const bf16_t*)(ws + WS_QKV) + (size_t)u.qoff + (size_t)(u.qrow_w + r32) * u.qs + hi * 8;
#pragma unroll
      for (int d0 = 0; d0 < NQ; ++d0) qr[d0] = *(const bf16x8*)(qrow + d0 * 16); }
    float m_reg = -1e30f, l_reg = 0.f;
#pragma unroll
    for (int dd = 0; dd < NB; ++dd)
#pragma unroll
        for (int r = 0; r < 16; ++r) o[dd][r] = 0.f;
    const int qidx = u.qrow_w + r32;
    unsigned selmask = 0;
    if constexpr (D == 128) {
        if (u.moba_n > 0) {
            const int n = u.moba_n; float g[7];
#pragma unroll
            for (int j = 0; j < 7; ++j) {
                g[j] = -INFINITY;
                if (j < n) {
                    const float* kmj = (const float*)(ws + WS_CTL) + CW_KM + u.kmoff + j * 128 + hi * 8; float s = 0.f;
#pragma unroll
                    for (int d0 = 0; d0 < NQ; ++d0) { const f32x4 a = *(const f32x4*)(kmj + d0 * 16), b = *(const f32x4*)(kmj + d0 * 16 + 4);
                        const u32x4 qw = __builtin_bit_cast(u32x4, qr[d0]);
                        s += bflo(qw.x) * a[0] + bfhi(qw.x) * a[1] + bflo(qw.y) * a[2] + bfhi(qw.y) * a[3] + bflo(qw.z) * b[0] + bfhi(qw.z) * b[1] + bflo(qw.w) * b[2] + bfhi(qw.w) * b[3]; }
                    auto rr = __builtin_amdgcn_permlane32_swap(__float_as_uint(s), __float_as_uint(s), false, false);
                    g[j] = __uint_as_float(rr[0]) + __uint_as_float(rr[1]);
                }
            }
#pragma unroll
            for (int j = 0; j < 7; ++j) { int cnt = 0;
#pragma unroll
                for (int i = 0; i < 7; ++i) if (i != j) cnt += (i < n && (g[i] > g[j] || (g[i] == g[j] && i < j))) ? 1 : 0;
                if (j < n && cnt < 3) selmask |= (1u << j); }
        }
    }
    const int nsteps = (d.nst + NSUB - 1) / NSUB;
    for (int st = 0; st < nsteps; ++st) {
        LAS unsigned char* bufc = lds + pb * ABUF; LAS unsigned char* bufn = lds + (pb ^ 1) * ABUF;
        const bool lastst = (st + 1 == nsteps);
#pragma unroll 1
        for (int sl = 0; sl < NSUB; ++sl) {
            const int sub = st * NSUB + sl;
            if (!lastst) { if (sub + NSUB < d.nst) stage_dma<D>(d, ws, sub + NSUB, bufn, sl, wid, lane); }
            else if (pre) { if (sl < dn.nst) stage_dma<D>(dn, ws, sl, bufn, sl, wid, lane); }
            if (sub < d.nst) {
                const int kb0 = d.kt0 + sub * d.ksub, kb1 = kb0 + d.koff1;
                int lo_q, hi_q;
                const int tabs = u.tbase + sub;
                if (u.moba_n >= 0 && tabs < 4 * u.moba_n) { const bool sel = (selmask >> (tabs >> 2)) & 1u; lo_q = sel ? -(1 << 28) : (1 << 28); hi_q = sel ? (1 << 28) : -(1 << 28); }
                else { lo_q = qidx - u.band; hi_q = u.causal ? qidx : (1 << 28); }
                bool any0 = __any(lo_q <= kb0 + 31 && hi_q >= kb0), any1 = __any(lo_q <= kb1 + 31 && hi_q >= kb1);
                if (u.pair) { any0 = any0 && (u.whalf == 0); any1 = any1 && (u.whalf == 1); }
#define HALF_STEP(HF, ANY, KBH) do { if (ANY) { \
                    const bool allv = __all(lo_q <= (KBH) && hi_q >= (KBH) + 31); \
                    f32x16 p; _Pragma("unroll") for (int r = 0; r < 16; ++r) p[r] = 0.f; \
                    LAS unsigned char* Kt = bufc + sl * KTB; \
                    _Pragma("unroll") for (int d0 = 0; d0 < NQ; ++d0) { const bf16x8 bk = *(const LAS bf16x8*)(Kt + kswz<D>(32 * (HF) + r32, (d0 * 16 + hi * 8) * 2)); p = __builtin_amdgcn_mfma_f32_32x32x16_bf16(bk, qr[d0], p, 0, 0, 0); } \
                    if (!allv) { _Pragma("unroll") for (int r = 0; r < 16; ++r) { const int kk = (KBH) + crow(r, hi); if (kk < lo_q || kk > hi_q) p[r] = -INFINITY; } } \
                    float pmax = p[0]; _Pragma("unroll") for (int r = 1; r < 16; ++r) pmax = fmaxf(pmax, p[r]); \
                    { auto rr = __builtin_amdgcn_permlane32_swap(__float_as_uint(pmax), __float_as_uint(pmax), false, false); pmax = fmaxf(__uint_as_float(rr[0]), __uint_as_float(rr[1])); } \
                    float alpha = 1.f; \
                    if (!__all(pmax - m_reg <= THRS)) { const float mn = fmaxf(m_reg, pmax); alpha = __builtin_amdgcn_exp2f((m_reg - mn) * C); m_reg = mn; } \
                    const float mnC = -m_reg * C; float ps = 0.f; \
                    _Pragma("unroll") for (int r = 0; r < 16; ++r) { p[r] = __builtin_amdgcn_exp2f(fmaf(p[r], C, mnC)); ps += p[r]; } \
                    { auto rr = __builtin_amdgcn_permlane32_swap(__float_as_uint(ps), __float_as_uint(ps), false, false); ps = __uint_as_float(rr[0]) + __uint_as_float(rr[1]); } \
                    l_reg = l_reg * alpha + ps; \
                    if (__any(alpha < 1.f)) { if (hi == 0) wsf[r32] = alpha; LDS_WAIT(); \
                        _Pragma("unroll") for (int dd = 0; dd < NB; ++dd) _Pragma("unroll") for (int r = 0; r < 16; ++r) o[dd][r] *= wsf[crow(r, hi)]; \
                        LDS_WAIT(); } \
                    bf16x8 paA, paB; PK4(p, 0, paA); PK4(p, 8, paB); \
                    const int vb = (int)(uintptr_t)(bufc + NSUB * KTB + sl * KTB) + v_rd_base(lane); \
                    pv_all<D, HF>(o, vb, paA, paB); } } while (0)
#define PK4(P, BASE, OUT) do { unsigned a0 = cvt_pk_bf16(P[BASE + 0], P[BASE + 1]), a1 = cvt_pk_bf16(P[BASE + 2], P[BASE + 3]);   \
    unsigned b0 = cvt_pk_bf16(P[BASE + 4], P[BASE + 5]), b1 = cvt_pk_bf16(P[BASE + 6], P[BASE + 7]);                              \
    auto r0 = __builtin_amdgcn_permlane32_swap(a0, b0, false, false); auto r1 = __builtin_amdgcn_permlane32_swap(a1, b1, false, false); \
    u32x4 w = {r0[0], r1[0], r0[1], r1[1]}; OUT = __builtin_bit_cast(bf16x8, w); } while (0)
                HALF_STEP(0, any0, kb0);
                HALF_STEP(1, any1, kb1);
#undef PK4
#undef HALF_STEP
            }
        }
        asm volatile("s_waitcnt vmcnt(0)" ::: "memory");
        __syncthreads();
        pb ^= 1;
    }
    m_out = m_reg; l_out = l_reg;
}

template <int D>
__device__ __forceinline__ void attn_epi(const AE& e, int qrow_w, int pbl, unsigned char* ws, LAS unsigned char* lds, int wid, int lane, float m_reg, float l_reg, const f32x16 (&o)[D / 32]) {
    constexpr int NB = D / 32;
    constexpr float SCALE = (D == 128) ? 0.088388347648318440f : 0.125f;
    const int r32 = lane & 31, hi = lane >> 5;
    LAS float* wsf = (LAS float*)(lds + XTBL_OFF + wid * 256);
    LAS bf16_t* stg = (LAS bf16_t*)(lds + pbl * ABUF + wid * 8192);
    float lt = l_reg;
    if (e.has_sink) lt += __builtin_amdgcn_exp2f((e.sink - m_reg * SCALE) * 1.4426950408889634f);
    if (hi == 0) wsf[r32] = lt > 0.f ? __builtin_amdgcn_rcpf(lt) : 0.f;
    LDS_WAIT();
    float rli[16];
#pragma unroll
    for (int r = 0; r < 16; ++r) rli[r] = wsf[crow(r, hi)];
    LDS_WAIT();
#pragma unroll
    for (int r = 0; r < 16; ++r) { const int orow = crow(r, hi);
#pragma unroll
        for (int d0 = 0; d0 < NB; ++d0) stg[orow * D + d0 * 32 + r32] = (bf16_t)f2bf(o[d0][r] * rli[r]); }
    LDS_WAIT();
    constexpr int CPR = D / 8, RPP = 64 / CPR;
    bf16_t* OB = (bf16_t*)(ws + (e.epi ? WS_Y : WS_OG));
    const bf16_t* GB = (const bf16_t*)(ws + WS_QKV);
#pragma unroll
    for (int i = 0; i < 32 / RPP; ++i) {
        const int row = i * RPP + lane / CPR, ch = lane % CPR;
        const u32x4 v = *(const LAS u32x4*)(stg + row * D + ch * 8);
        const size_t fidx = (size_t)(qrow_w + row);
        if (e.epi == 1) {
            const u32x4 g = *(const u32x4*)(GB + (size_t)e.goff + fidx * e.gs + ch * 8);
            u32x4 w;
            w.x = cvt_pk_bf16(bflo(v.x) * bflo(g.x), bfhi(v.x) * bfhi(g.x)); w.y = cvt_pk_bf16(bflo(v.y) * bflo(g.y), bfhi(v.y) * bfhi(g.y));
            w.z = cvt_pk_bf16(bflo(v.z) * bflo(g.z), bfhi(v.z) * bfhi(g.z)); w.w = cvt_pk_bf16(bflo(v.w) * bflo(g.w), bfhi(v.w) * bfhi(g.w));
            *(u32x4*)(OB + (size_t)e.ooff + fidx * e.os + ch * 8) = w;
        } else {
            *(u32x4*)(OB + (size_t)e.ooff + fidx * e.os + ch * 8) = v;
        }
    }
    if (e.epi == 0 && hi == 0) ((float*)(ws + WS_LSE))[(size_t)e.lseoff + (size_t)(qrow_w + r32) * e.lses] = l_reg > 0.f ? m_reg * SCALE + __logf(l_reg) : -1e30f;
    LDS_WAIT();
}

#define XB_TMO      128
#define XB_XCNT(j)  (256  + 64 * (j))
#define XB_XSUB(j)  (1280 + 64 * (j))
#define XB_XGEN(j)  (2304 + 64 * (j))
#define XB_TOP      3328
#define XB_TOPGEN   3392
#define XCD_BAR_WORDS 3456
#define XB_SPIN_CAP (1u << 18)
__device__ __forceinline__ unsigned xb_ld(unsigned* p)              { return __hip_atomic_load(p, __ATOMIC_RELAXED, __HIP_MEMORY_SCOPE_AGENT); }
__device__ __forceinline__ unsigned xb_add(unsigned* p, unsigned v) { return __hip_atomic_fetch_add(p, v, __ATOMIC_RELAXED, __HIP_MEMORY_SCOPE_AGENT); }
__device__ __forceinline__ unsigned xb_xcc_id() { return (unsigned)__builtin_amdgcn_s_getreg((3 << 11) | 20) & 0xFu; }
#define XB_SPIN(cond, bar) do { unsigned _sp = 0; while (cond) { __builtin_amdgcn_s_sleep(1); \
    if ((++_sp & 255u) == 0u) { if (xb_ld(&(bar)[XB_TMO])) break; if (_sp > XB_SPIN_CAP) { atomicAdd(&(bar)[XB_TMO], 1u); break; } } } } while (0)
struct XcdBarrier { unsigned* bar; unsigned x; volatile LAS unsigned* st; };
__device__ __forceinline__ XcdBarrier xcd_barrier_post(unsigned* bar, volatile LAS unsigned* st) {
    XcdBarrier b; b.bar = bar; b.x = xb_xcc_id(); b.st = st;
    if (threadIdx.x == 0) (void)xb_add(&bar[XB_XCNT(b.x)], 1u);
    return b;
}
__device__ __forceinline__ void xcd_barrier_complete(unsigned* bar, unsigned x, unsigned& nloc, unsigned& nx) {
    const unsigned G = gridDim.x * gridDim.y * gridDim.z;
    unsigned sum, cnt, mine, sp = 0u;
    for (;;) {
        sum = 0u; cnt = 0u; mine = 0u;
#pragma unroll
        for (unsigned j = 0; j < 16; ++j) { const unsigned c = xb_ld(&bar[XB_XCNT(j)]); sum += c; cnt += (c > 0u) ? 1u : 0u; mine = (j == x) ? c : mine; }
        if (sum == G) break;
        __builtin_amdgcn_s_sleep(1);
        if ((++sp & 255u) == 0u) { if (xb_ld(&bar[XB_TMO])) break; if (sp > XB_SPIN_CAP) { atomicAdd(&bar[XB_TMO], 1u); break; } }
    }
    nloc = mine > 0u ? mine : 1u; nx = cnt > 0u ? cnt : 1u;
}
__device__ __forceinline__ void xcd_barrier(const XcdBarrier& b) {
    asm volatile("s_waitcnt vmcnt(0)" ::: "memory");
    __syncthreads();
    if (threadIdx.x == 0) {
        unsigned* bar = b.bar;
        __builtin_amdgcn_s_waitcnt(0);
        unsigned nloc = b.st[0], nx = b.st[1];
        if (nloc == 0u) { xcd_barrier_complete(bar, b.x, nloc, nx); b.st[0] = nloc; b.st[1] = nx; }
        const unsigned old = xb_add(&bar[XB_XSUB(b.x)], 1u);
        const unsigned gen = old / nloc;
        if (old + 1u == (gen + 1u) * nloc) {
            __builtin_amdgcn_fence(__ATOMIC_RELEASE, "agent");
            asm volatile("s_waitcnt vmcnt(0)" ::: "memory");
            const unsigned og = xb_add(&bar[XB_TOP], 1u);
            const unsigned tg = og / nx;
            if (og + 1u == (tg + 1u) * nx) xb_add(&bar[XB_TOPGEN], 1u);
            else XB_SPIN(xb_ld(&bar[XB_TOPGEN]) == tg, bar);
            __builtin_amdgcn_fence(__ATOMIC_ACQUIRE, "agent");
            xb_add(&bar[XB_XGEN(b.x)], 1u);
            asm volatile("s_waitcnt vmcnt(0)" ::: "memory");
        } else {
            XB_SPIN(xb_ld(&bar[XB_XGEN(b.x)]) == gen, bar);
            __builtin_amdgcn_fence(__ATOMIC_ACQUIRE, "agent");
            asm volatile("s_waitcnt vmcnt(0)" ::: "memory");
        }
    }
    __syncthreads();
}

__device__ __forceinline__ float wave_sum(float v) {
#pragma unroll
    for (int o = 1; o < 64; o <<= 1) v += __shfl_xor(v, o);
    return v;
}
__device__ __forceinline__ int phys_even(int n) {
    if (n >= 4608) return n;
    const int seg = n / 768; if (seg == 2 || seg == 5) return n;
    const int i = n & 127, hb = n - i, ii = i & 63, g = ii >> 2, e = (ii & 3) + ((i >> 6) << 2);
    return hb + 8 * g + e;
}
__device__ __forceinline__ int phys_odd(int n) {
    if (n < 1728) { const int i = n & 63, hb = n - i, ii = i & 31, g = ii >> 2, e = (ii & 3) + ((i >> 5) << 2); return hb + 8 * g + e; }
    if (n < 1920) return n + 64;
    return n + 128;
}
__device__ __forceinline__ void convert_item(const float* W, int N, const float* gk, bf16_t* WT, int mapkind, int rowoff, int item, int lane) {
    const int nblk = N / 64, kb = item / nblk, nb = item % nblk, k0 = 64 * kb, n = 64 * nb + lane;
    const int p = (mapkind == 1 ? phys_even(n) : (mapkind == 2 ? phys_odd(n) : n)) + rowoff;
    const float* src = W + (size_t)k0 * N + n;
    bf16_t* dst = WT + (size_t)p * KDIM + k0;
    float v[64];
#pragma unroll
    for (int j = 0; j < 64; ++j) v[j] = src[(size_t)j * N];
    if (gk) {
#pragma unroll
        for (int j = 0; j < 64; ++j) v[j] *= gk[k0 + j];
    }
#pragma unroll
    for (int kk = 0; kk < 8; ++kk) { u32x4 o; o.x = pk2(v[8 * kk], v[8 * kk + 1]); o.y = pk2(v[8 * kk + 2], v[8 * kk + 3]); o.z = pk2(v[8 * kk + 4], v[8 * kk + 5]); o.w = pk2(v[8 * kk + 6], v[8 * kk + 7]);
        *(u32x4*)(dst + 8 * kk) = o; }
}

struct Args {
    const float* x; const float* mem; const int* pos;
    const float* even_norm; const float* even_w_in; const float* even_w_mkv; const float* even_w_out;
    const float* odd_norm; const float* odd_w_in; const float* odd_w_mkv; const float* odd_w_out; const float* odd_sinks;
    const float* mem_norm; const float* final_norm;
    float* out; unsigned char* ws;
    int ph_lo, ph_hi;
};
constexpr int N_PHASES = 18;

constexpr int NUNITS_EVEN = 1088, NUNITS_ODD = 896;
__device__ __forceinline__ bool unit_d64(int idx, int l) { return (l & 1) && idx >= 128; }
__device__ __forceinline__ void decode_kv(int idx, int l, KVD& d) {
    d.kvsel = 0; d.kd1 = 0; d.ksub = 64; d.koff1 = 32;
    if (!(l & 1)) {
        if (idx < 384) { const int n = 7 - idx / 48, rem = idx % 48, s = rem / 24, bh = rem % 24, b = bh / 6, h = bh % 6; const int tb = b * SEQ * EVEN_N;
            d.koff = tb + 3072 + h * 128; d.voff = tb + 3840 + h * 128; d.ks = EVEN_N; d.L = SEQ; d.kt0 = 128 * (n + 1) * s; d.nst = 2 * (n + 1);
        } else if (idx < 768) { const int i = idx - 384, pat = i / 192, j = i % 192, bh = j % 24, rr = j / 24, b = bh / 6, h = bh % 6;
            const int dil = pat ? 4 : 1, res = pat ? (rr & 3) : 0, kblk = pat ? (rr >> 2) : rr; const int tb = (b * SEQ + res) * EVEN_N;
            d.koff = tb + 768 + h * 128; d.voff = tb + 1536 + h * 128; d.ks = dil * EVEN_N; d.L = SEQ / dil; d.kt0 = (256 * kblk - 128) < 0 ? 0 : (256 * kblk - 128); d.nst = (256 * kblk + 256 - d.kt0) / 64;
        } else if (idx < 896) { const int i = idx - 768, b = i / 32, hm = (i / 8) % 4;
            d.kvsel = 1; d.koff = b * MEML * 4096 + l * 1024 + hm * 128; d.voff = d.koff + 512; d.ks = 4096; d.L = MEML; d.kt0 = 0; d.nst = 4;
        } else { const int i = idx - 896, bh = i % 24, u8 = i / 24, b = bh / 6, h = bh % 6; const int tp = (b * SEQ + 2 * u8) * EVEN_N;
            d.koff = tp + 768 + h * 128; d.voff = tp + 1536 + h * 128; d.kd1 = EVEN_N; d.ks = 16 * EVEN_N; d.L = 128; d.kt0 = 0; d.nst = 4; d.ksub = 32; d.koff1 = 0;
        }
    } else {
        if (idx < 128) { const int i = idx, b = i / 32, hm = (i / 8) % 4;
            d.kvsel = 1; d.koff = b * MEML * 4096 + l * 1024 + hm * 128; d.voff = d.koff + 512; d.ks = 4096; d.L = MEML; d.kt0 = 0; d.nst = 4;
        } else { const int i = idx - 128, b = i / 192, g = (i / 64) % 3, pblk = i % 64; const int tb = b * SEQ * ODD_NP;
            d.koff = tb + 1536 + g * 64; d.voff = tb + 1792 + g * 64; d.ks = ODD_NP; d.L = SEQ; d.kt0 = (32 * pblk - 128) < 0 ? 0 : (32 * pblk - 128); d.nst = (32 * pblk + 32 - d.kt0 + 63) / 64;
        }
    }
}
__device__ __forceinline__ void decode_q(int idx, int l, int wave, AU& u) {
    u.moba_n = -1; u.band = 1 << 28; u.causal = 1; u.pair = 0; u.whalf = 0; u.kmoff = 0; u.tbase = 0;
    if (!(l & 1)) {
        if (idx < 384) { const int n = 7 - idx / 48, rem = idx % 48, s = rem / 24, bh = rem % 24, b = bh / 6, h = bh % 6;
            u.qoff = b * SEQ * EVEN_N + 2304 + h * 128; u.qs = EVEN_N; u.qrow_w = 256 * n + 32 * wave; u.moba_n = n; u.tbase = 2 * (n + 1) * s;
            u.kmoff = (l >> 1) * (4 * 6 * 8 * 128) + ((b * 6 + h) * 8) * 128;
        } else if (idx < 768) { const int i = idx - 384, pat = i / 192, j = i % 192, bh = j % 24, rr = j / 24, b = bh / 6, h = bh % 6;
            const int dil = pat ? 4 : 1, res = pat ? (rr & 3) : 0, kblk = pat ? (rr >> 2) : rr;
            u.qoff = (b * SEQ + res) * EVEN_N + h * 128; u.qs = dil * EVEN_N; u.qrow_w = 256 * kblk + 32 * wave; u.band = 128;
        } else if (idx < 896) { const int i = idx - 768, b = i / 32, hm = (i / 8) % 4, blk = i % 8;
            u.qoff = b * SEQ * EVEN_N + 4608 + hm * 128; u.qs = EVEN_N; u.qrow_w = 256 * blk + 32 * wave; u.causal = 0;
        } else { const int i = idx - 896, bh = i % 24, u8 = i / 24, b = bh / 6, h = bh % 6; const int wh = wave >> 2;
            u.qoff = (b * SEQ + 2 * u8 + wh) * EVEN_N + h * 128; u.qs = 16 * EVEN_N; u.qrow_w = 32 * (wave & 3); u.pair = 1; u.whalf = wh; u.band = 128;
        }
    } else {
        if (idx < 128) { const int i = idx, b = i / 32, hm = (i / 8) % 4, blk = i % 8;
            u.qoff = b * SEQ * ODD_NP + 2048 + hm * 128; u.qs = ODD_NP; u.qrow_w = 256 * blk + 32 * wave; u.causal = 0;
        } else { const int i = idx - 128, b = i / 192, g = (i / 64) % 3, pblk = i % 64, hq = 8 * g + wave;
            u.qoff = b * SEQ * ODD_NP + hq * 64; u.qs = ODD_NP; u.qrow_w = 32 * pblk; u.band = 127;
        }
    }
}
__device__ __forceinline__ void decode_epi(int idx, int l, int wave, const float* sinks, AE& e) {
    e.has_sink = 0; e.sink = 0.f; e.lseoff = 0; e.lses = 0; e.goff = 0; e.gs = 0;
    if (!(l & 1)) {
        if (idx < 384) { const int rem = idx % 48, s = rem / 24, bh = rem % 24, b = bh / 6, h = bh % 6; const int tok0 = b * SEQ;
            e.epi = 0; e.ooff = (3 + s) * NTOK * 768 + tok0 * 768 + h * 128; e.os = 768; e.lseoff = (3 + s) * NTOK * 6 + tok0 * 6 + h; e.lses = 6;
        } else if (idx < 768) { const int i = idx - 384, pat = i / 192, j = i % 192, bh = j % 24, rr = j / 24, b = bh / 6, h = bh % 6;
            const int dil = pat ? 4 : 1, res = pat ? (rr & 3) : 0; const int tok0 = b * SEQ + res;
            e.epi = 0; e.ooff = pat * NTOK * 768 + tok0 * 768 + h * 128; e.os = dil * 768; e.lseoff = pat * NTOK * 6 + tok0 * 6 + h; e.lses = dil * 6;
        } else if (idx < 896) { const int i = idx - 768, b = i / 32, hm = (i / 8) % 4;
            e.epi = 1; e.ooff = b * SEQ * DM + 1536 + hm * 128; e.os = DM; e.goff = b * SEQ * EVEN_N + 5120 + 1536 + hm * 128; e.gs = EVEN_N;
        } else { const int i = idx - 896, bh = i % 24, u8 = i / 24, b = bh / 6, h = bh % 6; const int tokw = b * SEQ + 2 * u8 + (wave >> 2);
            e.epi = 0; e.ooff = 2 * NTOK * 768 + tokw * 768 + h * 128; e.os = 16 * 768; e.lseoff = 2 * NTOK * 6 + tokw * 6 + h; e.lses = 16 * 6;
        }
    } else {
        if (idx < 128) { const int i = idx, b = i / 32, hm = (i / 8) % 4;
            e.epi = 1; e.ooff = b * SEQ * DM + 1536 + hm * 128; e.os = DM; e.goff = b * SEQ * ODD_NP + 2560 + 1536 + hm * 128; e.gs = ODD_NP;
        } else { const int i = idx - 128, b = i / 192, g = (i / 64) % 3, hq = 8 * g + wave;
            e.epi = 1; e.ooff = b * SEQ * DM + hq * 64; e.os = DM; e.goff = b * SEQ * ODD_NP + 2560 + hq * 64; e.gs = ODD_NP;
            e.has_sink = 1; e.sink = sinks[(l >> 1) * 24 + hq];
        }
    }
}


constexpr int I_E = 32 * (EVEN_N / 64), I_O = 32 * (ODD_N / 64), I_W = 32 * (DM / 64), I_M = 32 * (1024 / 64);
constexpr int CV_A = I_E + 4 * I_M + I_W, CV_B = CV_A + I_O, CV_C = CV_B + I_E + I_W, CV_D = CV_C + I_O + 2 * I_W;
typedef __attribute__((address_space(4))) const Args* KArgsC;
__device__ __forceinline__ void convert_stage(KArgsC ka, unsigned char* ws, int lo, int hi, int worker, int nworkers, int lane) {
    for (int it = lo + worker; it < hi; it += nworkers) {
        int r = it;
        if (r < I_E) { convert_item(ka->even_w_in, EVEN_N, ka->even_norm, (bf16_t*)(ws + WS_WIN_E0), 1, 0, r, lane); continue; } r -= I_E;
        if (r < 4 * I_M) { const int l = r / I_M; r -= l * I_M; const float* W = ((l & 1) ? ka->odd_w_mkv : ka->even_w_mkv) + (size_t)(l >> 1) * DM * 1024;
            convert_item(W, 1024, nullptr, (bf16_t*)(ws + WS_WMKV), 0, l * 1024, r, lane); continue; } r -= 4 * I_M;
        if (r < I_W) { convert_item(ka->even_w_out, DM, nullptr, (bf16_t*)(ws + WS_WOUT), 0, 0, r, lane); continue; } r -= I_W;
        if (r < I_O) { convert_item(ka->odd_w_in, ODD_N, ka->odd_norm, (bf16_t*)(ws + WS_WIN_O0), 2, 0, r, lane); continue; } r -= I_O;
        if (r < I_E) { convert_item(ka->even_w_in + (size_t)DM * EVEN_N, EVEN_N, ka->even_norm + DM, (bf16_t*)(ws + WS_WIN_E1), 1, 0, r, lane); continue; } r -= I_E;
        if (r < I_W) { convert_item(ka->odd_w_out, DM, nullptr, (bf16_t*)(ws + WS_WOUT + (size_t)1 * 8 * MiB), 0, 0, r, lane); continue; } r -= I_W;
        if (r < I_O) { convert_item(ka->odd_w_in + (size_t)DM * ODD_N, ODD_N, ka->odd_norm + DM, (bf16_t*)(ws + WS_WIN_O1), 2, 0, r, lane); continue; } r -= I_O;
        { const int l = 2 + r / I_W; r -= (l - 2) * I_W; const float* W = ((l & 1) ? ka->odd_w_out : ka->even_w_out) + (size_t)(l >> 1) * DM * DM;
          convert_item(W, DM, nullptr, (bf16_t*)(ws + WS_WOUT + (size_t)l * 8 * MiB), 0, 0, r, lane); }
    }
}

}

typedef __attribute__((address_space(4))) const Args* KArgs;
#define LAUNDER_S(p) asm volatile("" : "+s"(p))

__global__ void __launch_bounds__(NWAVES * 64, 2) fwd_kernel(Args args_unused) {
    extern __shared__ __attribute__((aligned(16))) unsigned char lds_raw[];
    LAS unsigned char* lds = (LAS unsigned char*)lds_raw;
    volatile LAS unsigned* MISC = (volatile LAS unsigned*)(lds + MISC_OFF);
    const int tid0 = threadIdx.x;
    const int G = gridDim.x; const int bx = blockIdx.x; const int vcu = (G % 8 == 0) ? (bx % 8) * (G / 8) + bx / 8 : bx;
    const KArgs ka0 = (KArgs)__builtin_amdgcn_kernarg_segment_ptr();
    for (int i = tid0; i < (LDS_BYTES - LDSCTL_OFF) / 4; i += NWAVES * 64) ((LAS unsigned*)(lds + LDSCTL_OFF))[i] = 0u;
    __syncthreads();
    XcdBarrier bar; { unsigned char* ws0 = ka0->ws; bar.bar = (unsigned*)(ws0 + WS_CTL) + CW_BAR; bar.x = 0; bar.st = nullptr;
        if (!MK_PER_PHASE) bar = xcd_barrier_post((unsigned*)(ws0 + WS_CTL) + CW_BAR, MISC + 8); }
    const int ph_lo = ka0->ph_lo, ph_hi = ka0->ph_hi;

    unsigned long long tp_acc = 0ull;
    for (int ph = ph_lo; ph < ph_hi; ++ph) {
        unsigned long long tp_t0 = 0ull; if (TPROBE_MASK) tp_t0 = __builtin_amdgcn_s_memrealtime();
        int tid = tid0; asm volatile("" : "+v"(tid));
        const int lane = tid & 63, wave = __builtin_amdgcn_readfirstlane(tid >> 6);
        KArgs ka = ka0; LAUNDER_S(ka);
        unsigned char* ws = ka->ws;
        if (ph == 0 && (AN_MASK & 1)) {
            const int gw = vcu * NWAVES + wave, NGW = G * NWAVES;
            convert_stage(ka, ws, 0, CV_A, gw, NGW, lane);
            bf16_t* XB = (bf16_t*)(ws + WS_XB); bf16_t* MEMN = (bf16_t*)(ws + WS_MEMN); float* SSQ = (float*)(ws + WS_SSQ);
            const float* xin = ka->x; const float* memin = ka->mem; const float* mnorm = ka->mem_norm;
            for (int m = gw; m < NTOK + NMEM; m += NGW) {
                const bool isx = m < NTOK; const int row = isx ? m : m - NTOK;
                const f32x4* xr = (const f32x4*)((isx ? xin : memin) + (size_t)row * DM) + lane;
                f32x4 v[8]; float s = 0.f;
#pragma unroll
                for (int j = 0; j < 8; ++j) { v[j] = xr[64 * j]; s += (v[j].x * v[j].x + v[j].y * v[j].y) + (v[j].z * v[j].z + v[j].w * v[j].w); }
                s = wave_sum(s);
                unsigned long long* o8 = (unsigned long long*)((isx ? XB : MEMN) + (size_t)row * DM) + lane;
                if (isx) {
                    if (lane < 8) SSQ[(size_t)lane * NTOK + row] = lane == 0 ? s : 0.f;
#pragma unroll
                    for (int j = 0; j < 8; ++j) o8[64 * j] = (unsigned long long)pk2(v[j].x, v[j].y) | ((unsigned long long)pk2(v[j].z, v[j].w) << 32);
                } else {
                    const float rs = 1.0f / sqrtf(s * (1.0f / DM) + EPS);
                    const f32x4* gr = (const f32x4*)mnorm + lane;
#pragma unroll
                    for (int j = 0; j < 8; ++j) { const f32x4 g = gr[64 * j]; o8[64 * j] = (unsigned long long)pk2(v[j].x * rs * g.x, v[j].y * rs * g.y) | ((unsigned long long)pk2(v[j].z * rs * g.z, v[j].w * rs * g.w) << 32); }
                }
            }
            float* CS128 = (float*)(ws + WS_CS128); float* CS64 = (float*)(ws + WS_CS64); const int* posp = ka->pos;
            for (int tk = gw; tk < NTOK; tk += NGW) {
                const float pf = (float)posp[tk];
                { const float inv = expf((float)lane * (float)(-2.0 * 9.210340371976184 / 128.0)); const float ang = pf * inv;
                  const double rev = (double)ang * 0.15915494309189535; const float fr = (float)(rev - rint(rev));
                  CS128[(size_t)tk * 128 + lane] = __builtin_amdgcn_cosf(fr); CS128[(size_t)tk * 128 + 64 + lane] = __builtin_amdgcn_sinf(fr); }
                if (lane < 32) { const float inv = expf((float)lane * (float)(-2.0 * 9.210340371976184 / 64.0)); const float ang = pf * inv;
                  const double rev = (double)ang * 0.15915494309189535; const float fr = (float)(rev - rint(rev));
                  CS64[(size_t)tk * 64 + lane] = __builtin_amdgcn_cosf(fr); CS64[(size_t)tk * 64 + 32 + lane] = __builtin_amdgcn_sinf(fr); }
            }
        } else if (ph == 17 && (AN_MASK & 2) && G != 256) {
            const int gw = vcu * NWAVES + wave, NGW = G * NWAVES;
            const float* ssq = (const float*)(ws + WS_SSQ) + (size_t)4 * 8 * NTOK; float* outp = ka->out; const float* fnorm = ka->final_norm;
            for (int m = gw; m < NTOK; m += NGW) {
                float sq = 0.f;
#pragma unroll
                for (int j = 0; j < 8; ++j) sq += ssq[(size_t)j * NTOK + m];
                const float rs = 1.0f / sqrtf(sq * (1.0f / DM) + EPS);
                f32x4* xr = (f32x4*)(outp + (size_t)m * DM) + lane; const f32x4* gr = (const f32x4*)fnorm + lane;
#pragma unroll
                for (int j = 0; j < 8; ++j) { f32x4 v = xr[64 * j]; const f32x4 g = gr[64 * j]; v = v * rs * g; xr[64 * j] = v; }
            }
        } else if (ph >= 1 && ph <= 16) {
            const int l = (ph - 1) >> 2, sub = (ph - 1) & 3, odd = l & 1, li = l >> 1;
            if ((sub == 0 && (AN_MASK & 4)) || (sub == 3 && (AN_MASK & 8))) {
                GemmP P; P.ws = ws; P.l = l; P.xin = ka->x; P.out = ka->out; P.lds = lds; P.fnorm = ka->final_norm; P.fuse_final = (G == 256) ? 1 : 0;
                Order S; S.G = G; S.c = bx; S.nM0 = NTOK / 256;
                if (sub == 0) { P.mode = EM_INPROJ; P.A = (const bf16_t*)(ws + WS_XB); P.Bt = (const bf16_t*)(ws + (odd ? (li ? WS_WIN_O1 : WS_WIN_O0) : (li ? WS_WIN_E1 : WS_WIN_E0)));
                    S.nN0 = (odd ? ODD_NP : EVEN_N) / 256; S.nwg1 = (l == 0) ? 64 : 0; }
                else { P.mode = EM_OUTPROJ; P.A = (const bf16_t*)(ws + WS_Y); P.Bt = (const bf16_t*)(ws + WS_WOUT + (size_t)l * 8 * MiB); S.nN0 = DM / 256; S.nwg1 = 0; }
                S.nwg0 = S.nM0 * S.nN0;
                gemm_phase(lds, P, S, tid);
                if (sub == 0 && l < 3) {
                    const int nwg = S.nwg0 + S.nwg1, TT = nwg % G, lo = l == 0 ? CV_A : (l == 1 ? CV_B : CV_C), hi = l == 0 ? CV_B : (l == 1 ? CV_C : CV_D);
                    if (TT == 0) convert_stage(ka, ws, lo, hi, bx * NWAVES + wave, G * NWAVES, lane);
                    else if (bx >= TT) convert_stage(ka, ws, lo, hi, (bx - TT) * NWAVES + wave, (G - TT) * NWAVES, lane);
                }
            } else if (sub == 2 && (AN_MASK & 16)) {
                if (!odd) {
                    const float* LSE = (const float*)(ws + WS_LSE); const bf16_t* OG = (const bf16_t*)(ws + WS_OG); const bf16_t* QKV = (const bf16_t*)(ws + WS_QKV); bf16_t* Y = (bf16_t*)(ws + WS_Y);
                    const long NIT = (long)NTOK * 192;
                    for (long it = (long)bx * 512 + tid; it < NIT; it += (long)G * 512) {
                        const int tok = (int)(it / 192), c = (int)(it % 192), isb = c >= 96, cc8 = (isb ? c - 96 : c), h = cc8 >> 4;
                        const int g0 = isb ? 3 : 0;
                        const size_t lb = (size_t)tok * 6 + h, ob = (size_t)tok * 768 + cc8 * 8;
                        const float l0 = LSE[(size_t)g0 * NTOK * 6 + lb], l1 = LSE[(size_t)(g0 + 1) * NTOK * 6 + lb], l2 = isb ? -1e30f : LSE[(size_t)2 * NTOK * 6 + lb];
                        const float mx = fmaxf(l0, fmaxf(l1, l2));
                        float w0 = __expf(l0 - mx), w1 = __expf(l1 - mx), w2 = isb ? 0.f : __expf(l2 - mx); const float inv = 1.0f / (w0 + w1 + w2); w0 *= inv; w1 *= inv; w2 *= inv;
                        const u32x4 a = *(const u32x4*)(OG + (size_t)g0 * NTOK * 768 + ob), b = *(const u32x4*)(OG + (size_t)(g0 + 1) * NTOK * 768 + ob);
                        u32x4 cc = {0u, 0u, 0u, 0u}; if (!isb) cc = *(const u32x4*)(OG + (size_t)2 * NTOK * 768 + ob);
                        const u32x4 g = *(const u32x4*)(QKV + (size_t)tok * EVEN_N + 5120 + c * 8);
                        u32x4 o;
#define CMB(f) cvt_pk_bf16((w0 * bflo(a.f) + w1 * bflo(b.f) + w2 * bflo(cc.f)) * bflo(g.f), (w0 * bfhi(a.f) + w1 * bfhi(b.f) + w2 * bfhi(cc.f)) * bfhi(g.f))
                        o.x = CMB(x); o.y = CMB(y); o.z = CMB(z); o.w = CMB(w);
#undef CMB
                        *(u32x4*)(Y + (size_t)tok * DM + c * 8) = o;
                    }
                }
            } else if (sub == 1 && (AN_MASK & 32)) {
                gu32* qctr = (gu32*)(ws + WS_CTL) + CW_Q + 64 * l;
                const int NUNITS = odd ? NUNITS_ODD : NUNITS_EVEN;
                if (tid == 0) { MISC[16] = __hip_atomic_fetch_add(qctr, 1u, RLX_AGENT); MISC[17] = __hip_atomic_fetch_add(qctr, 1u, RLX_AGENT); }
                __syncthreads();
                int idx = (int)MISC[16], idx1 = (int)MISC[17];
                int it = 0, pb = 0; bool warm = false;
                while (idx < NUNITS) {
                    idx = __builtin_amdgcn_readfirstlane(idx); idx1 = __builtin_amdgcn_readfirstlane(idx1);
                    int tid_u = tid; asm volatile("" : "+v"(tid_u)); const int lane_u = tid_u & 63;
                    unsigned nx2 = 0; if (tid == 0) nx2 = __hip_atomic_fetch_add(qctr, 1u, RLX_AGENT);
                    const bool d64 = unit_d64(idx, l);
                    const int pre = (idx1 < NUNITS && unit_d64(idx1, l) == d64) ? 1 : 0;
                    KVD d, dn; decode_kv(idx, l, d); decode_kv(pre ? idx1 : idx, l, dn);
                    AU u; decode_q(idx, l, wave, u);
                    float m_reg, l_reg;
                    if (d64) { if (!warm) cold_start<64>(d, ws, lds + pb * ABUF, wave, lane_u);
                        f32x16 o[2]; attn_main<64>(u, d, dn, pre, pb, ws, lds, tid_u, wave, lane_u, m_reg, l_reg, o);
                        int idx2 = idx; LAUNDER_S(idx2); AE e; decode_epi(idx2, l, wave, ka->odd_sinks, e); attn_epi<64>(e, u.qrow_w, pb ^ 1, ws, lds, wave, lane_u, m_reg, l_reg, o); }
                    else { if (!warm) cold_start<128>(d, ws, lds + pb * ABUF, wave, lane_u);
                        f32x16 o[4]; attn_main<128>(u, d, dn, pre, pb, ws, lds, tid_u, wave, lane_u, m_reg, l_reg, o);
                        int idx2 = idx; LAUNDER_S(idx2); AE e; decode_epi(idx2, l, wave, ka->odd_sinks, e); attn_epi<128>(e, u.qrow_w, pb ^ 1, ws, lds, wave, lane_u, m_reg, l_reg, o); }
                    warm = pre != 0;
                    if (tid == 0) MISC[18 + (it & 1)] = nx2;
                    __syncthreads();
                    idx = idx1; idx1 = (int)MISC[18 + (it & 1)]; ++it;
                }
            }
        }
        if (ph + 1 < ph_hi && !(ph == 16 && G == 256)) { if (!(ph >= 1 && ph <= 16 && ((ph - 1) & 3) == 2 && (((ph - 1) >> 2) & 1))) xcd_barrier(bar); }
        if (TPROBE_MASK) { if ((TPROBE_MASK >> ph) & 1) tp_acc += __builtin_amdgcn_s_memrealtime() - tp_t0; }
    }
    if (TPROBE_MASK) { if (bx == 0) { const unsigned long long te = __builtin_amdgcn_s_memrealtime(); while (__builtin_amdgcn_s_memrealtime() - te < 4ull * tp_acc) __builtin_amdgcn_s_sleep(8); } }
}

extern "C" void kernel_launch(void* const* d_in, const int* in_sizes, int n_in, void* d_out, int out_size, void* d_ws, size_t ws_size, hipStream_t stream) {
    static int grid = 0;
    if (grid == 0) {
        if (n_in != 14 || in_sizes[0] != NTOK * DM || out_size != NTOK * DM || ws_size < WS_END) { fprintf(stderr, "kernel_launch: unexpected shapes (n_in %d, in0 %d, out %d, ws %zu)\n", n_in, n_in > 0 ? in_sizes[0] : -1, out_size, ws_size); grid = -1; return; }
        int dev = 0, cus = 0, per_cu = 0;
        if (hipGetDevice(&dev) != hipSuccess || hipDeviceGetAttribute(&cus, hipDeviceAttributeMultiprocessorCount, dev) != hipSuccess) { grid = -1; return; }
        if (hipFuncSetAttribute((const void*)fwd_kernel, hipFuncAttributeMaxDynamicSharedMemorySize, LDS_BYTES) != hipSuccess) { fprintf(stderr, "kernel_launch: hipFuncSetAttribute failed\n"); grid = -1; return; }
        if (hipOccupancyMaxActiveBlocksPerMultiprocessor(&per_cu, (const void*)fwd_kernel, NWAVES * 64, LDS_BYTES) != hipSuccess || per_cu < 1) { fprintf(stderr, "kernel_launch: occupancy query says %d blocks/CU\n", per_cu); }
        (void)hipGetLastError();
        grid = cus;
    }
    if (grid < 0) return;
    (void)hipMemsetAsync((char*)d_ws + WS_CTL, 0, CTL_ZERO_BYTES, stream);
    Args a{};
    a.x = (const float*)d_in[0]; a.mem = (const float*)d_in[1]; a.pos = (const int*)d_in[2];
    a.even_norm = (const float*)d_in[3]; a.even_w_in = (const float*)d_in[4]; a.even_w_mkv = (const float*)d_in[5]; a.even_w_out = (const float*)d_in[6];
    a.odd_norm = (const float*)d_in[7]; a.odd_w_in = (const float*)d_in[8]; a.odd_w_mkv = (const float*)d_in[9]; a.odd_w_out = (const float*)d_in[10]; a.odd_sinks = (const float*)d_in[11];
    a.mem_norm = (const float*)d_in[12]; a.final_norm = (const float*)d_in[13];
    a.out = (float*)d_out; a.ws = (unsigned char*)d_ws;
#if MK_PER_PHASE
    for (int ph = 0; ph < N_PHASES; ++ph) { a.ph_lo = ph; a.ph_hi = ph + 1; hipLaunchKernelGGL(fwd_kernel, dim3(grid), dim3(NWAVES * 64), LDS_BYTES, stream, a); }
#else
    a.ph_lo = 0; a.ph_hi = N_PHASES;
    hipLaunchKernelGGL(fwd_kernel, dim3(grid), dim3(NWAVES * 64), LDS_BYTES, stream, a);
#ifdef PROBE_PHASES
    {
        const int pp[] = PROBE_PHASES;
        (void)hipMemsetAsync((char*)d_ws + WS_CTL + (size_t)CW_Q * 4, 0, 64 * 8 * 4, stream);
        for (unsigned i = 0; i < sizeof(pp) / sizeof(pp[0]); ++i) { a.ph_lo = pp[i]; a.ph_hi = pp[i] + 1; hipLaunchKernelGGL(fwd_kernel, dim3(grid), dim3(NWAVES * 64), LDS_BYTES, stream, a); }
    }
#endif
#endif
    const hipError_t le = hipPeekAtLastError();
    if (le != hipSuccess) fprintf(stderr, "kernel_launch: launch failed: %s\n", hipGetErrorName(le));
}
```

```cpp
#include <hip/hip_runtime.h>
#include <cstdio>
#include <cstdint>

#ifndef TPROBE_MASK
#define TPROBE_MASK 0
#endif
#ifndef AN_MASK
#define AN_MASK 63
#endif
#ifndef MK_PER_PHASE
#define MK_PER_PHASE 0
#endif

namespace {
#define LAS __attribute__((address_space(3)))
#define GAS __attribute__((address_space(1)))
typedef unsigned short bf16_t;
typedef short bf16x8 __attribute__((ext_vector_type(8)));
typedef short s16x4 __attribute__((ext_vector_type(4)));
typedef float f32x4 __attribute__((ext_vector_type(4)));
typedef float f32x16 __attribute__((ext_vector_type(16)));
typedef unsigned u32x4 __attribute__((ext_vector_type(4)));
typedef GAS unsigned gu32;
#define RLX_AGENT __ATOMIC_RELAXED, __HIP_MEMORY_SCOPE_AGENT
#define LDS_WAIT() asm volatile("s_waitcnt lgkmcnt(0)" ::: "memory")
#define VM_WAIT() asm volatile("s_waitcnt vmcnt(0)" ::: "memory")
#define SBAR() __builtin_amdgcn_sched_barrier(0)

constexpr int BATCH = 4, SEQ = 2048, DM = 2048, NTOK = BATCH * SEQ, MEML = 256, NMEM = BATCH * MEML;
constexpr int EVEN_N = 7168, ODD_N = 4480, ODD_NP = 4608;
constexpr int KDIM = 2048;
constexpr float EPS = 1e-6f;
constexpr int NWAVES = 8;

constexpr size_t MiB = 1u << 20;
constexpr size_t WS_CTL = 0, CTL_ZERO_BYTES = 1 * MiB;
constexpr size_t WS_WIN_E0 = 1 * MiB, WS_WIN_E1 = 29 * MiB, WS_WIN_O0 = 57 * MiB, WS_WIN_O1 = 75 * MiB;
constexpr size_t WS_WOUT = 93 * MiB;
constexpr size_t WS_WMKV = 125 * MiB;
constexpr size_t WS_XB = 141 * MiB;
constexpr size_t WS_QKV = 173 * MiB;
constexpr size_t WS_Y = 285 * MiB;
constexpr size_t WS_OG = 374 * MiB;
constexpr size_t WS_LSE = 353 * MiB;
constexpr size_t WS_MKV = 354 * MiB;
constexpr size_t WS_MEMN = 362 * MiB;
constexpr size_t WS_CS128 = 366 * MiB;
constexpr size_t WS_CS64 = 370 * MiB;
constexpr size_t WS_SSQ = 372 * MiB;
constexpr size_t WS_END = 438 * MiB;
constexpr int CW_BAR = 4096;
constexpr int CW_SSQ = 16384;
constexpr int CW_KM = 65536;
constexpr int CW_Q = 131072;
constexpr int CW_PAN = 135168;
static_assert((CW_PAN + 64 * 32) * 4 <= (int)CTL_ZERO_BYTES, "ctl");

constexpr int RING_BYTES = 131072;
constexpr int LDSCTL_OFF = RING_BYTES, MISC_OFF = LDSCTL_OFF + 320;
constexpr int LDS_BYTES = 147456;
constexpr int XTBL_OFF = LDSCTL_OFF + 1024;

__device__ __forceinline__ unsigned f2bf(float f) { unsigned u = __builtin_bit_cast(unsigned, f); return (u + 0x7fffu + ((u >> 16) & 1u)) >> 16; }
typedef float f32x2_t __attribute__((ext_vector_type(2))); typedef __bf16 bf16x2_t __attribute__((ext_vector_type(2)));
__device__ __forceinline__ unsigned pk2(float lo, float hi) { f32x2_t v = {lo, hi}; bf16x2_t b = __builtin_convertvector(v, bf16x2_t); return __builtin_bit_cast(unsigned, b); }
__device__ __forceinline__ unsigned cvt_pk_bf16(float lo, float hi) { unsigned r; asm volatile("v_cvt_pk_bf16_f32 %0, %1, %2" : "=v"(r) : "v"(lo), "v"(hi)); return r; }
__device__ __forceinline__ float bflo(unsigned w) { return __builtin_bit_cast(float, w << 16); }
__device__ __forceinline__ float bfhi(unsigned w) { return __builtin_bit_cast(float, w & 0xffff0000u); }

constexpr int BM = 256, BK = 64, HALF = 128, HTB = HALF * BK * 2, NXCD = 8, WGM = 8;
__device__ __forceinline__ int lds_byte(int r, int c) { const int st = (r >> 4) * 2 + (c >> 5), rr = r & 15, cc = c & 31, ob = rr * 64 + cc * 2; return st * 1024 + (ob ^ (((ob >> 9) & 1) << 5)); }
__device__ __forceinline__ void stage_rc(int b, int& R, int& C) { const int st = b / 1024, sb = b % 1024, swz = sb ^ (((sb >> 9) & 1) << 5); R = (st >> 1) * 16 + swz / 64; C = (st & 1) * 32 + (swz % 64) / 2; }
__device__ __forceinline__ int perm32(int rho) { const int n = rho >> 4, i = rho & 15; return 8 * (i >> 2) + 4 * n + (i & 3); }

struct Unit { int pm, pn, s; };
enum { EM_PLAIN = 0, EM_INPROJ = 1, EM_OUTPROJ = 2 };
struct GemmP { const bf16_t* A; const bf16_t* Bt; int mode, l; unsigned char* ws; const float* xin; float* out; LAS unsigned char* lds; const float* fnorm; int fuse_final; };
__device__ __forceinline__ void tile_of(int wgid, int nM, int nN, int& pm, int& pn) {
    const int nwg = nM * nN; { const int q = nwg / NXCD, r = nwg % NXCD, xcd = wgid % NXCD, off = wgid / NXCD; wgid = (xcd < r ? xcd * (q + 1) : r * (q + 1) + (xcd - r) * q) + off; }
    const int nig = WGM * nN, gid = wgid / nig, fm = gid * WGM, gsz = (nM - fm) < WGM ? (nM - fm) : WGM;
    pm = fm + ((wgid % nig) % gsz); pn = (wgid % nig) / gsz;
}
struct Order {
    int nwg0, nwg1, nM0, nN0, G, c;
    __device__ __forceinline__ bool next(int i, Unit& u) const {
        const int L = i * G + c; if (L >= nwg0 + nwg1) return false;
        if (L < nwg0) { u.s = 0; tile_of(L, nM0, nN0, u.pm, u.pn); } else { u.s = 1; tile_of(L - nwg0, 4, 16, u.pm, u.pn); }
        return true;
    }
};

__device__ __forceinline__ void epi_run(const GemmP& P, const f32x4 (&acc)[2][2][4][2], const Unit& u, int wr, int wc, int fr, int fq) {
    const int row0 = u.pm * BM + wr * 64 + fr;
    const int colt = u.pn * BM + wc * 32 + 8 * fq;
    const int mode = u.s ? EM_PLAIN : P.mode;
    unsigned char* ws = P.ws;
    if (mode == EM_PLAIN) {
        bf16_t* O = (bf16_t*)(ws + WS_MKV);
#pragma unroll
        for (int ai = 0; ai < 2; ++ai)
#pragma unroll
            for (int m = 0; m < 4; ++m) { bf16_t* rowp = O + (size_t)(row0 + ai * HALF + m * 16) * 4096 + colt;
#pragma unroll
                for (int bj = 0; bj < 2; ++bj) { const f32x4 v0 = acc[ai][bj][m][0], v1 = acc[ai][bj][m][1];
                    u32x4 w; w.x = cvt_pk_bf16(v0[0], v0[1]); w.y = cvt_pk_bf16(v0[2], v0[3]); w.z = cvt_pk_bf16(v1[0], v1[1]); w.w = cvt_pk_bf16(v1[2], v1[3]);
                    *(u32x4*)(rowp + bj * HALF) = w; } }
    } else if (mode == EM_INPROJ) {
        const int l = P.l, odd = l & 1, ldo = odd ? ODD_NP : EVEN_N;
        bf16_t* O = (bf16_t*)(ws + WS_QKV);
        const float* cs128 = (const float*)(ws + WS_CS128); const float* cs64 = (const float*)(ws + WS_CS64);
        float* km = (float*)(ws + WS_CTL) + CW_KM + (size_t)(l >> 1) * (4 * 6 * 8 * 128);
        int kind; bool kmean = false;
        if (odd) { kind = (u.pn <= 6) ? 2 : (u.pn <= 9 ? 0 : 3); }
        else { kind = (u.pn < 6) ? 1 : (u.pn < 9 ? 0 : (u.pn < 15 ? 1 : (u.pn < 20 ? 0 : 3))); kmean = (u.pn >= 12 && u.pn < 15); }
        float ks[2][8];
#pragma unroll
        for (int bj = 0; bj < 2; ++bj)
#pragma unroll
            for (int e = 0; e < 8; ++e) ks[bj][e] = 0.f;
        f32x4 csA[8], snA[8];
#define EPI_TLOAD(I0) do { if (kind == 1) { _Pragma("unroll") for (int i = (I0); i < (I0) + 4; ++i) { const float* t = cs128 + (size_t)(row0 + (i >> 2) * HALF + (i & 3) * 16) * 128 + (16 * wc + 4 * fq); csA[i] = *(const f32x4*)t; snA[i] = *(const f32x4*)(t + 64); } } \
        else if (kind == 2) { _Pragma("unroll") for (int i = (I0); i < (I0) + 4; ++i) { const float* t = cs64 + (size_t)(row0 + (i >> 2) * HALF + (i & 3) * 16) * 64 + (16 * (wc & 1) + 4 * fq); csA[i] = *(const f32x4*)t; snA[i] = *(const f32x4*)(t + 32); } } \
        else { _Pragma("unroll") for (int i = (I0); i < (I0) + 4; ++i) { csA[i] = (f32x4){1.f, 1.f, 1.f, 1.f}; snA[i] = (f32x4){0.f, 0.f, 0.f, 0.f}; } } } while (0)
        EPI_TLOAD(0);
        { const int te = (wr * 4 + wc) * 64 + fq * 16 + fr;
          if (te < 256) { const float* sb = (const float*)(ws + WS_SSQ) + (size_t)l * 8 * NTOK + u.pm * BM; float t8[8];
#pragma unroll
              for (int j = 0; j < 8; ++j) { const float* sj = sb + (size_t)j * NTOK; t8[j] = sj[te]; }
              const float sq = ((t8[0] + t8[1]) + (t8[2] + t8[3])) + ((t8[4] + t8[5]) + (t8[6] + t8[7]));
              ((LAS float*)(P.lds + XTBL_OFF))[te] = __builtin_amdgcn_rsqf(sq * (1.0f / DM) + EPS); }
          LDS_WAIT(); __builtin_amdgcn_s_barrier(); asm volatile("" ::: "memory"); }
        const LAS float* rst = (const LAS float*)(P.lds + XTBL_OFF);
#pragma unroll
        for (int ai = 0; ai < 2; ++ai) {
#pragma unroll
            for (int m = 0; m < 4; ++m) {
                if (ai == 0 && m == 3) { asm volatile("" ::: "memory"); EPI_TLOAD(4); }
                const int row = row0 + ai * HALF + m * 16;
                const float rs = rst[ai * HALF + wr * 64 + m * 16 + fr];
                const f32x4 cs = csA[ai * 4 + m], sn = snA[ai * 4 + m];
                bf16_t* rowp = O + (size_t)row * ldo + colt;
#pragma unroll
                for (int bj = 0; bj < 2; ++bj) {
                    f32x4 v0 = acc[ai][bj][m][0] * rs, v1 = acc[ai][bj][m][1] * rs;
                    if (kind == 1 || kind == 2) { const f32x4 o0 = v0 * cs - v1 * sn, o1 = v1 * cs + v0 * sn; v0 = o0; v1 = o1; }
                    else if (kind == 3) {
#pragma unroll
                        for (int j = 0; j < 4; ++j) { v0[j] = v0[j] * __builtin_amdgcn_rcpf(1.0f + __builtin_amdgcn_exp2f(-1.4426950408889634f * v0[j]));
                                                      v1[j] = v1[j] * __builtin_amdgcn_rcpf(1.0f + __builtin_amdgcn_exp2f(-1.4426950408889634f * v1[j])); }
                    }
                    if (kmean) {
#pragma unroll
                        for (int j = 0; j < 4; ++j) { ks[bj][j] += v0[j]; ks[bj][4 + j] += v1[j]; }
                    }
                    u32x4 w; w.x = cvt_pk_bf16(v0[0], v0[1]); w.y = cvt_pk_bf16(v0[2], v0[3]); w.z = cvt_pk_bf16(v1[0], v1[1]); w.w = cvt_pk_bf16(v1[2], v1[3]);
                    *(u32x4*)(rowp + bj * HALF) = w;
                }
            }
        }
#undef EPI_TLOAD
        if (kmean) {
#pragma unroll
            for (int bj = 0; bj < 2; ++bj)
#pragma unroll
                for (int e = 0; e < 8; ++e) { float s = ks[bj][e]; s += __shfl_xor(s, 1); s += __shfl_xor(s, 2); s += __shfl_xor(s, 4); s += __shfl_xor(s, 8); ks[bj][e] = s; }
            if (fr == 0) {
                const int b = u.pm >> 3, n = u.pm & 7;
#pragma unroll
                for (int bj = 0; bj < 2; ++bj) { const int h = (u.pn - 12) * 2 + bj; float* dst = km + ((size_t)((b * 6 + h) * 8 + n)) * 128 + wc * 32 + 8 * fq;
#pragma unroll
                    for (int e = 0; e < 8; ++e) atomicAdd(dst + e, ks[bj][e]); }
            }
        }
    } else {
        const int l = P.l;
        float* xout = P.out;
        bf16_t* xb = (bf16_t*)(ws + WS_XB); const bool wxb = (l != 3);
        const bool fuse = (l == 3) && P.fuse_final;
        float* ssq_out = (float*)(ws + WS_SSQ) + (size_t)(l + 1) * 8 * NTOK + (size_t)u.pn * NTOK + u.pm * BM;
        LAS float* xt = (LAS float*)(P.lds + XTBL_OFF);
#pragma unroll
        for (int ai = 0; ai < 2; ++ai)
#pragma unroll
            for (int m = 0; m < 4; ++m) {
                const int row = row0 + ai * HALF + m * 16; float ss = 0.f;
#pragma unroll
                for (int bj = 0; bj < 2; ++bj) {
                    const size_t off = (size_t)row * DM + colt + bj * HALF;
                    const f32x4 v0 = acc[ai][bj][m][0], v1 = acc[ai][bj][m][1];
                    if (!fuse) { *(f32x4*)(xout + off) = v0; *(f32x4*)(xout + off + 4) = v1; }
                    if (wxb) { u32x4 w; w.x = cvt_pk_bf16(v0[0], v0[1]); w.y = cvt_pk_bf16(v0[2], v0[3]); w.z = cvt_pk_bf16(v1[0], v1[1]); w.w = cvt_pk_bf16(v1[2], v1[3]); *(u32x4*)(xb + off) = w; }
                    ss += (v0[0] * v0[0] + v0[1] * v0[1]) + (v0[2] * v0[2] + v0[3] * v0[3]) + (v1[0] * v1[0] + v1[1] * v1[1]) + (v1[2] * v1[2] + v1[3] * v1[3]);
                }
                ss += __shfl_xor(ss, 16); ss += __shfl_xor(ss, 32);
                if (fq == 0) xt[(ai * HALF + wr * 64 + m * 16 + fr) * 4 + wc] = ss;
            }
        LDS_WAIT(); __builtin_amdgcn_s_barrier(); asm volatile("" ::: "memory");
        const int lane = fq * 16 + fr, wid = wr * 4 + wc, r = wid * 32 + (lane & 31);
        if (!fuse) {
            if (lane < 32) { const f32x4 t = *(const LAS f32x4*)(xt + r * 4); ssq_out[r] = (t[0] + t[1]) + (t[2] + t[3]); }
        } else {
            if (lane < 32) { const f32x4 t = *(const LAS f32x4*)(xt + r * 4); __hip_atomic_store((unsigned*)(ssq_out + r), __float_as_uint((t[0] + t[1]) + (t[2] + t[3])), __ATOMIC_RELAXED, __HIP_MEMORY_SCOPE_AGENT); }
            asm volatile("s_waitcnt vmcnt(0)" ::: "memory"); LDS_WAIT();
            __builtin_amdgcn_s_barrier(); asm volatile("" ::: "memory");
            unsigned* pcnt = (unsigned*)(ws + WS_CTL) + CW_PAN + 64 * u.pm;
            if (wid == 0 && lane == 0) {
                __hip_atomic_fetch_add(pcnt, 1u, __ATOMIC_RELAXED, __HIP_MEMORY_SCOPE_AGENT);
                unsigned sp = 0; while (__hip_atomic_load(pcnt, __ATOMIC_RELAXED, __HIP_MEMORY_SCOPE_AGENT) < 8u) { __builtin_amdgcn_s_sleep(2); if (++sp > (1u << 22)) break; }
                __builtin_amdgcn_fence(__ATOMIC_ACQUIRE, "agent"); asm volatile("s_waitcnt vmcnt(0)" ::: "memory");
            }
            __builtin_amdgcn_s_barrier(); asm volatile("" ::: "memory");
            { const int te = wid * 64 + lane;
              if (te < 256) { const unsigned* sb = (const unsigned*)((const float*)(ws + WS_SSQ) + (size_t)4 * 8 * NTOK + u.pm * BM + te); float sq = 0.f;
#pragma unroll
                  for (int j = 0; j < 8; ++j) sq += __uint_as_float(__hip_atomic_load(sb + (size_t)j * NTOK, __ATOMIC_RELAXED, __HIP_MEMORY_SCOPE_AGENT));
                  xt[te] = 1.0f / sqrtf(sq * (1.0f / DM) + EPS); }
              LDS_WAIT(); __builtin_amdgcn_s_barrier(); asm volatile("" ::: "memory"); }
#pragma unroll
            for (int bj = 0; bj < 2; ++bj) {
                const f32x4 g0 = *(const f32x4*)(P.fnorm + colt + bj * HALF), g1 = *(const f32x4*)(P.fnorm + colt + bj * HALF + 4);
#pragma unroll
                for (int ai = 0; ai < 2; ++ai)
#pragma unroll
                    for (int m = 0; m < 4; ++m) {
                        const float rs = xt[ai * HALF + wr * 64 + m * 16 + fr];
                        const size_t off = (size_t)(row0 + ai * HALF + m * 16) * DM + colt + bj * HALF;
                        *(f32x4*)(xout + off) = acc[ai][bj][m][0] * rs * g0; *(f32x4*)(xout + off + 4) = acc[ai][bj][m][1] * rs * g1;
                    }
            }
        }
    }
}

__device__ __forceinline__ void gemm_phase(LAS unsigned char* lds, const GemmP& P, const Order& S, const int tid) {
    const int wid = __builtin_amdgcn_readfirstlane(tid >> 6), lane = tid & 63, wr = wid >> 2, wc = wid & 3, fr = lane & 15, fq = lane >> 4;
    constexpr int K = KDIM, nt = K / BK;
    unsigned voffA[2], voffB[2];
#pragma unroll
    for (int i = 0; i < 2; ++i) { int R, C; stage_rc(tid * 16 + i * 8192, R, C); const int Rb = (R & ~31) + perm32(R & 31);
        voffA[i] = (unsigned)(R * K + C) * 2u; voffB[i] = (unsigned)(Rb * K + C) * 2u; }
    constexpr size_t kstep = (size_t)(BK * 2);
    constexpr size_t hstep = (size_t)HALF * K * 2;
    constexpr size_t tstep = 2 * hstep;
    const unsigned ldsw = (unsigned)wid * 1024u;
    const int aoff = lds_byte(wr * 64 + fr, fq * 8), boff = lds_byte(wc * 32 + fr, fq * 8);
#define PG8_SA(b, h) (((b) * 2 + (h)) * HTB)
#define PG8_SB(b, h) ((4 + (b) * 2 + (h)) * HTB)
#define PG8_STAGE(bufoff, gbase, voff) do { _Pragma("unroll") for (int _i = 0; _i < 2; ++_i) \
        __builtin_amdgcn_global_load_lds((const unsigned*)((const char*)(gbase) + (voff)[_i]), (LAS unsigned*)(lds + (bufoff) + ldsw + _i * 8192), 16, 0, 0); } while (0)
#define PG8_LDA(dst, b, h) do { _Pragma("unroll") for (int m = 0; m < 4; ++m) _Pragma("unroll") for (int k = 0; k < 2; ++k) dst[m][k] = *(const LAS bf16x8*)(lds + PG8_SA(b, h) + aoff + m * 2048 + k * 1024); } while (0)
#define PG8_LDB(dst, b, h) do { _Pragma("unroll") for (int n = 0; n < 2; ++n) _Pragma("unroll") for (int k = 0; k < 2; ++k) dst[n][k] = *(const LAS bf16x8*)(lds + PG8_SB(b, h) + boff + n * 2048 + k * 1024); } while (0)
#define PG8_MMA(ai, bj, At, Bt) do { __builtin_amdgcn_s_setprio(1); _Pragma("unroll") for (int m = 0; m < 4; ++m) _Pragma("unroll") for (int n = 0; n < 2; ++n) _Pragma("unroll") for (int k = 0; k < 2; ++k) \
        acc[ai][bj][m][n] = __builtin_amdgcn_mfma_f32_16x16x32_bf16(Bt[n][k], At[m][k], acc[ai][bj][m][n], 0, 0, 0); __builtin_amdgcn_s_setprio(0); } while (0)
#define PG8_WAIT_V(n) asm volatile("s_waitcnt vmcnt(" #n ")" ::: "memory")
#define PG8_WAIT_L(n) asm volatile("s_waitcnt lgkmcnt(" #n ")" ::: "memory")
#define PG8_BAR __builtin_amdgcn_s_barrier()
#define PG8_SCHED __builtin_amdgcn_sched_barrier(0)
    Unit cur, nxt; int ui = 0;
    if (!S.next(0, cur)) return;
    f32x4 acc[2][2][4][2];
#define PG8_ACC_INIT(U) do { if (P.mode == EM_OUTPROJ && (U).s == 0) { \
        const char* rp = (const char*)(P.l == 0 ? P.xin : (const float*)P.out) + ((size_t)((U).pm * BM + wr * 64 + fr) * DM + (U).pn * BM + wc * 32 + 8 * fq) * 4; \
        _Pragma("unroll") for (int a = 0; a < 2; ++a) _Pragma("unroll") for (int m = 0; m < 4; ++m) { asm volatile("" : "+v"(rp)); \
            _Pragma("unroll") for (int b = 0; b < 2; ++b) _Pragma("unroll") for (int n = 0; n < 2; ++n) acc[a][b][m][n] = *(const f32x4*)(rp + b * 512 + n * 16); \
            rp += (m == 3 ? (size_t)(HALF - 48) : (size_t)16) * DM * 4; } \
    } else { _Pragma("unroll") for (int a = 0; a < 2; ++a) _Pragma("unroll") for (int b = 0; b < 2; ++b) _Pragma("unroll") for (int m = 0; m < 4; ++m) _Pragma("unroll") for (int n = 0; n < 2; ++n) acc[a][b][m][n] = (f32x4){0.f, 0.f, 0.f, 0.f}; } } while (0)
    PG8_ACC_INIT(cur);
    bf16x8 At[4][2], B0[2][2], B1[2][2];
    const char* cA = (cur.s ? (const char*)(P.ws + WS_MEMN) : (const char*)P.A) + (size_t)cur.pm * tstep; const char* cB = (cur.s ? (const char*)(P.ws + WS_WMKV) : (const char*)P.Bt) + (size_t)cur.pn * tstep;
    PG8_STAGE(PG8_SB(0, 0), cB, voffB); PG8_STAGE(PG8_SB(0, 1), cB + hstep, voffB); PG8_STAGE(PG8_SA(0, 0), cA, voffA); PG8_STAGE(PG8_SA(0, 1), cA + hstep, voffA);
    if (wr == 1) PG8_BAR;
    PG8_WAIT_V(2); PG8_BAR;
    PG8_STAGE(PG8_SB(1, 0), cB + kstep, voffB); PG8_STAGE(PG8_SA(1, 0), cA + kstep, voffA); PG8_STAGE(PG8_SB(1, 1), cB + hstep + kstep, voffB);
    PG8_WAIT_V(6); PG8_BAR;
    for (;;) {
        const bool has_next = S.next(ui + 1, nxt);
        const char* nA = has_next ? (nxt.s ? (const char*)(P.ws + WS_MEMN) : (const char*)P.A) + (size_t)nxt.pm * tstep : cA; const char* nB = has_next ? (nxt.s ? (const char*)(P.ws + WS_WMKV) : (const char*)P.Bt) + (size_t)nxt.pn * tstep : cB;
        for (int t = 0; t < nt; t += 2) {
            const bool last = (t == nt - 2);
            const char* a1 = cA + (size_t)(t + 1) * kstep;
            const char* a2 = last ? nA : cA + (size_t)(t + 2) * kstep; const char* b2 = last ? nB : cB + (size_t)(t + 2) * kstep;
            const char* a3 = a2 + kstep; const char* b3 = b2 + kstep;
            PG8_LDB(B0, 0, 0); PG8_LDB(B1, 0, 1); PG8_SCHED; PG8_LDA(At, 0, 0); PG8_STAGE(PG8_SA(1, 1), a1 + hstep, voffA);
            PG8_WAIT_V(8); PG8_WAIT_L(0); PG8_BAR; PG8_MMA(0, 0, At, B0); PG8_MMA(0, 1, At, B1); PG8_BAR; PG8_SCHED;
            PG8_LDA(At, 0, 1); PG8_STAGE(PG8_SB(0, 0), b2, voffB); PG8_STAGE(PG8_SB(0, 1), b2 + hstep, voffB); PG8_STAGE(PG8_SA(0, 0), a2, voffA);
            PG8_WAIT_V(8); PG8_WAIT_L(0); PG8_BAR; PG8_MMA(1, 0, At, B0); PG8_MMA(1, 1, At, B1); PG8_BAR; PG8_SCHED;
            PG8_LDB(B0, 1, 0); PG8_LDB(B1, 1, 1); PG8_SCHED; PG8_LDA(At, 1, 0); PG8_STAGE(PG8_SA(0, 1), a2 + hstep, voffA);
            PG8_WAIT_V(8); PG8_WAIT_L(0); PG8_BAR; PG8_MMA(0, 0, At, B0); PG8_MMA(0, 1, At, B1); PG8_BAR; PG8_SCHED;
            PG8_LDA(At, 1, 1); PG8_STAGE(PG8_SB(1, 0), b3, voffB); PG8_STAGE(PG8_SB(1, 1), b3 + hstep, voffB); PG8_STAGE(PG8_SA(1, 0), a3, voffA);
            PG8_WAIT_V(8); PG8_WAIT_L(0); PG8_BAR; PG8_MMA(1, 0, At, B0); PG8_MMA(1, 1, At, B1); PG8_BAR; PG8_SCHED;
        }
        if (wr == 0) PG8_BAR;
        { int lane_e = lane; asm volatile("" : "+v"(lane_e));
          epi_run(P, acc, cur, wr, wc, lane_e & 15, lane_e >> 4); }
        if (!has_next) break;
        PG8_ACC_INIT(nxt);
        cur = nxt; cA = nA; cB = nB; ++ui;
        if (wr == 1) PG8_BAR;
    }
    PG8_WAIT_V(0);
    PG8_BAR;
#undef PG8_ACC_INIT
#undef PG8_SA
#undef PG8_SB
#undef PG8_STAGE
#undef PG8_LDA
#undef PG8_LDB
#undef PG8_MMA
#undef PG8_WAIT_V
#undef PG8_WAIT_L
#undef PG8_BAR
#undef PG8_SCHED
}

struct KVD { int kvsel, koff, voff, kd1, ks, L, kt0, ksub, koff1, nst; };
struct AU { int qoff, qs, qrow_w, band, causal, pair, whalf, moba_n, tbase, kmoff; };
struct AE { int epi, ooff, os, goff, gs, lseoff, lses, has_sink; float sink; };
__device__ __forceinline__ int crow(int r, int hi) { return (r & 3) + 8 * (r >> 2) + 4 * hi; }
typedef short v4i16_t __attribute__((ext_vector_type(4)));
template <int OFF> __device__ __forceinline__ s16x4 tr_read(int vb) { return __builtin_bit_cast(s16x4, __builtin_amdgcn_ds_read_tr16_b64_v4i16((LAS v4i16_t*)(uintptr_t)(unsigned)(vb + OFF))); }
template <int D> __device__ __forceinline__ int kswz(int row, int colB) { if constexpr (D == 128) return row * 256 + (colB ^ ((row & 7) << 4)); else return row * 128 + (colB ^ (((row >> 1) & 7) << 4)); }
template <int D> __device__ __forceinline__ int v_st(int k, int c) { const int kk = (k & ~0xC) | ((k & 4) << 1) | ((k & 8) >> 1); return ((kk >> 3) * (D / 32) + (c >> 5)) * 512 + ((kk & 7) * 32 + (c & 31)) * 2; }
__device__ __forceinline__ int v_rd_base(int lane) { return ((lane & 3) << 3) | (((lane >> 2) & 3) << 6) | (((lane >> 4) & 1) << 5) | (((lane >> 5) & 1) << 8); }
template <int D> constexpr int v_rd_off(int d0, int ks, int half) { return d0 * 512 + (ks * 2 + half) * (D / 32) * 512; }

template <int D, int D0, int HF> __device__ __forceinline__ void pv_half(f32x16& od, int vb, bf16x8 pa, bf16x8 pb) {
    const s16x4 l0 = tr_read<v_rd_off<D>(D0, 2 * HF, 0)>(vb), h0 = tr_read<v_rd_off<D>(D0, 2 * HF, 1)>(vb), l1 = tr_read<v_rd_off<D>(D0, 2 * HF + 1, 0)>(vb), h1 = tr_read<v_rd_off<D>(D0, 2 * HF + 1, 1)>(vb);
#define PKV(Lx, Hx) (bf16x8){Lx[0], Lx[1], Lx[2], Lx[3], Hx[0], Hx[1], Hx[2], Hx[3]}
    od = __builtin_amdgcn_mfma_f32_32x32x16_bf16(pa, PKV(l0, h0), od, 0, 0, 0);
    od = __builtin_amdgcn_mfma_f32_32x32x16_bf16(pb, PKV(l1, h1), od, 0, 0, 0);
#undef PKV
}
template <int D, int HF> __device__ __forceinline__ void pv_all(f32x16* o, int vb, bf16x8 pa, bf16x8 pb) {
    pv_half<D, 0, HF>(o[0], vb, pa, pb); pv_half<D, 1, HF>(o[1], vb, pa, pb);
    if constexpr (D == 128) { pv_half<D, 2, HF>(o[2], vb, pa, pb); pv_half<D, 3, HF>(o[3], vb, pa, pb); }
}
template <int D> struct ACfg { static constexpr int NSUB = (D == 128) ? 2 : 3, KTB = 64 * D * 2; };
constexpr int ABUF = 65536;
__device__ __forceinline__ int swap23(int k) { return (k & ~0xC) | ((k & 4) << 1) | ((k & 8) >> 1); }
template <int D> __device__ __forceinline__ void stage_dma(const KVD& d, const unsigned char* ws, int sub, LAS unsigned char* buf, int slot, int wid, int lane) {
    constexpr int NSUB = ACfg<D>::NSUB, KTB = ACfg<D>::KTB, NBLK = D / 32, NP = KTB / 8192;
    const bf16_t* KVp = (const bf16_t*)(ws + (d.kvsel ? WS_MKV : WS_QKV));
    const int kb = d.kt0 + sub * d.ksub;
    LAS unsigned char* Kt = buf + slot * KTB; LAS unsigned char* Vt = buf + NSUB * KTB + slot * KTB;
#pragma unroll
    for (int i = 0; i < NP; ++i) {
        const int piece = wid + 8 * i;
        int row, c;
        if constexpr (D == 128) { row = piece * 4 + (lane >> 4); c = (lane & 15) ^ (row & 7); } else { row = piece * 8 + (lane >> 3); c = (lane & 7) ^ ((row >> 1) & 7); }
        { const int half = row >> 5; int a = kb + (row & 31) + half * d.koff1; a = a < 0 ? 0 : (a > d.L - 1 ? d.L - 1 : a);
          const bf16_t* src = KVp + d.koff + (size_t)a * d.ks + half * d.kd1 + c * 8;
          __builtin_amdgcn_global_load_lds((const unsigned*)src, (LAS unsigned*)(Kt + piece * 1024), 16, 0, 0); }
        { const int p = piece * 1024 + lane * 16, st = p >> 9, q = (p & 511) >> 1, kk = (st / NBLK) * 8 + (q >> 5), k = swap23(kk), col = (st % NBLK) * 32 + (q & 31);
          const int half = k >> 5; int a = kb + (k & 31) + half * d.koff1; a = a < 0 ? 0 : (a > d.L - 1 ? d.L - 1 : a);
          const bf16_t* src = KVp + d.voff + (size_t)a * d.ks + half * d.kd1 + col;
          __builtin_amdgcn_global_load_lds((const unsigned*)src, (LAS unsigned*)(Vt + piece * 1024), 16, 0, 0); }
    }
}
template <int D> __device__ __forceinline__ void cold_start(const KVD& d, const unsigned char* ws, LAS unsigned char* buf, int wid, int lane) {
#pragma unroll
    for (int sl = 0; sl < ACfg<D>::NSUB; ++sl) if (sl < d.nst) stage_dma<D>(d, ws, sl, buf, sl, wid, lane);
    asm volatile("s_waitcnt vmcnt(0)" ::: "memory");
    __syncthreads();
}

template <int D>
__device__ __forceinline__ void attn_main(const AU& u, const KVD& d, const KVD& dn, const int pre, int& pb, unsigned char* ws, LAS unsigned char* lds, int tid, int wid, int lane,
                                          float& m_out, float& l_out, f32x16 (&o)[D / 32]) {
    constexpr int NQ = D / 16, NB = D / 32, NSUB = ACfg<D>::NSUB, KTB = ACfg<D>::KTB;
    constexpr float SCALE = (D == 128) ? 0.088388347648318440f : 0.125f;
    constexpr float C = SCALE * 1.4426950408889634f;
    constexpr float THRS = 8.0f / SCALE;
    const int r32 = lane & 31, hi = lane >> 5;
    LAS float* wsf = (LAS float*)(lds + XTBL_OFF + wid * 256);
    bf16x8 qr[NQ];
    { const bf16_t* qrow = (const bf16_t*)(ws + WS_QKV) + (size_t)u.qoff + (size_t)(u.qrow_w + r32) * u.qs + hi * 8;
#pragma unroll
      for (int d0 = 0; d0 < NQ; ++d0) qr[d0] = *(const bf16x8*)(qrow + d0 * 16); }
    float m_reg = -1e30f, l_reg = 0.f;
#pragma unroll
    for (int dd = 0; dd < NB; ++dd)
#pragma unroll
        for (int r = 0; r < 16; ++r) o[dd][r] = 0.f;
    const int qidx = u.qrow_w + r32;
    unsigned selmask = 0;
    if constexpr (D == 128) {
        if (u.moba_n > 0) {
            const int n = u.moba_n; float g[7];
#pragma unroll
            for (int j = 0; j < 7; ++j) {
                g[j] = -INFINITY;
                if (j < n) {
                    const float* kmj = (const float*)(ws + WS_CTL) + CW_KM + u.kmoff + j * 128 + hi * 8; float s = 0.f;
#pragma unroll
                    for (int d0 = 0; d0 < NQ; ++d0) { const f32x4 a = *(const f32x4*)(kmj + d0 * 16), b = *(const f32x4*)(kmj + d0 * 16 + 4);
                        const u32x4 qw = __builtin_bit_cast(u32x4, qr[d0]);
                        s += bflo(qw.x) * a[0] + bfhi(qw.x) * a[1] + bflo(qw.y) * a[2] + bfhi(qw.y) * a[3] + bflo(qw.z) * b[0] + bfhi(qw.z) * b[1] + bflo(qw.w) * b[2] + bfhi(qw.w) * b[3]; }
                    auto rr = __builtin_amdgcn_permlane32_swap(__float_as_uint(s), __float_as_uint(s), false, false);
                    g[j] = __uint_as_float(rr[0]) + __uint_as_float(rr[1]);
                }
            }
#pragma unroll
            for (int j = 0; j < 7; ++j) { int cnt = 0;
#pragma unroll
                for (int i = 0; i < 7; ++i) if (i != j) cnt += (i < n && (g[i] > g[j] || (g[i] == g[j] && i < j))) ? 1 : 0;
                if (j < n && cnt < 3) selmask |= (1u << j); }
        }
    }
    const int nsteps = (d.nst + NSUB - 1) / NSUB;
    for (int st = 0; st < nsteps; ++st) {
        LAS unsigned char* bufc = lds + pb * ABUF; LAS unsigned char* bufn = lds + (pb ^ 1) * ABUF;
        const bool lastst = (st + 1 == nsteps);
#pragma unroll 1
        for (int sl = 0; sl < NSUB; ++sl) {
            const int sub = st * NSUB + sl;
            if (!lastst) { if (sub + NSUB < d.nst) stage_dma<D>(d, ws, sub + NSUB, bufn, sl, wid, lane); }
            else if (pre) { if (sl < dn.nst) stage_dma<D>(dn, ws, sl, bufn, sl, wid, lane); }
            if (sub < d.nst) {
                const int kb0 = d.kt0 + sub * d.ksub, kb1 = kb0 + d.koff1;
                int lo_q, hi_q;
                const int tabs = u.tbase + sub;
                if (u.moba_n >= 0 && tabs < 4 * u.moba_n) { const bool sel = (selmask >> (tabs >> 2)) & 1u; lo_q = sel ? -(1 << 28) : (1 << 28); hi_q = sel ? (1 << 28) : -(1 << 28); }
                else { lo_q = qidx - u.band; hi_q = u.causal ? qidx : (1 << 28); }
                bool any0 = __any(lo_q <= kb0 + 31 && hi_q >= kb0), any1 = __any(lo_q <= kb1 + 31 && hi_q >= kb1);
                if (u.pair) { any0 = any0 && (u.whalf == 0); any1 = any1 && (u.whalf == 1); }
#define HALF_STEP(HF, ANY, KBH) do { if (ANY) { \
                    const bool allv = __all(lo_q <= (KBH) && hi_q >= (KBH) + 31); \
                    f32x16 p; _Pragma("unroll") for (int r = 0; r < 16; ++r) p[r] = 0.f; \
                    LAS unsigned char* Kt = bufc + sl * KTB; \
                    _Pragma("unroll") for (int d0 = 0; d0 < NQ; ++d0) { const bf16x8 bk = *(const LAS bf16x8*)(Kt + kswz<D>(32 * (HF) + r32, (d0 * 16 + hi * 8) * 2)); p = __builtin_amdgcn_mfma_f32_32x32x16_bf16(bk, qr[d0], p, 0, 0, 0); } \
                    if (!allv) { _Pragma("unroll") for (int r = 0; r < 16; ++r) { const int kk = (KBH) + crow(r, hi); if (kk < lo_q || kk > hi_q) p[r] = -INFINITY; } } \
                    float pmax = p[0]; _Pragma("unroll") for (int r = 1; r < 16; ++r) pmax = fmaxf(pmax, p[r]); \
                    { auto rr = __builtin_amdgcn_permlane32_swap(__float_as_uint(pmax), __float_as_uint(pmax), false, false); pmax = fmaxf(__uint_as_float(rr[0]), __uint_as_float(rr[1])); } \
                    float alpha = 1.f; \
                    if (!__all(pmax - m_reg <= THRS)) { const float mn = fmaxf(m_reg, pmax); alpha = __builtin_amdgcn_exp2f((m_reg - mn) * C); m_reg = mn; } \
                    const float mnC = -m_reg * C; float ps = 0.f; \
                    _Pragma("unroll") for (int r = 0; r < 16; ++r) { p[r] = __builtin_amdgcn_exp2f(fmaf(p[r], C, mnC)); ps += p[r]; } \
                    { auto rr = __builtin_amdgcn_permlane32_swap(__float_as_uint(ps), __float_as_uint(ps), false, false); ps = __uint_as_float(rr[0]) + __uint_as_float(rr[1]); } \
                    l_reg = l_reg * alpha + ps; \
                    if (__any(alpha < 1.f)) { if (hi == 0) wsf[r32] = alpha; LDS_WAIT(); \
                        _Pragma("unroll") for (int dd = 0; dd < NB; ++dd) _Pragma("unroll") for (int r = 0; r < 16; ++r) o[dd][r] *= wsf[crow(r, hi)]; \
                        LDS_WAIT(); } \
                    bf16x8 paA, paB; PK4(p, 0, paA); PK4(p, 8, paB); \
                    const int vb = (int)(uintptr_t)(bufc + NSUB * KTB + sl * KTB) + v_rd_base(lane); \
                    pv_all<D, HF>(o, vb, paA, paB); } } while (0)
#define PK4(P, BASE, OUT) do { unsigned a0 = cvt_pk_bf16(P[BASE + 0], P[BASE + 1]), a1 = cvt_pk_bf16(P[BASE + 2], P[BASE + 3]);   \
    unsigned b0 = cvt_pk_bf16(P[BASE + 4], P[BASE + 5]), b1 = cvt_pk_bf16(P[BASE + 6], P[BASE + 7]);                              \
    auto r0 = __builtin_amdgcn_permlane32_swap(a0, b0, false, false); auto r1 = __builtin_amdgcn_permlane32_swap(a1, b1, false, false); \
    u32x4 w = {r0[0], r1[0], r0[1], r1[1]}; OUT = __builtin_bit_cast(bf16x8, w); } while (0)
                HALF_STEP(0, any0, kb0);
                HALF_STEP(1, any1, kb1);
#undef PK4
#undef HALF_STEP
            }
        }
        asm volatile("s_waitcnt vmcnt(0)" ::: "memory");
        __syncthreads();
        pb ^= 1;
    }
    m_out = m_reg; l_out = l_reg;
}

__device__ __forceinline__ void attn_c_main(const AU& u, const KVD& d, const KVD& dn, const int pre, int& pb, unsigned char* ws, LAS unsigned char* lds, int wid, int lane,
                                            float (&m_out)[2], float (&l_out)[2], f32x16 (&oA)[2], f32x16 (&oB)[2]) {
    constexpr int D = 64, NQ = 4, NSUB = 3, KTB = 8192;
    constexpr float SCALE = 0.125f, C = SCALE * 1.4426950408889634f, THRS = 8.0f / SCALE;
    const int r32 = lane & 31, hi = lane >> 5;
    LAS float* wsf = (LAS float*)(lds + XTBL_OFF + wid * 256);
    bf16x8 qA[NQ], qB[NQ];
    { const bf16_t* qrow = (const bf16_t*)(ws + WS_QKV) + (size_t)u.qoff + (size_t)(u.qrow_w + r32) * u.qs + hi * 8;
#pragma unroll
      for (int d0 = 0; d0 < NQ; ++d0) { qA[d0] = *(const bf16x8*)(qrow + d0 * 16); qB[d0] = *(const bf16x8*)(qrow + (size_t)32 * u.qs + d0 * 16); } }
    float mA = -1e30f, lA = 0.f, mB = -1e30f, lB = 0.f;
#pragma unroll
    for (int dd = 0; dd < 2; ++dd)
#pragma unroll
        for (int r = 0; r < 16; ++r) { oA[dd][r] = 0.f; oB[dd][r] = 0.f; }
    const int qiA = u.qrow_w + r32, qiB = qiA + 32;
    const int loA = qiA - u.band, loB = qiB - u.band;
    LAS unsigned char* bufc = lds + pb * ABUF; LAS unsigned char* bufn = lds + (pb ^ 1) * ABUF;
#define PK4(P, BASE, OUT) do { unsigned a0 = cvt_pk_bf16(P[BASE + 0], P[BASE + 1]), a1 = cvt_pk_bf16(P[BASE + 2], P[BASE + 3]);   \
    unsigned b0 = cvt_pk_bf16(P[BASE + 4], P[BASE + 5]), b1 = cvt_pk_bf16(P[BASE + 6], P[BASE + 7]);                              \
    auto r0 = __builtin_amdgcn_permlane32_swap(a0, b0, false, false); auto r1 = __builtin_amdgcn_permlane32_swap(a1, b1, false, false); \
    u32x4 w = {r0[0], r1[0], r0[1], r1[1]}; OUT = __builtin_bit_cast(bf16x8, w); } while (0)
#define PKV(Lx, Hx) (bf16x8){Lx[0], Lx[1], Lx[2], Lx[3], Hx[0], Hx[1], Hx[2], Hx[3]}
#define C_SINGLE(HF, KBH, QF, LOQ, HIQ, MR, LR, OO) do { \
        f32x16 p; _Pragma("unroll") for (int r = 0; r < 16; ++r) p[r] = 0.f; \
        _Pragma("unroll") for (int d0 = 0; d0 < NQ; ++d0) { const bf16x8 bk = *(const LAS bf16x8*)(Kt + kswz<D>(32 * (HF) + r32, (d0 * 16 + hi * 8) * 2)); p = __builtin_amdgcn_mfma_f32_32x32x16_bf16(bk, QF[d0], p, 0, 0, 0); } \
        _Pragma("unroll") for (int r = 0; r < 16; ++r) { const int kk = (KBH) + crow(r, hi); if (kk < (LOQ) || kk > (HIQ)) p[r] = -INFINITY; } \
        float pmax = p[0]; _Pragma("unroll") for (int r = 1; r < 16; ++r) pmax = fmaxf(pmax, p[r]); \
        { auto rr = __builtin_amdgcn_permlane32_swap(__float_as_uint(pmax), __float_as_uint(pmax), false, false); pmax = fmaxf(__uint_as_float(rr[0]), __uint_as_float(rr[1])); } \
        float alpha = 1.f; if (!__all(pmax - MR <= THRS)) { const float mn = fmaxf(MR, pmax); alpha = __builtin_amdgcn_exp2f((MR - mn) * C); MR = mn; } \
        const float mnC = -MR * C; float ps = 0.f; \
        _Pragma("unroll") for (int r = 0; r < 16; ++r) { p[r] = __builtin_amdgcn_exp2f(fmaf(p[r], C, mnC)); ps += p[r]; } \
        { auto rr = __builtin_amdgcn_permlane32_swap(__float_as_uint(ps), __float_as_uint(ps), false, false); ps = __uint_as_float(rr[0]) + __uint_as_float(rr[1]); } \
        LR = LR * alpha + ps; \
        if (__any(alpha < 1.f)) { if (hi == 0) wsf[r32] = alpha; LDS_WAIT(); \
            _Pragma("unroll") for (int dd = 0; dd < 2; ++dd) _Pragma("unroll") for (int r = 0; r < 16; ++r) OO[dd][r] *= wsf[crow(r, hi)]; LDS_WAIT(); } \
        bf16x8 pa, pb2; PK4(p, 0, pa); PK4(p, 8, pb2); \
        pv_all<D, HF>(OO, vb, pa, pb2); } while (0)
#define C_DUAL(HF, KBH) do { \
        f32x16 pa_, pb_; _Pragma("unroll") for (int r = 0; r < 16; ++r) { pa_[r] = 0.f; pb_[r] = 0.f; } \
        _Pragma("unroll") for (int d0 = 0; d0 < NQ; ++d0) { const bf16x8 bk = *(const LAS bf16x8*)(Kt + kswz<D>(32 * (HF) + r32, (d0 * 16 + hi * 8) * 2)); \
            pa_ = __builtin_amdgcn_mfma_f32_32x32x16_bf16(bk, qA[d0], pa_, 0, 0, 0); pb_ = __builtin_amdgcn_mfma_f32_32x32x16_bf16(bk, qB[d0], pb_, 0, 0, 0); } \
        _Pragma("unroll") for (int r = 0; r < 16; ++r) { const int kk = (KBH) + crow(r, hi); if (kk < loA || kk > qiA) pa_[r] = -INFINITY; if (kk < loB || kk > qiB) pb_[r] = -INFINITY; } \
        float xa = pa_[0], xb = pb_[0]; _Pragma("unroll") for (int r = 1; r < 16; ++r) { xa = fmaxf(xa, pa_[r]); xb = fmaxf(xb, pb_[r]); } \
        { auto rr = __builtin_amdgcn_permlane32_swap(__float_as_uint(xa), __float_as_uint(xa), false, false); xa = fmaxf(__uint_as_float(rr[0]), __uint_as_float(rr[1])); } \
        { auto rr = __builtin_amdgcn_permlane32_swap(__float_as_uint(xb), __float_as_uint(xb), false, false); xb = fmaxf(__uint_as_float(rr[0]), __uint_as_float(rr[1])); } \
        float alA = 1.f, alB = 1.f; \
        if (!__all(xa - mA <= THRS && xb - mB <= THRS)) { const float na = fmaxf(mA, xa), nb = fmaxf(mB, xb); alA = __builtin_amdgcn_exp2f((mA - na) * C); alB = __builtin_amdgcn_exp2f((mB - nb) * C); mA = na; mB = nb; } \
        const float cA_ = -mA * C, cB_ = -mB * C; float sa = 0.f, sb = 0.f; \
        _Pragma("unroll") for (int r = 0; r < 16; ++r) { pa_[r] = __builtin_amdgcn_exp2f(fmaf(pa_[r], C, cA_)); sa += pa_[r]; pb_[r] = __builtin_amdgcn_exp2f(fmaf(pb_[r], C, cB_)); sb += pb_[r]; } \
        { auto rr = __builtin_amdgcn_permlane32_swap(__float_as_uint(sa), __float_as_uint(sa), false, false); sa = __uint_as_float(rr[0]) + __uint_as_float(rr[1]); } \
        { auto rr = __builtin_amdgcn_permlane32_swap(__float_as_uint(sb), __float_as_uint(sb), false, false); sb = __uint_as_float(rr[0]) + __uint_as_float(rr[1]); } \
        lA = lA * alA + sa; lB = lB * alB + sb; \
        if (__any(alA < 1.f || alB < 1.f)) { if (hi == 0) { wsf[r32] = alA; wsf[32 + r32] = alB; } LDS_WAIT(); \
            _Pragma("unroll") for (int dd = 0; dd < 2; ++dd) _Pragma("unroll") for (int r = 0; r < 16; ++r) { oA[dd][r] *= wsf[crow(r, hi)]; oB[dd][r] *= wsf[32 + crow(r, hi)]; } LDS_WAIT(); } \
        bf16x8 a0_, a1_, b0_, b1_; PK4(pa_, 0, a0_); PK4(pa_, 8, a1_); PK4(pb_, 0, b0_); PK4(pb_, 8, b1_); \
        _Pragma("unroll") for (int d0 = 0; d0 < 2; ++d0) { \
            const s16x4 l0 = __builtin_bit_cast(s16x4, __builtin_amdgcn_ds_read_tr16_b64_v4i16((LAS v4i16_t*)(uintptr_t)(unsigned)(vb + d0 * 512 + ((2 * (HF)) * 2 + 0) * 1024))), \
                        h0 = __builtin_bit_cast(s16x4, __builtin_amdgcn_ds_read_tr16_b64_v4i16((LAS v4i16_t*)(uintptr_t)(unsigned)(vb + d0 * 512 + ((2 * (HF)) * 2 + 1) * 1024))), \
                        l1 = __builtin_bit_cast(s16x4, __builtin_amdgcn_ds_read_tr16_b64_v4i16((LAS v4i16_t*)(uintptr_t)(unsigned)(vb + d0 * 512 + ((2 * (HF) + 1) * 2 + 0) * 1024))), \
                        h1 = __builtin_bit_cast(s16x4, __builtin_amdgcn_ds_read_tr16_b64_v4i16((LAS v4i16_t*)(uintptr_t)(unsigned)(vb + d0 * 512 + ((2 * (HF) + 1) * 2 + 1) * 1024))); \
            const bf16x8 v0_ = PKV(l0, h0), v1_ = PKV(l1, h1); \
            oA[d0] = __builtin_amdgcn_mfma_f32_32x32x16_bf16(a0_, v0_, oA[d0], 0, 0, 0); oB[d0] = __builtin_amdgcn_mfma_f32_32x32x16_bf16(b0_, v0_, oB[d0], 0, 0, 0); \
            oA[d0] = __builtin_amdgcn_mfma_f32_32x32x16_bf16(a1_, v1_, oA[d0], 0, 0, 0); oB[d0] = __builtin_amdgcn_mfma_f32_32x32x16_bf16(b1_, v1_, oB[d0], 0, 0, 0); } } while (0)
#pragma unroll 1
    for (int sl = 0; sl < NSUB; ++sl) {
        if (pre) { if (sl < dn.nst) stage_dma<D>(dn, ws, sl, bufn, sl, wid, lane); }
        if (sl < d.nst) {
            LAS unsigned char* Kt = bufc + sl * KTB;
            const int vb = (int)(uintptr_t)(bufc + NSUB * KTB + sl * KTB) + v_rd_base(lane);
            const int kb0 = d.kt0 + sl * 64, kb1 = kb0 + 32;
            { const bool anA = __any(loA <= kb0 + 31 && qiA >= kb0), anB = __any(loB <= kb0 + 31 && qiB >= kb0);
              if (anA && anB) C_DUAL(0, kb0); else if (anA) C_SINGLE(0, kb0, qA, loA, qiA, mA, lA, oA); else if (anB) C_SINGLE(0, kb0, qB, loB, qiB, mB, lB, oB); }
            { const bool anA = __any(loA <= kb1 + 31 && qiA >= kb1), anB = __any(loB <= kb1 + 31 && qiB >= kb1);
              if (anA && anB) C_DUAL(1, kb1); else if (anA) C_SINGLE(1, kb1, qA, loA, qiA, mA, lA, oA); else if (anB) C_SINGLE(1, kb1, qB, loB, qiB, mB, lB, oB); }
        }
    }
#undef C_DUAL
#undef C_SINGLE
#undef PKV
#undef PK4
    asm volatile("s_waitcnt vmcnt(0)" ::: "memory");
    __syncthreads();
    pb ^= 1;
    m_out[0] = mA; m_out[1] = mB; l_out[0] = lA; l_out[1] = lB;
}

template <int D>
__device__ __forceinline__ void attn_epi(const AE& e, int qrow_w, int pbl, unsigned char* ws, LAS unsigned char* lds, int wid, int lane, float m_reg, float l_reg, const f32x16 (&o)[D / 32]) {
    constexpr int NB = D / 32;
    constexpr float SCALE = (D == 128) ? 0.088388347648318440f : 0.125f;
    const int r32 = lane & 31, hi = lane >> 5;
    LAS float* wsf = (LAS float*)(lds + XTBL_OFF + wid * 256);
    LAS bf16_t* stg = (LAS bf16_t*)(lds + pbl * ABUF + wid * 8192);
    float lt = l_reg;
    if (e.has_sink) lt += __builtin_amdgcn_exp2f((e.sink - m_reg * SCALE) * 1.4426950408889634f);
    if (hi == 0) wsf[r32] = lt > 0.f ? __builtin_amdgcn_rcpf(lt) : 0.f;
    LDS_WAIT();
    float rli[16];
#pragma unroll
    for (int r = 0; r < 16; ++r) rli[r] = wsf[crow(r, hi)];
    LDS_WAIT();
#pragma unroll
    for (int r = 0; r < 16; ++r) { const int orow = crow(r, hi);
#pragma unroll
        for (int d0 = 0; d0 < NB; ++d0) stg[orow * D + d0 * 32 + r32] = (bf16_t)f2bf(o[d0][r] * rli[r]); }
    LDS_WAIT();
    constexpr int CPR = D / 8, RPP = 64 / CPR;
    bf16_t* OB = (bf16_t*)(ws + (e.epi ? WS_Y : WS_OG));
    const bf16_t* GB = (const bf16_t*)(ws + WS_QKV);
#pragma unroll
    for (int i = 0; i < 32 / RPP; ++i) {
        const int row = i * RPP + lane / CPR, ch = lane % CPR;
        const u32x4 v = *(const LAS u32x4*)(stg + row * D + ch * 8);
        const size_t fidx = (size_t)(qrow_w + row);
        if (e.epi == 1) {
            const u32x4 g = *(const u32x4*)(GB + (size_t)e.goff + fidx * e.gs + ch * 8);
            u32x4 w;
            w.x = cvt_pk_bf16(bflo(v.x) * bflo(g.x), bfhi(v.x) * bfhi(g.x)); w.y = cvt_pk_bf16(bflo(v.y) * bflo(g.y), bfhi(v.y) * bfhi(g.y));
            w.z = cvt_pk_bf16(bflo(v.z) * bflo(g.z), bfhi(v.z) * bfhi(g.z)); w.w = cvt_pk_bf16(bflo(v.w) * bflo(g.w), bfhi(v.w) * bfhi(g.w));
            *(u32x4*)(OB + (size_t)e.ooff + fidx * e.os + ch * 8) = w;
        } else {
            *(u32x4*)(OB + (size_t)e.ooff + fidx * e.os + ch * 8) = v;
        }
    }
    if (e.epi == 0 && hi == 0) ((float*)(ws + WS_LSE))[(size_t)e.lseoff + (size_t)(qrow_w + r32) * e.lses] = l_reg > 0.f ? m_reg * SCALE + __logf(l_reg) : -1e30f;
    LDS_WAIT();
}

#define XB_TMO      128
#define XB_XCNT(j)  (256  + 64 * (j))
#define XB_XSUB(j)  (1280 + 64 * (j))
#define XB_XGEN(j)  (2304 + 64 * (j))
#define XB_TOP      3328
#define XB_TOPGEN   3392
#define XCD_BAR_WORDS 3456
#define XB_SPIN_CAP (1u << 18)
__device__ __forceinline__ unsigned xb_ld(unsigned* p)              { return __hip_atomic_load(p, __ATOMIC_RELAXED, __HIP_MEMORY_SCOPE_AGENT); }
__device__ __forceinline__ unsigned xb_add(unsigned* p, unsigned v) { return __hip_atomic_fetch_add(p, v, __ATOMIC_RELAXED, __HIP_MEMORY_SCOPE_AGENT); }
__device__ __forceinline__ unsigned xb_xcc_id() { return (unsigned)__builtin_amdgcn_s_getreg((3 << 11) | 20) & 0xFu; }
#define XB_SPIN(cond, bar) do { unsigned _sp = 0; while (cond) { __builtin_amdgcn_s_sleep(1); \
    if ((++_sp & 255u) == 0u) { if (xb_ld(&(bar)[XB_TMO])) break; if (_sp > XB_SPIN_CAP) { atomicAdd(&(bar)[XB_TMO], 1u); break; } } } } while (0)
struct XcdBarrier { unsigned* bar; unsigned x; volatile LAS unsigned* st; };
__device__ __forceinline__ XcdBarrier xcd_barrier_post(unsigned* bar, volatile LAS unsigned* st) {
    XcdBarrier b; b.bar = bar; b.x = xb_xcc_id(); b.st = st;
    if (threadIdx.x == 0) (void)xb_add(&bar[XB_XCNT(b.x)], 1u);
    return b;
}
__device__ __forceinline__ void xcd_barrier_complete(unsigned* bar, unsigned x, unsigned& nloc, unsigned& nx) {
    const unsigned G = gridDim.x * gridDim.y * gridDim.z;
    unsigned sum, cnt, mine, sp = 0u;
    for (;;) {
        sum = 0u; cnt = 0u; mine = 0u;
#pragma unroll
        for (unsigned j = 0; j < 16; ++j) { const unsigned c = xb_ld(&bar[XB_XCNT(j)]); sum += c; cnt += (c > 0u) ? 1u : 0u; mine = (j == x) ? c : mine; }
        if (sum == G) break;
        __builtin_amdgcn_s_sleep(1);
        if ((++sp & 255u) == 0u) { if (xb_ld(&bar[XB_TMO])) break; if (sp > XB_SPIN_CAP) { atomicAdd(&bar[XB_TMO], 1u); break; } }
    }
    nloc = mine > 0u ? mine : 1u; nx = cnt > 0u ? cnt : 1u;
}
__device__ __forceinline__ void xcd_barrier(const XcdBarrier& b) {
    asm volatile("s_waitcnt vmcnt(0)" ::: "memory");
    __syncthreads();
    if (threadIdx.x == 0) {
        unsigned* bar = b.bar;
        __builtin_amdgcn_s_waitcnt(0);
        unsigned nloc = b.st[0], nx = b.st[1];
        if (nloc == 0u) { xcd_barrier_complete(bar, b.x, nloc, nx); b.st[0] = nloc; b.st[1] = nx; }
        const unsigned old = xb_add(&bar[XB_XSUB(b.x)], 1u);
        const unsigned gen = old / nloc;
        if (old + 1u == (gen + 1u) * nloc) {
            __builtin_amdgcn_fence(__ATOMIC_RELEASE, "agent");
            asm volatile("s_waitcnt vmcnt(0)" ::: "memory");
            const unsigned og = xb_add(&bar[XB_TOP], 1u);
            const unsigned tg = og / nx;
            if (og + 1u == (tg + 1u) * nx) xb_add(&bar[XB_TOPGEN], 1u);
            else XB_SPIN(xb_ld(&bar[XB_TOPGEN]) == tg, bar);
            __builtin_amdgcn_fence(__ATOMIC_ACQUIRE, "agent");
            xb_add(&bar[XB_XGEN(b.x)], 1u);
            asm volatile("s_waitcnt vmcnt(0)" ::: "memory");
        } else {
            XB_SPIN(xb_ld(&bar[XB_XGEN(b.x)]) == gen, bar);
            __builtin_amdgcn_fence(__ATOMIC_ACQUIRE, "agent");
            asm volatile("s_waitcnt vmcnt(0)" ::: "memory");
        }
    }
    __syncthreads();
}

__device__ __forceinline__ float wave_sum(float v) {
#pragma unroll
    for (int o = 1; o < 64; o <<= 1) v += __shfl_xor(v, o);
    return v;
}
__device__ __forceinline__ int phys_even(int n) {
    if (n >= 4608) return n;
    const int seg = n / 768; if (seg == 2 || seg == 5) return n;
    const int i = n & 127, hb = n - i, ii = i & 63, g = ii >> 2, e = (ii & 3) + ((i >> 6) << 2);
    return hb + 8 * g + e;
}
__device__ __forceinline__ int phys_odd(int n) {
    if (n < 1728) { const int i = n & 63, hb = n - i, ii = i & 31, g = ii >> 2, e = (ii & 3) + ((i >> 5) << 2); return hb + 8 * g + e; }
    if (n < 1920) return n + 64;
    return n + 128;
}
__device__ __forceinline__ void convert_item(const float* W, int N, const float* gk, bf16_t* WT, int mapkind, int rowoff, int item, int lane) {
    const int nblk = N / 64, kb = item / nblk, nb = item % nblk, k0 = 64 * kb, n = 64 * nb + lane;
    const int p = (mapkind == 1 ? phys_even(n) : (mapkind == 2 ? phys_odd(n) : n)) + rowoff;
    const float* src = W + (size_t)k0 * N + n;
    bf16_t* dst = WT + (size_t)p * KDIM + k0;
    float v[64];
#pragma unroll
    for (int j = 0; j < 64; ++j) v[j] = src[(size_t)j * N];
    if (gk) {
#pragma unroll
        for (int j = 0; j < 64; ++j) v[j] *= gk[k0 + j];
    }
#pragma unroll
    for (int kk = 0; kk < 8; ++kk) { u32x4 o; o.x = pk2(v[8 * kk], v[8 * kk + 1]); o.y = pk2(v[8 * kk + 2], v[8 * kk + 3]); o.z = pk2(v[8 * kk + 4], v[8 * kk + 5]); o.w = pk2(v[8 * kk + 6], v[8 * kk + 7]);
        *(u32x4*)(dst + 8 * kk) = o; }
}

struct Args {
    const float* x; const float* mem; const int* pos;
    const float* even_norm; const float* even_w_in; const float* even_w_mkv; const float* even_w_out;
    const float* odd_norm; const float* odd_w_in; const float* odd_w_mkv; const float* odd_w_out; const float* odd_sinks;
    const float* mem_norm; const float* final_norm;
    float* out; unsigned char* ws;
    int ph_lo, ph_hi;
};
constexpr int N_PHASES = 18;

constexpr int NUNITS_EVEN = 1088, NUNITS_ODD = 512;
__device__ __forceinline__ bool unit_d64(int idx, int l) { return (l & 1) && idx >= 128; }
__device__ __forceinline__ void decode_kv(int idx, int l, KVD& d) {
    d.kvsel = 0; d.kd1 = 0; d.ksub = 64; d.koff1 = 32;
    if (!(l & 1)) {
        if (idx < 384) { const int n = 7 - idx / 48, rem = idx % 48, s = rem / 24, bh = rem % 24, b = bh / 6, h = bh % 6; const int tb = b * SEQ * EVEN_N;
            d.koff = tb + 3072 + h * 128; d.voff = tb + 3840 + h * 128; d.ks = EVEN_N; d.L = SEQ; d.kt0 = 128 * (n + 1) * s; d.nst = 2 * (n + 1);
        } else if (idx < 768) { const int i = idx - 384, pat = i / 192, j = i % 192, bh = j % 24, rr = j / 24, b = bh / 6, h = bh % 6;
            const int dil = pat ? 4 : 1, res = pat ? (rr & 3) : 0, kblk = pat ? (rr >> 2) : rr; const int tb = (b * SEQ + res) * EVEN_N;
            d.koff = tb + 768 + h * 128; d.voff = tb + 1536 + h * 128; d.ks = dil * EVEN_N; d.L = SEQ / dil; d.kt0 = (256 * kblk - 128) < 0 ? 0 : (256 * kblk - 128); d.nst = (256 * kblk + 256 - d.kt0) / 64;
        } else if (idx < 896) { const int i = idx - 768, b = i / 32, hm = (i / 8) % 4;
            d.kvsel = 1; d.koff = b * MEML * 4096 + l * 1024 + hm * 128; d.voff = d.koff + 512; d.ks = 4096; d.L = MEML; d.kt0 = 0; d.nst = 4;
        } else { const int i = idx - 896, bh = i % 24, u8 = i / 24, b = bh / 6, h = bh % 6; const int tp = (b * SEQ + 2 * u8) * EVEN_N;
            d.koff = tp + 768 + h * 128; d.voff = tp + 1536 + h * 128; d.kd1 = EVEN_N; d.ks = 16 * EVEN_N; d.L = 128; d.kt0 = 0; d.nst = 4; d.ksub = 32; d.koff1 = 0;
        }
    } else {
        if (idx < 128) { const int i = idx, b = i / 32, hm = (i / 8) % 4;
            d.kvsel = 1; d.koff = b * MEML * 4096 + l * 1024 + hm * 128; d.voff = d.koff + 512; d.ks = 4096; d.L = MEML; d.kt0 = 0; d.nst = 4;
        } else { const int i = idx - 128, b = i / 96, g = (i / 32) % 3, pblk = i % 32; const int tb = b * SEQ * ODD_NP;
            d.koff = tb + 1536 + g * 64; d.voff = tb + 1792 + g * 64; d.ks = ODD_NP; d.L = SEQ; d.kt0 = (64 * pblk - 128) < 0 ? 0 : (64 * pblk - 128); d.nst = (64 * pblk + 64 - d.kt0) / 64;
        }
    }
}
__device__ __forceinline__ void decode_q(int idx, int l, int wave, AU& u) {
    u.moba_n = -1; u.band = 1 << 28; u.causal = 1; u.pair = 0; u.whalf = 0; u.kmoff = 0; u.tbase = 0;
    if (!(l & 1)) {
        if (idx < 384) { const int n = 7 - idx / 48, rem = idx % 48, s = rem / 24, bh = rem % 24, b = bh / 6, h = bh % 6;
            u.qoff = b * SEQ * EVEN_N + 2304 + h * 128; u.qs = EVEN_N; u.qrow_w = 256 * n + 32 * wave; u.moba_n = n; u.tbase = 2 * (n + 1) * s;
            u.kmoff = (l >> 1) * (4 * 6 * 8 * 128) + ((b * 6 + h) * 8) * 128;
        } else if (idx < 768) { const int i = idx - 384, pat = i / 192, j = i % 192, bh = j % 24, rr = j / 24, b = bh / 6, h = bh % 6;
            const int dil = pat ? 4 : 1, res = pat ? (rr & 3) : 0, kblk = pat ? (rr >> 2) : rr;
            u.qoff = (b * SEQ + res) * EVEN_N + h * 128; u.qs = dil * EVEN_N; u.qrow_w = 256 * kblk + 32 * wave; u.band = 128;
        } else if (idx < 896) { const int i = idx - 768, b = i / 32, hm = (i / 8) % 4, blk = i % 8;
            u.qoff = b * SEQ * EVEN_N + 4608 + hm * 128; u.qs = EVEN_N; u.qrow_w = 256 * blk + 32 * wave; u.causal = 0;
        } else { const int i = idx - 896, bh = i % 24, u8 = i / 24, b = bh / 6, h = bh % 6; const int wh = wave >> 2;
            u.qoff = (b * SEQ + 2 * u8 + wh) * EVEN_N + h * 128; u.qs = 16 * EVEN_N; u.qrow_w = 32 * (wave & 3); u.pair = 1; u.whalf = wh; u.band = 128;
        }
    } else {
        if (idx < 128) { const int i = idx, b = i / 32, hm = (i / 8) % 4, blk = i % 8;
            u.qoff = b * SEQ * ODD_NP + 2048 + hm * 128; u.qs = ODD_NP; u.qrow_w = 256 * blk + 32 * wave; u.causal = 0;
        } else { const int i = idx - 128, b = i / 96, g = (i / 32) % 3, pblk = i % 32, hq = 8 * g + wave;
            u.qoff = b * SEQ * ODD_NP + hq * 64; u.qs = ODD_NP; u.qrow_w = 64 * pblk; u.band = 127;
        }
    }
}
__device__ __forceinline__ void decode_epi(int idx, int l, int wave, const float* sinks, AE& e) {
    e.has_sink = 0; e.sink = 0.f; e.lseoff = 0; e.lses = 0; e.goff = 0; e.gs = 0;
    if (!(l & 1)) {
        if (idx < 384) { const int rem = idx % 48, s = rem / 24, bh = rem % 24, b = bh / 6, h = bh % 6; const int tok0 = b * SEQ;
            e.epi = 0; e.ooff = (3 + s) * NTOK * 768 + tok0 * 768 + h * 128; e.os = 768; e.lseoff = (3 + s) * NTOK * 6 + tok0 * 6 + h; e.lses = 6;
        } else if (idx < 768) { const int i = idx - 384, pat = i / 192, j = i % 192, bh = j % 24, rr = j / 24, b = bh / 6, h = bh % 6;
            const int dil = pat ? 4 : 1, res = pat ? (rr & 3) : 0; const int tok0 = b * SEQ + res;
            e.epi = 0; e.ooff = pat * NTOK * 768 + tok0 * 768 + h * 128; e.os = dil * 768; e.lseoff = pat * NTOK * 6 + tok0 * 6 + h; e.lses = dil * 6;
        } else if (idx < 896) { const int i = idx - 768, b = i / 32, hm = (i / 8) % 4;
            e.epi = 1; e.ooff = b * SEQ * DM + 1536 + hm * 128; e.os = DM; e.goff = b * SEQ * EVEN_N + 5120 + 1536 + hm * 128; e.gs = EVEN_N;
        } else { const int i = idx - 896, bh = i % 24, u8 = i / 24, b = bh / 6, h = bh % 6; const int tokw = b * SEQ + 2 * u8 + (wave >> 2);
            e.epi = 0; e.ooff = 2 * NTOK * 768 + tokw * 768 + h * 128; e.os = 16 * 768; e.lseoff = 2 * NTOK * 6 + tokw * 6 + h; e.lses = 16 * 6;
        }
    } else {
        if (idx < 128) { const int i = idx, b = i / 32, hm = (i / 8) % 4;
            e.epi = 1; e.ooff = b * SEQ * DM + 1536 + hm * 128; e.os = DM; e.goff = b * SEQ * ODD_NP + 2560 + 1536 + hm * 128; e.gs = ODD_NP;
        } else { const int i = idx - 128, b = i / 96, g = (i / 32) % 3, hq = 8 * g + wave;
            e.epi = 1; e.ooff = b * SEQ * DM + hq * 64; e.os = DM; e.goff = b * SEQ * ODD_NP + 2560 + hq * 64; e.gs = ODD_NP;
            e.has_sink = 1; e.sink = sinks[(l >> 1) * 24 + hq];
        }
    }
}


constexpr int I_E = 32 * (EVEN_N / 64), I_O = 32 * (ODD_N / 64), I_W = 32 * (DM / 64), I_M = 32 * (1024 / 64);
constexpr int CV_A = I_E + 4 * I_M + I_W, CV_B = CV_A + I_O, CV_C = CV_B + I_E + I_W, CV_D = CV_C + I_O + 2 * I_W;
typedef __attribute__((address_space(4))) const Args* KArgsC;
__device__ __forceinline__ void convert_stage(KArgsC ka, unsigned char* ws, int lo, int hi, int worker, int nworkers, int lane) {
    for (int it = lo + worker; it < hi; it += nworkers) {
        int r = it;
        if (r < I_E) { convert_item(ka->even_w_in, EVEN_N, ka->even_norm, (bf16_t*)(ws + WS_WIN_E0), 1, 0, r, lane); continue; } r -= I_E;
        if (r < 4 * I_M) { const int l = r / I_M; r -= l * I_M; const float* W = ((l & 1) ? ka->odd_w_mkv : ka->even_w_mkv) + (size_t)(l >> 1) * DM * 1024;
            convert_item(W, 1024, nullptr, (bf16_t*)(ws + WS_WMKV), 0, l * 1024, r, lane); continue; } r -= 4 * I_M;
        if (r < I_W) { convert_item(ka->even_w_out, DM, nullptr, (bf16_t*)(ws + WS_WOUT), 0, 0, r, lane); continue; } r -= I_W;
        if (r < I_O) { convert_item(ka->odd_w_in, ODD_N, ka->odd_norm, (bf16_t*)(ws + WS_WIN_O0), 2, 0, r, lane); continue; } r -= I_O;
        if (r < I_E) { convert_item(ka->even_w_in + (size_t)DM * EVEN_N, EVEN_N, ka->even_norm + DM, (bf16_t*)(ws + WS_WIN_E1), 1, 0, r, lane); continue; } r -= I_E;
        if (r < I_W) { convert_item(ka->odd_w_out, DM, nullptr, (bf16_t*)(ws + WS_WOUT + (size_t)1 * 8 * MiB), 0, 0, r, lane); continue; } r -= I_W;
        if (r < I_O) { convert_item(ka->odd_w_in + (size_t)DM * ODD_N, ODD_N, ka->odd_norm + DM, (bf16_t*)(ws + WS_WIN_O1), 2, 0, r, lane); continue; } r -= I_O;
        { const int l = 2 + r / I_W; r -= (l - 2) * I_W; const float* W = ((l & 1) ? ka->odd_w_out : ka->even_w_out) + (size_t)(l >> 1) * DM * DM;
          convert_item(W, DM, nullptr, (bf16_t*)(ws + WS_WOUT + (size_t)l * 8 * MiB), 0, 0, r, lane); }
    }
}

}

typedef __attribute__((address_space(4))) const Args* KArgs;
#define LAUNDER_S(p) asm volatile("" : "+s"(p))

__global__ void __launch_bounds__(NWAVES * 64, 2) fwd_kernel(Args args_unused) {
    extern __shared__ __attribute__((aligned(16))) unsigned char lds_raw[];
    LAS unsigned char* lds = (LAS unsigned char*)lds_raw;
    volatile LAS unsigned* MISC = (volatile LAS unsigned*)(lds + MISC_OFF);
    const int tid0 = threadIdx.x;
    const int G = gridDim.x; const int bx = blockIdx.x; const int vcu = (G % 8 == 0) ? (bx % 8) * (G / 8) + bx / 8 : bx;
    const KArgs ka0 = (KArgs)__builtin_amdgcn_kernarg_segment_ptr();
    for (int i = tid0; i < (LDS_BYTES - LDSCTL_OFF) / 4; i += NWAVES * 64) ((LAS unsigned*)(lds + LDSCTL_OFF))[i] = 0u;
    __syncthreads();
    XcdBarrier bar; { unsigned char* ws0 = ka0->ws; bar.bar = (unsigned*)(ws0 + WS_CTL) + CW_BAR; bar.x = 0; bar.st = nullptr;
        if (!MK_PER_PHASE) bar = xcd_barrier_post((unsigned*)(ws0 + WS_CTL) + CW_BAR, MISC + 8); }
    const int ph_lo = ka0->ph_lo, ph_hi = ka0->ph_hi;

    unsigned long long tp_acc = 0ull;
    for (int ph = ph_lo; ph < ph_hi; ++ph) {
        unsigned long long tp_t0 = 0ull; if (TPROBE_MASK) tp_t0 = __builtin_amdgcn_s_memrealtime();
        int tid = tid0; asm volatile("" : "+v"(tid));
        const int lane = tid & 63, wave = __builtin_amdgcn_readfirstlane(tid >> 6);
        KArgs ka = ka0; LAUNDER_S(ka);
        unsigned char* ws = ka->ws;
        if (ph == 0 && (AN_MASK & 1)) {
            const int gw = vcu * NWAVES + wave, NGW = G * NWAVES;
            convert_stage(ka, ws, 0, CV_A, gw, NGW, lane);
            bf16_t* XB = (bf16_t*)(ws + WS_XB); bf16_t* MEMN = (bf16_t*)(ws + WS_MEMN); float* SSQ = (float*)(ws + WS_SSQ);
            const float* xin = ka->x; const float* memin = ka->mem; const float* mnorm = ka->mem_norm;
            for (int m = gw; m < NTOK + NMEM; m += NGW) {
                const bool isx = m < NTOK; const int row = isx ? m : m - NTOK;
                const f32x4* xr = (const f32x4*)((isx ? xin : memin) + (size_t)row * DM) + lane;
                f32x4 v[8]; float s = 0.f;
#pragma unroll
                for (int j = 0; j < 8; ++j) { v[j] = xr[64 * j]; s += (v[j].x * v[j].x + v[j].y * v[j].y) + (v[j].z * v[j].z + v[j].w * v[j].w); }
                s = wave_sum(s);
                unsigned long long* o8 = (unsigned long long*)((isx ? XB : MEMN) + (size_t)row * DM) + lane;
                if (isx) {
                    if (lane < 8) SSQ[(size_t)lane * NTOK + row] = lane == 0 ? s : 0.f;
#pragma unroll
                    for (int j = 0; j < 8; ++j) o8[64 * j] = (unsigned long long)pk2(v[j].x, v[j].y) | ((unsigned long long)pk2(v[j].z, v[j].w) << 32);
                } else {
                    const float rs = 1.0f / sqrtf(s * (1.0f / DM) + EPS);
                    const f32x4* gr = (const f32x4*)mnorm + lane;
#pragma unroll
                    for (int j = 0; j < 8; ++j) { const f32x4 g = gr[64 * j]; o8[64 * j] = (unsigned long long)pk2(v[j].x * rs * g.x, v[j].y * rs * g.y) | ((unsigned long long)pk2(v[j].z * rs * g.z, v[j].w * rs * g.w) << 32); }
                }
            }
            float* CS128 = (float*)(ws + WS_CS128); float* CS64 = (float*)(ws + WS_CS64); const int* posp = ka->pos;
            for (int tk = gw; tk < NTOK; tk += NGW) {
                const float pf = (float)posp[tk];
                { const float inv = expf((float)lane * (float)(-2.0 * 9.210340371976184 / 128.0)); const float ang = pf * inv;
                  const double rev = (double)ang * 0.15915494309189535; const float fr = (float)(rev - rint(rev));
                  CS128[(size_t)tk * 128 + lane] = __builtin_amdgcn_cosf(fr); CS128[(size_t)tk * 128 + 64 + lane] = __builtin_amdgcn_sinf(fr); }
                if (lane < 32) { const float inv = expf((float)lane * (float)(-2.0 * 9.210340371976184 / 64.0)); const float ang = pf * inv;
                  const double rev = (double)ang * 0.15915494309189535; const float fr = (float)(rev - rint(rev));
                  CS64[(size_t)tk * 64 + lane] = __builtin_amdgcn_cosf(fr); CS64[(size_t)tk * 64 + 32 + lane] = __builtin_amdgcn_sinf(fr); }
            }
        } else if (ph == 17 && (AN_MASK & 2) && G != 256) {
            const int gw = vcu * NWAVES + wave, NGW = G * NWAVES;
            const float* ssq = (const float*)(ws + WS_SSQ) + (size_t)4 * 8 * NTOK; float* outp = ka->out; const float* fnorm = ka->final_norm;
            for (int m = gw; m < NTOK; m += NGW) {
                float sq = 0.f;
#pragma unroll
                for (int j = 0; j < 8; ++j) sq += ssq[(size_t)j * NTOK + m];
                const float rs = 1.0f / sqrtf(sq * (1.0f / DM) + EPS);
                f32x4* xr = (f32x4*)(outp + (size_t)m * DM) + lane; const f32x4* gr = (const f32x4*)fnorm + lane;
#pragma unroll
                for (int j = 0; j < 8; ++j) { f32x4 v = xr[64 * j]; const f32x4 g = gr[64 * j]; v = v * rs * g; xr[64 * j] = v; }
            }
        } else if (ph >= 1 && ph <= 16) {
            const int l = (ph - 1) >> 2, sub = (ph - 1) & 3, odd = l & 1, li = l >> 1;
            if ((sub == 0 && (AN_MASK & 4)) || (sub == 3 && (AN_MASK & 8))) {
                GemmP P; P.ws = ws; P.l = l; P.xin = ka->x; P.out = ka->out; P.lds = lds; P.fnorm = ka->final_norm; P.fuse_final = (G == 256) ? 1 : 0;
                Order S; S.G = G; S.c = bx; S.nM0 = NTOK / 256;
                if (sub == 0) { P.mode = EM_INPROJ; P.A = (const bf16_t*)(ws + WS_XB); P.Bt = (const bf16_t*)(ws + (odd ? (li ? WS_WIN_O1 : WS_WIN_O0) : (li ? WS_WIN_E1 : WS_WIN_E0)));
                    S.nN0 = (odd ? ODD_NP : EVEN_N) / 256; S.nwg1 = (l == 0) ? 64 : 0; }
                else { P.mode = EM_OUTPROJ; P.A = (const bf16_t*)(ws + WS_Y); P.Bt = (const bf16_t*)(ws + WS_WOUT + (size_t)l * 8 * MiB); S.nN0 = DM / 256; S.nwg1 = 0; }
                S.nwg0 = S.nM0 * S.nN0;
                gemm_phase(lds, P, S, tid);
                if (sub == 0 && l < 3) {
                    const int nwg = S.nwg0 + S.nwg1, TT = nwg % G, lo = l == 0 ? CV_A : (l == 1 ? CV_B : CV_C), hi = l == 0 ? CV_B : (l == 1 ? CV_C : CV_D);
                    if (TT == 0) convert_stage(ka, ws, lo, hi, bx * NWAVES + wave, G * NWAVES, lane);
                    else if (bx >= TT) convert_stage(ka, ws, lo, hi, (bx - TT) * NWAVES + wave, (G - TT) * NWAVES, lane);
                }
            } else if (sub == 2 && (AN_MASK & 16)) {
                if (!odd) {
                    const float* LSE = (const float*)(ws + WS_LSE); const bf16_t* OG = (const bf16_t*)(ws + WS_OG); const bf16_t* QKV = (const bf16_t*)(ws + WS_QKV); bf16_t* Y = (bf16_t*)(ws + WS_Y);
                    const long NIT = (long)NTOK * 192;
                    for (long it = (long)bx * 512 + tid; it < NIT; it += (long)G * 512) {
                        const int tok = (int)(it / 192), c = (int)(it % 192), isb = c >= 96, cc8 = (isb ? c - 96 : c), h = cc8 >> 4;
                        const int g0 = isb ? 3 : 0;
                        const size_t lb = (size_t)tok * 6 + h, ob = (size_t)tok * 768 + cc8 * 8;
                        const float l0 = LSE[(size_t)g0 * NTOK * 6 + lb], l1 = LSE[(size_t)(g0 + 1) * NTOK * 6 + lb], l2 = isb ? -1e30f : LSE[(size_t)2 * NTOK * 6 + lb];
                        const float mx = fmaxf(l0, fmaxf(l1, l2));
                        float w0 = __expf(l0 - mx), w1 = __expf(l1 - mx), w2 = isb ? 0.f : __expf(l2 - mx); const float inv = 1.0f / (w0 + w1 + w2); w0 *= inv; w1 *= inv; w2 *= inv;
                        const u32x4 a = *(const u32x4*)(OG + (size_t)g0 * NTOK * 768 + ob), b = *(const u32x4*)(OG + (size_t)(g0 + 1) * NTOK * 768 + ob);
                        u32x4 cc = {0u, 0u, 0u, 0u}; if (!isb) cc = *(const u32x4*)(OG + (size_t)2 * NTOK * 768 + ob);
                        const u32x4 g = *(const u32x4*)(QKV + (size_t)tok * EVEN_N + 5120 + c * 8);
                        u32x4 o;
#define CMB(f) cvt_pk_bf16((w0 * bflo(a.f) + w1 * bflo(b.f) + w2 * bflo(cc.f)) * bflo(g.f), (w0 * bfhi(a.f) + w1 * bfhi(b.f) + w2 * bfhi(cc.f)) * bfhi(g.f))
                        o.x = CMB(x); o.y = CMB(y); o.z = CMB(z); o.w = CMB(w);
#undef CMB
                        *(u32x4*)(Y + (size_t)tok * DM + c * 8) = o;
                    }
                }
            } else if (sub == 1 && (AN_MASK & 32)) {
                gu32* qctr = (gu32*)(ws + WS_CTL) + CW_Q + 64 * l;
                const int NUNITS = odd ? NUNITS_ODD : NUNITS_EVEN;
                int idx = bx, idx1 = G + bx;
                int it = 0, pb = 0; bool warm = false;
                while (idx < NUNITS) {
                    idx = __builtin_amdgcn_readfirstlane(idx); idx1 = __builtin_amdgcn_readfirstlane(idx1);
                    int tid_u = tid; asm volatile("" : "+v"(tid_u)); const int lane_u = tid_u & 63;
                    unsigned nx2 = 0; if (tid == 0) nx2 = 2u * (unsigned)G + __hip_atomic_fetch_add(qctr, 1u, RLX_AGENT);
                    const bool d64 = unit_d64(idx, l);
                    const int pre = (idx1 < NUNITS && unit_d64(idx1, l) == d64) ? 1 : 0;
                    KVD d, dn; decode_kv(idx, l, d); decode_kv(pre ? idx1 : idx, l, dn);
                    AU u; decode_q(idx, l, wave, u);
                    float m_reg, l_reg;
                    if (d64) { if (!warm) cold_start<64>(d, ws, lds + pb * ABUF, wave, lane_u);
                        f32x16 oA[2], oB[2]; float m2[2], l2[2];
                        attn_c_main(u, d, dn, pre, pb, ws, lds, wave, lane_u, m2, l2, oA, oB);
                        int idx2 = idx; LAUNDER_S(idx2); AE e; decode_epi(idx2, l, wave, ka->odd_sinks, e);
                        attn_epi<64>(e, u.qrow_w, pb ^ 1, ws, lds, wave, lane_u, m2[0], l2[0], oA);
                        attn_epi<64>(e, u.qrow_w + 32, pb ^ 1, ws, lds, wave, lane_u, m2[1], l2[1], oB); }
                    else { if (!warm) cold_start<128>(d, ws, lds + pb * ABUF, wave, lane_u);
                        f32x16 o[4]; attn_main<128>(u, d, dn, pre, pb, ws, lds, tid_u, wave, lane_u, m_reg, l_reg, o);
                        int idx2 = idx; LAUNDER_S(idx2); AE e; decode_epi(idx2, l, wave, ka->odd_sinks, e); attn_epi<128>(e, u.qrow_w, pb ^ 1, ws, lds, wave, lane_u, m_reg, l_reg, o); }
                    warm = pre != 0;
                    if (tid == 0) MISC[18 + (it & 1)] = nx2;
                    __syncthreads();
                    idx = idx1; idx1 = (int)MISC[18 + (it & 1)]; ++it;
                }
            }
        }
        if (ph + 1 < ph_hi && !(ph == 16 && G == 256)) { if (!(ph >= 1 && ph <= 16 && ((ph - 1) & 3) == 2 && (((ph - 1) >> 2) & 1))) xcd_barrier(bar); }
        if (TPROBE_MASK) { if ((TPROBE_MASK >> ph) & 1) tp_acc += __builtin_amdgcn_s_memrealtime() - tp_t0; }
    }
    if (TPROBE_MASK) { if (bx == 0) { const unsigned long long te = __builtin_amdgcn_s_memrealtime(); while (__builtin_amdgcn_s_memrealtime() - te < 4ull * tp_acc) __builtin_amdgcn_s_sleep(8); } }
}

extern "C" void kernel_launch(void* const* d_in, const int* in_sizes, int n_in, void* d_out, int out_size, void* d_ws, size_t ws_size, hipStream_t stream) {
    static int grid = 0;
    if (grid == 0) {
        if (n_in != 14 || in_sizes[0] != NTOK * DM || out_size != NTOK * DM || ws_size < WS_END) { fprintf(stderr, "kernel_launch: unexpected shapes (n_in %d, in0 %d, out %d, ws %zu)\n", n_in, n_in > 0 ? in_sizes[0] : -1, out_size, ws_size); grid = -1; return; }
        int dev = 0, cus = 0, per_cu = 0;
        if (hipGetDevice(&dev) != hipSuccess || hipDeviceGetAttribute(&cus, hipDeviceAttributeMultiprocessorCount, dev) != hipSuccess) { grid = -1; return; }
        if (hipFuncSetAttribute((const void*)fwd_kernel, hipFuncAttributeMaxDynamicSharedMemorySize, LDS_BYTES) != hipSuccess) { fprintf(stderr, "kernel_launch: hipFuncSetAttribute failed\n"); grid = -1; return; }
        if (hipOccupancyMaxActiveBlocksPerMultiprocessor(&per_cu, (const void*)fwd_kernel, NWAVES * 64, LDS_BYTES) != hipSuccess || per_cu < 1) { fprintf(stderr, "kernel_launch: occupancy query says %d blocks/CU\n", per_cu); }
        (void)hipGetLastError();
        grid = cus;
    }
    if (grid < 0) return;
    (void)hipMemsetAsync((char*)d_ws + WS_CTL, 0, CTL_ZERO_BYTES, stream);
    Args a{};
    a.x = (const float*)d_in[0]; a.mem = (const float*)d_in[1]; a.pos = (const int*)d_in[2];
    a.even_norm = (const float*)d_in[3]; a.even_w_in = (const float*)d_in[4]; a.even_w_mkv = (const float*)d_in[5]; a.even_w_out = (const float*)d_in[6];
    a.odd_norm = (const float*)d_in[7]; a.odd_w_in = (const float*)d_in[8]; a.odd_w_mkv = (const float*)d_in[9]; a.odd_w_out = (const float*)d_in[10]; a.odd_sinks = (const float*)d_in[11];
    a.mem_norm = (const float*)d_in[12]; a.final_norm = (const float*)d_in[13];
    a.out = (float*)d_out; a.ws = (unsigned char*)d_ws;
#if MK_PER_PHASE
    for (int ph = 0; ph < N_PHASES; ++ph) { a.ph_lo = ph; a.ph_hi = ph + 1; hipLaunchKernelGGL(fwd_kernel, dim3(grid), dim3(NWAVES * 64), LDS_BYTES, stream, a); }
#else
    a.ph_lo = 0; a.ph_hi = N_PHASES;
    hipLaunchKernelGGL(fwd_kernel, dim3(grid), dim3(NWAVES * 64), LDS_BYTES, stream, a);
#ifdef PROBE_PHASES
    {
        const int pp[] = PROBE_PHASES;
        (void)hipMemsetAsync((char*)d_ws + WS_CTL + (size_t)CW_Q * 4, 0, 64 * 8 * 4, stream);
        for (unsigned i = 0; i < sizeof(pp) / sizeof(pp[0]); ++i) { a.ph_lo = pp[i]; a.ph_hi = pp[i] + 1; hipLaunchKernelGGL(fwd_kernel, dim3(grid), dim3(NWAVES * 64), LDS_BYTES, stream, a); }
    }
#endif
#endif
    const hipError_t le = hipPeekAtLastError();
    if (le != hipSuccess) fprintf(stderr, "kernel_launch: launch failed: %s\n", hipGetErrorName(le));
}
```

```cpp
#include <hip/hip_runtime.h>
#include <cstdio>
#include <cstdint>

#ifndef TPROBE_MASK
#define TPROBE_MASK 0
#endif
#ifndef AN_MASK
#define AN_MASK 63
#endif
#ifndef MK_PER_PHASE
#define MK_PER_PHASE 0
#endif

namespace {
#define LAS __attribute__((address_space(3)))
#define GAS __attribute__((address_space(1)))
typedef unsigned short bf16_t;
typedef short bf16x8 __attribute__((ext_vector_type(8)));
typedef short s16x4 __attribute__((ext_vector_type(4)));
typedef float f32x4 __attribute__((ext_vector_type(4)));
typedef float f32x16 __attribute__((ext_vector_type(16)));
typedef unsigned u32x4 __attribute__((ext_vector_type(4)));
typedef GAS unsigned gu32;
#define RLX_AGENT __ATOMIC_RELAXED, __HIP_MEMORY_SCOPE_AGENT
#define LDS_WAIT() asm volatile("s_waitcnt lgkmcnt(0)" ::: "memory")
#define VM_WAIT() asm volatile("s_waitcnt vmcnt(0)" ::: "memory")
#define SBAR() __builtin_amdgcn_sched_barrier(0)

constexpr int BATCH = 4, SEQ = 2048, DM = 2048, NTOK = BATCH * SEQ, MEML = 256, NMEM = BATCH * MEML;
constexpr int EVEN_N = 7168, ODD_N = 4480, ODD_NP = 4608;
constexpr int KDIM = 2048;
constexpr float EPS = 1e-6f;
constexpr int NWAVES = 8;

constexpr size_t MiB = 1u << 20;
constexpr size_t WS_CTL = 0, CTL_ZERO_BYTES = 1 * MiB;
constexpr size_t WS_WIN_E0 = 1 * MiB, WS_WIN_E1 = 29 * MiB, WS_WIN_O0 = 57 * MiB, WS_WIN_O1 = 75 * MiB;
constexpr size_t WS_WOUT = 93 * MiB;
constexpr size_t WS_WMKV = 125 * MiB;
constexpr size_t WS_XB = 141 * MiB;
constexpr size_t WS_QKV = 173 * MiB;
constexpr size_t WS_Y = 285 * MiB;
constexpr size_t WS_OG = 374 * MiB;
constexpr size_t WS_LSE = 353 * MiB;
constexpr size_t WS_MKV = 354 * MiB;
constexpr size_t WS_MEMN = 362 * MiB;
constexpr size_t WS_CS128 = 366 * MiB;
constexpr size_t WS_CS64 = 370 * MiB;
constexpr size_t WS_SSQ = 372 * MiB;
constexpr size_t WS_END = 438 * MiB;
constexpr int CW_BAR = 4096;
constexpr int CW_SSQ = 16384;
constexpr int CW_KM = 65536;
constexpr int CW_Q = 131072;
constexpr int CW_PAN = 135168;
static_assert((CW_PAN + 64 * 32) * 4 <= (int)CTL_ZERO_BYTES, "ctl");

constexpr int RING_BYTES = 131072;
constexpr int LDSCTL_OFF = RING_BYTES, MISC_OFF = LDSCTL_OFF + 320;
constexpr int LDS_BYTES = 147456;
constexpr int XTBL_OFF = LDSCTL_OFF + 1024;

__device__ __forceinline__ unsigned f2bf(float f) { unsigned u = __builtin_bit_cast(unsigned, f); return (u + 0x7fffu + ((u >> 16) & 1u)) >> 16; }
typedef float f32x2_t __attribute__((ext_vector_type(2))); typedef __bf16 bf16x2_t __attribute__((ext_vector_type(2)));
__device__ __forceinline__ unsigned pk2(float lo, float hi) { f32x2_t v = {lo, hi}; bf16x2_t b = __builtin_convertvector(v, bf16x2_t); return __builtin_bit_cast(unsigned, b); }
__device__ __forceinline__ unsigned cvt_pk_bf16(float lo, float hi) { unsigned r; asm volatile("v_cvt_pk_bf16_f32 %0, %1, %2" : "=v"(r) : "v"(lo), "v"(hi)); return r; }
__device__ __forceinline__ float bflo(unsigned w) { return __builtin_bit_cast(float, w << 16); }
__device__ __forceinline__ float bfhi(unsigned w) { return __builtin_bit_cast(float, w & 0xffff0000u); }

constexpr int BM = 256, BK = 64, HALF = 128, HTB = HALF * BK * 2, NXCD = 8, WGM = 8;
__device__ __forceinline__ int lds_byte(int r, int c) { const int st = (r >> 4) * 2 + (c >> 5), rr = r & 15, cc = c & 31, ob = rr * 64 + cc * 2; return st * 1024 + (ob ^ (((ob >> 9) & 1) << 5)); }
__device__ __forceinline__ void stage_rc(int b, int& R, int& C) { const int st = b / 1024, sb = b % 1024, swz = sb ^ (((sb >> 9) & 1) << 5); R = (st >> 1) * 16 + swz / 64; C = (st & 1) * 32 + (swz % 64) / 2; }
__device__ __forceinline__ int perm32(int rho) { const int n = rho >> 4, i = rho & 15; return 8 * (i >> 2) + 4 * n + (i & 3); }

struct Unit { int pm, pn, s; };
enum { EM_PLAIN = 0, EM_INPROJ = 1, EM_OUTPROJ = 2 };
struct GemmP { const bf16_t* A; const bf16_t* Bt; int mode, l; unsigned char* ws; const float* xin; float* out; LAS unsigned char* lds; const float* fnorm; int fuse_final; };
__device__ __forceinline__ void tile_of(int wgid, int nM, int nN, int& pm, int& pn) {
    const int nwg = nM * nN; { const int q = nwg / NXCD, r = nwg % NXCD, xcd = wgid % NXCD, off = wgid / NXCD; wgid = (xcd < r ? xcd * (q + 1) : r * (q + 1) + (xcd - r) * q) + off; }
    const int nig = WGM * nN, gid = wgid / nig, fm = gid * WGM, gsz = (nM - fm) < WGM ? (nM - fm) : WGM;
    pm = fm + ((wgid % nig) % gsz); pn = (wgid % nig) / gsz;
}
struct Order {
    int nwg0, nwg1, nM0, nN0, G, c;
    __device__ __forceinline__ bool next(int i, Unit& u) const {
        const int L = i * G + c; if (L >= nwg0 + nwg1) return false;
        if (L < nwg0) { u.s = 0; tile_of(L, nM0, nN0, u.pm, u.pn); } else { u.s = 1; tile_of(L - nwg0, 4, 16, u.pm, u.pn); }
        return true;
    }
};

__device__ __forceinline__ void epi_run(const GemmP& P, const f32x4 (&acc)[2][2][4][2], const Unit& u, int wr, int wc, int fr, int fq) {
    const int row0 = u.pm * BM + wr * 64 + fr;
    const int colt = u.pn * BM + wc * 32 + 8 * fq;
    const int mode = u.s ? EM_PLAIN : P.mode;
    unsigned char* ws = P.ws;
    if (mode == EM_PLAIN) {
        bf16_t* O = (bf16_t*)(ws + WS_MKV);
#pragma unroll
        for (int ai = 0; ai < 2; ++ai)
#pragma unroll
            for (int m = 0; m < 4; ++m) { bf16_t* rowp = O + (size_t)(row0 + ai * HALF + m * 16) * 4096 + colt;
#pragma unroll
                for (int bj = 0; bj < 2; ++bj) { const f32x4 v0 = acc[ai][bj][m][0], v1 = acc[ai][bj][m][1];
                    u32x4 w; w.x = cvt_pk_bf16(v0[0], v0[1]); w.y = cvt_pk_bf16(v0[2], v0[3]); w.z = cvt_pk_bf16(v1[0], v1[1]); w.w = cvt_pk_bf16(v1[2], v1[3]);
                    *(u32x4*)(rowp + bj * HALF) = w; } }
    } else if (mode == EM_INPROJ) {
        const int l = P.l, odd = l & 1, ldo = odd ? ODD_NP : EVEN_N;
        bf16_t* O = (bf16_t*)(ws + WS_QKV);
        const float* cs128 = (const float*)(ws + WS_CS128); const float* cs64 = (const float*)(ws + WS_CS64);
        float* km = (float*)(ws + WS_CTL) + CW_KM + (size_t)(l >> 1) * (4 * 6 * 8 * 128);
        int kind; bool kmean = false;
        if (odd) { kind = (u.pn <= 6) ? 2 : (u.pn <= 9 ? 0 : 3); }
        else { kind = (u.pn < 6) ? 1 : (u.pn < 9 ? 0 : (u.pn < 15 ? 1 : (u.pn < 20 ? 0 : 3))); kmean = (u.pn >= 12 && u.pn < 15); }
        float ks[2][8];
#pragma unroll
        for (int bj = 0; bj < 2; ++bj)
#pragma unroll
            for (int e = 0; e < 8; ++e) ks[bj][e] = 0.f;
        f32x4 csA[8], snA[8];
#define EPI_TLOAD(I0) do { if (kind == 1) { _Pragma("unroll") for (int i = (I0); i < (I0) + 4; ++i) { const float* t = cs128 + (size_t)(row0 + (i >> 2) * HALF + (i & 3) * 16) * 128 + (16 * wc + 4 * fq); csA[i] = *(const f32x4*)t; snA[i] = *(const f32x4*)(t + 64); } } \
        else if (kind == 2) { _Pragma("unroll") for (int i = (I0); i < (I0) + 4; ++i) { const float* t = cs64 + (size_t)(row0 + (i >> 2) * HALF + (i & 3) * 16) * 64 + (16 * (wc & 1) + 4 * fq); csA[i] = *(const f32x4*)t; snA[i] = *(const f32x4*)(t + 32); } } \
        else { _Pragma("unroll") for (int i = (I0); i < (I0) + 4; ++i) { csA[i] = (f32x4){1.f, 1.f, 1.f, 1.f}; snA[i] = (f32x4){0.f, 0.f, 0.f, 0.f}; } } } while (0)
        EPI_TLOAD(0);
        { const int te = (wr * 4 + wc) * 64 + fq * 16 + fr;
          if (te < 256) { const float* sb = (const float*)(ws + WS_SSQ) + (size_t)l * 8 * NTOK + u.pm * BM; float t8[8];
#pragma unroll
              for (int j = 0; j < 8; ++j) { const float* sj = sb + (size_t)j * NTOK; t8[j] = sj[te]; }
              const float sq = ((t8[0] + t8[1]) + (t8[2] + t8[3])) + ((t8[4] + t8[5]) + (t8[6] + t8[7]));
              ((LAS float*)(P.lds + XTBL_OFF))[te] = __builtin_amdgcn_rsqf(sq * (1.0f / DM) + EPS); }
          LDS_WAIT(); __builtin_amdgcn_s_barrier(); asm volatile("" ::: "memory"); }
        const LAS float* rst = (const LAS float*)(P.lds + XTBL_OFF);
#pragma unroll
        for (int ai = 0; ai < 2; ++ai) {
#pragma unroll
            for (int m = 0; m < 4; ++m) {
                if (ai == 0 && m == 3) { asm volatile("" ::: "memory"); EPI_TLOAD(4); }
                const int row = row0 + ai * HALF + m * 16;
                const float rs = rst[ai * HALF + wr * 64 + m * 16 + fr];
                const f32x4 cs = csA[ai * 4 + m], sn = snA[ai * 4 + m];
                bf16_t* rowp = O + (size_t)row * ldo + colt;
#pragma unroll
                for (int bj = 0; bj < 2; ++bj) {
                    f32x4 v0 = acc[ai][bj][m][0] * rs, v1 = acc[ai][bj][m][1] * rs;
                    if (kind == 1 || kind == 2) { const f32x4 o0 = v0 * cs - v1 * sn, o1 = v1 * cs + v0 * sn; v0 = o0; v1 = o1; }
                    else if (kind == 3) {
#pragma unroll
                        for (int j = 0; j < 4; ++j) { v0[j] = v0[j] * __builtin_amdgcn_rcpf(1.0f + __builtin_amdgcn_exp2f(-1.4426950408889634f * v0[j]));
                                                      v1[j] = v1[j] * __builtin_amdgcn_rcpf(1.0f + __builtin_amdgcn_exp2f(-1.4426950408889634f * v1[j])); }
                    }
                    if (kmean) {
#pragma unroll
                        for (int j = 0; j < 4; ++j) { ks[bj][j] += v0[j]; ks[bj][4 + j] += v1[j]; }
                    }
                    u32x4 w; w.x = cvt_pk_bf16(v0[0], v0[1]); w.y = cvt_pk_bf16(v0[2], v0[3]); w.z = cvt_pk_bf16(v1[0], v1[1]); w.w = cvt_pk_bf16(v1[2], v1[3]);
                    *(u32x4*)(rowp + bj * HALF) = w;
                }
            }
        }
#undef EPI_TLOAD
        if (kmean) {
#pragma unroll
            for (int bj = 0; bj < 2; ++bj)
#pragma unroll
                for (int e = 0; e < 8; ++e) { float s = ks[bj][e]; s += __shfl_xor(s, 1); s += __shfl_xor(s, 2); s += __shfl_xor(s, 4); s += __shfl_xor(s, 8); ks[bj][e] = s; }
            if (fr == 0) {
                const int b = u.pm >> 3, n = u.pm & 7;
#pragma unroll
                for (int bj = 0; bj < 2; ++bj) { const int h = (u.pn - 12) * 2 + bj; float* dst = km + ((size_t)((b * 6 + h) * 8 + n)) * 128 + wc * 32 + 8 * fq;
#pragma unroll
                    for (int e = 0; e < 8; ++e) atomicAdd(dst + e, ks[bj][e]); }
            }
        }
    } else {
        const int l = P.l;
        float* xout = P.out;
        bf16_t* xb = (bf16_t*)(ws + WS_XB); const bool wxb = (l != 3);
        const bool fuse = (l == 3) && P.fuse_final;
        float* ssq_out = (float*)(ws + WS_SSQ) + (size_t)(l + 1) * 8 * NTOK + (size_t)u.pn * NTOK + u.pm * BM;
        LAS float* xt = (LAS float*)(P.lds + XTBL_OFF);
#pragma unroll
        for (int ai = 0; ai < 2; ++ai)
#pragma unroll
            for (int m = 0; m < 4; ++m) {
                const int row = row0 + ai * HALF + m * 16; float ss = 0.f;
#pragma unroll
                for (int bj = 0; bj < 2; ++bj) {
                    const size_t off = (size_t)row * DM + colt + bj * HALF;
                    const f32x4 v0 = acc[ai][bj][m][0], v1 = acc[ai][bj][m][1];
                    if (!fuse) { *(f32x4*)(xout + off) = v0; *(f32x4*)(xout + off + 4) = v1; }
                    if (wxb) { u32x4 w; w.x = cvt_pk_bf16(v0[0], v0[1]); w.y = cvt_pk_bf16(v0[2], v0[3]); w.z = cvt_pk_bf16(v1[0], v1[1]); w.w = cvt_pk_bf16(v1[2], v1[3]); *(u32x4*)(xb + off) = w; }
                    ss += (v0[0] * v0[0] + v0[1] * v0[1]) + (v0[2] * v0[2] + v0[3] * v0[3]) + (v1[0] * v1[0] + v1[1] * v1[1]) + (v1[2] * v1[2] + v1[3] * v1[3]);
                }
                ss += __shfl_xor(ss, 16); ss += __shfl_xor(ss, 32);
                if (fq == 0) xt[(ai * HALF + wr * 64 + m * 16 + fr) * 4 + wc] = ss;
            }
        LDS_WAIT(); __builtin_amdgcn_s_barrier(); asm volatile("" ::: "memory");
        const int lane = fq * 16 + fr, wid = wr * 4 + wc, r = wid * 32 + (lane & 31);
        if (!fuse) {
            if (lane < 32) { const f32x4 t = *(const LAS f32x4*)(xt + r * 4); ssq_out[r] = (t[0] + t[1]) + (t[2] + t[3]); }
        } else {
            if (lane < 32) { const f32x4 t = *(const LAS f32x4*)(xt + r * 4); __hip_atomic_store((unsigned*)(ssq_out + r), __float_as_uint((t[0] + t[1]) + (t[2] + t[3])), __ATOMIC_RELAXED, __HIP_MEMORY_SCOPE_AGENT); }
            asm volatile("s_waitcnt vmcnt(0)" ::: "memory"); LDS_WAIT();
            __builtin_amdgcn_s_barrier(); asm volatile("" ::: "memory");
            unsigned* pcnt = (unsigned*)(ws + WS_CTL) + CW_PAN + 64 * u.pm;
            if (wid == 0 && lane == 0) {
                __hip_atomic_fetch_add(pcnt, 1u, __ATOMIC_RELAXED, __HIP_MEMORY_SCOPE_AGENT);
                unsigned sp = 0; while (__hip_atomic_load(pcnt, __ATOMIC_RELAXED, __HIP_MEMORY_SCOPE_AGENT) < 8u) { __builtin_amdgcn_s_sleep(2); if (++sp > (1u << 22)) break; }
                __builtin_amdgcn_fence(__ATOMIC_ACQUIRE, "agent"); asm volatile("s_waitcnt vmcnt(0)" ::: "memory");
            }
            __builtin_amdgcn_s_barrier(); asm volatile("" ::: "memory");
            { const int te = wid * 64 + lane;
              if (te < 256) { const unsigned* sb = (const unsigned*)((const float*)(ws + WS_SSQ) + (size_t)4 * 8 * NTOK + u.pm * BM + te); float sq = 0.f;
#pragma unroll
                  for (int j = 0; j < 8; ++j) sq += __uint_as_float(__hip_atomic_load(sb + (size_t)j * NTOK, __ATOMIC_RELAXED, __HIP_MEMORY_SCOPE_AGENT));
                  xt[te] = 1.0f / sqrtf(sq * (1.0f / DM) + EPS); }
              LDS_WAIT(); __builtin_amdgcn_s_barrier(); asm volatile("" ::: "memory"); }
#pragma unroll
            for (int bj = 0; bj < 2; ++bj) {
                const f32x4 g0 = *(const f32x4*)(P.fnorm + colt + bj * HALF), g1 = *(const f32x4*)(P.fnorm + colt + bj * HALF + 4);
#pragma unroll
                for (int ai = 0; ai < 2; ++ai)
#pragma unroll
                    for (int m = 0; m < 4; ++m) {
                        const float rs = xt[ai * HALF + wr * 64 + m * 16 + fr];
                        const size_t off = (size_t)(row0 + ai * HALF + m * 16) * DM + colt + bj * HALF;
                        *(f32x4*)(xout + off) = acc[ai][bj][m][0] * rs * g0; *(f32x4*)(xout + off + 4) = acc[ai][bj][m][1] * rs * g1;
                    }
            }
        }
    }
}

__device__ __forceinline__ void gemm_phase(LAS unsigned char* lds, const GemmP& P, const Order& S, const int tid) {
    const int wid = __builtin_amdgcn_readfirstlane(tid >> 6), lane = tid & 63, wr = wid >> 2, wc = wid & 3, fr = lane & 15, fq = lane >> 4;
    constexpr int K = KDIM, nt = K / BK;
    unsigned voffA[2], voffB[2];
#pragma unroll
    for (int i = 0; i < 2; ++i) { int R, C; stage_rc(tid * 16 + i * 8192, R, C); const int Rb = (R & ~31) + perm32(R & 31);
        voffA[i] = (unsigned)(R * K + C) * 2u; voffB[i] = (unsigned)(Rb * K + C) * 2u; }
    constexpr size_t kstep = (size_t)(BK * 2);
    constexpr size_t hstep = (size_t)HALF * K * 2;
    constexpr size_t tstep = 2 * hstep;
    const unsigned ldsw = (unsigned)wid * 1024u;
    const int aoff = lds_byte(wr * 64 + fr, fq * 8), boff = lds_byte(wc * 32 + fr, fq * 8);
#define PG8_SA(b, h) (((b) * 2 + (h)) * HTB)
#define PG8_SB(b, h) ((4 + (b) * 2 + (h)) * HTB)
#define PG8_STAGE(bufoff, gbase, voff) do { _Pragma("unroll") for (int _i = 0; _i < 2; ++_i) \
        __builtin_amdgcn_global_load_lds((const unsigned*)((const char*)(gbase) + (voff)[_i]), (LAS unsigned*)(lds + (bufoff) + ldsw + _i * 8192), 16, 0, 0); } while (0)
#define PG8_LDA(dst, b, h) do { _Pragma("unroll") for (int m = 0; m < 4; ++m) _Pragma("unroll") for (int k = 0; k < 2; ++k) dst[m][k] = *(const LAS bf16x8*)(lds + PG8_SA(b, h) + aoff + m * 2048 + k * 1024); } while (0)
#define PG8_LDB(dst, b, h) do { _Pragma("unroll") for (int n = 0; n < 2; ++n) _Pragma("unroll") for (int k = 0; k < 2; ++k) dst[n][k] = *(const LAS bf16x8*)(lds + PG8_SB(b, h) + boff + n * 2048 + k * 1024); } while (0)
#define PG8_MMA(ai, bj, At, Bt) do { __builtin_amdgcn_s_setprio(1); _Pragma("unroll") for (int m = 0; m < 4; ++m) _Pragma("unroll") for (int n = 0; n < 2; ++n) _Pragma("unroll") for (int k = 0; k < 2; ++k) \
        acc[ai][bj][m][n] = __builtin_amdgcn_mfma_f32_16x16x32_bf16(Bt[n][k], At[m][k], acc[ai][bj][m][n], 0, 0, 0); __builtin_amdgcn_s_setprio(0); } while (0)
#define PG8_WAIT_V(n) asm volatile("s_waitcnt vmcnt(" #n ")" ::: "memory")
#define PG8_WAIT_L(n) asm volatile("s_waitcnt lgkmcnt(" #n ")" ::: "memory")
#define PG8_BAR __builtin_amdgcn_s_barrier()
#define PG8_SCHED __builtin_amdgcn_sched_barrier(0)
    Unit cur, nxt; int ui = 0;
    if (!S.next(0, cur)) return;
    f32x4 acc[2][2][4][2];
#define PG8_ACC_INIT(U) do { if (P.mode == EM_OUTPROJ && (U).s == 0) { \
        const char* rp = (const char*)(P.l == 0 ? P.xin : (const float*)P.out) + ((size_t)((U).pm * BM + wr * 64 + fr) * DM + (U).pn * BM + wc * 32 + 8 * fq) * 4; \
        _Pragma("unroll") for (int a = 0; a < 2; ++a) _Pragma("unroll") for (int m = 0; m < 4; ++m) { asm volatile("" : "+v"(rp)); \
            _Pragma("unroll") for (int b = 0; b < 2; ++b) _Pragma("unroll") for (int n = 0; n < 2; ++n) acc[a][b][m][n] = __builtin_nontemporal_load((const f32x4*)(rp + b * 512 + n * 16)); \
            rp += (m == 3 ? (size_t)(HALF - 48) : (size_t)16) * DM * 4; } \
    } else { _Pragma("unroll") for (int a = 0; a < 2; ++a) _Pragma("unroll") for (int b = 0; b < 2; ++b) _Pragma("unroll") for (int m = 0; m < 4; ++m) _Pragma("unroll") for (int n = 0; n < 2; ++n) acc[a][b][m][n] = (f32x4){0.f, 0.f, 0.f, 0.f}; } } while (0)
    PG8_ACC_INIT(cur);
    bf16x8 At[4][2], B0[2][2], B1[2][2];
    const char* cA = (cur.s ? (const char*)(P.ws + WS_MEMN) : (const char*)P.A) + (size_t)cur.pm * tstep; const char* cB = (cur.s ? (const char*)(P.ws + WS_WMKV) : (const char*)P.Bt) + (size_t)cur.pn * tstep;
    PG8_STAGE(PG8_SB(0, 0), cB, voffB); PG8_STAGE(PG8_SB(0, 1), cB + hstep, voffB); PG8_STAGE(PG8_SA(0, 0), cA, voffA); PG8_STAGE(PG8_SA(0, 1), cA + hstep, voffA);
    if (wr == 1) PG8_BAR;
    PG8_WAIT_V(2); PG8_BAR;
    PG8_STAGE(PG8_SB(1, 0), cB + kstep, voffB); PG8_STAGE(PG8_SA(1, 0), cA + kstep, voffA); PG8_STAGE(PG8_SB(1, 1), cB + hstep + kstep, voffB);
    PG8_WAIT_V(6); PG8_BAR;
    for (;;) {
        const bool has_next = S.next(ui + 1, nxt);
        const char* nA = has_next ? (nxt.s ? (const char*)(P.ws + WS_MEMN) : (const char*)P.A) + (size_t)nxt.pm * tstep : cA; const char* nB = has_next ? (nxt.s ? (const char*)(P.ws + WS_WMKV) : (const char*)P.Bt) + (size_t)nxt.pn * tstep : cB;
        for (int t = 0; t < nt; t += 2) {
            const bool last = (t == nt - 2);
            const char* a1 = cA + (size_t)(t + 1) * kstep;
            const char* a2 = last ? nA : cA + (size_t)(t + 2) * kstep; const char* b2 = last ? nB : cB + (size_t)(t + 2) * kstep;
            const char* a3 = a2 + kstep; const char* b3 = b2 + kstep;
            PG8_LDB(B0, 0, 0); PG8_LDB(B1, 0, 1); PG8_SCHED; PG8_LDA(At, 0, 0); PG8_STAGE(PG8_SA(1, 1), a1 + hstep, voffA);
            PG8_WAIT_V(8); PG8_WAIT_L(0); PG8_BAR; PG8_MMA(0, 0, At, B0); PG8_MMA(0, 1, At, B1); PG8_BAR; PG8_SCHED;
            PG8_LDA(At, 0, 1); PG8_STAGE(PG8_SB(0, 0), b2, voffB); PG8_STAGE(PG8_SB(0, 1), b2 + hstep, voffB); PG8_STAGE(PG8_SA(0, 0), a2, voffA);
            PG8_WAIT_V(8); PG8_WAIT_L(0); PG8_BAR; PG8_MMA(1, 0, At, B0); PG8_MMA(1, 1, At, B1); PG8_BAR; PG8_SCHED;
            PG8_LDB(B0, 1, 0); PG8_LDB(B1, 1, 1); PG8_SCHED; PG8_LDA(At, 1, 0); PG8_STAGE(PG8_SA(0, 1), a2 + hstep, voffA);
            PG8_WAIT_V(8); PG8_WAIT_L(0); PG8_BAR; PG8_MMA(0, 0, At, B0); PG8_MMA(0, 1, At, B1); PG8_BAR; PG8_SCHED;
            PG8_LDA(At, 1, 1); PG8_STAGE(PG8_SB(1, 0), b3, voffB); PG8_STAGE(PG8_SB(1, 1), b3 + hstep, voffB); PG8_STAGE(PG8_SA(1, 0), a3, voffA);
            PG8_WAIT_V(8); PG8_WAIT_L(0); PG8_BAR; PG8_MMA(1, 0, At, B0); PG8_MMA(1, 1, At, B1); PG8_BAR; PG8_SCHED;
        }
        if (wr == 0) PG8_BAR;
        { int lane_e = lane; asm volatile("" : "+v"(lane_e));
          epi_run(P, acc, cur, wr, wc, lane_e & 15, lane_e >> 4); }
        if (!has_next) break;
        PG8_ACC_INIT(nxt);
        cur = nxt; cA = nA; cB = nB; ++ui;
        if (wr == 1) PG8_BAR;
    }
    PG8_WAIT_V(0);
    PG8_BAR;
#undef PG8_ACC_INIT
#undef PG8_SA
#undef PG8_SB
#undef PG8_STAGE
#undef PG8_LDA
#undef PG8_LDB
#undef PG8_MMA
#undef PG8_WAIT_V
#undef PG8_WAIT_L
#undef PG8_BAR
#undef PG8_SCHED
}

struct KVD { int kvsel, koff, voff, kd1, ks, L, kt0, ksub, koff1, nst; };
struct AU { int qoff, qs, qrow_w, band, causal, pair, whalf, moba_n, tbase, kmoff; };
struct AE { int epi, ooff, os, goff, gs, lseoff, lses, has_sink; float sink; };
__device__ __forceinline__ int crow(int r, int hi) { return (r & 3) + 8 * (r >> 2) + 4 * hi; }
typedef short v4i16_t __attribute__((ext_vector_type(4)));
template <int OFF> __device__ __forceinline__ s16x4 tr_read(int vb) { return __builtin_bit_cast(s16x4, __builtin_amdgcn_ds_read_tr16_b64_v4i16((LAS v4i16_t*)(uintptr_t)(unsigned)(vb + OFF))); }
template <int D> __device__ __forceinline__ int kswz(int row, int colB) { if constexpr (D == 128) return row * 256 + (colB ^ ((row & 7) << 4)); else return row * 128 + (colB ^ (((row >> 1) & 7) << 4)); }
template <int D> __device__ __forceinline__ int v_st(int k, int c) { const int kk = (k & ~0xC) | ((k & 4) << 1) | ((k & 8) >> 1); return ((kk >> 3) * (D / 32) + (c >> 5)) * 512 + ((kk & 7) * 32 + (c & 31)) * 2; }
__device__ __forceinline__ int v_rd_base(int lane) { return ((lane & 3) << 3) | (((lane >> 2) & 3) << 6) | (((lane >> 4) & 1) << 5) | (((lane >> 5) & 1) << 8); }
template <int D> constexpr int v_rd_off(int d0, int ks, int half) { return d0 * 512 + (ks * 2 + half) * (D / 32) * 512; }

template <int D, int D0, int HF> __device__ __forceinline__ void pv_half(f32x16& od, int vb, bf16x8 pa, bf16x8 pb) {
    const s16x4 l0 = tr_read<v_rd_off<D>(D0, 2 * HF, 0)>(vb), h0 = tr_read<v_rd_off<D>(D0, 2 * HF, 1)>(vb), l1 = tr_read<v_rd_off<D>(D0, 2 * HF + 1, 0)>(vb), h1 = tr_read<v_rd_off<D>(D0, 2 * HF + 1, 1)>(vb);
#define PKV(Lx, Hx) (bf16x8){Lx[0], Lx[1], Lx[2], Lx[3], Hx[0], Hx[1], Hx[2], Hx[3]}
    od = __builtin_amdgcn_mfma_f32_32x32x16_bf16(pa, PKV(l0, h0), od, 0, 0, 0);
    od = __builtin_amdgcn_mfma_f32_32x32x16_bf16(pb, PKV(l1, h1), od, 0, 0, 0);
#undef PKV
}
template <int D, int HF> __device__ __forceinline__ void pv_all(f32x16* o, int vb, bf16x8 pa, bf16x8 pb) {
    pv_half<D, 0, HF>(o[0], vb, pa, pb); pv_half<D, 1, HF>(o[1], vb, pa, pb);
    if constexpr (D == 128) { pv_half<D, 2, HF>(o[2], vb, pa, pb); pv_half<D, 3, HF>(o[3], vb, pa, pb); }
}
template <int D> struct ACfg { static constexpr int NSUB = (D == 128) ? 2 : 3, KTB = 64 * D * 2; };
constexpr int ABUF = 65536;
__device__ __forceinline__ int swap23(int k) { return (k & ~0xC) | ((k & 4) << 1) | ((k & 8) >> 1); }
template <int D> __device__ __forceinline__ void stage_dma(const KVD& d, const unsigned char* ws, int sub, LAS unsigned char* buf, int slot, int wid, int lane) {
    constexpr int NSUB = ACfg<D>::NSUB, KTB = ACfg<D>::KTB, NBLK = D / 32, NP = KTB / 8192;
    const bf16_t* KVp = (const bf16_t*)(ws + (d.kvsel ? WS_MKV : WS_QKV));
    const int kb = d.kt0 + sub * d.ksub;
    LAS unsigned char* Kt = buf + slot * KTB; LAS unsigned char* Vt = buf + NSUB * KTB + slot * KTB;
#pragma unroll
    for (int i = 0; i < NP; ++i) {
        const int piece = wid + 8 * i;
        int row, c;
        if constexpr (D == 128) { row = piece * 4 + (lane >> 4); c = (lane & 15) ^ (row & 7); } else { row = piece * 8 + (lane >> 3); c = (lane & 7) ^ ((row >> 1) & 7); }
        { const int half = row >> 5; int a = kb + (row & 31) + half * d.koff1; a = a < 0 ? 0 : (a > d.L - 1 ? d.L - 1 : a);
          const bf16_t* src = KVp + d.koff + (size_t)a * d.ks + half * d.kd1 + c * 8;
          __builtin_amdgcn_global_load_lds((const unsigned*)src, (LAS unsigned*)(Kt + piece * 1024), 16, 0, 0); }
        { const int p = piece * 1024 + lane * 16, st = p >> 9, q = (p & 511) >> 1, kk = (st / NBLK) * 8 + (q >> 5), k = swap23(kk), col = (st % NBLK) * 32 + (q & 31);
          const int half = k >> 5; int a = kb + (k & 31) + half * d.koff1; a = a < 0 ? 0 : (a > d.L - 1 ? d.L - 1 : a);
          const bf16_t* src = KVp + d.voff + (size_t)a * d.ks + half * d.kd1 + col;
          __builtin_amdgcn_global_load_lds((const unsigned*)src, (LAS unsigned*)(Vt + piece * 1024), 16, 0, 0); }
    }
}
template <int D> __device__ __forceinline__ void cold_start(const KVD& d, const unsigned char* ws, LAS unsigned char* buf, int wid, int lane) {
#pragma unroll
    for (int sl = 0; sl < ACfg<D>::NSUB; ++sl) if (sl < d.nst) stage_dma<D>(d, ws, sl, buf, sl, wid, lane);
    asm volatile("s_waitcnt vmcnt(0)" ::: "memory");
    __syncthreads();
}

template <int D>
__device__ __forceinline__ void attn_main(const AU& u, const KVD& d, const KVD& dn, const int pre, int& pb, unsigned char* ws, LAS unsigned char* lds, int tid, int wid, int lane,
                                          float& m_out, float& l_out, f32x16 (&o)[D / 32]) {
    constexpr int NQ = D / 16, NB = D / 32, NSUB = ACfg<D>::NSUB, KTB = ACfg<D>::KTB;
    constexpr float SCALE = (D == 128) ? 0.088388347648318440f : 0.125f;
    constexpr float C = SCALE * 1.4426950408889634f;
    constexpr float THRS = 8.0f / SCALE;
    const int r32 = lane & 31, hi = lane >> 5;
    LAS float* wsf = (LAS float*)(lds + XTBL_OFF + wid * 256);
    bf16x8 qr[NQ];
    { const bf16_t* qrow = (const bf16_t*)(ws + WS_QKV) + (size_t)u.qoff + (size_t)(u.qrow_w + r32) * u.qs + hi * 8;
#pragma unroll
      for (int d0 = 0; d0 < NQ; ++d0) qr[d0] = *(const bf16x8*)(qrow + d0 * 16); }
    float m_reg = -1e30f, l_reg = 0.f;
#pragma unroll
    for (int dd = 0; dd < NB; ++dd)
#pragma unroll
        for (int r = 0; r < 16; ++r) o[dd][r] = 0.f;
    const int qidx = u.qrow_w + r32;
    unsigned selmask = 0;
    if constexpr (D == 128) {
        if (u.moba_n > 0) {
            const int n = u.moba_n; float g[7];
#pragma unroll
            for (int j = 0; j < 7; ++j) {
                g[j] = -INFINITY;
                if (j < n) {
                    const float* kmj = (const float*)(ws + WS_CTL) + CW_KM + u.kmoff + j * 128 + hi * 8; float s = 0.f;
#pragma unroll
                    for (int d0 = 0; d0 < NQ; ++d0) { const f32x4 a = *(const f32x4*)(kmj + d0 * 16), b = *(const f32x4*)(kmj + d0 * 16 + 4);
                        const u32x4 qw = __builtin_bit_cast(u32x4, qr[d0]);
                        s += bflo(qw.x) * a[0] + bfhi(qw.x) * a[1] + bflo(qw.y) * a[2] + bfhi(qw.y) * a[3] + bflo(qw.z) * b[0] + bfhi(qw.z) * b[1] + bflo(qw.w) * b[2] + bfhi(qw.w) * b[3]; }
                    auto rr = __builtin_amdgcn_permlane32_swap(__float_as_uint(s), __float_as_uint(s), false, false);
                    g[j] = __uint_as_float(rr[0]) + __uint_as_float(rr[1]);
                }
            }
#pragma unroll
            for (int j = 0; j < 7; ++j) { int cnt = 0;
#pragma unroll
                for (int i = 0; i < 7; ++i) if (i != j) cnt += (i < n && (g[i] > g[j] || (g[i] == g[j] && i < j))) ? 1 : 0;
                if (j < n && cnt < 3) selmask |= (1u << j); }
        }
    }
    const int nsteps = (d.nst + NSUB - 1) / NSUB;
    for (int st = 0; st < nsteps; ++st) {
        LAS unsigned char* bufc = lds + pb * ABUF; LAS unsigned char* bufn = lds + (pb ^ 1) * ABUF;
        const bool lastst = (st + 1 == nsteps);
#pragma unroll 1
        for (int sl = 0; sl < NSUB; ++sl) {
            const int sub = st * NSUB + sl;
            if (!lastst) { if (sub + NSUB < d.nst) stage_dma<D>(d, ws, sub + NSUB, bufn, sl, wid, lane); }
            else if (pre) { if (sl < dn.nst) stage_dma<D>(dn, ws, sl, bufn, sl, wid, lane); }
            if (sub < d.nst) {
                const int kb0 = d.kt0 + sub * d.ksub, kb1 = kb0 + d.koff1;
                int lo_q, hi_q;
                const int tabs = u.tbase + sub;
                if (u.moba_n >= 0 && tabs < 4 * u.moba_n) { const bool sel = (selmask >> (tabs >> 2)) & 1u; lo_q = sel ? -(1 << 28) : (1 << 28); hi_q = sel ? (1 << 28) : -(1 << 28); }
                else { lo_q = qidx - u.band; hi_q = u.causal ? qidx : (1 << 28); }
                bool any0 = __any(lo_q <= kb0 + 31 && hi_q >= kb0), any1 = __any(lo_q <= kb1 + 31 && hi_q >= kb1);
                if (u.pair) { any0 = any0 && (u.whalf == 0); any1 = any1 && (u.whalf == 1); }
#define HALF_STEP(HF, ANY, KBH) do { if (ANY) { \
                    const bool allv = __all(lo_q <= (KBH) && hi_q >= (KBH) + 31); \
                    f32x16 p; _Pragma("unroll") for (int r = 0; r < 16; ++r) p[r] = 0.f; \
                    LAS unsigned char* Kt = bufc + sl * KTB; \
                    _Pragma("unroll") for (int d0 = 0; d0 < NQ; ++d0) { const bf16x8 bk = *(const LAS bf16x8*)(Kt + kswz<D>(32 * (HF) + r32, (d0 * 16 + hi * 8) * 2)); p = __builtin_amdgcn_mfma_f32_32x32x16_bf16(bk, qr[d0], p, 0, 0, 0); } \
                    if (!allv) { _Pragma("unroll") for (int r = 0; r < 16; ++r) { const int kk = (KBH) + crow(r, hi); if (kk < lo_q || kk > hi_q) p[r] = -INFINITY; } } \
                    float pmax = p[0]; _Pragma("unroll") for (int r = 1; r < 16; ++r) pmax = fmaxf(pmax, p[r]); \
                    { auto rr = __builtin_amdgcn_permlane32_swap(__float_as_uint(pmax), __float_as_uint(pmax), false, false); pmax = fmaxf(__uint_as_float(rr[0]), __uint_as_float(rr[1])); } \
                    float alpha = 1.f; \
                    if (!__all(pmax - m_reg <= THRS)) { const float mn = fmaxf(m_reg, pmax); alpha = __builtin_amdgcn_exp2f((m_reg - mn) * C); m_reg = mn; } \
                    const float mnC = -m_reg * C; float ps = 0.f; \
                    _Pragma("unroll") for (int r = 0; r < 16; ++r) { p[r] = __builtin_amdgcn_exp2f(fmaf(p[r], C, mnC)); ps += p[r]; } \
                    { auto rr = __builtin_amdgcn_permlane32_swap(__float_as_uint(ps), __float_as_uint(ps), false, false); ps = __uint_as_float(rr[0]) + __uint_as_float(rr[1]); } \
                    l_reg = l_reg * alpha + ps; \
                    if (__any(alpha < 1.f)) { if (hi == 0) wsf[r32] = alpha; LDS_WAIT(); \
                        _Pragma("unroll") for (int dd = 0; dd < NB; ++dd) _Pragma("unroll") for (int r = 0; r < 16; ++r) o[dd][r] *= wsf[crow(r, hi)]; \
                        LDS_WAIT(); } \
                    bf16x8 paA, paB; PK4(p, 0, paA); PK4(p, 8, paB); \
                    const int vb = (int)(uintptr_t)(bufc + NSUB * KTB + sl * KTB) + v_rd_base(lane); \
                    pv_all<D, HF>(o, vb, paA, paB); } } while (0)
#define PK4(P, BASE, OUT) do { unsigned a0 = cvt_pk_bf16(P[BASE + 0], P[BASE + 1]), a1 = cvt_pk_bf16(P[BASE + 2], P[BASE + 3]);   \
    unsigned b0 = cvt_pk_bf16(P[BASE + 4], P[BASE + 5]), b1 = cvt_pk_bf16(P[BASE + 6], P[BASE + 7]);                              \
    auto r0 = __builtin_amdgcn_permlane32_swap(a0, b0, false, false); auto r1 = __builtin_amdgcn_permlane32_swap(a1, b1, false, false); \
    u32x4 w = {r0[0], r1[0], r0[1], r1[1]}; OUT = __builtin_bit_cast(bf16x8, w); } while (0)
                HALF_STEP(0, any0, kb0);
                HALF_STEP(1, any1, kb1);
#undef PK4
#undef HALF_STEP
            }
        }
        asm volatile("s_waitcnt vmcnt(0)" ::: "memory");
        __syncthreads();
        pb ^= 1;
    }
    m_out = m_reg; l_out = l_reg;
}

__device__ __forceinline__ void attn_c_main(const AU& u, const KVD& d, const KVD& dn, const int pre, int& pb, unsigned char* ws, LAS unsigned char* lds, int wid, int lane,
                                            float (&m_out)[2], float (&l_out)[2], f32x16 (&oA)[2], f32x16 (&oB)[2]) {
    constexpr int D = 64, NQ = 4, NSUB = 3, KTB = 8192;
    constexpr float SCALE = 0.125f, C = SCALE * 1.4426950408889634f, THRS = 8.0f / SCALE;
    const int r32 = lane & 31, hi = lane >> 5;
    LAS float* wsf = (LAS float*)(lds + XTBL_OFF + wid * 256);
    bf16x8 qA[NQ], qB[NQ];
    { const bf16_t* qrow = (const bf16_t*)(ws + WS_QKV) + (size_t)u.qoff + (size_t)(u.qrow_w + r32) * u.qs + hi * 8;
#pragma unroll
      for (int d0 = 0; d0 < NQ; ++d0) { qA[d0] = *(const bf16x8*)(qrow + d0 * 16); qB[d0] = *(const bf16x8*)(qrow + (size_t)32 * u.qs + d0 * 16); } }
    float mA = -1e30f, lA = 0.f, mB = -1e30f, lB = 0.f;
#pragma unroll
    for (int dd = 0; dd < 2; ++dd)
#pragma unroll
        for (int r = 0; r < 16; ++r) { oA[dd][r] = 0.f; oB[dd][r] = 0.f; }
    const int qiA = u.qrow_w + r32, qiB = qiA + 32;
    const int loA = qiA - u.band, loB = qiB - u.band;
    LAS unsigned char* bufc = lds + pb * ABUF; LAS unsigned char* bufn = lds + (pb ^ 1) * ABUF;
#define PK4(P, BASE, OUT) do { unsigned a0 = cvt_pk_bf16(P[BASE + 0], P[BASE + 1]), a1 = cvt_pk_bf16(P[BASE + 2], P[BASE + 3]);   \
    unsigned b0 = cvt_pk_bf16(P[BASE + 4], P[BASE + 5]), b1 = cvt_pk_bf16(P[BASE + 6], P[BASE + 7]);                              \
    auto r0 = __builtin_amdgcn_permlane32_swap(a0, b0, false, false); auto r1 = __builtin_amdgcn_permlane32_swap(a1, b1, false, false); \
    u32x4 w = {r0[0], r1[0], r0[1], r1[1]}; OUT = __builtin_bit_cast(bf16x8, w); } while (0)
#define PKV(Lx, Hx) (bf16x8){Lx[0], Lx[1], Lx[2], Lx[3], Hx[0], Hx[1], Hx[2], Hx[3]}
#define C_SINGLE(HF, KBH, QF, LOQ, HIQ, MR, LR, OO) do { \
        f32x16 p; _Pragma("unroll") for (int r = 0; r < 16; ++r) p[r] = 0.f; \
        _Pragma("unroll") for (int d0 = 0; d0 < NQ; ++d0) { const bf16x8 bk = *(const LAS bf16x8*)(Kt + kswz<D>(32 * (HF) + r32, (d0 * 16 + hi * 8) * 2)); p = __builtin_amdgcn_mfma_f32_32x32x16_bf16(bk, QF[d0], p, 0, 0, 0); } \
        _Pragma("unroll") for (int r = 0; r < 16; ++r) { const int kk = (KBH) + crow(r, hi); if (kk < (LOQ) || kk > (HIQ)) p[r] = -INFINITY; } \
        float pmax = p[0]; _Pragma("unroll") for (int r = 1; r < 16; ++r) pmax = fmaxf(pmax, p[r]); \
        { auto rr = __builtin_amdgcn_permlane32_swap(__float_as_uint(pmax), __float_as_uint(pmax), false, false); pmax = fmaxf(__uint_as_float(rr[0]), __uint_as_float(rr[1])); } \
        float alpha = 1.f; if (!__all(pmax - MR <= THRS)) { const float mn = fmaxf(MR, pmax); alpha = __builtin_amdgcn_exp2f((MR - mn) * C); MR = mn; } \
        const float mnC = -MR * C; float ps = 0.f; \
        _Pragma("unroll") for (int r = 0; r < 16; ++r) { p[r] = __builtin_amdgcn_exp2f(fmaf(p[r], C, mnC)); ps += p[r]; } \
        { auto rr = __builtin_amdgcn_permlane32_swap(__float_as_uint(ps), __float_as_uint(ps), false, false); ps = __uint_as_float(rr[0]) + __uint_as_float(rr[1]); } \
        LR = LR * alpha + ps; \
        if (__any(alpha < 1.f)) { if (hi == 0) wsf[r32] = alpha; LDS_WAIT(); \
            _Pragma("unroll") for (int dd = 0; dd < 2; ++dd) _Pragma("unroll") for (int r = 0; r < 16; ++r) OO[dd][r] *= wsf[crow(r, hi)]; LDS_WAIT(); } \
        bf16x8 pa, pb2; PK4(p, 0, pa); PK4(p, 8, pb2); \
        pv_all<D, HF>(OO, vb, pa, pb2); } while (0)
#define C_DUAL(HF, KBH) do { \
        f32x16 pa_, pb_; _Pragma("unroll") for (int r = 0; r < 16; ++r) { pa_[r] = 0.f; pb_[r] = 0.f; } \
        _Pragma("unroll") for (int d0 = 0; d0 < NQ; ++d0) { const bf16x8 bk = *(const LAS bf16x8*)(Kt + kswz<D>(32 * (HF) + r32, (d0 * 16 + hi * 8) * 2)); \
            pa_ = __builtin_amdgcn_mfma_f32_32x32x16_bf16(bk, qA[d0], pa_, 0, 0, 0); pb_ = __builtin_amdgcn_mfma_f32_32x32x16_bf16(bk, qB[d0], pb_, 0, 0, 0); } \
        _Pragma("unroll") for (int r = 0; r < 16; ++r) { const int kk = (KBH) + crow(r, hi); if (kk < loA || kk > qiA) pa_[r] = -INFINITY; if (kk < loB || kk > qiB) pb_[r] = -INFINITY; } \
        float xa = pa_[0], xb = pb_[0]; _Pragma("unroll") for (int r = 1; r < 16; ++r) { xa = fmaxf(xa, pa_[r]); xb = fmaxf(xb, pb_[r]); } \
        { auto rr = __builtin_amdgcn_permlane32_swap(__float_as_uint(xa), __float_as_uint(xa), false, false); xa = fmaxf(__uint_as_float(rr[0]), __uint_as_float(rr[1])); } \
        { auto rr = __builtin_amdgcn_permlane32_swap(__float_as_uint(xb), __float_as_uint(xb), false, false); xb = fmaxf(__uint_as_float(rr[0]), __uint_as_float(rr[1])); } \
        float alA = 1.f, alB = 1.f; \
        if (!__all(xa - mA <= THRS && xb - mB <= THRS)) { const float na = fmaxf(mA, xa), nb = fmaxf(mB, xb); alA = __builtin_amdgcn_exp2f((mA - na) * C); alB = __builtin_amdgcn_exp2f((mB - nb) * C); mA = na; mB = nb; } \
        const float cA_ = -mA * C, cB_ = -mB * C; float sa = 0.f, sb = 0.f; \
        _Pragma("unroll") for (int r = 0; r < 16; ++r) { pa_[r] = __builtin_amdgcn_exp2f(fmaf(pa_[r], C, cA_)); sa += pa_[r]; pb_[r] = __builtin_amdgcn_exp2f(fmaf(pb_[r], C, cB_)); sb += pb_[r]; } \
        { auto rr = __builtin_amdgcn_permlane32_swap(__float_as_uint(sa), __float_as_uint(sa), false, false); sa = __uint_as_float(rr[0]) + __uint_as_float(rr[1]); } \
        { auto rr = __builtin_amdgcn_permlane32_swap(__float_as_uint(sb), __float_as_uint(sb), false, false); sb = __uint_as_float(rr[0]) + __uint_as_float(rr[1]); } \
        lA = lA * alA + sa; lB = lB * alB + sb; \
        if (__any(alA < 1.f || alB < 1.f)) { if (hi == 0) { wsf[r32] = alA; wsf[32 + r32] = alB; } LDS_WAIT(); \
            _Pragma("unroll") for (int dd = 0; dd < 2; ++dd) _Pragma("unroll") for (int r = 0; r < 16; ++r) { oA[dd][r] *= wsf[crow(r, hi)]; oB[dd][r] *= wsf[32 + crow(r, hi)]; } LDS_WAIT(); } \
        bf16x8 a0_, a1_, b0_, b1_; PK4(pa_, 0, a0_); PK4(pa_, 8, a1_); PK4(pb_, 0, b0_); PK4(pb_, 8, b1_); \
        _Pragma("unroll") for (int d0 = 0; d0 < 2; ++d0) { \
            const s16x4 l0 = __builtin_bit_cast(s16x4, __builtin_amdgcn_ds_read_tr16_b64_v4i16((LAS v4i16_t*)(uintptr_t)(unsigned)(vb + d0 * 512 + ((2 * (HF)) * 2 + 0) * 1024))), \
                        h0 = __builtin_bit_cast(s16x4, __builtin_amdgcn_ds_read_tr16_b64_v4i16((LAS v4i16_t*)(uintptr_t)(unsigned)(vb + d0 * 512 + ((2 * (HF)) * 2 + 1) * 1024))), \
                        l1 = __builtin_bit_cast(s16x4, __builtin_amdgcn_ds_read_tr16_b64_v4i16((LAS v4i16_t*)(uintptr_t)(unsigned)(vb + d0 * 512 + ((2 * (HF) + 1) * 2 + 0) * 1024))), \
                        h1 = __builtin_bit_cast(s16x4, __builtin_amdgcn_ds_read_tr16_b64_v4i16((LAS v4i16_t*)(uintptr_t)(unsigned)(vb + d0 * 512 + ((2 * (HF) + 1) * 2 + 1) * 1024))); \
            const bf16x8 v0_ = PKV(l0, h0), v1_ = PKV(l1, h1); \
            oA[d0] = __builtin_amdgcn_mfma_f32_32x32x16_bf16(a0_, v0_, oA[d0], 0, 0, 0); oB[d0] = __builtin_amdgcn_mfma_f32_32x32x16_bf16(b0_, v0_, oB[d0], 0, 0, 0); \
            oA[d0] = __builtin_amdgcn_mfma_f32_32x32x16_bf16(a1_, v1_, oA[d0], 0, 0, 0); oB[d0] = __builtin_amdgcn_mfma_f32_32x32x16_bf16(b1_, v1_, oB[d0], 0, 0, 0); } } while (0)
#pragma unroll 1
    for (int sl = 0; sl < NSUB; ++sl) {
        if (pre) { if (sl < dn.nst) stage_dma<D>(dn, ws, sl, bufn, sl, wid, lane); }
        if (sl < d.nst) {
            LAS unsigned char* Kt = bufc + sl * KTB;
            const int vb = (int)(uintptr_t)(bufc + NSUB * KTB + sl * KTB) + v_rd_base(lane);
            const int kb0 = d.kt0 + sl * 64, kb1 = kb0 + 32;
            { const bool anA = __any(loA <= kb0 + 31 && qiA >= kb0), anB = __any(loB <= kb0 + 31 && qiB >= kb0);
              if (anA && anB) C_DUAL(0, kb0); else if (anA) C_SINGLE(0, kb0, qA, loA, qiA, mA, lA, oA); else if (anB) C_SINGLE(0, kb0, qB, loB, qiB, mB, lB, oB); }
            { const bool anA = __any(loA <= kb1 + 31 && qiA >= kb1), anB = __any(loB <= kb1 + 31 && qiB >= kb1);
              if (anA && anB) C_DUAL(1, kb1); else if (anA) C_SINGLE(1, kb1, qA, loA, qiA, mA, lA, oA); else if (anB) C_SINGLE(1, kb1, qB, loB, qiB, mB, lB, oB); }
        }
    }
#undef C_DUAL
#undef C_SINGLE
#undef PKV
#undef PK4
    asm volatile("s_waitcnt vmcnt(0)" ::: "memory");
    __syncthreads();
    pb ^= 1;
    m_out[0] = mA; m_out[1] = mB; l_out[0] = lA; l_out[1] = lB;
}

template <int D, bool PRE = false>
__device__ __forceinline__ void attn_epi(const AE& e, int qrow_w, int pbl, unsigned char* ws, LAS unsigned char* lds, int wid, int lane, float m_reg, float l_reg, const f32x16 (&o)[D / 32], const u32x4* gpre = nullptr) {
    constexpr int NB = D / 32;
    constexpr float SCALE = (D == 128) ? 0.088388347648318440f : 0.125f;
    const int r32 = lane & 31, hi = lane >> 5;
    LAS float* wsf = (LAS float*)(lds + XTBL_OFF + wid * 256);
    LAS bf16_t* stg = (LAS bf16_t*)(lds + pbl * ABUF + wid * 8192);
    float lt = l_reg;
    if (e.has_sink) lt += __builtin_amdgcn_exp2f((e.sink - m_reg * SCALE) * 1.4426950408889634f);
    if (hi == 0) wsf[r32] = lt > 0.f ? __builtin_amdgcn_rcpf(lt) : 0.f;
    LDS_WAIT();
    float rli[16];
#pragma unroll
    for (int r = 0; r < 16; ++r) rli[r] = wsf[crow(r, hi)];
    LDS_WAIT();
#pragma unroll
    for (int r = 0; r < 16; ++r) { const int orow = crow(r, hi);
#pragma unroll
        for (int d0 = 0; d0 < NB; ++d0) stg[orow * D + d0 * 32 + r32] = (bf16_t)f2bf(o[d0][r] * rli[r]); }
    LDS_WAIT();
    constexpr int CPR = D / 8, RPP = 64 / CPR;
    bf16_t* OB = (bf16_t*)(ws + (e.epi ? WS_Y : WS_OG));
    const bf16_t* GB = (const bf16_t*)(ws + WS_QKV);
#pragma unroll
    for (int i = 0; i < 32 / RPP; ++i) {
        const int row = i * RPP + lane / CPR, ch = lane % CPR;
        const u32x4 v = *(const LAS u32x4*)(stg + row * D + ch * 8);
        const size_t fidx = (size_t)(qrow_w + row);
        if (e.epi == 1) {
            u32x4 g; if constexpr (PRE) g = gpre[i]; else g = *(const u32x4*)(GB + (size_t)e.goff + fidx * e.gs + ch * 8);
            u32x4 w;
            w.x = cvt_pk_bf16(bflo(v.x) * bflo(g.x), bfhi(v.x) * bfhi(g.x)); w.y = cvt_pk_bf16(bflo(v.y) * bflo(g.y), bfhi(v.y) * bfhi(g.y));
            w.z = cvt_pk_bf16(bflo(v.z) * bflo(g.z), bfhi(v.z) * bfhi(g.z)); w.w = cvt_pk_bf16(bflo(v.w) * bflo(g.w), bfhi(v.w) * bfhi(g.w));
            *(u32x4*)(OB + (size_t)e.ooff + fidx * e.os + ch * 8) = w;
        } else {
            *(u32x4*)(OB + (size_t)e.ooff + fidx * e.os + ch * 8) = v;
        }
    }
    if (e.epi == 0 && hi == 0) ((float*)(ws + WS_LSE))[(size_t)e.lseoff + (size_t)(qrow_w + r32) * e.lses] = l_reg > 0.f ? m_reg * SCALE + __logf(l_reg) : -1e30f;
    LDS_WAIT();
}

#define XB_TMO      128
#define XB_XCNT(j)  (256  + 64 * (j))
#define XB_XSUB(j)  (1280 + 64 * (j))
#define XB_XGEN(j)  (2304 + 64 * (j))
#define XB_TOP      3328
#define XB_TOPGEN   3392
#define XCD_BAR_WORDS 3456
#define XB_SPIN_CAP (1u << 18)
__device__ __forceinline__ unsigned xb_ld(unsigned* p)              { return __hip_atomic_load(p, __ATOMIC_RELAXED, __HIP_MEMORY_SCOPE_AGENT); }
__device__ __forceinline__ unsigned xb_add(unsigned* p, unsigned v) { return __hip_atomic_fetch_add(p, v, __ATOMIC_RELAXED, __HIP_MEMORY_SCOPE_AGENT); }
__device__ __forceinline__ unsigned xb_xcc_id() { return (unsigned)__builtin_amdgcn_s_getreg((3 << 11) | 20) & 0xFu; }
#define XB_SPIN(cond, bar) do { unsigned _sp = 0; while (cond) { __builtin_amdgcn_s_sleep(1); \
    if ((++_sp & 255u) == 0u) { if (xb_ld(&(bar)[XB_TMO])) break; if (_sp > XB_SPIN_CAP) { atomicAdd(&(bar)[XB_TMO], 1u); break; } } } } while (0)
struct XcdBarrier { unsigned* bar; unsigned x; volatile LAS unsigned* st; };
__device__ __forceinline__ XcdBarrier xcd_barrier_post(unsigned* bar, volatile LAS unsigned* st) {
    XcdBarrier b; b.bar = bar; b.x = xb_xcc_id(); b.st = st;
    if (threadIdx.x == 0) (void)xb_add(&bar[XB_XCNT(b.x)], 1u);
    return b;
}
__device__ __forceinline__ void xcd_barrier_complete(unsigned* bar, unsigned x, unsigned& nloc, unsigned& nx) {
    const unsigned G = gridDim.x * gridDim.y * gridDim.z;
    unsigned sum, cnt, mine, sp = 0u;
    for (;;) {
        sum = 0u; cnt = 0u; mine = 0u;
#pragma unroll
        for (unsigned j = 0; j < 16; ++j) { const unsigned c = xb_ld(&bar[XB_XCNT(j)]); sum += c; cnt += (c > 0u) ? 1u : 0u; mine = (j == x) ? c : mine; }
        if (sum == G) break;
        __builtin_amdgcn_s_sleep(1);
        if ((++sp & 255u) == 0u) { if (xb_ld(&bar[XB_TMO])) break; if (sp > XB_SPIN_CAP) { atomicAdd(&bar[XB_TMO], 1u); break; } }
    }
    nloc = mine > 0u ? mine : 1u; nx = cnt > 0u ? cnt : 1u;
}
__device__ __forceinline__ void xcd_barrier(const XcdBarrier& b) {
    asm volatile("s_waitcnt vmcnt(0)" ::: "memory");
    __syncthreads();
    if (threadIdx.x == 0) {
        unsigned* bar = b.bar;
        __builtin_amdgcn_s_waitcnt(0);
        unsigned nloc = b.st[0], nx = b.st[1];
        if (nloc == 0u) { xcd_barrier_complete(bar, b.x, nloc, nx); b.st[0] = nloc; b.st[1] = nx; }
        const unsigned old = xb_add(&bar[XB_XSUB(b.x)], 1u);
        const unsigned gen = old / nloc;
        if (old + 1u == (gen + 1u) * nloc) {
            __builtin_amdgcn_fence(__ATOMIC_RELEASE, "agent");
            asm volatile("s_waitcnt vmcnt(0)" ::: "memory");
            const unsigned og = xb_add(&bar[XB_TOP], 1u);
            const unsigned tg = og / nx;
            if (og + 1u == (tg + 1u) * nx) xb_add(&bar[XB_TOPGEN], 1u);
            else XB_SPIN(xb_ld(&bar[XB_TOPGEN]) == tg, bar);
            __builtin_amdgcn_fence(__ATOMIC_ACQUIRE, "agent");
            xb_add(&bar[XB_XGEN(b.x)], 1u);
            asm volatile("s_waitcnt vmcnt(0)" ::: "memory");
        } else {
            XB_SPIN(xb_ld(&bar[XB_XGEN(b.x)]) == gen, bar);
            __builtin_amdgcn_fence(__ATOMIC_ACQUIRE, "agent");
            asm volatile("s_waitcnt vmcnt(0)" ::: "memory");
        }
    }
    __syncthreads();
}

__device__ __forceinline__ float wave_sum(float v) {
#pragma unroll
    for (int o = 1; o < 64; o <<= 1) v += __shfl_xor(v, o);
    return v;
}
__device__ __forceinline__ int phys_even(int n) {
    if (n >= 4608) return n;
    const int seg = n / 768; if (seg == 2 || seg == 5) return n;
    const int i = n & 127, hb = n - i, ii = i & 63, g = ii >> 2, e = (ii & 3) + ((i >> 6) << 2);
    return hb + 8 * g + e;
}
__device__ __forceinline__ int phys_odd(int n) {
    if (n < 1728) { const int i = n & 63, hb = n - i, ii = i & 31, g = ii >> 2, e = (ii & 3) + ((i >> 5) << 2); return hb + 8 * g + e; }
    if (n < 1920) return n + 64;
    return n + 128;
}
__device__ __forceinline__ void convert_item(const float* W, int N, const float* gk, bf16_t* WT, int mapkind, int rowoff, int item, int lane) {
    const int nblk = N / 64, kb = item / nblk, nb = item % nblk, k0 = 64 * kb, n = 64 * nb + lane;
    const int p = (mapkind == 1 ? phys_even(n) : (mapkind == 2 ? phys_odd(n) : n)) + rowoff;
    const float* src = W + (size_t)k0 * N + n;
    bf16_t* dst = WT + (size_t)p * KDIM + k0;
    float v[64];
#pragma unroll
    for (int j = 0; j < 64; ++j) v[j] = __builtin_nontemporal_load(src + (size_t)j * N);
    if (gk) {
#pragma unroll
        for (int j = 0; j < 64; ++j) v[j] *= gk[k0 + j];
    }
#pragma unroll
    for (int kk = 0; kk < 8; ++kk) { u32x4 o; o.x = pk2(v[8 * kk], v[8 * kk + 1]); o.y = pk2(v[8 * kk + 2], v[8 * kk + 3]); o.z = pk2(v[8 * kk + 4], v[8 * kk + 5]); o.w = pk2(v[8 * kk + 6], v[8 * kk + 7]);
        *(u32x4*)(dst + 8 * kk) = o; }
}

struct Args {
    const float* x; const float* mem; const int* pos;
    const float* even_norm; const float* even_w_in; const float* even_w_mkv; const float* even_w_out;
    const float* odd_norm; const float* odd_w_in; const float* odd_w_mkv; const float* odd_w_out; const float* odd_sinks;
    const float* mem_norm; const float* final_norm;
    float* out; unsigned char* ws;
    int ph_lo, ph_hi;
};
constexpr int N_PHASES = 18;

constexpr int NUNITS_EVEN = 1088, NUNITS_ODD = 512;
__device__ __forceinline__ bool unit_d64(int idx, int l) { return (l & 1) && idx >= 128; }
__device__ __forceinline__ void decode_kv(int idx, int l, KVD& d) {
    d.kvsel = 0; d.kd1 = 0; d.ksub = 64; d.koff1 = 32;
    if (!(l & 1)) {
        if (idx < 384) { const int n = 7 - idx / 48, rem = idx % 48, s = rem / 24, bh = rem % 24, b = bh / 6, h = bh % 6; const int tb = b * SEQ * EVEN_N;
            d.koff = tb + 3072 + h * 128; d.voff = tb + 3840 + h * 128; d.ks = EVEN_N; d.L = SEQ; d.kt0 = 128 * (n + 1) * s; d.nst = 2 * (n + 1);
        } else if (idx < 768) { const int i = idx - 384, pat = i / 192, j = i % 192, bh = j % 24, rr = j / 24, b = bh / 6, h = bh % 6;
            const int dil = pat ? 4 : 1, res = pat ? (rr & 3) : 0, kblk = pat ? (rr >> 2) : rr; const int tb = (b * SEQ + res) * EVEN_N;
            d.koff = tb + 768 + h * 128; d.voff = tb + 1536 + h * 128; d.ks = dil * EVEN_N; d.L = SEQ / dil; d.kt0 = (256 * kblk - 128) < 0 ? 0 : (256 * kblk - 128); d.nst = (256 * kblk + 256 - d.kt0) / 64;
        } else if (idx < 896) { const int i = idx - 768, b = i / 32, hm = (i / 8) % 4;
            d.kvsel = 1; d.koff = b * MEML * 4096 + l * 1024 + hm * 128; d.voff = d.koff + 512; d.ks = 4096; d.L = MEML; d.kt0 = 0; d.nst = 4;
        } else { const int i = idx - 896, bh = i % 24, u8 = i / 24, b = bh / 6, h = bh % 6; const int tp = (b * SEQ + 2 * u8) * EVEN_N;
            d.koff = tp + 768 + h * 128; d.voff = tp + 1536 + h * 128; d.kd1 = EVEN_N; d.ks = 16 * EVEN_N; d.L = 128; d.kt0 = 0; d.nst = 4; d.ksub = 32; d.koff1 = 0;
        }
    } else {
        if (idx < 128) { const int i = idx, b = i / 32, hm = (i / 8) % 4;
            d.kvsel = 1; d.koff = b * MEML * 4096 + l * 1024 + hm * 128; d.voff = d.koff + 512; d.ks = 4096; d.L = MEML; d.kt0 = 0; d.nst = 4;
        } else { const int i = idx - 128, b = i / 96, g = (i / 32) % 3, pblk = i % 32; const int tb = b * SEQ * ODD_NP;
            d.koff = tb + 1536 + g * 64; d.voff = tb + 1792 + g * 64; d.ks = ODD_NP; d.L = SEQ; d.kt0 = (64 * pblk - 128) < 0 ? 0 : (64 * pblk - 128); d.nst = (64 * pblk + 64 - d.kt0) / 64;
        }
    }
}
__device__ __forceinline__ void decode_q(int idx, int l, int wave, AU& u) {
    u.moba_n = -1; u.band = 1 << 28; u.causal = 1; u.pair = 0; u.whalf = 0; u.kmoff = 0; u.tbase = 0;
    if (!(l & 1)) {
        if (idx < 384) { const int n = 7 - idx / 48, rem = idx % 48, s = rem / 24, bh = rem % 24, b = bh / 6, h = bh % 6;
            u.qoff = b * SEQ * EVEN_N + 2304 + h * 128; u.qs = EVEN_N; u.qrow_w = 256 * n + 32 * wave; u.moba_n = n; u.tbase = 2 * (n + 1) * s;
            u.kmoff = (l >> 1) * (4 * 6 * 8 * 128) + ((b * 6 + h) * 8) * 128;
        } else if (idx < 768) { const int i = idx - 384, pat = i / 192, j = i % 192, bh = j % 24, rr = j / 24, b = bh / 6, h = bh % 6;
            const int dil = pat ? 4 : 1, res = pat ? (rr & 3) : 0, kblk = pat ? (rr >> 2) : rr;
            u.qoff = (b * SEQ + res) * EVEN_N + h * 128; u.qs = dil * EVEN_N; u.qrow_w = 256 * kblk + 32 * wave; u.band = 128;
        } else if (idx < 896) { const int i = idx - 768, b = i / 32, hm = (i / 8) % 4, blk = i % 8;
            u.qoff = b * SEQ * EVEN_N + 4608 + hm * 128; u.qs = EVEN_N; u.qrow_w = 256 * blk + 32 * wave; u.causal = 0;
        } else { const int i = idx - 896, bh = i % 24, u8 = i / 24, b = bh / 6, h = bh % 6; const int wh = wave >> 2;
            u.qoff = (b * SEQ + 2 * u8 + wh) * EVEN_N + h * 128; u.qs = 16 * EVEN_N; u.qrow_w = 32 * (wave & 3); u.pair = 1; u.whalf = wh; u.band = 128;
        }
    } else {
        if (idx < 128) { const int i = idx, b = i / 32, hm = (i / 8) % 4, blk = i % 8;
            u.qoff = b * SEQ * ODD_NP + 2048 + hm * 128; u.qs = ODD_NP; u.qrow_w = 256 * blk + 32 * wave; u.causal = 0;
        } else { const int i = idx - 128, b = i / 96, g = (i / 32) % 3, pblk = i % 32, hq = 8 * g + wave;
            u.qoff = b * SEQ * ODD_NP + hq * 64; u.qs = ODD_NP; u.qrow_w = 64 * pblk; u.band = 127;
        }
    }
}
__device__ __forceinline__ void decode_epi(int idx, int l, int wave, const float* sinks, AE& e) {
    e.has_sink = 0; e.sink = 0.f; e.lseoff = 0; e.lses = 0; e.goff = 0; e.gs = 0;
    if (!(l & 1)) {
        if (idx < 384) { const int rem = idx % 48, s = rem / 24, bh = rem % 24, b = bh / 6, h = bh % 6; const int tok0 = b * SEQ;
            e.epi = 0; e.ooff = (3 + s) * NTOK * 768 + tok0 * 768 + h * 128; e.os = 768; e.lseoff = (3 + s) * NTOK * 6 + tok0 * 6 + h; e.lses = 6;
        } else if (idx < 768) { const int i = idx - 384, pat = i / 192, j = i % 192, bh = j % 24, rr = j / 24, b = bh / 6, h = bh % 6;
            const int dil = pat ? 4 : 1, res = pat ? (rr & 3) : 0; const int tok0 = b * SEQ + res;
            e.epi = 0; e.ooff = pat * NTOK * 768 + tok0 * 768 + h * 128; e.os = dil * 768; e.lseoff = pat * NTOK * 6 + tok0 * 6 + h; e.lses = dil * 6;
        } else if (idx < 896) { const int i = idx - 768, b = i / 32, hm = (i / 8) % 4;
            e.epi = 1; e.ooff = b * SEQ * DM + 1536 + hm * 128; e.os = DM; e.goff = b * SEQ * EVEN_N + 5120 + 1536 + hm * 128; e.gs = EVEN_N;
        } else { const int i = idx - 896, bh = i % 24, u8 = i / 24, b = bh / 6, h = bh % 6; const int tokw = b * SEQ + 2 * u8 + (wave >> 2);
            e.epi = 0; e.ooff = 2 * NTOK * 768 + tokw * 768 + h * 128; e.os = 16 * 768; e.lseoff = 2 * NTOK * 6 + tokw * 6 + h; e.lses = 16 * 6;
        }
    } else {
        if (idx < 128) { const int i = idx, b = i / 32, hm = (i / 8) % 4;
            e.epi = 1; e.ooff = b * SEQ * DM + 1536 + hm * 128; e.os = DM; e.goff = b * SEQ * ODD_NP + 2560 + 1536 + hm * 128; e.gs = ODD_NP;
        } else { const int i = idx - 128, b = i / 96, g = (i / 32) % 3, hq = 8 * g + wave;
            e.epi = 1; e.ooff = b * SEQ * DM + hq * 64; e.os = DM; e.goff = b * SEQ * ODD_NP + 2560 + hq * 64; e.gs = ODD_NP;
            e.has_sink = 1; e.sink = sinks[(l >> 1) * 24 + hq];
        }
    }
}


constexpr int I_E = 32 * (EVEN_N / 64), I_O = 32 * (ODD_N / 64), I_W = 32 * (DM / 64), I_M = 32 * (1024 / 64);
constexpr int CV_A = I_E + 4 * I_M + I_W, CV_B = CV_A + I_O, CV_C = CV_B + I_E + I_W, CV_D = CV_C + I_O + 2 * I_W;
typedef __attribute__((address_space(4))) const Args* KArgsC;
__device__ __forceinline__ void convert_stage(KArgsC ka, unsigned char* ws, int lo, int hi, int worker, int nworkers, int lane) {
    for (int it = lo + worker; it < hi; it += nworkers) {
        int r = it;
        if (r < I_E) { convert_item(ka->even_w_in, EVEN_N, ka->even_norm, (bf16_t*)(ws + WS_WIN_E0), 1, 0, r, lane); continue; } r -= I_E;
        if (r < 4 * I_M) { const int l = r / I_M; r -= l * I_M; const float* W = ((l & 1) ? ka->odd_w_mkv : ka->even_w_mkv) + (size_t)(l >> 1) * DM * 1024;
            convert_item(W, 1024, nullptr, (bf16_t*)(ws + WS_WMKV), 0, l * 1024, r, lane); continue; } r -= 4 * I_M;
        if (r < I_W) { convert_item(ka->even_w_out, DM, nullptr, (bf16_t*)(ws + WS_WOUT), 0, 0, r, lane); continue; } r -= I_W;
        if (r < I_O) { convert_item(ka->odd_w_in, ODD_N, ka->odd_norm, (bf16_t*)(ws + WS_WIN_O0), 2, 0, r, lane); continue; } r -= I_O;
        if (r < I_E) { convert_item(ka->even_w_in + (size_t)DM * EVEN_N, EVEN_N, ka->even_norm + DM, (bf16_t*)(ws + WS_WIN_E1), 1, 0, r, lane); continue; } r -= I_E;
        if (r < I_W) { convert_item(ka->odd_w_out, DM, nullptr, (bf16_t*)(ws + WS_WOUT + (size_t)1 * 8 * MiB), 0, 0, r, lane); continue; } r -= I_W;
        if (r < I_O) { convert_item(ka->odd_w_in + (size_t)DM * ODD_N, ODD_N, ka->odd_norm + DM, (bf16_t*)(ws + WS_WIN_O1), 2, 0, r, lane); continue; } r -= I_O;
        { const int l = 2 + r / I_W; r -= (l - 2) * I_W; const float* W = ((l & 1) ? ka->odd_w_out : ka->even_w_out) + (size_t)(l >> 1) * DM * DM;
          convert_item(W, DM, nullptr, (bf16_t*)(ws + WS_WOUT + (size_t)l * 8 * MiB), 0, 0, r, lane); }
    }
}

}

typedef __attribute__((address_space(4))) const Args* KArgs;
#define LAUNDER_S(p) asm volatile("" : "+s"(p))

__global__ void __launch_bounds__(NWAVES * 64, 2) fwd_kernel(Args args_unused) {
    extern __shared__ __attribute__((aligned(16))) unsigned char lds_raw[];
    LAS unsigned char* lds = (LAS unsigned char*)lds_raw;
    volatile LAS unsigned* MISC = (volatile LAS unsigned*)(lds + MISC_OFF);
    const int tid0 = threadIdx.x;
    const int G = gridDim.x; const int bx = blockIdx.x; const int vcu = (G % 8 == 0) ? (bx % 8) * (G / 8) + bx / 8 : bx;
    const KArgs ka0 = (KArgs)__builtin_amdgcn_kernarg_segment_ptr();
    for (int i = tid0; i < (LDS_BYTES - LDSCTL_OFF) / 4; i += NWAVES * 64) ((LAS unsigned*)(lds + LDSCTL_OFF))[i] = 0u;
    __syncthreads();
    XcdBarrier bar; { unsigned char* ws0 = ka0->ws; bar.bar = (unsigned*)(ws0 + WS_CTL) + CW_BAR; bar.x = 0; bar.st = nullptr;
        if (!MK_PER_PHASE) bar = xcd_barrier_post((unsigned*)(ws0 + WS_CTL) + CW_BAR, MISC + 8); }
    const int ph_lo = ka0->ph_lo, ph_hi = ka0->ph_hi;

    unsigned long long tp_acc = 0ull;
    for (int ph = ph_lo; ph < ph_hi; ++ph) {
        unsigned long long tp_t0 = 0ull; if (TPROBE_MASK) tp_t0 = __builtin_amdgcn_s_memrealtime();
        int tid = tid0; asm volatile("" : "+v"(tid));
        const int lane = tid & 63, wave = __builtin_amdgcn_readfirstlane(tid >> 6);
        KArgs ka = ka0; LAUNDER_S(ka);
        unsigned char* ws = ka->ws;
        if (ph == 0 && (AN_MASK & 1)) {
            const int gw = vcu * NWAVES + wave, NGW = G * NWAVES;
            convert_stage(ka, ws, 0, CV_A, gw, NGW, lane);
            bf16_t* XB = (bf16_t*)(ws + WS_XB); bf16_t* MEMN = (bf16_t*)(ws + WS_MEMN); float* SSQ = (float*)(ws + WS_SSQ);
            const float* xin = ka->x; const float* memin = ka->mem; const float* mnorm = ka->mem_norm;
            for (int m = gw; m < NTOK + NMEM; m += NGW) {
                const bool isx = m < NTOK; const int row = isx ? m : m - NTOK;
                const f32x4* xr = (const f32x4*)((isx ? xin : memin) + (size_t)row * DM) + lane;
                f32x4 v[8]; float s = 0.f;
#pragma unroll
                for (int j = 0; j < 8; ++j) { v[j] = __builtin_nontemporal_load(xr + 64 * j); s += (v[j].x * v[j].x + v[j].y * v[j].y) + (v[j].z * v[j].z + v[j].w * v[j].w); }
                s = wave_sum(s);
                unsigned long long* o8 = (unsigned long long*)((isx ? XB : MEMN) + (size_t)row * DM) + lane;
                if (isx) {
                    if (lane < 8) SSQ[(size_t)lane * NTOK + row] = lane == 0 ? s : 0.f;
#pragma unroll
                    for (int j = 0; j < 8; ++j) o8[64 * j] = (unsigned long long)pk2(v[j].x, v[j].y) | ((unsigned long long)pk2(v[j].z, v[j].w) << 32);
                } else {
                    const float rs = 1.0f / sqrtf(s * (1.0f / DM) + EPS);
                    const f32x4* gr = (const f32x4*)mnorm + lane;
#pragma unroll
                    for (int j = 0; j < 8; ++j) { const f32x4 g = gr[64 * j]; o8[64 * j] = (unsigned long long)pk2(v[j].x * rs * g.x, v[j].y * rs * g.y) | ((unsigned long long)pk2(v[j].z * rs * g.z, v[j].w * rs * g.w) << 32); }
                }
            }
            float* CS128 = (float*)(ws + WS_CS128); float* CS64 = (float*)(ws + WS_CS64); const int* posp = ka->pos;
            for (int tk = gw; tk < NTOK; tk += NGW) {
                const float pf = (float)posp[tk];
                { const float inv = expf((float)lane * (float)(-2.0 * 9.210340371976184 / 128.0)); const float ang = pf * inv;
                  const double rev = (double)ang * 0.15915494309189535; const float fr = (float)(rev - rint(rev));
                  CS128[(size_t)tk * 128 + lane] = __builtin_amdgcn_cosf(fr); CS128[(size_t)tk * 128 + 64 + lane] = __builtin_amdgcn_sinf(fr); }
                if (lane < 32) { const float inv = expf((float)lane * (float)(-2.0 * 9.210340371976184 / 64.0)); const float ang = pf * inv;
                  const double rev = (double)ang * 0.15915494309189535; const float fr = (float)(rev - rint(rev));
                  CS64[(size_t)tk * 64 + lane] = __builtin_amdgcn_cosf(fr); CS64[(size_t)tk * 64 + 32 + lane] = __builtin_amdgcn_sinf(fr); }
            }
        } else if (ph == 17 && (AN_MASK & 2) && G != 256) {
            const int gw = vcu * NWAVES + wave, NGW = G * NWAVES;
            const float* ssq = (const float*)(ws + WS_SSQ) + (size_t)4 * 8 * NTOK; float* outp = ka->out; const float* fnorm = ka->final_norm;
            for (int m = gw; m < NTOK; m += NGW) {
                float sq = 0.f;
#pragma unroll
                for (int j = 0; j < 8; ++j) sq += ssq[(size_t)j * NTOK + m];
                const float rs = 1.0f / sqrtf(sq * (1.0f / DM) + EPS);
                f32x4* xr = (f32x4*)(outp + (size_t)m * DM) + lane; const f32x4* gr = (const f32x4*)fnorm + lane;
#pragma unroll
                for (int j = 0; j < 8; ++j) { f32x4 v = xr[64 * j]; const f32x4 g = gr[64 * j]; v = v * rs * g; xr[64 * j] = v; }
            }
        } else if (ph >= 1 && ph <= 16) {
            const int l = (ph - 1) >> 2, sub = (ph - 1) & 3, odd = l & 1, li = l >> 1;
            if ((sub == 0 && (AN_MASK & 4)) || (sub == 3 && (AN_MASK & 8))) {
                GemmP P; P.ws = ws; P.l = l; P.xin = ka->x; P.out = ka->out; P.lds = lds; P.fnorm = ka->final_norm; P.fuse_final = (G == 256) ? 1 : 0;
                Order S; S.G = G; S.c = bx; S.nM0 = NTOK / 256;
                if (sub == 0) { P.mode = EM_INPROJ; P.A = (const bf16_t*)(ws + WS_XB); P.Bt = (const bf16_t*)(ws + (odd ? (li ? WS_WIN_O1 : WS_WIN_O0) : (li ? WS_WIN_E1 : WS_WIN_E0)));
                    S.nN0 = (odd ? ODD_NP : EVEN_N) / 256; S.nwg1 = (l == 0) ? 64 : 0; }
                else { P.mode = EM_OUTPROJ; P.A = (const bf16_t*)(ws + WS_Y); P.Bt = (const bf16_t*)(ws + WS_WOUT + (size_t)l * 8 * MiB); S.nN0 = DM / 256; S.nwg1 = 0; }
                S.nwg0 = S.nM0 * S.nN0;
                gemm_phase(lds, P, S, tid);
                if (sub == 0 && l < 3) {
                    const int nwg = S.nwg0 + S.nwg1, TT = nwg % G, lo = l == 0 ? CV_A : (l == 1 ? CV_B : CV_C), hi = l == 0 ? CV_B : (l == 1 ? CV_C : CV_D);
                    if (TT == 0) convert_stage(ka, ws, lo, hi, bx * NWAVES + wave, G * NWAVES, lane);
                    else if (bx >= TT) convert_stage(ka, ws, lo, hi, (bx - TT) * NWAVES + wave, (G - TT) * NWAVES, lane);
                }
            } else if (sub == 2 && (AN_MASK & 16)) {
                if (!odd) {
                    const float* LSE = (const float*)(ws + WS_LSE); const bf16_t* OG = (const bf16_t*)(ws + WS_OG); const bf16_t* QKV = (const bf16_t*)(ws + WS_QKV); bf16_t* Y = (bf16_t*)(ws + WS_Y);
                    const long NIT = (long)NTOK * 192;
                    for (long it = (long)bx * 512 + tid; it < NIT; it += (long)G * 512) {
                        const int tok = (int)(it / 192), c = (int)(it % 192), isb = c >= 96, cc8 = (isb ? c - 96 : c), h = cc8 >> 4;
                        const int g0 = isb ? 3 : 0;
                        const size_t lb = (size_t)tok * 6 + h, ob = (size_t)tok * 768 + cc8 * 8;
                        const float l0 = LSE[(size_t)g0 * NTOK * 6 + lb], l1 = LSE[(size_t)(g0 + 1) * NTOK * 6 + lb], l2 = isb ? -1e30f : LSE[(size_t)2 * NTOK * 6 + lb];
                        const float mx = fmaxf(l0, fmaxf(l1, l2));
                        float w0 = __expf(l0 - mx), w1 = __expf(l1 - mx), w2 = isb ? 0.f : __expf(l2 - mx); const float inv = 1.0f / (w0 + w1 + w2); w0 *= inv; w1 *= inv; w2 *= inv;
                        const u32x4 a = *(const u32x4*)(OG + (size_t)g0 * NTOK * 768 + ob), b = *(const u32x4*)(OG + (size_t)(g0 + 1) * NTOK * 768 + ob);
                        u32x4 cc = {0u, 0u, 0u, 0u}; if (!isb) cc = *(const u32x4*)(OG + (size_t)2 * NTOK * 768 + ob);
                        const u32x4 g = *(const u32x4*)(QKV + (size_t)tok * EVEN_N + 5120 + c * 8);
                        u32x4 o;
#define CMB(f) cvt_pk_bf16((w0 * bflo(a.f) + w1 * bflo(b.f) + w2 * bflo(cc.f)) * bflo(g.f), (w0 * bfhi(a.f) + w1 * bfhi(b.f) + w2 * bfhi(cc.f)) * bfhi(g.f))
                        o.x = CMB(x); o.y = CMB(y); o.z = CMB(z); o.w = CMB(w);
#undef CMB
                        *(u32x4*)(Y + (size_t)tok * DM + c * 8) = o;
                    }
                }
            } else if (sub == 1 && (AN_MASK & 32)) {
                gu32* qctr = (gu32*)(ws + WS_CTL) + CW_Q + 64 * l;
                const int NUNITS = odd ? NUNITS_ODD : NUNITS_EVEN;
                int idx = bx, idx1 = G + bx;
                int it = 0, pb = 0; bool warm = false;
                while (idx < NUNITS) {
                    idx = __builtin_amdgcn_readfirstlane(idx); idx1 = __builtin_amdgcn_readfirstlane(idx1);
                    int tid_u = tid; asm volatile("" : "+v"(tid_u)); const int lane_u = tid_u & 63;
                    unsigned nx2 = 0; if (tid == 0) nx2 = 2u * (unsigned)G + __hip_atomic_fetch_add(qctr, 1u, RLX_AGENT);
                    const bool d64 = unit_d64(idx, l);
                    const int pre = (idx1 < NUNITS && unit_d64(idx1, l) == d64) ? 1 : 0;
                    KVD d, dn; decode_kv(idx, l, d); decode_kv(pre ? idx1 : idx, l, dn);
                    AU u; decode_q(idx, l, wave, u);
                    float m_reg, l_reg;
                    if (d64) { if (!warm) cold_start<64>(d, ws, lds + pb * ABUF, wave, lane_u);
                        u32x4 gA[4], gB[4];
                        { const int ic = idx - 128, bc = ic / 96, gc = (ic / 32) % 3;
                          const bf16_t* GBp = (const bf16_t*)(ws + WS_QKV) + (size_t)(bc * SEQ * ODD_NP + 2560 + (8 * gc + wave) * 64) + (size_t)(u.qrow_w + (lane_u >> 3)) * ODD_NP + (lane_u & 7) * 8;
#pragma unroll
                          for (int i = 0; i < 4; ++i) gA[i] = *(const u32x4*)(GBp + (size_t)(i * 8) * ODD_NP); }
                        f32x16 oA[2], oB[2]; float m2[2], l2[2];
                        attn_c_main(u, d, dn, pre, pb, ws, lds, wave, lane_u, m2, l2, oA, oB);
                        int idx2 = idx; LAUNDER_S(idx2); AE e; decode_epi(idx2, l, wave, ka->odd_sinks, e);
                        { const bf16_t* GBp = (const bf16_t*)(ws + WS_QKV) + (size_t)e.goff + (size_t)(u.qrow_w + 32 + (lane_u >> 3)) * e.gs + (lane_u & 7) * 8;
#pragma unroll
                          for (int i = 0; i < 4; ++i) gB[i] = *(const u32x4*)(GBp + (size_t)(i * 8) * e.gs); }
                        attn_epi<64, true>(e, u.qrow_w, pb ^ 1, ws, lds, wave, lane_u, m2[0], l2[0], oA, gA);
                        attn_epi<64, true>(e, u.qrow_w + 32, pb ^ 1, ws, lds, wave, lane_u, m2[1], l2[1], oB, gB); }
                    else { if (!warm) cold_start<128>(d, ws, lds + pb * ABUF, wave, lane_u);
                        f32x16 o[4]; attn_main<128>(u, d, dn, pre, pb, ws, lds, tid_u, wave, lane_u, m_reg, l_reg, o);
                        int idx2 = idx; LAUNDER_S(idx2); AE e; decode_epi(idx2, l, wave, ka->odd_sinks, e); attn_epi<128>(e, u.qrow_w, pb ^ 1, ws, lds, wave, lane_u, m_reg, l_reg, o); }
                    warm = pre != 0;
                    if (tid == 0) MISC[18 + (it & 1)] = nx2;
                    __syncthreads();
                    idx = idx1; idx1 = (int)MISC[18 + (it & 1)]; ++it;
                }
            }
        }
        if (ph + 1 < ph_hi && !(ph == 16 && G == 256)) { if (!(ph >= 1 && ph <= 16 && ((ph - 1) & 3) == 2 && (((ph - 1) >> 2) & 1))) xcd_barrier(bar); }
        if (TPROBE_MASK) { if ((TPROBE_MASK >> ph) & 1) tp_acc += __builtin_amdgcn_s_memrealtime() - tp_t0; }
    }
    if (TPROBE_MASK) { if (bx == 0) { const unsigned long long te = __builtin_amdgcn_s_memrealtime(); while (__builtin_amdgcn_s_memrealtime() - te < 4ull * tp_acc) __builtin_amdgcn_s_sleep(8); } }
}

extern "C" void kernel_launch(void* const* d_in, const int* in_sizes, int n_in, void* d_out, int out_size, void* d_ws, size_t ws_size, hipStream_t stream) {
    static int grid = 0;
    if (grid == 0) {
        if (n_in != 14 || in_sizes[0] != NTOK * DM || out_size != NTOK * DM || ws_size < WS_END) { fprintf(stderr, "kernel_launch: unexpected shapes (n_in %d, in0 %d, out %d, ws %zu)\n", n_in, n_in > 0 ? in_sizes[0] : -1, out_size, ws_size); grid = -1; return; }
        int dev = 0, cus = 0, per_cu = 0;
        if (hipGetDevice(&dev) != hipSuccess || hipDeviceGetAttribute(&cus, hipDeviceAttributeMultiprocessorCount, dev) != hipSuccess) { grid = -1; return; }
        if (hipFuncSetAttribute((const void*)fwd_kernel, hipFuncAttributeMaxDynamicSharedMemorySize, LDS_BYTES) != hipSuccess) { fprintf(stderr, "kernel_launch: hipFuncSetAttribute failed\n"); grid = -1; return; }
        if (hipOccupancyMaxActiveBlocksPerMultiprocessor(&per_cu, (const void*)fwd_kernel, NWAVES * 64, LDS_BYTES) != hipSuccess || per_cu < 1) { fprintf(stderr, "kernel_launch: occupancy query says %d blocks/CU\n", per_cu); }
        (void)hipGetLastError();
        grid = cus;
    }
    if (grid < 0) return;
    (void)hipMemsetAsync((char*)d_ws + WS_CTL, 0, CTL_ZERO_BYTES, stream);
    Args a{};
    a.x = (const float*)d_in[0]; a.mem = (const float*)d_in[1]; a.pos = (const int*)d_in[2];
    a.even_norm = (const float*)d_in[3]; a.even_w_in = (const float*)d_in[4]; a.even_w_mkv = (const float*)d_in[5]; a.even_w_out = (const float*)d_in[6];
    a.odd_norm = (const float*)d_in[7]; a.odd_w_in = (const float*)d_in[8]; a.odd_w_mkv = (const float*)d_in[9]; a.odd_w_out = (const float*)d_in[10]; a.odd_sinks = (const float*)d_in[11];
    a.mem_norm = (const float*)d_in[12]; a.final_norm = (const float*)d_in[13];
    a.out = (float*)d_out; a.ws = (unsigned char*)d_ws;
#if MK_PER_PHASE
    for (int ph = 0; ph < N_PHASES; ++ph) { a.ph_lo = ph; a.ph_hi = ph + 1; hipLaunchKernelGGL(fwd_kernel, dim3(grid), dim3(NWAVES * 64), LDS_BYTES, stream, a); }
#else
    a.ph_lo = 0; a.ph_hi = N_PHASES;
    hipLaunchKernelGGL(fwd_kernel, dim3(grid), dim3(NWAVES * 64), LDS_BYTES, stream, a);
#ifdef PROBE_PHASES
    {
        const int pp[] = PROBE_PHASES;
        (void)hipMemsetAsync((char*)d_ws + WS_CTL + (size_t)CW_Q * 4, 0, 64 * 8 * 4, stream);
        for (unsigned i = 0; i < sizeof(pp) / sizeof(pp[0]); ++i) { a.ph_lo = pp[i]; a.ph_hi = pp[i] + 1; hipLaunchKernelGGL(fwd_kernel, dim3(grid), dim3(NWAVES * 64), LDS_BYTES, stream, a); }
    }
#endif
#endif
    const hipError_t le = hipPeekAtLastError();
    if (le != hipSuccess) fprintf(stderr, "kernel_launch: launch failed: %s\n", hipGetErrorName(le));
}
```

```cpp
#include <hip/hip_runtime.h>
#include <cstdio>
#include <cstdint>

#ifndef TPROBE_MASK
#define TPROBE_MASK 0
#endif
#ifndef AN_MASK
#define AN_MASK 63
#endif
#ifndef MK_PER_PHASE
#define MK_PER_PHASE 0
#endif

namespace {
#define LAS __attribute__((address_space(3)))
#define GAS __attribute__((address_space(1)))
typedef unsigned short bf16_t;
typedef short bf16x8 __attribute__((ext_vector_type(8)));
typedef short s16x4 __attribute__((ext_vector_type(4)));
typedef float f32x4 __attribute__((ext_vector_type(4)));
typedef float f32x16 __attribute__((ext_vector_type(16)));
typedef unsigned u32x4 __attribute__((ext_vector_type(4)));
typedef GAS unsigned gu32;
#define RLX_AGENT __ATOMIC_RELAXED, __HIP_MEMORY_SCOPE_AGENT
#define LDS_WAIT() asm volatile("s_waitcnt lgkmcnt(0)" ::: "memory")
#define VM_WAIT() asm volatile("s_waitcnt vmcnt(0)" ::: "memory")
#define SBAR() __builtin_amdgcn_sched_barrier(0)

constexpr int BATCH = 4, SEQ = 2048, DM = 2048, NTOK = BATCH * SEQ, MEML = 256, NMEM = BATCH * MEML;
constexpr int EVEN_N = 7168, ODD_N = 4480, ODD_NP = 4608;
constexpr int KDIM = 2048;
constexpr float EPS = 1e-6f;
constexpr int NWAVES = 8;

constexpr size_t MiB = 1u << 20;
constexpr size_t WS_CTL = 0, CTL_ZERO_BYTES = 1 * MiB;
constexpr size_t WS_WIN_E0 = 1 * MiB, WS_WIN_E1 = 29 * MiB, WS_WIN_O0 = 57 * MiB, WS_WIN_O1 = 75 * MiB;
constexpr size_t WS_WOUT = 93 * MiB;
constexpr size_t WS_WMKV = 125 * MiB;
constexpr size_t WS_XB = 141 * MiB;
constexpr size_t WS_QKV = 173 * MiB;
constexpr size_t WS_Y = 285 * MiB;
constexpr size_t WS_OG = 374 * MiB;
constexpr size_t WS_XL = 317 * MiB;
constexpr size_t WS_LSE = 353 * MiB;
constexpr size_t WS_MKV = 354 * MiB;
constexpr size_t WS_MEMN = 362 * MiB;
constexpr size_t WS_CS128 = 366 * MiB;
constexpr size_t WS_CS64 = 370 * MiB;
constexpr size_t WS_SSQ = 372 * MiB;
constexpr size_t WS_END = 438 * MiB;
constexpr int CW_BAR = 4096;
constexpr int CW_SSQ = 16384;
constexpr int CW_KM = 65536;
constexpr int CW_Q = 131072;
constexpr int CW_PAN = 135168;
static_assert((CW_PAN + 64 * 32) * 4 <= (int)CTL_ZERO_BYTES, "ctl");

constexpr int RING_BYTES = 131072;
constexpr int LDSCTL_OFF = RING_BYTES, MISC_OFF = LDSCTL_OFF + 320;
constexpr int LDS_BYTES = 147456;
constexpr int XTBL_OFF = LDSCTL_OFF + 1024;

__device__ __forceinline__ unsigned f2bf(float f) { unsigned u = __builtin_bit_cast(unsigned, f); return (u + 0x7fffu + ((u >> 16) & 1u)) >> 16; }
typedef float f32x2_t __attribute__((ext_vector_type(2))); typedef __bf16 bf16x2_t __attribute__((ext_vector_type(2)));
__device__ __forceinline__ unsigned pk2(float lo, float hi) { f32x2_t v = {lo, hi}; bf16x2_t b = __builtin_convertvector(v, bf16x2_t); return __builtin_bit_cast(unsigned, b); }
__device__ __forceinline__ unsigned cvt_pk_bf16(float lo, float hi) { unsigned r; asm volatile("v_cvt_pk_bf16_f32 %0, %1, %2" : "=v"(r) : "v"(lo), "v"(hi)); return r; }
__device__ __forceinline__ float bflo(unsigned w) { return __builtin_bit_cast(float, w << 16); }
__device__ __forceinline__ float bfhi(unsigned w) { return __builtin_bit_cast(float, w & 0xffff0000u); }

constexpr int BM = 256, BK = 64, HALF = 128, HTB = HALF * BK * 2, NXCD = 8, WGM = 8;
__device__ __forceinline__ int lds_byte(int r, int c) { const int st = (r >> 4) * 2 + (c >> 5), rr = r & 15, cc = c & 31, ob = rr * 64 + cc * 2; return st * 1024 + (ob ^ (((ob >> 9) & 1) << 5)); }
__device__ __forceinline__ void stage_rc(int b, int& R, int& C) { const int st = b / 1024, sb = b % 1024, swz = sb ^ (((sb >> 9) & 1) << 5); R = (st >> 1) * 16 + swz / 64; C = (st & 1) * 32 + (swz % 64) / 2; }
__device__ __forceinline__ int perm32(int rho) { const int n = rho >> 4, i = rho & 15; return 8 * (i >> 2) + 4 * n + (i & 3); }

struct Unit { int pm, pn, s; };
enum { EM_PLAIN = 0, EM_INPROJ = 1, EM_OUTPROJ = 2 };
struct GemmP { const bf16_t* A; const bf16_t* Bt; int mode, l; unsigned char* ws; const float* xin; float* out; LAS unsigned char* lds; const float* fnorm; int fuse_final; };
__device__ __forceinline__ void tile_of(int wgid, int nM, int nN, int& pm, int& pn) {
    const int nwg = nM * nN; { const int q = nwg / NXCD, r = nwg % NXCD, xcd = wgid % NXCD, off = wgid / NXCD; wgid = (xcd < r ? xcd * (q + 1) : r * (q + 1) + (xcd - r) * q) + off; }
    const int nig = WGM * nN, gid = wgid / nig, fm = gid * WGM, gsz = (nM - fm) < WGM ? (nM - fm) : WGM;
    pm = fm + ((wgid % nig) % gsz); pn = (wgid % nig) / gsz;
}
struct Order {
    int nwg0, nwg1, nM0, nN0, G, c;
    __device__ __forceinline__ bool next(int i, Unit& u) const {
        const int L = i * G + c; if (L >= nwg0 + nwg1) return false;
        if (L < nwg0) { u.s = 0; tile_of(L, nM0, nN0, u.pm, u.pn); } else { u.s = 1; tile_of(L - nwg0, 4, 16, u.pm, u.pn); }
        return true;
    }
};

__device__ __forceinline__ void epi_run(const GemmP& P, const f32x4 (&acc)[2][2][4][2], const Unit& u, int wr, int wc, int fr, int fq) {
    const int row0 = u.pm * BM + wr * 64 + fr;
    const int colt = u.pn * BM + wc * 32 + 8 * fq;
    const int mode = u.s ? EM_PLAIN : P.mode;
    unsigned char* ws = P.ws;
    if (mode == EM_PLAIN) {
        bf16_t* O = (bf16_t*)(ws + WS_MKV);
#pragma unroll
        for (int ai = 0; ai < 2; ++ai)
#pragma unroll
            for (int m = 0; m < 4; ++m) { bf16_t* rowp = O + (size_t)(row0 + ai * HALF + m * 16) * 4096 + colt;
#pragma unroll
                for (int bj = 0; bj < 2; ++bj) { const f32x4 v0 = acc[ai][bj][m][0], v1 = acc[ai][bj][m][1];
                    u32x4 w; w.x = cvt_pk_bf16(v0[0], v0[1]); w.y = cvt_pk_bf16(v0[2], v0[3]); w.z = cvt_pk_bf16(v1[0], v1[1]); w.w = cvt_pk_bf16(v1[2], v1[3]);
                    *(u32x4*)(rowp + bj * HALF) = w; } }
    } else if (mode == EM_INPROJ) {
        const int l = P.l, odd = l & 1, ldo = odd ? ODD_NP : EVEN_N;
        bf16_t* O = (bf16_t*)(ws + WS_QKV);
        const float* cs128 = (const float*)(ws + WS_CS128); const float* cs64 = (const float*)(ws + WS_CS64);
        float* km = (float*)(ws + WS_CTL) + CW_KM + (size_t)(l >> 1) * (4 * 6 * 8 * 128);
        int kind; bool kmean = false;
        if (odd) { kind = (u.pn <= 6) ? 2 : (u.pn <= 9 ? 0 : 3); }
        else { kind = (u.pn < 6) ? 1 : (u.pn < 9 ? 0 : (u.pn < 15 ? 1 : (u.pn < 20 ? 0 : 3))); kmean = (u.pn >= 12 && u.pn < 15); }
        float ks[2][8];
#pragma unroll
        for (int bj = 0; bj < 2; ++bj)
#pragma unroll
            for (int e = 0; e < 8; ++e) ks[bj][e] = 0.f;
        f32x4 csA[8], snA[8];
#define EPI_TLOAD(I0) do { if (kind == 1) { _Pragma("unroll") for (int i = (I0); i < (I0) + 4; ++i) { const float* t = cs128 + (size_t)(row0 + (i >> 2) * HALF + (i & 3) * 16) * 128 + (16 * wc + 4 * fq); csA[i] = *(const f32x4*)t; snA[i] = *(const f32x4*)(t + 64); } } \
        else if (kind == 2) { _Pragma("unroll") for (int i = (I0); i < (I0) + 4; ++i) { const float* t = cs64 + (size_t)(row0 + (i >> 2) * HALF + (i & 3) * 16) * 64 + (16 * (wc & 1) + 4 * fq); csA[i] = *(const f32x4*)t; snA[i] = *(const f32x4*)(t + 32); } } \
        else { _Pragma("unroll") for (int i = (I0); i < (I0) + 4; ++i) { csA[i] = (f32x4){1.f, 1.f, 1.f, 1.f}; snA[i] = (f32x4){0.f, 0.f, 0.f, 0.f}; } } } while (0)
        EPI_TLOAD(0);
        { const int te = (wr * 4 + wc) * 64 + fq * 16 + fr;
          if (te < 256) { const float* sb = (const float*)(ws + WS_SSQ) + (size_t)l * 8 * NTOK + u.pm * BM; float t8[8];
#pragma unroll
              for (int j = 0; j < 8; ++j) { const float* sj = sb + (size_t)j * NTOK; t8[j] = sj[te]; }
              const float sq = ((t8[0] + t8[1]) + (t8[2] + t8[3])) + ((t8[4] + t8[5]) + (t8[6] + t8[7]));
              ((LAS float*)(P.lds + XTBL_OFF))[te] = __builtin_amdgcn_rsqf(sq * (1.0f / DM) + EPS); }
          LDS_WAIT(); __builtin_amdgcn_s_barrier(); asm volatile("" ::: "memory"); }
        const LAS float* rst = (const LAS float*)(P.lds + XTBL_OFF);
#pragma unroll
        for (int ai = 0; ai < 2; ++ai) {
#pragma unroll
            for (int m = 0; m < 4; ++m) {
                if (ai == 0 && m == 3) { asm volatile("" ::: "memory"); EPI_TLOAD(4); }
                const int row = row0 + ai * HALF + m * 16;
                const float rs = rst[ai * HALF + wr * 64 + m * 16 + fr];
                const f32x4 cs = csA[ai * 4 + m], sn = snA[ai * 4 + m];
                bf16_t* rowp = O + (size_t)row * ldo + colt;
#pragma unroll
                for (int bj = 0; bj < 2; ++bj) {
                    f32x4 v0 = acc[ai][bj][m][0] * rs, v1 = acc[ai][bj][m][1] * rs;
                    if (kind == 1 || kind == 2) { const f32x4 o0 = v0 * cs - v1 * sn, o1 = v1 * cs + v0 * sn; v0 = o0; v1 = o1; }
                    else if (kind == 3) {
#pragma unroll
                        for (int j = 0; j < 4; ++j) { v0[j] = v0[j] * __builtin_amdgcn_rcpf(1.0f + __builtin_amdgcn_exp2f(-1.4426950408889634f * v0[j]));
                                                      v1[j] = v1[j] * __builtin_amdgcn_rcpf(1.0f + __builtin_amdgcn_exp2f(-1.4426950408889634f * v1[j])); }
                    }
                    if (kmean) {
#pragma unroll
                        for (int j = 0; j < 4; ++j) { ks[bj][j] += v0[j]; ks[bj][4 + j] += v1[j]; }
                    }
                    u32x4 w; w.x = cvt_pk_bf16(v0[0], v0[1]); w.y = cvt_pk_bf16(v0[2], v0[3]); w.z = cvt_pk_bf16(v1[0], v1[1]); w.w = cvt_pk_bf16(v1[2], v1[3]);
                    *(u32x4*)(rowp + bj * HALF) = w;
                }
            }
        }
#undef EPI_TLOAD
        if (kmean) {
#pragma unroll
            for (int bj = 0; bj < 2; ++bj)
#pragma unroll
                for (int e = 0; e < 8; ++e) { float s = ks[bj][e]; s += __shfl_xor(s, 1); s += __shfl_xor(s, 2); s += __shfl_xor(s, 4); s += __shfl_xor(s, 8); ks[bj][e] = s; }
            if (fr == 0) {
                const int b = u.pm >> 3, n = u.pm & 7;
#pragma unroll
                for (int bj = 0; bj < 2; ++bj) { const int h = (u.pn - 12) * 2 + bj; float* dst = km + ((size_t)((b * 6 + h) * 8 + n)) * 128 + wc * 32 + 8 * fq;
#pragma unroll
                    for (int e = 0; e < 8; ++e) atomicAdd(dst + e, ks[bj][e]); }
            }
        }
    } else {
        const int l = P.l;
        float* xout = P.out;
        bf16_t* xb = (bf16_t*)(ws + WS_XB); const bool wxb = (l != 3);
        const bool fuse = (l == 3) && P.fuse_final;
        float* ssq_out = (float*)(ws + WS_SSQ) + (size_t)(l + 1) * 8 * NTOK + (size_t)u.pn * NTOK + u.pm * BM;
        LAS float* xt = (LAS float*)(P.lds + XTBL_OFF);
#pragma unroll
        for (int ai = 0; ai < 2; ++ai)
#pragma unroll
            for (int m = 0; m < 4; ++m) {
                const int row = row0 + ai * HALF + m * 16; float ss = 0.f;
#pragma unroll
                for (int bj = 0; bj < 2; ++bj) {
                    const size_t off = (size_t)row * DM + colt + bj * HALF;
                    const f32x4 v0 = acc[ai][bj][m][0], v1 = acc[ai][bj][m][1];
                    if (!fuse && !P.fuse_final) { *(f32x4*)(xout + off) = v0; *(f32x4*)(xout + off + 4) = v1; }
                    if (wxb) { u32x4 w; w.x = cvt_pk_bf16(v0[0], v0[1]); w.y = cvt_pk_bf16(v0[2], v0[3]); w.z = cvt_pk_bf16(v1[0], v1[1]); w.w = cvt_pk_bf16(v1[2], v1[3]); *(u32x4*)(xb + off) = w;
                        if (P.fuse_final) {
                            u32x4 q; q.x = cvt_pk_bf16(v0[0] - bflo(w.x), v0[1] - bfhi(w.x)); q.y = cvt_pk_bf16(v0[2] - bflo(w.y), v0[3] - bfhi(w.y));
                            q.z = cvt_pk_bf16(v1[0] - bflo(w.z), v1[1] - bfhi(w.z)); q.w = cvt_pk_bf16(v1[2] - bflo(w.w), v1[3] - bfhi(w.w));
                            *(u32x4*)((bf16_t*)(ws + WS_XL) + off) = q; } }
                    ss += (v0[0] * v0[0] + v0[1] * v0[1]) + (v0[2] * v0[2] + v0[3] * v0[3]) + (v1[0] * v1[0] + v1[1] * v1[1]) + (v1[2] * v1[2] + v1[3] * v1[3]);
                }
                ss += __shfl_xor(ss, 16); ss += __shfl_xor(ss, 32);
                if (fq == 0) xt[(ai * HALF + wr * 64 + m * 16 + fr) * 4 + wc] = ss;
            }
        LDS_WAIT(); __builtin_amdgcn_s_barrier(); asm volatile("" ::: "memory");
        const int lane = fq * 16 + fr, wid = wr * 4 + wc, r = wid * 32 + (lane & 31);
        if (!fuse) {
            if (lane < 32) { const f32x4 t = *(const LAS f32x4*)(xt + r * 4); ssq_out[r] = (t[0] + t[1]) + (t[2] + t[3]); }
        } else {
            if (lane < 32) { const f32x4 t = *(const LAS f32x4*)(xt + r * 4); __hip_atomic_store((unsigned*)(ssq_out + r), __float_as_uint((t[0] + t[1]) + (t[2] + t[3])), __ATOMIC_RELAXED, __HIP_MEMORY_SCOPE_AGENT); }
            asm volatile("s_waitcnt vmcnt(0)" ::: "memory"); LDS_WAIT();
            __builtin_amdgcn_s_barrier(); asm volatile("" ::: "memory");
            unsigned* pcnt = (unsigned*)(ws + WS_CTL) + CW_PAN + 64 * u.pm;
            if (wid == 0 && lane == 0) {
                __hip_atomic_fetch_add(pcnt, 1u, __ATOMIC_RELAXED, __HIP_MEMORY_SCOPE_AGENT);
                unsigned sp = 0; while (__hip_atomic_load(pcnt, __ATOMIC_RELAXED, __HIP_MEMORY_SCOPE_AGENT) < 8u) { __builtin_amdgcn_s_sleep(2); if (++sp > (1u << 22)) break; }
                __builtin_amdgcn_fence(__ATOMIC_ACQUIRE, "agent"); asm volatile("s_waitcnt vmcnt(0)" ::: "memory");
            }
            __builtin_amdgcn_s_barrier(); asm volatile("" ::: "memory");
            { const int te = wid * 64 + lane;
              if (te < 256) { const unsigned* sb = (const unsigned*)((const float*)(ws + WS_SSQ) + (size_t)4 * 8 * NTOK + u.pm * BM + te); float sq = 0.f;
#pragma unroll
                  for (int j = 0; j < 8; ++j) sq += __uint_as_float(__hip_atomic_load(sb + (size_t)j * NTOK, __ATOMIC_RELAXED, __HIP_MEMORY_SCOPE_AGENT));
                  xt[te] = 1.0f / sqrtf(sq * (1.0f / DM) + EPS); }
              LDS_WAIT(); __builtin_amdgcn_s_barrier(); asm volatile("" ::: "memory"); }
#pragma unroll
            for (int bj = 0; bj < 2; ++bj) {
                const f32x4 g0 = *(const f32x4*)(P.fnorm + colt + bj * HALF), g1 = *(const f32x4*)(P.fnorm + colt + bj * HALF + 4);
#pragma unroll
                for (int ai = 0; ai < 2; ++ai)
#pragma unroll
                    for (int m = 0; m < 4; ++m) {
                        const float rs = xt[ai * HALF + wr * 64 + m * 16 + fr];
                        const size_t off = (size_t)(row0 + ai * HALF + m * 16) * DM + colt + bj * HALF;
                        *(f32x4*)(xout + off) = acc[ai][bj][m][0] * rs * g0; *(f32x4*)(xout + off + 4) = acc[ai][bj][m][1] * rs * g1;
                    }
            }
        }
    }
}

__device__ __forceinline__ void gemm_phase(LAS unsigned char* lds, const GemmP& P, const Order& S, const int tid) {
    const int wid = __builtin_amdgcn_readfirstlane(tid >> 6), lane = tid & 63, wr = wid >> 2, wc = wid & 3, fr = lane & 15, fq = lane >> 4;
    constexpr int K = KDIM, nt = K / BK;
    unsigned voffA[2], voffB[2];
#pragma unroll
    for (int i = 0; i < 2; ++i) { int R, C; stage_rc(tid * 16 + i * 8192, R, C); const int Rb = (R & ~31) + perm32(R & 31);
        voffA[i] = (unsigned)(R * K + C) * 2u; voffB[i] = (unsigned)(Rb * K + C) * 2u; }
    constexpr size_t kstep = (size_t)(BK * 2);
    constexpr size_t hstep = (size_t)HALF * K * 2;
    constexpr size_t tstep = 2 * hstep;
    const unsigned ldsw = (unsigned)wid * 1024u;
    const int aoff = lds_byte(wr * 64 + fr, fq * 8), boff = lds_byte(wc * 32 + fr, fq * 8);
#define PG8_SA(b, h) (((b) * 2 + (h)) * HTB)
#define PG8_SB(b, h) ((4 + (b) * 2 + (h)) * HTB)
#define PG8_STAGE(bufoff, gbase, voff) do { _Pragma("unroll") for (int _i = 0; _i < 2; ++_i) \
        __builtin_amdgcn_global_load_lds((const unsigned*)((const char*)(gbase) + (voff)[_i]), (LAS unsigned*)(lds + (bufoff) + ldsw + _i * 8192), 16, 0, 0); } while (0)
#define PG8_LDA(dst, b, h) do { _Pragma("unroll") for (int m = 0; m < 4; ++m) _Pragma("unroll") for (int k = 0; k < 2; ++k) dst[m][k] = *(const LAS bf16x8*)(lds + PG8_SA(b, h) + aoff + m * 2048 + k * 1024); } while (0)
#define PG8_LDB(dst, b, h) do { _Pragma("unroll") for (int n = 0; n < 2; ++n) _Pragma("unroll") for (int k = 0; k < 2; ++k) dst[n][k] = *(const LAS bf16x8*)(lds + PG8_SB(b, h) + boff + n * 2048 + k * 1024); } while (0)
#define PG8_MMA(ai, bj, At, Bt) do { __builtin_amdgcn_s_setprio(1); _Pragma("unroll") for (int m = 0; m < 4; ++m) _Pragma("unroll") for (int n = 0; n < 2; ++n) _Pragma("unroll") for (int k = 0; k < 2; ++k) \
        acc[ai][bj][m][n] = __builtin_amdgcn_mfma_f32_16x16x32_bf16(Bt[n][k], At[m][k], acc[ai][bj][m][n], 0, 0, 0); __builtin_amdgcn_s_setprio(0); } while (0)
#define PG8_WAIT_V(n) asm volatile("s_waitcnt vmcnt(" #n ")" ::: "memory")
#define PG8_WAIT_L(n) asm volatile("s_waitcnt lgkmcnt(" #n ")" ::: "memory")
#define PG8_BAR __builtin_amdgcn_s_barrier()
#define PG8_SCHED __builtin_amdgcn_sched_barrier(0)
    Unit cur, nxt; int ui = 0;
    if (!S.next(0, cur)) return;
    f32x4 acc[2][2][4][2];
#define PG8_ACC_INIT(U) do { if (P.mode == EM_OUTPROJ && (U).s == 0 && P.l > 0 && P.fuse_final) { \
          \
        const size_t eo = (size_t)((U).pm * BM + wr * 64 + fr) * DM + (U).pn * BM + wc * 32 + 8 * fq; \
        const char* hp = (const char*)(P.ws + WS_XB) + eo * 2; const char* lp = (const char*)(P.ws + WS_XL) + eo * 2; \
        _Pragma("unroll") for (int a = 0; a < 2; ++a) _Pragma("unroll") for (int m = 0; m < 4; ++m) { asm volatile("" : "+v"(hp), "+v"(lp)); \
            _Pragma("unroll") for (int b = 0; b < 2; ++b) { const u32x4 h4 = __builtin_nontemporal_load((const u32x4*)(hp + b * 256)), l4 = __builtin_nontemporal_load((const u32x4*)(lp + b * 256)); \
                acc[a][b][m][0] = (f32x4){bflo(h4.x) + bflo(l4.x), bfhi(h4.x) + bfhi(l4.x), bflo(h4.y) + bflo(l4.y), bfhi(h4.y) + bfhi(l4.y)}; \
                acc[a][b][m][1] = (f32x4){bflo(h4.z) + bflo(l4.z), bfhi(h4.z) + bfhi(l4.z), bflo(h4.w) + bflo(l4.w), bfhi(h4.w) + bfhi(l4.w)}; } \
            hp += (m == 3 ? (size_t)(HALF - 48) : (size_t)16) * DM * 2; lp += (m == 3 ? (size_t)(HALF - 48) : (size_t)16) * DM * 2; } \
    } else if (P.mode == EM_OUTPROJ && (U).s == 0) { \
        const char* rp = (const char*)(P.l == 0 ? P.xin : (const float*)P.out) + ((size_t)((U).pm * BM + wr * 64 + fr) * DM + (U).pn * BM + wc * 32 + 8 * fq) * 4; \
        _Pragma("unroll") for (int a = 0; a < 2; ++a) _Pragma("unroll") for (int m = 0; m < 4; ++m) { asm volatile("" : "+v"(rp)); \
            _Pragma("unroll") for (int b = 0; b < 2; ++b) _Pragma("unroll") for (int n = 0; n < 2; ++n) acc[a][b][m][n] = __builtin_nontemporal_load((const f32x4*)(rp + b * 512 + n * 16)); \
            rp += (m == 3 ? (size_t)(HALF - 48) : (size_t)16) * DM * 4; } \
    } else { _Pragma("unroll") for (int a = 0; a < 2; ++a) _Pragma("unroll") for (int b = 0; b < 2; ++b) _Pragma("unroll") for (int m = 0; m < 4; ++m) _Pragma("unroll") for (int n = 0; n < 2; ++n) acc[a][b][m][n] = (f32x4){0.f, 0.f, 0.f, 0.f}; } } while (0)
    PG8_ACC_INIT(cur);
    bf16x8 At[4][2], B0[2][2], B1[2][2];
    const char* cA = (cur.s ? (const char*)(P.ws + WS_MEMN) : (const char*)P.A) + (size_t)cur.pm * tstep; const char* cB = (cur.s ? (const char*)(P.ws + WS_WMKV) : (const char*)P.Bt) + (size_t)cur.pn * tstep;
    PG8_STAGE(PG8_SB(0, 0), cB, voffB); PG8_STAGE(PG8_SB(0, 1), cB + hstep, voffB); PG8_STAGE(PG8_SA(0, 0), cA, voffA); PG8_STAGE(PG8_SA(0, 1), cA + hstep, voffA);
    if (wr == 1) PG8_BAR;
    PG8_WAIT_V(2); PG8_BAR;
    PG8_STAGE(PG8_SB(1, 0), cB + kstep, voffB); PG8_STAGE(PG8_SA(1, 0), cA + kstep, voffA); PG8_STAGE(PG8_SB(1, 1), cB + hstep + kstep, voffB);
    PG8_WAIT_V(6); PG8_BAR;
    for (;;) {
        const bool has_next = S.next(ui + 1, nxt);
        const char* nA = has_next ? (nxt.s ? (const char*)(P.ws + WS_MEMN) : (const char*)P.A) + (size_t)nxt.pm * tstep : cA; const char* nB = has_next ? (nxt.s ? (const char*)(P.ws + WS_WMKV) : (const char*)P.Bt) + (size_t)nxt.pn * tstep : cB;
        for (int t = 0; t < nt; t += 2) {
            const bool last = (t == nt - 2);
            const char* a1 = cA + (size_t)(t + 1) * kstep;
            const char* a2 = last ? nA : cA + (size_t)(t + 2) * kstep; const char* b2 = last ? nB : cB + (size_t)(t + 2) * kstep;
            const char* a3 = a2 + kstep; const char* b3 = b2 + kstep;
            PG8_LDB(B0, 0, 0); PG8_LDB(B1, 0, 1); PG8_SCHED; PG8_LDA(At, 0, 0); PG8_STAGE(PG8_SA(1, 1), a1 + hstep, voffA);
            PG8_WAIT_V(8); PG8_WAIT_L(0); PG8_BAR; PG8_MMA(0, 0, At, B0); PG8_MMA(0, 1, At, B1); PG8_BAR; PG8_SCHED;
            PG8_LDA(At, 0, 1); PG8_STAGE(PG8_SB(0, 0), b2, voffB); PG8_STAGE(PG8_SB(0, 1), b2 + hstep, voffB); PG8_STAGE(PG8_SA(0, 0), a2, voffA);
            PG8_WAIT_V(8); PG8_WAIT_L(0); PG8_BAR; PG8_MMA(1, 0, At, B0); PG8_MMA(1, 1, At, B1); PG8_BAR; PG8_SCHED;
            PG8_LDB(B0, 1, 0); PG8_LDB(B1, 1, 1); PG8_SCHED; PG8_LDA(At, 1, 0); PG8_STAGE(PG8_SA(0, 1), a2 + hstep, voffA);
            PG8_WAIT_V(8); PG8_WAIT_L(0); PG8_BAR; PG8_MMA(0, 0, At, B0); PG8_MMA(0, 1, At, B1); PG8_BAR; PG8_SCHED;
            PG8_LDA(At, 1, 1); PG8_STAGE(PG8_SB(1, 0), b3, voffB); PG8_STAGE(PG8_SB(1, 1), b3 + hstep, voffB); PG8_STAGE(PG8_SA(1, 0), a3, voffA);
            PG8_WAIT_V(8); PG8_WAIT_L(0); PG8_BAR; PG8_MMA(1, 0, At, B0); PG8_MMA(1, 1, At, B1); PG8_BAR; PG8_SCHED;
        }
        if (wr == 0) PG8_BAR;
        { int lane_e = lane; asm volatile("" : "+v"(lane_e));
          epi_run(P, acc, cur, wr, wc, lane_e & 15, lane_e >> 4); }
        if (!has_next) break;
        PG8_ACC_INIT(nxt);
        cur = nxt; cA = nA; cB = nB; ++ui;
        if (wr == 1) PG8_BAR;
    }
    PG8_WAIT_V(0);
    PG8_BAR;
#undef PG8_ACC_INIT
#undef PG8_SA
#undef PG8_SB
#undef PG8_STAGE
#undef PG8_LDA
#undef PG8_LDB
#undef PG8_MMA
#undef PG8_WAIT_V
#undef PG8_WAIT_L
#undef PG8_BAR
#undef PG8_SCHED
}

struct KVD { int kvsel, koff, voff, kd1, ks, L, kt0, ksub, koff1, nst; };
struct AU { int qoff, qs, qrow_w, band, causal, pair, whalf, moba_n, tbase, kmoff; };
struct AE { int epi, ooff, os, goff, gs, lseoff, lses, has_sink; float sink; };
__device__ __forceinline__ int crow(int r, int hi) { return (r & 3) + 8 * (r >> 2) + 4 * hi; }
typedef short v4i16_t __attribute__((ext_vector_type(4)));
template <int OFF> __device__ __forceinline__ s16x4 tr_read(int vb) { return __builtin_bit_cast(s16x4, __builtin_amdgcn_ds_read_tr16_b64_v4i16((LAS v4i16_t*)(uintptr_t)(unsigned)(vb + OFF))); }
template <int D> __device__ __forceinline__ int kswz(int row, int colB) { if constexpr (D == 128) return row * 256 + (colB ^ ((row & 7) << 4)); else return row * 128 + (colB ^ (((row >> 1) & 7) << 4)); }
template <int D> __device__ __forceinline__ int v_st(int k, int c) { const int kk = (k & ~0xC) | ((k & 4) << 1) | ((k & 8) >> 1); return ((kk >> 3) * (D / 32) + (c >> 5)) * 512 + ((kk & 7) * 32 + (c & 31)) * 2; }
__device__ __forceinline__ int v_rd_base(int lane) { return ((lane & 3) << 3) | (((lane >> 2) & 3) << 6) | (((lane >> 4) & 1) << 5) | (((lane >> 5) & 1) << 8); }
template <int D> constexpr int v_rd_off(int d0, int ks, int half) { return d0 * 512 + (ks * 2 + half) * (D / 32) * 512; }

template <int D, int D0, int HF> __device__ __forceinline__ void pv_half(f32x16& od, int vb, bf16x8 pa, bf16x8 pb) {
    const s16x4 l0 = tr_read<v_rd_off<D>(D0, 2 * HF, 0)>(vb), h0 = tr_read<v_rd_off<D>(D0, 2 * HF, 1)>(vb), l1 = tr_read<v_rd_off<D>(D0, 2 * HF + 1, 0)>(vb), h1 = tr_read<v_rd_off<D>(D0, 2 * HF + 1, 1)>(vb);
#define PKV(Lx, Hx) (bf16x8){Lx[0], Lx[1], Lx[2], Lx[3], Hx[0], Hx[1], Hx[2], Hx[3]}
    od = __builtin_amdgcn_mfma_f32_32x32x16_bf16(pa, PKV(l0, h0), od, 0, 0, 0);
    od = __builtin_amdgcn_mfma_f32_32x32x16_bf16(pb, PKV(l1, h1), od, 0, 0, 0);
#undef PKV
}
template <int D, int HF> __device__ __forceinline__ void pv_all(f32x16* o, int vb, bf16x8 pa, bf16x8 pb) {
    pv_half<D, 0, HF>(o[0], vb, pa, pb); pv_half<D, 1, HF>(o[1], vb, pa, pb);
    if constexpr (D == 128) { pv_half<D, 2, HF>(o[2], vb, pa, pb); pv_half<D, 3, HF>(o[3], vb, pa, pb); }
}
template <int D> struct ACfg { static constexpr int NSUB = (D == 128) ? 2 : 3, KTB = 64 * D * 2; };
constexpr int ABUF = 65536;
__device__ __forceinline__ int swap23(int k) { return (k & ~0xC) | ((k & 4) << 1) | ((k & 8) >> 1); }
template <int D> __device__ __forceinline__ void stage_dma(const KVD& d, const unsigned char* ws, int sub, LAS unsigned char* buf, int slot, int wid, int lane) {
    constexpr int NSUB = ACfg<D>::NSUB, KTB = ACfg<D>::KTB, NBLK = D / 32, NP = KTB / 8192;
    const bf16_t* KVp = (const bf16_t*)(ws + (d.kvsel ? WS_MKV : WS_QKV));
    const int kb = d.kt0 + sub * d.ksub;
    LAS unsigned char* Kt = buf + slot * KTB; LAS unsigned char* Vt = buf + NSUB * KTB + slot * KTB;
#pragma unroll
    for (int i = 0; i < NP; ++i) {
        const int piece = wid + 8 * i;
        int row, c;
        if constexpr (D == 128) { row = piece * 4 + (lane >> 4); c = (lane & 15) ^ (row & 7); } else { row = piece * 8 + (lane >> 3); c = (lane & 7) ^ ((row >> 1) & 7); }
        { const int half = row >> 5; int a = kb + (row & 31) + half * d.koff1; a = a < 0 ? 0 : (a > d.L - 1 ? d.L - 1 : a);
          const bf16_t* src = KVp + d.koff + (size_t)a * d.ks + half * d.kd1 + c * 8;
          __builtin_amdgcn_global_load_lds((const unsigned*)src, (LAS unsigned*)(Kt + piece * 1024), 16, 0, 0); }
        { const int p = piece * 1024 + lane * 16, st = p >> 9, q = (p & 511) >> 1, kk = (st / NBLK) * 8 + (q >> 5), k = swap23(kk), col = (st % NBLK) * 32 + (q & 31);
          const int half = k >> 5; int a = kb + (k & 31) + half * d.koff1; a = a < 0 ? 0 : (a > d.L - 1 ? d.L - 1 : a);
          const bf16_t* src = KVp + d.voff + (size_t)a * d.ks + half * d.kd1 + col;
          __builtin_amdgcn_global_load_lds((const unsigned*)src, (LAS unsigned*)(Vt + piece * 1024), 16, 0, 0); }
    }
}
template <int D> __device__ __forceinline__ void cold_start(const KVD& d, const unsigned char* ws, LAS unsigned char* buf, int wid, int lane) {
#pragma unroll
    for (int sl = 0; sl < ACfg<D>::NSUB; ++sl) if (sl < d.nst) stage_dma<D>(d, ws, sl, buf, sl, wid, lane);
    asm volatile("s_waitcnt vmcnt(0)" ::: "memory");
    __syncthreads();
}

template <int D>
__device__ __forceinline__ void attn_main(const AU& u, const KVD& d, const KVD& dn, const int pre, int& pb, unsigned char* ws, LAS unsigned char* lds, int tid, int wid, int lane,
                                          float& m_out, float& l_out, f32x16 (&o)[D / 32]) {
    constexpr int NQ = D / 16, NB = D / 32, NSUB = ACfg<D>::NSUB, KTB = ACfg<D>::KTB;
    constexpr float SCALE = (D == 128) ? 0.088388347648318440f : 0.125f;
    constexpr float C = SCALE * 1.4426950408889634f;
    constexpr float THRS = 8.0f / SCALE;
    const int r32 = lane & 31, hi = lane >> 5;
    LAS float* wsf = (LAS float*)(lds + XTBL_OFF + wid * 256);
    bf16x8 qr[NQ];
    { const bf16_t* qrow = (const bf16_t*)(ws + WS_QKV) + (size_t)u.qoff + (size_t)(u.qrow_w + r32) * u.qs + hi * 8;
#pragma unroll
      for (int d0 = 0; d0 < NQ; ++d0) qr[d0] = *(const bf16x8*)(qrow + d0 * 16); }
    float m_reg = -1e30f, l_reg = 0.f;
#pragma unroll
    for (int dd = 0; dd < NB; ++dd)
#pragma unroll
        for (int r = 0; r < 16; ++r) o[dd][r] = 0.f;
    const int qidx = u.qrow_w + r32;
    unsigned selmask = 0;
    if constexpr (D == 128) {
        if (u.moba_n > 0) {
            const int n = u.moba_n; float g[7];
#pragma unroll
            for (int j = 0; j < 7; ++j) {
                g[j] = -INFINITY;
                if (j < n) {
                    const float* kmj = (const float*)(ws + WS_CTL) + CW_KM + u.kmoff + j * 128 + hi * 8; float s = 0.f;
#pragma unroll
                    for (int d0 = 0; d0 < NQ; ++d0) { const f32x4 a = *(const f32x4*)(kmj + d0 * 16), b = *(const f32x4*)(kmj + d0 * 16 + 4);
                        const u32x4 qw = __builtin_bit_cast(u32x4, qr[d0]);
                        s += bflo(qw.x) * a[0] + bfhi(qw.x) * a[1] + bflo(qw.y) * a[2] + bfhi(qw.y) * a[3] + bflo(qw.z) * b[0] + bfhi(qw.z) * b[1] + bflo(qw.w) * b[2] + bfhi(qw.w) * b[3]; }
                    auto rr = __builtin_amdgcn_permlane32_swap(__float_as_uint(s), __float_as_uint(s), false, false);
                    g[j] = __uint_as_float(rr[0]) + __uint_as_float(rr[1]);
                }
            }
#pragma unroll
            for (int j = 0; j < 7; ++j) { int cnt = 0;
#pragma unroll
                for (int i = 0; i < 7; ++i) if (i != j) cnt += (i < n && (g[i] > g[j] || (g[i] == g[j] && i < j))) ? 1 : 0;
                if (j < n && cnt < 3) selmask |= (1u << j); }
        }
    }
    const int nsteps = (d.nst + NSUB - 1) / NSUB;
    for (int st = 0; st < nsteps; ++st) {
        LAS unsigned char* bufc = lds + pb * ABUF; LAS unsigned char* bufn = lds + (pb ^ 1) * ABUF;
        const bool lastst = (st + 1 == nsteps);
#pragma unroll 1
        for (int sl = 0; sl < NSUB; ++sl) {
            const int sub = st * NSUB + sl;
            if (!lastst) { if (sub + NSUB < d.nst) stage_dma<D>(d, ws, sub + NSUB, bufn, sl, wid, lane); }
            else if (pre) { if (sl < dn.nst) stage_dma<D>(dn, ws, sl, bufn, sl, wid, lane); }
            if (sub < d.nst) {
                const int kb0 = d.kt0 + sub * d.ksub, kb1 = kb0 + d.koff1;
                int lo_q, hi_q;
                const int tabs = u.tbase + sub;
                if (u.moba_n >= 0 && tabs < 4 * u.moba_n) { const bool sel = (selmask >> (tabs >> 2)) & 1u; lo_q = sel ? -(1 << 28) : (1 << 28); hi_q = sel ? (1 << 28) : -(1 << 28); }
                else { lo_q = qidx - u.band; hi_q = u.causal ? qidx : (1 << 28); }
                bool any0 = __any(lo_q <= kb0 + 31 && hi_q >= kb0), any1 = __any(lo_q <= kb1 + 31 && hi_q >= kb1);
                if (u.pair) { any0 = any0 && (u.whalf == 0); any1 = any1 && (u.whalf == 1); }
#define HALF_STEP(HF, ANY, KBH) do { if (ANY) { \
                    const bool allv = __all(lo_q <= (KBH) && hi_q >= (KBH) + 31); \
                    f32x16 p; _Pragma("unroll") for (int r = 0; r < 16; ++r) p[r] = 0.f; \
                    LAS unsigned char* Kt = bufc + sl * KTB; \
                    _Pragma("unroll") for (int d0 = 0; d0 < NQ; ++d0) { const bf16x8 bk = *(const LAS bf16x8*)(Kt + kswz<D>(32 * (HF) + r32, (d0 * 16 + hi * 8) * 2)); p = __builtin_amdgcn_mfma_f32_32x32x16_bf16(bk, qr[d0], p, 0, 0, 0); } \
                    if (!allv) { _Pragma("unroll") for (int r = 0; r < 16; ++r) { const int kk = (KBH) + crow(r, hi); if (kk < lo_q || kk > hi_q) p[r] = -INFINITY; } } \
                    float pmax = p[0]; _Pragma("unroll") for (int r = 1; r < 16; ++r) pmax = fmaxf(pmax, p[r]); \
                    { auto rr = __builtin_amdgcn_permlane32_swap(__float_as_uint(pmax), __float_as_uint(pmax), false, false); pmax = fmaxf(__uint_as_float(rr[0]), __uint_as_float(rr[1])); } \
                    float alpha = 1.f; \
                    if (!__all(pmax - m_reg <= THRS)) { const float mn = fmaxf(m_reg, pmax); alpha = __builtin_amdgcn_exp2f((m_reg - mn) * C); m_reg = mn; } \
                    const float mnC = -m_reg * C; float ps = 0.f; \
                    _Pragma("unroll") for (int r = 0; r < 16; ++r) { p[r] = __builtin_amdgcn_exp2f(fmaf(p[r], C, mnC)); ps += p[r]; } \
                    { auto rr = __builtin_amdgcn_permlane32_swap(__float_as_uint(ps), __float_as_uint(ps), false, false); ps = __uint_as_float(rr[0]) + __uint_as_float(rr[1]); } \
                    l_reg = l_reg * alpha + ps; \
                    if (__any(alpha < 1.f)) { if (hi == 0) wsf[r32] = alpha; LDS_WAIT(); \
                        _Pragma("unroll") for (int dd = 0; dd < NB; ++dd) _Pragma("unroll") for (int r = 0; r < 16; ++r) o[dd][r] *= wsf[crow(r, hi)]; \
                        LDS_WAIT(); } \
                    bf16x8 paA, paB; PK4(p, 0, paA); PK4(p, 8, paB); \
                    const int vb = (int)(uintptr_t)(bufc + NSUB * KTB + sl * KTB) + v_rd_base(lane); \
                    pv_all<D, HF>(o, vb, paA, paB); } } while (0)
#define PK4(P, BASE, OUT) do { unsigned a0 = cvt_pk_bf16(P[BASE + 0], P[BASE + 1]), a1 = cvt_pk_bf16(P[BASE + 2], P[BASE + 3]);   \
    unsigned b0 = cvt_pk_bf16(P[BASE + 4], P[BASE + 5]), b1 = cvt_pk_bf16(P[BASE + 6], P[BASE + 7]);                              \
    auto r0 = __builtin_amdgcn_permlane32_swap(a0, b0, false, false); auto r1 = __builtin_amdgcn_permlane32_swap(a1, b1, false, false); \
    u32x4 w = {r0[0], r1[0], r0[1], r1[1]}; OUT = __builtin_bit_cast(bf16x8, w); } while (0)
                HALF_STEP(0, any0, kb0);
                HALF_STEP(1, any1, kb1);
#undef PK4
#undef HALF_STEP
            }
        }
        asm volatile("s_waitcnt vmcnt(0)" ::: "memory");
        __syncthreads();
        pb ^= 1;
    }
    m_out = m_reg; l_out = l_reg;
}

__device__ __forceinline__ void attn_c_main(const AU& u, const KVD& d, const KVD& dn, const int pre, int& pb, unsigned char* ws, LAS unsigned char* lds, int wid, int lane,
                                            float (&m_out)[2], float (&l_out)[2], f32x16 (&oA)[2], f32x16 (&oB)[2]) {
    constexpr int D = 64, NQ = 4, NSUB = 3, KTB = 8192;
    constexpr float SCALE = 0.125f, C = SCALE * 1.4426950408889634f, THRS = 8.0f / SCALE;
    const int r32 = lane & 31, hi = lane >> 5;
    LAS float* wsf = (LAS float*)(lds + XTBL_OFF + wid * 256);
    bf16x8 qA[NQ], qB[NQ];
    { const bf16_t* qrow = (const bf16_t*)(ws + WS_QKV) + (size_t)u.qoff + (size_t)(u.qrow_w + r32) * u.qs + hi * 8;
#pragma unroll
      for (int d0 = 0; d0 < NQ; ++d0) { qA[d0] = *(const bf16x8*)(qrow + d0 * 16); qB[d0] = *(const bf16x8*)(qrow + (size_t)32 * u.qs + d0 * 16); } }
    float mA = -1e30f, lA = 0.f, mB = -1e30f, lB = 0.f;
#pragma unroll
    for (int dd = 0; dd < 2; ++dd)
#pragma unroll
        for (int r = 0; r < 16; ++r) { oA[dd][r] = 0.f; oB[dd][r] = 0.f; }
    const int qiA = u.qrow_w + r32, qiB = qiA + 32;
    const int loA = qiA - u.band, loB = qiB - u.band;
    LAS unsigned char* bufc = lds + pb * ABUF; LAS unsigned char* bufn = lds + (pb ^ 1) * ABUF;
#define PK4(P, BASE, OUT) do { unsigned a0 = cvt_pk_bf16(P[BASE + 0], P[BASE + 1]), a1 = cvt_pk_bf16(P[BASE + 2], P[BASE + 3]);   \
    unsigned b0 = cvt_pk_bf16(P[BASE + 4], P[BASE + 5]), b1 = cvt_pk_bf16(P[BASE + 6], P[BASE + 7]);                              \
    auto r0 = __builtin_amdgcn_permlane32_swap(a0, b0, false, false); auto r1 = __builtin_amdgcn_permlane32_swap(a1, b1, false, false); \
    u32x4 w = {r0[0], r1[0], r0[1], r1[1]}; OUT = __builtin_bit_cast(bf16x8, w); } while (0)
#define PKV(Lx, Hx) (bf16x8){Lx[0], Lx[1], Lx[2], Lx[3], Hx[0], Hx[1], Hx[2], Hx[3]}
#define C_SINGLE(HF, KBH, QF, LOQ, HIQ, MR, LR, OO) do { \
        f32x16 p; _Pragma("unroll") for (int r = 0; r < 16; ++r) p[r] = 0.f; \
        _Pragma("unroll") for (int d0 = 0; d0 < NQ; ++d0) { const bf16x8 bk = *(const LAS bf16x8*)(Kt + kswz<D>(32 * (HF) + r32, (d0 * 16 + hi * 8) * 2)); p = __builtin_amdgcn_mfma_f32_32x32x16_bf16(bk, QF[d0], p, 0, 0, 0); } \
        _Pragma("unroll") for (int r = 0; r < 16; ++r) { const int kk = (KBH) + crow(r, hi); if (kk < (LOQ) || kk > (HIQ)) p[r] = -INFINITY; } \
        float pmax = p[0]; _Pragma("unroll") for (int r = 1; r < 16; ++r) pmax = fmaxf(pmax, p[r]); \
        { auto rr = __builtin_amdgcn_permlane32_swap(__float_as_uint(pmax), __float_as_uint(pmax), false, false); pmax = fmaxf(__uint_as_float(rr[0]), __uint_as_float(rr[1])); } \
        float alpha = 1.f; if (!__all(pmax - MR <= THRS)) { const float mn = fmaxf(MR, pmax); alpha = __builtin_amdgcn_exp2f((MR - mn) * C); MR = mn; } \
        const float mnC = -MR * C; float ps = 0.f; \
        _Pragma("unroll") for (int r = 0; r < 16; ++r) { p[r] = __builtin_amdgcn_exp2f(fmaf(p[r], C, mnC)); ps += p[r]; } \
        { auto rr = __builtin_amdgcn_permlane32_swap(__float_as_uint(ps), __float_as_uint(ps), false, false); ps = __uint_as_float(rr[0]) + __uint_as_float(rr[1]); } \
        LR = LR * alpha + ps; \
        if (__any(alpha < 1.f)) { if (hi == 0) wsf[r32] = alpha; LDS_WAIT(); \
            _Pragma("unroll") for (int dd = 0; dd < 2; ++dd) _Pragma("unroll") for (int r = 0; r < 16; ++r) OO[dd][r] *= wsf[crow(r, hi)]; LDS_WAIT(); } \
        bf16x8 pa, pb2; PK4(p, 0, pa); PK4(p, 8, pb2); \
        pv_all<D, HF>(OO, vb, pa, pb2); } while (0)
#define C_DUAL(HF, KBH) do { \
        f32x16 pa_, pb_; _Pragma("unroll") for (int r = 0; r < 16; ++r) { pa_[r] = 0.f; pb_[r] = 0.f; } \
        _Pragma("unroll") for (int d0 = 0; d0 < NQ; ++d0) { const bf16x8 bk = *(const LAS bf16x8*)(Kt + kswz<D>(32 * (HF) + r32, (d0 * 16 + hi * 8) * 2)); \
            pa_ = __builtin_amdgcn_mfma_f32_32x32x16_bf16(bk, qA[d0], pa_, 0, 0, 0); pb_ = __builtin_amdgcn_mfma_f32_32x32x16_bf16(bk, qB[d0], pb_, 0, 0, 0); } \
        _Pragma("unroll") for (int r = 0; r < 16; ++r) { const int kk = (KBH) + crow(r, hi); if (kk < loA || kk > qiA) pa_[r] = -INFINITY; if (kk < loB || kk > qiB) pb_[r] = -INFINITY; } \
        float xa = pa_[0], xb = pb_[0]; _Pragma("unroll") for (int r = 1; r < 16; ++r) { xa = fmaxf(xa, pa_[r]); xb = fmaxf(xb, pb_[r]); } \
        { auto rr = __builtin_amdgcn_permlane32_swap(__float_as_uint(xa), __float_as_uint(xa), false, false); xa = fmaxf(__uint_as_float(rr[0]), __uint_as_float(rr[1])); } \
        { auto rr = __builtin_amdgcn_permlane32_swap(__float_as_uint(xb), __float_as_uint(xb), false, false); xb = fmaxf(__uint_as_float(rr[0]), __uint_as_float(rr[1])); } \
        float alA = 1.f, alB = 1.f; \
        if (!__all(xa - mA <= THRS && xb - mB <= THRS)) { const float na = fmaxf(mA, xa), nb = fmaxf(mB, xb); alA = __builtin_amdgcn_exp2f((mA - na) * C); alB = __builtin_amdgcn_exp2f((mB - nb) * C); mA = na; mB = nb; } \
        const float cA_ = -mA * C, cB_ = -mB * C; float sa = 0.f, sb = 0.f; \
        _Pragma("unroll") for (int r = 0; r < 16; ++r) { pa_[r] = __builtin_amdgcn_exp2f(fmaf(pa_[r], C, cA_)); sa += pa_[r]; pb_[r] = __builtin_amdgcn_exp2f(fmaf(pb_[r], C, cB_)); sb += pb_[r]; } \
        { auto rr = __builtin_amdgcn_permlane32_swap(__float_as_uint(sa), __float_as_uint(sa), false, false); sa = __uint_as_float(rr[0]) + __uint_as_float(rr[1]); } \
        { auto rr = __builtin_amdgcn_permlane32_swap(__float_as_uint(sb), __float_as_uint(sb), false, false); sb = __uint_as_float(rr[0]) + __uint_as_float(rr[1]); } \
        lA = lA * alA + sa; lB = lB * alB + sb; \
        if (__any(alA < 1.f || alB < 1.f)) { if (hi == 0) { wsf[r32] = alA; wsf[32 + r32] = alB; } LDS_WAIT(); \
            _Pragma("unroll") for (int dd = 0; dd < 2; ++dd) _Pragma("unroll") for (int r = 0; r < 16; ++r) { oA[dd][r] *= wsf[crow(r, hi)]; oB[dd][r] *= wsf[32 + crow(r, hi)]; } LDS_WAIT(); } \
        bf16x8 a0_, a1_, b0_, b1_; PK4(pa_, 0, a0_); PK4(pa_, 8, a1_); PK4(pb_, 0, b0_); PK4(pb_, 8, b1_); \
        _Pragma("unroll") for (int d0 = 0; d0 < 2; ++d0) { \
            const s16x4 l0 = __builtin_bit_cast(s16x4, __builtin_amdgcn_ds_read_tr16_b64_v4i16((LAS v4i16_t*)(uintptr_t)(unsigned)(vb + d0 * 512 + ((2 * (HF)) * 2 + 0) * 1024))), \
                        h0 = __builtin_bit_cast(s16x4, __builtin_amdgcn_ds_read_tr16_b64_v4i16((LAS v4i16_t*)(uintptr_t)(unsigned)(vb + d0 * 512 + ((2 * (HF)) * 2 + 1) * 1024))), \
                        l1 = __builtin_bit_cast(s16x4, __builtin_amdgcn_ds_read_tr16_b64_v4i16((LAS v4i16_t*)(uintptr_t)(unsigned)(vb + d0 * 512 + ((2 * (HF) + 1) * 2 + 0) * 1024))), \
                        h1 = __builtin_bit_cast(s16x4, __builtin_amdgcn_ds_read_tr16_b64_v4i16((LAS v4i16_t*)(uintptr_t)(unsigned)(vb + d0 * 512 + ((2 * (HF) + 1) * 2 + 1) * 1024))); \
            const bf16x8 v0_ = PKV(l0, h0), v1_ = PKV(l1, h1); \
            oA[d0] = __builtin_amdgcn_mfma_f32_32x32x16_bf16(a0_, v0_, oA[d0], 0, 0, 0); oB[d0] = __builtin_amdgcn_mfma_f32_32x32x16_bf16(b0_, v0_, oB[d0], 0, 0, 0); \
            oA[d0] = __builtin_amdgcn_mfma_f32_32x32x16_bf16(a1_, v1_, oA[d0], 0, 0, 0); oB[d0] = __builtin_amdgcn_mfma_f32_32x32x16_bf16(b1_, v1_, oB[d0], 0, 0, 0); } } while (0)
#pragma unroll 1
    for (int sl = 0; sl < NSUB; ++sl) {
        if (pre) { if (sl < dn.nst) stage_dma<D>(dn, ws, sl, bufn, sl, wid, lane); }
        if (sl < d.nst) {
            LAS unsigned char* Kt = bufc + sl * KTB;
            const int vb = (int)(uintptr_t)(bufc + NSUB * KTB + sl * KTB) + v_rd_base(lane);
            const int kb0 = d.kt0 + sl * 64, kb1 = kb0 + 32;
            { const bool anA = __any(loA <= kb0 + 31 && qiA >= kb0), anB = __any(loB <= kb0 + 31 && qiB >= kb0);
              if (anA && anB) C_DUAL(0, kb0); else if (anA) C_SINGLE(0, kb0, qA, loA, qiA, mA, lA, oA); else if (anB) C_SINGLE(0, kb0, qB, loB, qiB, mB, lB, oB); }
            { const bool anA = __any(loA <= kb1 + 31 && qiA >= kb1), anB = __any(loB <= kb1 + 31 && qiB >= kb1);
              if (anA && anB) C_DUAL(1, kb1); else if (anA) C_SINGLE(1, kb1, qA, loA, qiA, mA, lA, oA); else if (anB) C_SINGLE(1, kb1, qB, loB, qiB, mB, lB, oB); }
        }
    }
#undef C_DUAL
#undef C_SINGLE
#undef PKV
#undef PK4
    asm volatile("s_waitcnt vmcnt(0)" ::: "memory");
    __syncthreads();
    pb ^= 1;
    m_out[0] = mA; m_out[1] = mB; l_out[0] = lA; l_out[1] = lB;
}

template <int D, bool PRE = false>
__device__ __forceinline__ void attn_epi(const AE& e, int qrow_w, int pbl, unsigned char* ws, LAS unsigned char* lds, int wid, int lane, float m_reg, float l_reg, const f32x16 (&o)[D / 32], const u32x4* gpre = nullptr) {
    constexpr int NB = D / 32;
    constexpr float SCALE = (D == 128) ? 0.088388347648318440f : 0.125f;
    const int r32 = lane & 31, hi = lane >> 5;
    LAS float* wsf = (LAS float*)(lds + XTBL_OFF + wid * 256);
    LAS bf16_t* stg = (LAS bf16_t*)(lds + pbl * ABUF + wid * 8192);
    float lt = l_reg;
    if (e.has_sink) lt += __builtin_amdgcn_exp2f((e.sink - m_reg * SCALE) * 1.4426950408889634f);
    if (hi == 0) wsf[r32] = lt > 0.f ? __builtin_amdgcn_rcpf(lt) : 0.f;
    LDS_WAIT();
    float rli[16];
#pragma unroll
    for (int r = 0; r < 16; ++r) rli[r] = wsf[crow(r, hi)];
    LDS_WAIT();
#pragma unroll
    for (int r = 0; r < 16; ++r) { const int orow = crow(r, hi);
#pragma unroll
        for (int d0 = 0; d0 < NB; ++d0) stg[orow * D + d0 * 32 + r32] = (bf16_t)f2bf(o[d0][r] * rli[r]); }
    LDS_WAIT();
    constexpr int CPR = D / 8, RPP = 64 / CPR;
    bf16_t* OB = (bf16_t*)(ws + (e.epi ? WS_Y : WS_OG));
    const bf16_t* GB = (const bf16_t*)(ws + WS_QKV);
#pragma unroll
    for (int i = 0; i < 32 / RPP; ++i) {
        const int row = i * RPP + lane / CPR, ch = lane % CPR;
        const u32x4 v = *(const LAS u32x4*)(stg + row * D + ch * 8);
        const size_t fidx = (size_t)(qrow_w + row);
        if (e.epi == 1) {
            u32x4 g; if constexpr (PRE) g = gpre[i]; else g = *(const u32x4*)(GB + (size_t)e.goff + fidx * e.gs + ch * 8);
            u32x4 w;
            w.x = cvt_pk_bf16(bflo(v.x) * bflo(g.x), bfhi(v.x) * bfhi(g.x)); w.y = cvt_pk_bf16(bflo(v.y) * bflo(g.y), bfhi(v.y) * bfhi(g.y));
            w.z = cvt_pk_bf16(bflo(v.z) * bflo(g.z), bfhi(v.z) * bfhi(g.z)); w.w = cvt_pk_bf16(bflo(v.w) * bflo(g.w), bfhi(v.w) * bfhi(g.w));
            *(u32x4*)(OB + (size_t)e.ooff + fidx * e.os + ch * 8) = w;
        } else {
            *(u32x4*)(OB + (size_t)e.ooff + fidx * e.os + ch * 8) = v;
        }
    }
    if (e.epi == 0 && hi == 0) ((float*)(ws + WS_LSE))[(size_t)e.lseoff + (size_t)(qrow_w + r32) * e.lses] = l_reg > 0.f ? m_reg * SCALE + __logf(l_reg) : -1e30f;
    LDS_WAIT();
}

#define XB_TMO      128
#define XB_XCNT(j)  (256  + 64 * (j))
#define XB_XSUB(j)  (1280 + 64 * (j))
#define XB_XGEN(j)  (2304 + 64 * (j))
#define XB_TOP      3328
#define XB_TOPGEN   3392
#define XCD_BAR_WORDS 3456
#define XB_SPIN_CAP (1u << 18)
__device__ __forceinline__ unsigned xb_ld(unsigned* p)              { return __hip_atomic_load(p, __ATOMIC_RELAXED, __HIP_MEMORY_SCOPE_AGENT); }
__device__ __forceinline__ unsigned xb_add(unsigned* p, unsigned v) { return __hip_atomic_fetch_add(p, v, __ATOMIC_RELAXED, __HIP_MEMORY_SCOPE_AGENT); }
__device__ __forceinline__ unsigned xb_xcc_id() { return (unsigned)__builtin_amdgcn_s_getreg((3 << 11) | 20) & 0xFu; }
#define XB_SPIN(cond, bar) do { unsigned _sp = 0; while (cond) { __builtin_amdgcn_s_sleep(1); \
    if ((++_sp & 255u) == 0u) { if (xb_ld(&(bar)[XB_TMO])) break; if (_sp > XB_SPIN_CAP) { atomicAdd(&(bar)[XB_TMO], 1u); break; } } } } while (0)
struct XcdBarrier { unsigned* bar; unsigned x; volatile LAS unsigned* st; };
__device__ __forceinline__ XcdBarrier xcd_barrier_post(unsigned* bar, volatile LAS unsigned* st) {
    XcdBarrier b; b.bar = bar; b.x = xb_xcc_id(); b.st = st;
    if (threadIdx.x == 0) (void)xb_add(&bar[XB_XCNT(b.x)], 1u);
    return b;
}
__device__ __forceinline__ void xcd_barrier_complete(unsigned* bar, unsigned x, unsigned& nloc, unsigned& nx) {
    const unsigned G = gridDim.x * gridDim.y * gridDim.z;
    unsigned sum, cnt, mine, sp = 0u;
    for (;;) {
        sum = 0u; cnt = 0u; mine = 0u;
#pragma unroll
        for (unsigned j = 0; j < 16; ++j) { const unsigned c = xb_ld(&bar[XB_XCNT(j)]); sum += c; cnt += (c > 0u) ? 1u : 0u; mine = (j == x) ? c : mine; }
        if (sum == G) break;
        __builtin_amdgcn_s_sleep(1);
        if ((++sp & 255u) == 0u) { if (xb_ld(&bar[XB_TMO])) break; if (sp > XB_SPIN_CAP) { atomicAdd(&bar[XB_TMO], 1u); break; } }
    }
    nloc = mine > 0u ? mine : 1u; nx = cnt > 0u ? cnt : 1u;
}
__device__ __forceinline__ void xcd_barrier(const XcdBarrier& b) {
    asm volatile("s_waitcnt vmcnt(0)" ::: "memory");
    __syncthreads();
    if (threadIdx.x == 0) {
        unsigned* bar = b.bar;
        __builtin_amdgcn_s_waitcnt(0);
        unsigned nloc = b.st[0], nx = b.st[1];
        if (nloc == 0u) { xcd_barrier_complete(bar, b.x, nloc, nx); b.st[0] = nloc; b.st[1] = nx; }
        const unsigned old = xb_add(&bar[XB_XSUB(b.x)], 1u);
        const unsigned gen = old / nloc;
        if (old + 1u == (gen + 1u) * nloc) {
            __builtin_amdgcn_fence(__ATOMIC_RELEASE, "agent");
            asm volatile("s_waitcnt vmcnt(0)" ::: "memory");
            const unsigned og = xb_add(&bar[XB_TOP], 1u);
            const unsigned tg = og / nx;
            if (og + 1u == (tg + 1u) * nx) xb_add(&bar[XB_TOPGEN], 1u);
            else XB_SPIN(xb_ld(&bar[XB_TOPGEN]) == tg, bar);
            __builtin_amdgcn_fence(__ATOMIC_ACQUIRE, "agent");
            xb_add(&bar[XB_XGEN(b.x)], 1u);
            asm volatile("s_waitcnt vmcnt(0)" ::: "memory");
        } else {
            XB_SPIN(xb_ld(&bar[XB_XGEN(b.x)]) == gen, bar);
            __builtin_amdgcn_fence(__ATOMIC_ACQUIRE, "agent");
            asm volatile("s_waitcnt vmcnt(0)" ::: "memory");
        }
    }
    __syncthreads();
}

__device__ __forceinline__ float wave_sum(float v) {
#pragma unroll
    for (int o = 1; o < 64; o <<= 1) v += __shfl_xor(v, o);
    return v;
}
__device__ __forceinline__ int phys_even(int n) {
    if (n >= 4608) return n;
    const int seg = n / 768; if (seg == 2 || seg == 5) return n;
    const int i = n & 127, hb = n - i, ii = i & 63, g = ii >> 2, e = (ii & 3) + ((i >> 6) << 2);
    return hb + 8 * g + e;
}
__device__ __forceinline__ int phys_odd(int n) {
    if (n < 1728) { const int i = n & 63, hb = n - i, ii = i & 31, g = ii >> 2, e = (ii & 3) + ((i >> 5) << 2); return hb + 8 * g + e; }
    if (n < 1920) return n + 64;
    return n + 128;
}
__device__ __forceinline__ void convert_item(const float* W, int N, const float* gk, bf16_t* WT, int mapkind, int rowoff, int item, int lane) {
    const int nblk = N / 64, kb = item / nblk, nb = item % nblk, k0 = 64 * kb, n = 64 * nb + lane;
    const int p = (mapkind == 1 ? phys_even(n) : (mapkind == 2 ? phys_odd(n) : n)) + rowoff;
    const float* src = W + (size_t)k0 * N + n;
    bf16_t* dst = WT + (size_t)p * KDIM + k0;
    float v[64];
#pragma unroll
    for (int j = 0; j < 64; ++j) v[j] = __builtin_nontemporal_load(src + (size_t)j * N);
    if (gk) {
#pragma unroll
        for (int j = 0; j < 64; ++j) v[j] *= gk[k0 + j];
    }
#pragma unroll
    for (int kk = 0; kk < 8; ++kk) { u32x4 o; o.x = pk2(v[8 * kk], v[8 * kk + 1]); o.y = pk2(v[8 * kk + 2], v[8 * kk + 3]); o.z = pk2(v[8 * kk + 4], v[8 * kk + 5]); o.w = pk2(v[8 * kk + 6], v[8 * kk + 7]);
        *(u32x4*)(dst + 8 * kk) = o; }
}

struct Args {
    const float* x; const float* mem; const int* pos;
    const float* even_norm; const float* even_w_in; const float* even_w_mkv; const float* even_w_out;
    const float* odd_norm; const float* odd_w_in; const float* odd_w_mkv; const float* odd_w_out; const float* odd_sinks;
    const float* mem_norm; const float* final_norm;
    float* out; unsigned char* ws;
    int ph_lo, ph_hi;
};
constexpr int N_PHASES = 18;

constexpr int NUNITS_EVEN = 1088, NUNITS_ODD = 512;
__device__ __forceinline__ bool unit_d64(int idx, int l) { return (l & 1) && idx >= 128; }
__device__ __forceinline__ void decode_kv(int idx, int l, KVD& d) {
    d.kvsel = 0; d.kd1 = 0; d.ksub = 64; d.koff1 = 32;
    if (!(l & 1)) {
        if (idx < 384) { const int n = 7 - idx / 48, rem = idx % 48, s = rem / 24, bh = rem % 24, b = bh / 6, h = bh % 6; const int tb = b * SEQ * EVEN_N;
            d.koff = tb + 3072 + h * 128; d.voff = tb + 3840 + h * 128; d.ks = EVEN_N; d.L = SEQ; d.kt0 = 128 * (n + 1) * s; d.nst = 2 * (n + 1);
        } else if (idx < 768) { const int i = idx - 384, pat = i / 192, j = i % 192, bh = j % 24, rr = j / 24, b = bh / 6, h = bh % 6;
            const int dil = pat ? 4 : 1, res = pat ? (rr & 3) : 0, kblk = pat ? (rr >> 2) : rr; const int tb = (b * SEQ + res) * EVEN_N;
            d.koff = tb + 768 + h * 128; d.voff = tb + 1536 + h * 128; d.ks = dil * EVEN_N; d.L = SEQ / dil; d.kt0 = (256 * kblk - 128) < 0 ? 0 : (256 * kblk - 128); d.nst = (256 * kblk + 256 - d.kt0) / 64;
        } else if (idx < 896) { const int i = idx - 768, b = i / 32, hm = (i / 8) % 4;
            d.kvsel = 1; d.koff = b * MEML * 4096 + l * 1024 + hm * 128; d.voff = d.koff + 512; d.ks = 4096; d.L = MEML; d.kt0 = 0; d.nst = 4;
        } else { const int i = idx - 896, bh = i % 24, u8 = i / 24, b = bh / 6, h = bh % 6; const int tp = (b * SEQ + 2 * u8) * EVEN_N;
            d.koff = tp + 768 + h * 128; d.voff = tp + 1536 + h * 128; d.kd1 = EVEN_N; d.ks = 16 * EVEN_N; d.L = 128; d.kt0 = 0; d.nst = 4; d.ksub = 32; d.koff1 = 0;
        }
    } else {
        if (idx < 128) { const int i = idx, b = i / 32, hm = (i / 8) % 4;
            d.kvsel = 1; d.koff = b * MEML * 4096 + l * 1024 + hm * 128; d.voff = d.koff + 512; d.ks = 4096; d.L = MEML; d.kt0 = 0; d.nst = 4;
        } else { const int i = idx - 128, b = i / 96, g = (i / 32) % 3, pblk = i % 32; const int tb = b * SEQ * ODD_NP;
            d.koff = tb + 1536 + g * 64; d.voff = tb + 1792 + g * 64; d.ks = ODD_NP; d.L = SEQ; d.kt0 = (64 * pblk - 128) < 0 ? 0 : (64 * pblk - 128); d.nst = (64 * pblk + 64 - d.kt0) / 64;
        }
    }
}
__device__ __forceinline__ void decode_q(int idx, int l, int wave, AU& u) {
    u.moba_n = -1; u.band = 1 << 28; u.causal = 1; u.pair = 0; u.whalf = 0; u.kmoff = 0; u.tbase = 0;
    if (!(l & 1)) {
        if (idx < 384) { const int n = 7 - idx / 48, rem = idx % 48, s = rem / 24, bh = rem % 24, b = bh / 6, h = bh % 6;
            u.qoff = b * SEQ * EVEN_N + 2304 + h * 128; u.qs = EVEN_N; u.qrow_w = 256 * n + 32 * wave; u.moba_n = n; u.tbase = 2 * (n + 1) * s;
            u.kmoff = (l >> 1) * (4 * 6 * 8 * 128) + ((b * 6 + h) * 8) * 128;
        } else if (idx < 768) { const int i = idx - 384, pat = i / 192, j = i % 192, bh = j % 24, rr = j / 24, b = bh / 6, h = bh % 6;
            const int dil = pat ? 4 : 1, res = pat ? (rr & 3) : 0, kblk = pat ? (rr >> 2) : rr;
            u.qoff = (b * SEQ + res) * EVEN_N + h * 128; u.qs = dil * EVEN_N; u.qrow_w = 256 * kblk + 32 * wave; u.band = 128;
        } else if (idx < 896) { const int i = idx - 768, b = i / 32, hm = (i / 8) % 4, blk = i % 8;
            u.qoff = b * SEQ * EVEN_N + 4608 + hm * 128; u.qs = EVEN_N; u.qrow_w = 256 * blk + 32 * wave; u.causal = 0;
        } else { const int i = idx - 896, bh = i % 24, u8 = i / 24, b = bh / 6, h = bh % 6; const int wh = wave >> 2;
            u.qoff = (b * SEQ + 2 * u8 + wh) * EVEN_N + h * 128; u.qs = 16 * EVEN_N; u.qrow_w = 32 * (wave & 3); u.pair = 1; u.whalf = wh; u.band = 128;
        }
    } else {
        if (idx < 128) { const int i = idx, b = i / 32, hm = (i / 8) % 4, blk = i % 8;
            u.qoff = b * SEQ * ODD_NP + 2048 + hm * 128; u.qs = ODD_NP; u.qrow_w = 256 * blk + 32 * wave; u.causal = 0;
        } else { const int i = idx - 128, b = i / 96, g = (i / 32) % 3, pblk = i % 32, hq = 8 * g + wave;
            u.qoff = b * SEQ * ODD_NP + hq * 64; u.qs = ODD_NP; u.qrow_w = 64 * pblk; u.band = 127;
        }
    }
}
__device__ __forceinline__ void decode_epi(int idx, int l, int wave, const float* sinks, AE& e) {
    e.has_sink = 0; e.sink = 0.f; e.lseoff = 0; e.lses = 0; e.goff = 0; e.gs = 0;
    if (!(l & 1)) {
        if (idx < 384) { const int rem = idx % 48, s = rem / 24, bh = rem % 24, b = bh / 6, h = bh % 6; const int tok0 = b * SEQ;
            e.epi = 0; e.ooff = (3 + s) * NTOK * 768 + tok0 * 768 + h * 128; e.os = 768; e.lseoff = (3 + s) * NTOK * 6 + tok0 * 6 + h; e.lses = 6;
        } else if (idx < 768) { const int i = idx - 384, pat = i / 192, j = i % 192, bh = j % 24, rr = j / 24, b = bh / 6, h = bh % 6;
            const int dil = pat ? 4 : 1, res = pat ? (rr & 3) : 0; const int tok0 = b * SEQ + res;
            e.epi = 0; e.ooff = pat * NTOK * 768 + tok0 * 768 + h * 128; e.os = dil * 768; e.lseoff = pat * NTOK * 6 + tok0 * 6 + h; e.lses = dil * 6;
        } else if (idx < 896) { const int i = idx - 768, b = i / 32, hm = (i / 8) % 4;
            e.epi = 1; e.ooff = b * SEQ * DM + 1536 + hm * 128; e.os = DM; e.goff = b * SEQ * EVEN_N + 5120 + 1536 + hm * 128; e.gs = EVEN_N;
        } else { const int i = idx - 896, bh = i % 24, u8 = i / 24, b = bh / 6, h = bh % 6; const int tokw = b * SEQ + 2 * u8 + (wave >> 2);
            e.epi = 0; e.ooff = 2 * NTOK * 768 + tokw * 768 + h * 128; e.os = 16 * 768; e.lseoff = 2 * NTOK * 6 + tokw * 6 + h; e.lses = 16 * 6;
        }
    } else {
        if (idx < 128) { const int i = idx, b = i / 32, hm = (i / 8) % 4;
            e.epi = 1; e.ooff = b * SEQ * DM + 1536 + hm * 128; e.os = DM; e.goff = b * SEQ * ODD_NP + 2560 + 1536 + hm * 128; e.gs = ODD_NP;
        } else { const int i = idx - 128, b = i / 96, g = (i / 32) % 3, hq = 8 * g + wave;
            e.epi = 1; e.ooff = b * SEQ * DM + hq * 64; e.os = DM; e.goff = b * SEQ * ODD_NP + 2560 + hq * 64; e.gs = ODD_NP;
            e.has_sink = 1; e.sink = sinks[(l >> 1) * 24 + hq];
        }
    }
}


constexpr int I_E = 32 * (EVEN_N / 64), I_O = 32 * (ODD_N / 64), I_W = 32 * (DM / 64), I_M = 32 * (1024 / 64);
constexpr int CV_A = I_E + 4 * I_M + I_W, CV_B = CV_A + I_O, CV_C = CV_B + I_E + I_W, CV_D = CV_C + I_O + 2 * I_W;
typedef __attribute__((address_space(4))) const Args* KArgsC;
__device__ __forceinline__ void convert_stage(KArgsC ka, unsigned char* ws, int lo, int hi, int worker, int nworkers, int lane) {
    for (int it = lo + worker; it < hi; it += nworkers) {
        int r = it;
        if (r < I_E) { convert_item(ka->even_w_in, EVEN_N, ka->even_norm, (bf16_t*)(ws + WS_WIN_E0), 1, 0, r, lane); continue; } r -= I_E;
        if (r < 4 * I_M) { const int l = r / I_M; r -= l * I_M; const float* W = ((l & 1) ? ka->odd_w_mkv : ka->even_w_mkv) + (size_t)(l >> 1) * DM * 1024;
            convert_item(W, 1024, nullptr, (bf16_t*)(ws + WS_WMKV), 0, l * 1024, r, lane); continue; } r -= 4 * I_M;
        if (r < I_W) { convert_item(ka->even_w_out, DM, nullptr, (bf16_t*)(ws + WS_WOUT), 0, 0, r, lane); continue; } r -= I_W;
        if (r < I_O) { convert_item(ka->odd_w_in, ODD_N, ka->odd_norm, (bf16_t*)(ws + WS_WIN_O0), 2, 0, r, lane); continue; } r -= I_O;
        if (r < I_E) { convert_item(ka->even_w_in + (size_t)DM * EVEN_N, EVEN_N, ka->even_norm + DM, (bf16_t*)(ws + WS_WIN_E1), 1, 0, r, lane); continue; } r -= I_E;
        if (r < I_W) { convert_item(ka->odd_w_out, DM, nullptr, (bf16_t*)(ws + WS_WOUT + (size_t)1 * 8 * MiB), 0, 0, r, lane); continue; } r -= I_W;
        if (r < I_O) { convert_item(ka->odd_w_in + (size_t)DM * ODD_N, ODD_N, ka->odd_norm + DM, (bf16_t*)(ws + WS_WIN_O1), 2, 0, r, lane); continue; } r -= I_O;
        { const int l = 2 + r / I_W; r -= (l - 2) * I_W; const float* W = ((l & 1) ? ka->odd_w_out : ka->even_w_out) + (size_t)(l >> 1) * DM * DM;
          convert_item(W, DM, nullptr, (bf16_t*)(ws + WS_WOUT + (size_t)l * 8 * MiB), 0, 0, r, lane); }
    }
}

}

typedef __attribute__((address_space(4))) const Args* KArgs;
#define LAUNDER_S(p) asm volatile("" : "+s"(p))

__global__ void __launch_bounds__(NWAVES * 64, 2) fwd_kernel(Args args_unused) {
    extern __shared__ __attribute__((aligned(16))) unsigned char lds_raw[];
    LAS unsigned char* lds = (LAS unsigned char*)lds_raw;
    volatile LAS unsigned* MISC = (volatile LAS unsigned*)(lds + MISC_OFF);
    const int tid0 = threadIdx.x;
    const int G = gridDim.x; const int bx = blockIdx.x; const int vcu = (G % 8 == 0) ? (bx % 8) * (G / 8) + bx / 8 : bx;
    const KArgs ka0 = (KArgs)__builtin_amdgcn_kernarg_segment_ptr();
    for (int i = tid0; i < (LDS_BYTES - LDSCTL_OFF) / 4; i += NWAVES * 64) ((LAS unsigned*)(lds + LDSCTL_OFF))[i] = 0u;
    __syncthreads();
    XcdBarrier bar; { unsigned char* ws0 = ka0->ws; bar.bar = (unsigned*)(ws0 + WS_CTL) + CW_BAR; bar.x = 0; bar.st = nullptr;
        if (!MK_PER_PHASE) bar = xcd_barrier_post((unsigned*)(ws0 + WS_CTL) + CW_BAR, MISC + 8); }
    const int ph_lo = ka0->ph_lo, ph_hi = ka0->ph_hi;

    unsigned long long tp_acc = 0ull;
    for (int ph = ph_lo; ph < ph_hi; ++ph) {
        unsigned long long tp_t0 = 0ull; if (TPROBE_MASK) tp_t0 = __builtin_amdgcn_s_memrealtime();
        int tid = tid0; asm volatile("" : "+v"(tid));
        const int lane = tid & 63, wave = __builtin_amdgcn_readfirstlane(tid >> 6);
        KArgs ka = ka0; LAUNDER_S(ka);
        unsigned char* ws = ka->ws;
        if (ph == 0 && (AN_MASK & 1)) {
            const int gw = vcu * NWAVES + wave, NGW = G * NWAVES;
            convert_stage(ka, ws, 0, CV_A, gw, NGW, lane);
            bf16_t* XB = (bf16_t*)(ws + WS_XB); bf16_t* MEMN = (bf16_t*)(ws + WS_MEMN); float* SSQ = (float*)(ws + WS_SSQ);
            const float* xin = ka->x; const float* memin = ka->mem; const float* mnorm = ka->mem_norm;
            for (int m = gw; m < NTOK + NMEM; m += NGW) {
                const bool isx = m < NTOK; const int row = isx ? m : m - NTOK;
                const f32x4* xr = (const f32x4*)((isx ? xin : memin) + (size_t)row * DM) + lane;
                f32x4 v[8]; float s = 0.f;
#pragma unroll
                for (int j = 0; j < 8; ++j) { v[j] = __builtin_nontemporal_load(xr + 64 * j); s += (v[j].x * v[j].x + v[j].y * v[j].y) + (v[j].z * v[j].z + v[j].w * v[j].w); }
                s = wave_sum(s);
                unsigned long long* o8 = (unsigned long long*)((isx ? XB : MEMN) + (size_t)row * DM) + lane;
                if (isx) {
                    if (lane < 8) SSQ[(size_t)lane * NTOK + row] = lane == 0 ? s : 0.f;
#pragma unroll
                    for (int j = 0; j < 8; ++j) o8[64 * j] = (unsigned long long)pk2(v[j].x, v[j].y) | ((unsigned long long)pk2(v[j].z, v[j].w) << 32);
                } else {
                    const float rs = 1.0f / sqrtf(s * (1.0f / DM) + EPS);
                    const f32x4* gr = (const f32x4*)mnorm + lane;
#pragma unroll
                    for (int j = 0; j < 8; ++j) { const f32x4 g = gr[64 * j]; o8[64 * j] = (unsigned long long)pk2(v[j].x * rs * g.x, v[j].y * rs * g.y) | ((unsigned long long)pk2(v[j].z * rs * g.z, v[j].w * rs * g.w) << 32); }
                }
            }
            float* CS128 = (float*)(ws + WS_CS128); float* CS64 = (float*)(ws + WS_CS64); const int* posp = ka->pos;
            for (int tk = gw; tk < NTOK; tk += NGW) {
                const float pf = (float)posp[tk];
                { const float inv = expf((float)lane * (float)(-2.0 * 9.210340371976184 / 128.0)); const float ang = pf * inv;
                  const double rev = (double)ang * 0.15915494309189535; const float fr = (float)(rev - rint(rev));
                  CS128[(size_t)tk * 128 + lane] = __builtin_amdgcn_cosf(fr); CS128[(size_t)tk * 128 + 64 + lane] = __builtin_amdgcn_sinf(fr); }
                if (lane < 32) { const float inv = expf((float)lane * (float)(-2.0 * 9.210340371976184 / 64.0)); const float ang = pf * inv;
                  const double rev = (double)ang * 0.15915494309189535; const float fr = (float)(rev - rint(rev));
                  CS64[(size_t)tk * 64 + lane] = __builtin_amdgcn_cosf(fr); CS64[(size_t)tk * 64 + 32 + lane] = __builtin_amdgcn_sinf(fr); }
            }
        } else if (ph == 17 && (AN_MASK & 2) && G != 256) {
            const int gw = vcu * NWAVES + wave, NGW = G * NWAVES;
            const float* ssq = (const float*)(ws + WS_SSQ) + (size_t)4 * 8 * NTOK; float* outp = ka->out; const float* fnorm = ka->final_norm;
            for (int m = gw; m < NTOK; m += NGW) {
                float sq = 0.f;
#pragma unroll
                for (int j = 0; j < 8; ++j) sq += ssq[(size_t)j * NTOK + m];
                const float rs = 1.0f / sqrtf(sq * (1.0f / DM) + EPS);
                f32x4* xr = (f32x4*)(outp + (size_t)m * DM) + lane; const f32x4* gr = (const f32x4*)fnorm + lane;
#pragma unroll
                for (int j = 0; j < 8; ++j) { f32x4 v = xr[64 * j]; const f32x4 g = gr[64 * j]; v = v * rs * g; xr[64 * j] = v; }
            }
        } else if (ph >= 1 && ph <= 16) {
            const int l = (ph - 1) >> 2, sub = (ph - 1) & 3, odd = l & 1, li = l >> 1;
            if ((sub == 0 && (AN_MASK & 4)) || (sub == 3 && (AN_MASK & 8))) {
                GemmP P; P.ws = ws; P.l = l; P.xin = ka->x; P.out = ka->out; P.lds = lds; P.fnorm = ka->final_norm; P.fuse_final = (G == 256) ? 1 : 0;
                Order S; S.G = G; S.c = bx; S.nM0 = NTOK / 256;
                if (sub == 0) { P.mode = EM_INPROJ; P.A = (const bf16_t*)(ws + WS_XB); P.Bt = (const bf16_t*)(ws + (odd ? (li ? WS_WIN_O1 : WS_WIN_O0) : (li ? WS_WIN_E1 : WS_WIN_E0)));
                    S.nN0 = (odd ? ODD_NP : EVEN_N) / 256; S.nwg1 = (l == 0) ? 64 : 0; }
                else { P.mode = EM_OUTPROJ; P.A = (const bf16_t*)(ws + WS_Y); P.Bt = (const bf16_t*)(ws + WS_WOUT + (size_t)l * 8 * MiB); S.nN0 = DM / 256; S.nwg1 = 0; }
                S.nwg0 = S.nM0 * S.nN0;
                gemm_phase(lds, P, S, tid);
                if (sub == 0 && l < 3) {
                    const int nwg = S.nwg0 + S.nwg1, TT = nwg % G, lo = l == 0 ? CV_A : (l == 1 ? CV_B : CV_C), hi = l == 0 ? CV_B : (l == 1 ? CV_C : CV_D);
                    if (TT == 0) convert_stage(ka, ws, lo, hi, bx * NWAVES + wave, G * NWAVES, lane);
                    else if (bx >= TT) convert_stage(ka, ws, lo, hi, (bx - TT) * NWAVES + wave, (G - TT) * NWAVES, lane);
                }
            } else if (sub == 2 && (AN_MASK & 16)) {
                if (!odd) {
                    const float* LSE = (const float*)(ws + WS_LSE); const bf16_t* OG = (const bf16_t*)(ws + WS_OG); const bf16_t* QKV = (const bf16_t*)(ws + WS_QKV); bf16_t* Y = (bf16_t*)(ws + WS_Y);
                    const long NIT = (long)NTOK * 192;
                    for (long it = (long)bx * 512 + tid; it < NIT; it += (long)G * 512) {
                        const int tok = (int)(it / 192), c = (int)(it % 192), isb = c >= 96, cc8 = (isb ? c - 96 : c), h = cc8 >> 4;
                        const int g0 = isb ? 3 : 0;
                        const size_t lb = (size_t)tok * 6 + h, ob = (size_t)tok * 768 + cc8 * 8;
                        const float l0 = LSE[(size_t)g0 * NTOK * 6 + lb], l1 = LSE[(size_t)(g0 + 1) * NTOK * 6 + lb], l2 = isb ? -1e30f : LSE[(size_t)2 * NTOK * 6 + lb];
                        const float mx = fmaxf(l0, fmaxf(l1, l2));
                        float w0 = __expf(l0 - mx), w1 = __expf(l1 - mx), w2 = isb ? 0.f : __expf(l2 - mx); const float inv = 1.0f / (w0 + w1 + w2); w0 *= inv; w1 *= inv; w2 *= inv;
                        const u32x4 a = *(const u32x4*)(OG + (size_t)g0 * NTOK * 768 + ob), b = *(const u32x4*)(OG + (size_t)(g0 + 1) * NTOK * 768 + ob);
                        u32x4 cc = {0u, 0u, 0u, 0u}; if (!isb) cc = *(const u32x4*)(OG + (size_t)2 * NTOK * 768 + ob);
                        const u32x4 g = *(const u32x4*)(QKV + (size_t)tok * EVEN_N + 5120 + c * 8);
                        u32x4 o;
#define CMB(f) cvt_pk_bf16((w0 * bflo(a.f) + w1 * bflo(b.f) + w2 * bflo(cc.f)) * bflo(g.f), (w0 * bfhi(a.f) + w1 * bfhi(b.f) + w2 * bfhi(cc.f)) * bfhi(g.f))
                        o.x = CMB(x); o.y = CMB(y); o.z = CMB(z); o.w = CMB(w);
#undef CMB
                        *(u32x4*)(Y + (size_t)tok * DM + c * 8) = o;
                    }
                }
            } else if (sub == 1 && (AN_MASK & 32)) {
                gu32* qctr = (gu32*)(ws + WS_CTL) + CW_Q + 64 * l;
                const int NUNITS = odd ? NUNITS_ODD : NUNITS_EVEN;
                int idx = bx, idx1 = G + bx;
                int it = 0, pb = 0; bool warm = false;
                while (idx < NUNITS) {
                    idx = __builtin_amdgcn_readfirstlane(idx); idx1 = __builtin_amdgcn_readfirstlane(idx1);
                    int tid_u = tid; asm volatile("" : "+v"(tid_u)); const int lane_u = tid_u & 63;
                    unsigned nx2 = 0; if (tid == 0) nx2 = 2u * (unsigned)G + __hip_atomic_fetch_add(qctr, 1u, RLX_AGENT);
                    const bool d64 = unit_d64(idx, l);
                    const int pre = (idx1 < NUNITS && unit_d64(idx1, l) == d64) ? 1 : 0;
                    KVD d, dn; decode_kv(idx, l, d); decode_kv(pre ? idx1 : idx, l, dn);
                    AU u; decode_q(idx, l, wave, u);
                    float m_reg, l_reg;
                    if (d64) { if (!warm) cold_start<64>(d, ws, lds + pb * ABUF, wave, lane_u);
                        u32x4 gA[4], gB[4];
                        { const int ic = idx - 128, bc = ic / 96, gc = (ic / 32) % 3;
                          const bf16_t* GBp = (const bf16_t*)(ws + WS_QKV) + (size_t)(bc * SEQ * ODD_NP + 2560 + (8 * gc + wave) * 64) + (size_t)(u.qrow_w + (lane_u >> 3)) * ODD_NP + (lane_u & 7) * 8;
#pragma unroll
                          for (int i = 0; i < 4; ++i) gA[i] = *(const u32x4*)(GBp + (size_t)(i * 8) * ODD_NP); }
                        f32x16 oA[2], oB[2]; float m2[2], l2[2];
                        attn_c_main(u, d, dn, pre, pb, ws, lds, wave, lane_u, m2, l2, oA, oB);
                        int idx2 = idx; LAUNDER_S(idx2); AE e; decode_epi(idx2, l, wave, ka->odd_sinks, e);
                        { const bf16_t* GBp = (const bf16_t*)(ws + WS_QKV) + (size_t)e.goff + (size_t)(u.qrow_w + 32 + (lane_u >> 3)) * e.gs + (lane_u & 7) * 8;
#pragma unroll
                          for (int i = 0; i < 4; ++i) gB[i] = *(const u32x4*)(GBp + (size_t)(i * 8) * e.gs); }
                        attn_epi<64, true>(e, u.qrow_w, pb ^ 1, ws, lds, wave, lane_u, m2[0], l2[0], oA, gA);
                        attn_epi<64, true>(e, u.qrow_w + 32, pb ^ 1, ws, lds, wave, lane_u, m2[1], l2[1], oB, gB); }
                    else { if (!warm) cold_start<128>(d, ws, lds + pb * ABUF, wave, lane_u);
                        f32x16 o[4]; attn_main<128>(u, d, dn, pre, pb, ws, lds, tid_u, wave, lane_u, m_reg, l_reg, o);
                        int idx2 = idx; LAUNDER_S(idx2); AE e; decode_epi(idx2, l, wave, ka->odd_sinks, e); attn_epi<128>(e, u.qrow_w, pb ^ 1, ws, lds, wave, lane_u, m_reg, l_reg, o); }
                    warm = pre != 0;
                    if (tid == 0) MISC[18 + (it & 1)] = nx2;
                    __syncthreads();
                    idx = idx1; idx1 = (int)MISC[18 + (it & 1)]; ++it;
                }
            }
        }
        if (ph + 1 < ph_hi && !(ph == 16 && G == 256)) { if (!(ph >= 1 && ph <= 16 && ((ph - 1) & 3) == 2 && (((ph - 1) >> 2) & 1))) xcd_barrier(bar); }
        if (TPROBE_MASK) { if ((TPROBE_MASK >> ph) & 1) tp_acc += __builtin_amdgcn_s_memrealtime() - tp_t0; }
    }
    if (TPROBE_MASK) { if (bx == 0) { const unsigned long long te = __builtin_amdgcn_s_memrealtime(); while (__builtin_amdgcn_s_memrealtime() - te < 4ull * tp_acc) __builtin_amdgcn_s_sleep(8); } }
}

extern "C" void kernel_launch(void* const* d_in, const int* in_sizes, int n_in, void* d_out, int out_size, void* d_ws, size_t ws_size, hipStream_t stream) {
    static int grid = 0;
    if (grid == 0) {
        if (n_in != 14 || in_sizes[0] != NTOK * DM || out_size != NTOK * DM || ws_size < WS_END) { fprintf(stderr, "kernel_launch: unexpected shapes (n_in %d, in0 %d, out %d, ws %zu)\n", n_in, n_in > 0 ? in_sizes[0] : -1, out_size, ws_size); grid = -1; return; }
        int dev = 0, cus = 0, per_cu = 0;
        if (hipGetDevice(&dev) != hipSuccess || hipDeviceGetAttribute(&cus, hipDeviceAttributeMultiprocessorCount, dev) != hipSuccess) { grid = -1; return; }
        if (hipFuncSetAttribute((const void*)fwd_kernel, hipFuncAttributeMaxDynamicSharedMemorySize, LDS_BYTES) != hipSuccess) { fprintf(stderr, "kernel_launch: hipFuncSetAttribute failed\n"); grid = -1; return; }
        if (hipOccupancyMaxActiveBlocksPerMultiprocessor(&per_cu, (const void*)fwd_kernel, NWAVES * 64, LDS_BYTES) != hipSuccess || per_cu < 1) { fprintf(stderr, "kernel_launch: occupancy query says %d blocks/CU\n", per_cu); }
        (void)hipGetLastError();
        grid = cus;
    }
    if (grid < 0) return;
    (void)hipMemsetAsync((char*)d_ws + WS_CTL, 0, CTL_ZERO_BYTES, stream);
    Args a{};
    a.x = (const float*)d_in[0]; a.mem = (const float*)d_in[1]; a.pos = (const int*)d_in[2];
    a.even_norm = (const float*)d_in[3]; a.even_w_in = (const float*)d_in[4]; a.even_w_mkv = (const float*)d_in[5]; a.even_w_out = (const float*)d_in[6];
    a.odd_norm = (const float*)d_in[7]; a.odd_w_in = (const float*)d_in[8]; a.odd_w_mkv = (const float*)d_in[9]; a.odd_w_out = (const float*)d_in[10]; a.odd_sinks = (const float*)d_in[11];
    a.mem_norm = (const float*)d_in[12]; a.final_norm = (const float*)d_in[13];
    a.out = (float*)d_out; a.ws = (unsigned char*)d_ws;
#if MK_PER_PHASE
    for (int ph = 0; ph < N_PHASES; ++ph) { a.ph_lo = ph; a.ph_hi = ph + 1; hipLaunchKernelGGL(fwd_kernel, dim3(grid), dim3(NWAVES * 64), LDS_BYTES, stream, a); }
#else
    a.ph_lo = 0; a.ph_hi = N_PHASES;
    hipLaunchKernelGGL(fwd_kernel, dim3(grid), dim3(NWAVES * 64), LDS_BYTES, stream, a);
#ifdef PROBE_PHASES
    {
        const int pp[] = PROBE_PHASES;
        (void)hipMemsetAsync((char*)d_ws + WS_CTL + (size_t)CW_Q * 4, 0, 64 * 8 * 4, stream);
        for (unsigned i = 0; i < sizeof(pp) / sizeof(pp[0]); ++i) { a.ph_lo = pp[i]; a.ph_hi = pp[i] + 1; hipLaunchKernelGGL(fwd_kernel, dim3(grid), dim3(NWAVES * 64), LDS_BYTES, stream, a); }
    }
#endif
#endif
    const hipError_t le = hipPeekAtLastError();
    if (le != hipSuccess) fprintf(stderr, "kernel_launch: launch failed: %s\n", hipGetErrorName(le));
}
```

```cpp
#include <hip/hip_runtime.h>
#include <cstdio>
#include <cstdint>

#ifndef RES_LO
#define RES_LO 0
#endif
#ifndef RPROBE
#define RPROBE 0
#endif
#ifndef RP_MODE
#define RP_MODE EM_OUTPROJ
#endif
#ifndef TPROBE_MASK
#define TPROBE_MASK 0
#endif
#ifndef AN_MASK
#define AN_MASK 63
#endif
#ifndef MK_PER_PHASE
#define MK_PER_PHASE 0
#endif

namespace {
#define LAS __attribute__((address_space(3)))
#define GAS __attribute__((address_space(1)))
typedef unsigned short bf16_t;
typedef short bf16x8 __attribute__((ext_vector_type(8)));
typedef short s16x4 __attribute__((ext_vector_type(4)));
typedef float f32x4 __attribute__((ext_vector_type(4)));
typedef float f32x16 __attribute__((ext_vector_type(16)));
typedef unsigned u32x4 __attribute__((ext_vector_type(4)));
typedef GAS unsigned gu32;
#define RLX_AGENT __ATOMIC_RELAXED, __HIP_MEMORY_SCOPE_AGENT
#define LDS_WAIT() asm volatile("s_waitcnt lgkmcnt(0)" ::: "memory")
#define VM_WAIT() asm volatile("s_waitcnt vmcnt(0)" ::: "memory")
#define SBAR() __builtin_amdgcn_sched_barrier(0)

constexpr int BATCH = 4, SEQ = 2048, DM = 2048, NTOK = BATCH * SEQ, MEML = 256, NMEM = BATCH * MEML;
constexpr int EVEN_N = 7168, ODD_N = 4480, ODD_NP = 4608;
constexpr int KDIM = 2048;
constexpr float EPS = 1e-6f;
constexpr int NWAVES = 8;

constexpr size_t MiB = 1u << 20;
constexpr size_t WS_CTL = 0, CTL_ZERO_BYTES = 1 * MiB;
constexpr size_t WS_WIN_E0 = 1 * MiB, WS_WIN_E1 = 29 * MiB, WS_WIN_O0 = 57 * MiB, WS_WIN_O1 = 75 * MiB;
constexpr size_t WS_WOUT = 93 * MiB;
constexpr size_t WS_WMKV = 125 * MiB;
constexpr size_t WS_XB = 141 * MiB;
constexpr size_t WS_QKV = 173 * MiB;
constexpr size_t WS_Y = 285 * MiB;
constexpr size_t WS_OG = 374 * MiB;
constexpr size_t WS_XL = 317 * MiB;
constexpr size_t WS_LSE = 353 * MiB;
constexpr size_t WS_MKV = 354 * MiB;
constexpr size_t WS_MEMN = 362 * MiB;
constexpr size_t WS_CS128 = 366 * MiB;
constexpr size_t WS_CS64 = 370 * MiB;
constexpr size_t WS_SSQ = 372 * MiB;
constexpr size_t WS_END = 438 * MiB;
constexpr int CW_BAR = 4096;
constexpr int CW_SSQ = 16384;
constexpr int CW_KM = 65536;
constexpr int CW_Q = 131072;
constexpr int CW_PAN = 135168;
static_assert((CW_PAN + 64 * 32) * 4 <= (int)CTL_ZERO_BYTES, "ctl");

constexpr int RING_BYTES = 131072;
constexpr int LDSCTL_OFF = RING_BYTES, MISC_OFF = LDSCTL_OFF + 320;
constexpr int LDS_BYTES = 147456;
constexpr int KMBUF_OFF = LDSCTL_OFF + 9216;
constexpr int XTBL_OFF = LDSCTL_OFF + 1024;

__device__ __forceinline__ unsigned f2bf(float f) { unsigned u = __builtin_bit_cast(unsigned, f); return (u + 0x7fffu + ((u >> 16) & 1u)) >> 16; }
typedef float f32x2_t __attribute__((ext_vector_type(2))); typedef __bf16 bf16x2_t __attribute__((ext_vector_type(2)));
__device__ __forceinline__ unsigned pk2(float lo, float hi) { f32x2_t v = {lo, hi}; bf16x2_t b = __builtin_convertvector(v, bf16x2_t); return __builtin_bit_cast(unsigned, b); }
__device__ __forceinline__ unsigned cvt_pk_bf16(float lo, float hi) { unsigned r; asm volatile("v_cvt_pk_bf16_f32 %0, %1, %2" : "=v"(r) : "v"(lo), "v"(hi)); return r; }
__device__ __forceinline__ float bflo(unsigned w) { return __builtin_bit_cast(float, w << 16); }
__device__ __forceinline__ float bfhi(unsigned w) { return __builtin_bit_cast(float, w & 0xffff0000u); }

constexpr int BM = 256, BK = 64, HALF = 128, HTB = HALF * BK * 2, NXCD = 8, WGM = 8;
__device__ __forceinline__ int lds_byte(int r, int c) { const int st = (r >> 4) * 2 + (c >> 5), rr = r & 15, cc = c & 31, ob = rr * 64 + cc * 2; return st * 1024 + (ob ^ (((ob >> 9) & 1) << 5)); }
__device__ __forceinline__ void stage_rc(int b, int& R, int& C) { const int st = b / 1024, sb = b % 1024, swz = sb ^ (((sb >> 9) & 1) << 5); R = (st >> 1) * 16 + swz / 64; C = (st & 1) * 32 + (swz % 64) / 2; }
__device__ __forceinline__ int perm32(int rho) { const int n = rho >> 4, i = rho & 15; return 8 * (i >> 2) + 4 * n + (i & 3); }

template <int M> __device__ __forceinline__ float xor_lt32(float v) { return __int_as_float(__builtin_amdgcn_ds_swizzle(__float_as_int(v), (M << 10) | 0x1f)); }
__device__ __forceinline__ float add_xor32(float v) { auto rr = __builtin_amdgcn_permlane32_swap(__float_as_uint(v), __float_as_uint(v), false, false); return __uint_as_float(rr[0]) + __uint_as_float(rr[1]); }
struct Unit { int pm, pn, s, kind, q; };
enum { EM_PLAIN = 0, EM_INPROJ = 1, EM_OUTPROJ = 2 };
struct GemmP { const bf16_t* A; const bf16_t* Bt; int mode, l; unsigned char* ws; const float* xin; float* out; LAS unsigned char* lds; const float* fnorm; int fuse_final; };
__device__ __forceinline__ void tile_of(int wgid, int nM, int nN, int& pm, int& pn) {
    const int nwg = nM * nN; { const int q = nwg / NXCD, r = nwg % NXCD, xcd = wgid % NXCD, off = wgid / NXCD; wgid = (xcd < r ? xcd * (q + 1) : r * (q + 1) + (xcd - r) * q) + off; }
    const int nig = WGM * nN, gid = wgid / nig, fm = gid * WGM, gsz = (nM - fm) < WGM ? (nM - fm) : WGM;
    pm = fm + ((wgid % nig) % gsz); pn = (wgid % nig) / gsz;
}
struct Order {
    int nwg0, nwg1, nM0, nN0, G, c, maxi, qt;
    __device__ __forceinline__ bool next(int i, Unit& u) const {
        u.kind = 0; u.q = 0;
        if (qt && i >= maxi) { if (i > maxi) return false;
            const int s8 = c >> 3; u.s = 0; u.kind = 1; u.q = s8 & 3; tile_of(maxi * G + (c & 7) + 8 * (s8 >> 2), nM0, nN0, u.pm, u.pn); return true; }
        const int L = i * G + c; if (L >= nwg0 + nwg1) return false;
        if (L < nwg0) { u.s = 0; tile_of(L, nM0, nN0, u.pm, u.pn); } else { u.s = 1; tile_of(L - nwg0, 4, 16, u.pm, u.pn); }
        return true;
    }
};

__device__ __forceinline__ void epi_run(const GemmP& P, const f32x4 (&acc)[2][2][4][2], const Unit& u, int wr, int wc, int fr, int fq) {
    const int row0 = u.pm * BM + wr * 64 + fr;
    const int colt = u.pn * BM + wc * 32 + 8 * fq;
    const int mode = u.s ? EM_PLAIN : P.mode;
    unsigned char* ws = P.ws;
    if (mode == EM_PLAIN) {
        bf16_t* O = (bf16_t*)(ws + WS_MKV);
#pragma unroll
        for (int ai = 0; ai < 2; ++ai)
#pragma unroll
            for (int m = 0; m < 4; ++m) { bf16_t* rowp = O + (size_t)(row0 + ai * HALF + m * 16) * 4096 + colt;
#pragma unroll
                for (int bj = 0; bj < 2; ++bj) { const f32x4 v0 = acc[ai][bj][m][0], v1 = acc[ai][bj][m][1];
                    u32x4 w; w.x = cvt_pk_bf16(v0[0], v0[1]); w.y = cvt_pk_bf16(v0[2], v0[3]); w.z = cvt_pk_bf16(v1[0], v1[1]); w.w = cvt_pk_bf16(v1[2], v1[3]);
                    *(u32x4*)(rowp + bj * HALF) = w; } }
    } else if (mode == EM_INPROJ) {
        const int l = P.l, odd = l & 1, ldo = odd ? ODD_NP : EVEN_N;
        bf16_t* O = (bf16_t*)(ws + WS_QKV);
        const float* cs128 = (const float*)(ws + WS_CS128); const float* cs64 = (const float*)(ws + WS_CS64);
        float* km = (float*)(ws + WS_CTL) + CW_KM + (size_t)(l >> 1) * (4 * 6 * 8 * 128);
        int kind; bool kmean = false;
        if (odd) { kind = (u.pn <= 6) ? 2 : (u.pn <= 9 ? 0 : 3); }
        else { kind = (u.pn < 6) ? 1 : (u.pn < 9 ? 0 : (u.pn < 15 ? 1 : (u.pn < 20 ? 0 : 3))); kmean = (u.pn >= 12 && u.pn < 15); }
        float ks[2][8];
#pragma unroll
        for (int bj = 0; bj < 2; ++bj)
#pragma unroll
            for (int e = 0; e < 8; ++e) ks[bj][e] = 0.f;
        f32x4 csA[8], snA[8];
#define EPI_TLOAD(I0) do { if (kind == 1) { _Pragma("unroll") for (int i = (I0); i < (I0) + 4; ++i) { const float* t = cs128 + (size_t)(row0 + (i >> 2) * HALF + (i & 3) * 16) * 128 + (16 * wc + 4 * fq); csA[i] = *(const f32x4*)t; snA[i] = *(const f32x4*)(t + 64); } } \
        else if (kind == 2) { _Pragma("unroll") for (int i = (I0); i < (I0) + 4; ++i) { const float* t = cs64 + (size_t)(row0 + (i >> 2) * HALF + (i & 3) * 16) * 64 + (16 * (wc & 1) + 4 * fq); csA[i] = *(const f32x4*)t; snA[i] = *(const f32x4*)(t + 32); } } \
        else { _Pragma("unroll") for (int i = (I0); i < (I0) + 4; ++i) { csA[i] = (f32x4){1.f, 1.f, 1.f, 1.f}; snA[i] = (f32x4){0.f, 0.f, 0.f, 0.f}; } } } while (0)
        EPI_TLOAD(0);
        { const int te = (wr * 4 + wc) * 64 + fq * 16 + fr;
          if (te < 256) { const float* sb = (const float*)(ws + WS_SSQ) + (size_t)l * 8 * NTOK + u.pm * BM; float t8[8];
#pragma unroll
              for (int j = 0; j < 8; ++j) { const float* sj = sb + (size_t)j * NTOK; t8[j] = sj[te]; }
              const float sq = ((t8[0] + t8[1]) + (t8[2] + t8[3])) + ((t8[4] + t8[5]) + (t8[6] + t8[7]));
              ((LAS float*)(P.lds + XTBL_OFF))[te] = __builtin_amdgcn_rsqf(sq * (1.0f / DM) + EPS); }
          LDS_WAIT(); __builtin_amdgcn_s_barrier(); asm volatile("" ::: "memory"); }
        const LAS float* rst = (const LAS float*)(P.lds + XTBL_OFF);
#pragma unroll
        for (int ai = 0; ai < 2; ++ai) {
#pragma unroll
            for (int m = 0; m < 4; ++m) {
                if (ai == 0 && m == 3) { asm volatile("" ::: "memory"); EPI_TLOAD(4); }
                const int row = row0 + ai * HALF + m * 16;
                const float rs = rst[ai * HALF + wr * 64 + m * 16 + fr];
                const f32x4 cs = csA[ai * 4 + m], sn = snA[ai * 4 + m];
                bf16_t* rowp = O + (size_t)row * ldo + colt;
#pragma unroll
                for (int bj = 0; bj < 2; ++bj) {
                    f32x4 v0 = acc[ai][bj][m][0] * rs, v1 = acc[ai][bj][m][1] * rs;
                    if (kind == 1 || kind == 2) { const f32x4 o0 = v0 * cs - v1 * sn, o1 = v1 * cs + v0 * sn; v0 = o0; v1 = o1; }
                    else if (kind == 3) {
#pragma unroll
                        for (int j = 0; j < 4; ++j) { v0[j] = v0[j] * __builtin_amdgcn_rcpf(1.0f + __builtin_amdgcn_exp2f(-1.4426950408889634f * v0[j]));
                                                      v1[j] = v1[j] * __builtin_amdgcn_rcpf(1.0f + __builtin_amdgcn_exp2f(-1.4426950408889634f * v1[j])); }
                    }
                    if (kmean) {
#pragma unroll
                        for (int j = 0; j < 4; ++j) { ks[bj][j] += v0[j]; ks[bj][4 + j] += v1[j]; }
                    }
                    u32x4 w; w.x = cvt_pk_bf16(v0[0], v0[1]); w.y = cvt_pk_bf16(v0[2], v0[3]); w.z = cvt_pk_bf16(v1[0], v1[1]); w.w = cvt_pk_bf16(v1[2], v1[3]);
                    *(u32x4*)(rowp + bj * HALF) = w;
                }
            }
        }
#undef EPI_TLOAD
        if (kmean) {
#pragma unroll
            for (int bj = 0; bj < 2; ++bj)
#pragma unroll
                for (int e = 0; e < 8; ++e) { float s = ks[bj][e]; s += xor_lt32<1>(s); s += xor_lt32<2>(s); s += xor_lt32<4>(s); s += xor_lt32<8>(s); ks[bj][e] = s; }
            if (fr == 0) {
                const int b = u.pm >> 3, n = u.pm & 7;
#pragma unroll
                for (int bj = 0; bj < 2; ++bj) { const int h = (u.pn - 12) * 2 + bj; float* dst = km + ((size_t)((b * 6 + h) * 8 + n)) * 128 + wc * 32 + 8 * fq;
#pragma unroll
                    for (int e = 0; e < 8; ++e) atomicAdd(dst + e, ks[bj][e]); }
            }
        }
    } else {
        const int l = P.l;
        float* xout = P.out;
        bf16_t* xb = (bf16_t*)(ws + WS_XB); const bool wxb = (l != 3);
        const bool fuse = (l == 3) && P.fuse_final;
        float* ssq_out = (float*)(ws + WS_SSQ) + (size_t)(l + 1) * 8 * NTOK + (size_t)u.pn * NTOK + u.pm * BM;
        LAS float* xt = (LAS float*)(P.lds + XTBL_OFF);
#pragma unroll
        for (int ai = 0; ai < 2; ++ai)
#pragma unroll
            for (int m = 0; m < 4; ++m) {
                const int row = row0 + ai * HALF + m * 16; float ss = 0.f;
#pragma unroll
                for (int bj = 0; bj < 2; ++bj) {
                    const size_t off = (size_t)row * DM + colt + bj * HALF;
                    const f32x4 v0 = acc[ai][bj][m][0], v1 = acc[ai][bj][m][1];
                    if (!fuse && !P.fuse_final) { *(f32x4*)(xout + off) = v0; *(f32x4*)(xout + off + 4) = v1; }
                    if (wxb) { u32x4 w; w.x = cvt_pk_bf16(v0[0], v0[1]); w.y = cvt_pk_bf16(v0[2], v0[3]); w.z = cvt_pk_bf16(v1[0], v1[1]); w.w = cvt_pk_bf16(v1[2], v1[3]); *(u32x4*)(xb + off) = w;
                        if (RES_LO && P.fuse_final) {
                            u32x4 q; q.x = cvt_pk_bf16(v0[0] - bflo(w.x), v0[1] - bfhi(w.x)); q.y = cvt_pk_bf16(v0[2] - bflo(w.y), v0[3] - bfhi(w.y));
                            q.z = cvt_pk_bf16(v1[0] - bflo(w.z), v1[1] - bfhi(w.z)); q.w = cvt_pk_bf16(v1[2] - bflo(w.w), v1[3] - bfhi(w.w));
                            *(u32x4*)((bf16_t*)(ws + WS_XL) + off) = q; } }
                    ss += (v0[0] * v0[0] + v0[1] * v0[1]) + (v0[2] * v0[2] + v0[3] * v0[3]) + (v1[0] * v1[0] + v1[1] * v1[1]) + (v1[2] * v1[2] + v1[3] * v1[3]);
                }
                ss += xor_lt32<16>(ss); ss = add_xor32(ss);
                if (fq == 0) xt[(ai * HALF + wr * 64 + m * 16 + fr) * 4 + wc] = ss;
            }
        LDS_WAIT(); __builtin_amdgcn_s_barrier(); asm volatile("" ::: "memory");
        const int lane = fq * 16 + fr, wid = wr * 4 + wc, r = wid * 32 + (lane & 31);
        if (!fuse) {
            if (lane < 32) { const f32x4 t = *(const LAS f32x4*)(xt + r * 4); ssq_out[r] = (t[0] + t[1]) + (t[2] + t[3]); }
        } else {
            if (lane < 32) { const f32x4 t = *(const LAS f32x4*)(xt + r * 4); __hip_atomic_store((unsigned*)(ssq_out + r), __float_as_uint((t[0] + t[1]) + (t[2] + t[3])), __ATOMIC_RELAXED, __HIP_MEMORY_SCOPE_AGENT); }
            asm volatile("s_waitcnt vmcnt(0)" ::: "memory"); LDS_WAIT();
            __builtin_amdgcn_s_barrier(); asm volatile("" ::: "memory");
            unsigned* pcnt = (unsigned*)(ws + WS_CTL) + CW_PAN + 64 * u.pm;
            if (wid == 0 && lane == 0) {
                __hip_atomic_fetch_add(pcnt, 1u, __ATOMIC_RELAXED, __HIP_MEMORY_SCOPE_AGENT);
                unsigned sp = 0; while (__hip_atomic_load(pcnt, __ATOMIC_RELAXED, __HIP_MEMORY_SCOPE_AGENT) < 8u) { __builtin_amdgcn_s_sleep(2); if (++sp > (1u << 22)) break; }
                __builtin_amdgcn_fence(__ATOMIC_ACQUIRE, "agent"); asm volatile("s_waitcnt vmcnt(0)" ::: "memory");
            }
            __builtin_amdgcn_s_barrier(); asm volatile("" ::: "memory");
            { const int te = wid * 64 + lane;
              if (te < 256) { const unsigned* sb = (const unsigned*)((const float*)(ws + WS_SSQ) + (size_t)4 * 8 * NTOK + u.pm * BM + te); float sq = 0.f;
#pragma unroll
                  for (int j = 0; j < 8; ++j) sq += __uint_as_float(__hip_atomic_load(sb + (size_t)j * NTOK, __ATOMIC_RELAXED, __HIP_MEMORY_SCOPE_AGENT));
                  xt[te] = 1.0f / sqrtf(sq * (1.0f / DM) + EPS); }
              LDS_WAIT(); __builtin_amdgcn_s_barrier(); asm volatile("" ::: "memory"); }
#pragma unroll
            for (int bj = 0; bj < 2; ++bj) {
                const f32x4 g0 = *(const f32x4*)(P.fnorm + colt + bj * HALF), g1 = *(const f32x4*)(P.fnorm + colt + bj * HALF + 4);
#pragma unroll
                for (int ai = 0; ai < 2; ++ai)
#pragma unroll
                    for (int m = 0; m < 4; ++m) {
                        const float rs = xt[ai * HALF + wr * 64 + m * 16 + fr];
                        const size_t off = (size_t)(row0 + ai * HALF + m * 16) * DM + colt + bj * HALF;
                        *(f32x4*)(xout + off) = acc[ai][bj][m][0] * rs * g0; *(f32x4*)(xout + off + 4) = acc[ai][bj][m][1] * rs * g1;
                    }
            }
        }
    }
}

__device__ __forceinline__ void epi_quad(const GemmP& P, const f32x4 (&aq)[4][2], const Unit& u, int wr, int wc, int fr, int fq) {
    const int ai = u.q >> 1, bj = u.q & 1;
    const int row0 = u.pm * BM + ai * HALF + wr * 64 + fr;
    const int colt = u.pn * BM + bj * HALF + wc * 32 + 8 * fq;
    unsigned char* ws = P.ws;
    const int l = P.l, odd = l & 1, ldo = odd ? ODD_NP : EVEN_N;
    bf16_t* O = (bf16_t*)(ws + WS_QKV);
    const float* cs128 = (const float*)(ws + WS_CS128); const float* cs64 = (const float*)(ws + WS_CS64);
    int kind;
    if (odd) { kind = (u.pn <= 6) ? 2 : (u.pn <= 9 ? 0 : 3); }
    else { kind = (u.pn < 6) ? 1 : (u.pn < 9 ? 0 : (u.pn < 15 ? 1 : (u.pn < 20 ? 0 : 3))); }
    f32x4 csA[4], snA[4];
    if (kind == 1) {
#pragma unroll
        for (int i = 0; i < 4; ++i) { const float* t = cs128 + (size_t)(row0 + i * 16) * 128 + (16 * wc + 4 * fq); csA[i] = *(const f32x4*)t; snA[i] = *(const f32x4*)(t + 64); } }
    else if (kind == 2) {
#pragma unroll
        for (int i = 0; i < 4; ++i) { const float* t = cs64 + (size_t)(row0 + i * 16) * 64 + (16 * (wc & 1) + 4 * fq); csA[i] = *(const f32x4*)t; snA[i] = *(const f32x4*)(t + 32); } }
    else {
#pragma unroll
        for (int i = 0; i < 4; ++i) { csA[i] = (f32x4){1.f, 1.f, 1.f, 1.f}; snA[i] = (f32x4){0.f, 0.f, 0.f, 0.f}; } }
    { const int te = (wr * 4 + wc) * 64 + fq * 16 + fr;
      if (te < 256) { const float* sb = (const float*)(ws + WS_SSQ) + (size_t)l * 8 * NTOK + u.pm * BM; float t8[8];
#pragma unroll
          for (int j = 0; j < 8; ++j) { const float* sj = sb + (size_t)j * NTOK; t8[j] = sj[te]; }
          const float sq = ((t8[0] + t8[1]) + (t8[2] + t8[3])) + ((t8[4] + t8[5]) + (t8[6] + t8[7]));
          ((LAS float*)(P.lds + XTBL_OFF))[te] = __builtin_amdgcn_rsqf(sq * (1.0f / DM) + EPS); }
      LDS_WAIT(); __builtin_amdgcn_s_barrier(); asm volatile("" ::: "memory"); }
    const LAS float* rst = (const LAS float*)(P.lds + XTBL_OFF);
#pragma unroll
    for (int m = 0; m < 4; ++m) {
        const float rs = rst[ai * HALF + wr * 64 + m * 16 + fr];
        const f32x4 cs = csA[m], sn = snA[m];
        f32x4 v0 = aq[m][0] * rs, v1 = aq[m][1] * rs;
        if (kind == 1 || kind == 2) { const f32x4 o0 = v0 * cs - v1 * sn, o1 = v1 * cs + v0 * sn; v0 = o0; v1 = o1; }
        else if (kind == 3) {
#pragma unroll
            for (int j = 0; j < 4; ++j) { v0[j] = v0[j] * __builtin_amdgcn_rcpf(1.0f + __builtin_amdgcn_exp2f(-1.4426950408889634f * v0[j]));
                                          v1[j] = v1[j] * __builtin_amdgcn_rcpf(1.0f + __builtin_amdgcn_exp2f(-1.4426950408889634f * v1[j])); }
        }
        u32x4 w; w.x = cvt_pk_bf16(v0[0], v0[1]); w.y = cvt_pk_bf16(v0[2], v0[3]); w.z = cvt_pk_bf16(v1[0], v1[1]); w.w = cvt_pk_bf16(v1[2], v1[3]);
        *(u32x4*)(O + (size_t)(row0 + m * 16) * ldo + colt) = w;
    }
}

#define XB_TMO      128
#define XB_XCNT(j)  (256  + 64 * (j))
#define XB_XSUB(j)  (1280 + 64 * (j))
#define XB_XGEN(j)  (2304 + 64 * (j))
#define XB_TOP      3328
#define XB_TOPGEN   3392
#define XCD_BAR_WORDS 3456
#define XB_SPIN_CAP (1u << 18)
__device__ __forceinline__ unsigned xb_ld(unsigned* p)              { return __hip_atomic_load(p, __ATOMIC_RELAXED, __HIP_MEMORY_SCOPE_AGENT); }
__device__ __forceinline__ unsigned xb_add(unsigned* p, unsigned v) { return __hip_atomic_fetch_add(p, v, __ATOMIC_RELAXED, __HIP_MEMORY_SCOPE_AGENT); }
__device__ __forceinline__ unsigned xb_xcc_id() { return (unsigned)__builtin_amdgcn_s_getreg((3 << 11) | 20) & 0xFu; }
#define XB_SPIN(cond, bar) do { unsigned _sp = 0; while (cond) { __builtin_amdgcn_s_sleep(1); \
    if ((++_sp & 255u) == 0u) { if (xb_ld(&(bar)[XB_TMO])) break; if (_sp > XB_SPIN_CAP) { atomicAdd(&(bar)[XB_TMO], 1u); break; } } } } while (0)
struct XcdBarrier { unsigned* bar; unsigned x; volatile LAS unsigned* st; };
__device__ __forceinline__ XcdBarrier xcd_barrier_post(unsigned* bar, volatile LAS unsigned* st, bool leader) {
    XcdBarrier b; b.bar = bar; b.x = xb_xcc_id(); b.st = st;
    if (leader) (void)xb_add(&bar[XB_XCNT(b.x)], 1u);
    return b;
}
__device__ __forceinline__ void xcd_barrier_complete(unsigned* bar, unsigned x, unsigned& nloc, unsigned& nx) {
    const unsigned G = gridDim.x * gridDim.y * gridDim.z;
    unsigned sum, cnt, mine, sp = 0u;
    for (;;) {
        sum = 0u; cnt = 0u; mine = 0u;
#pragma unroll
        for (unsigned j = 0; j < 16; ++j) { const unsigned c = xb_ld(&bar[XB_XCNT(j)]); sum += c; cnt += (c > 0u) ? 1u : 0u; }
        if (sum == G) { mine = xb_ld(&bar[XB_XCNT(x)]); break; }
        __builtin_amdgcn_s_sleep(1);
        if ((++sp & 255u) == 0u) { if (xb_ld(&bar[XB_TMO])) break; if (sp > XB_SPIN_CAP) { atomicAdd(&bar[XB_TMO], 1u); break; } }
    }
    nloc = mine > 0u ? mine : 1u; nx = cnt > 0u ? cnt : 1u;
}
__device__ __forceinline__ void xcd_barrier(const XcdBarrier& b, bool leader) {
    asm volatile("s_waitcnt vmcnt(0)" ::: "memory");
    __syncthreads();
    if (leader) {
        unsigned* bar = b.bar;
        __builtin_amdgcn_s_waitcnt(0);
        unsigned nloc = b.st[0], nx = b.st[1];
        if (nloc == 0u) { xcd_barrier_complete(bar, b.x, nloc, nx); b.st[0] = nloc; b.st[1] = nx; }
        const unsigned old = xb_add(&bar[XB_XSUB(b.x)], 1u);
        const unsigned gen = old / nloc;
        if (old + 1u == (gen + 1u) * nloc) {
            __builtin_amdgcn_fence(__ATOMIC_RELEASE, "agent");
            asm volatile("s_waitcnt vmcnt(0)" ::: "memory");
            const unsigned og = xb_add(&bar[XB_TOP], 1u);
            const unsigned tg = og / nx;
            if (og + 1u == (tg + 1u) * nx) xb_add(&bar[XB_TOPGEN], 1u);
            else XB_SPIN(xb_ld(&bar[XB_TOPGEN]) == tg, bar);
            __builtin_amdgcn_fence(__ATOMIC_ACQUIRE, "agent");
            xb_add(&bar[XB_XGEN(b.x)], 1u);
            asm volatile("s_waitcnt vmcnt(0)" ::: "memory");
        } else {
            XB_SPIN(xb_ld(&bar[XB_XGEN(b.x)]) == gen, bar);
            __builtin_amdgcn_fence(__ATOMIC_ACQUIRE, "agent");
            asm volatile("s_waitcnt vmcnt(0)" ::: "memory");
        }
    }
    __syncthreads();
}

template <class PF> __device__ __forceinline__ void xcd_barrier_pf(const XcdBarrier& b, const int tid, PF&& pf) {
    asm volatile("s_waitcnt vmcnt(0)" ::: "memory");
    __syncthreads();
    unsigned* bar = b.bar;
    unsigned nloc = 1u, nx = 1u, old = 0u, gen = 0u, lead = 0u;
    if (tid == 0) {
        nloc = b.st[0]; nx = b.st[1];
        if (nloc == 0u) { xcd_barrier_complete(bar, b.x, nloc, nx); b.st[0] = nloc; b.st[1] = nx; }
        old = xb_add(&bar[XB_XSUB(b.x)], 1u);
        gen = old / nloc; lead = (old + 1u == (gen + 1u) * nloc) ? 1u : 0u;
    }
    if (tid < 64) lead = __builtin_amdgcn_readfirstlane(lead);
    if (!lead) pf();
    if (tid == 0) {
        if (lead) {
            __builtin_amdgcn_fence(__ATOMIC_RELEASE, "agent");
            asm volatile("s_waitcnt vmcnt(0)" ::: "memory");
            const unsigned og = xb_add(&bar[XB_TOP], 1u);
            const unsigned tg = og / nx;
            if (og + 1u == (tg + 1u) * nx) xb_add(&bar[XB_TOPGEN], 1u);
            else XB_SPIN(xb_ld(&bar[XB_TOPGEN]) == tg, bar);
            __builtin_amdgcn_fence(__ATOMIC_ACQUIRE, "agent");
            xb_add(&bar[XB_XGEN(b.x)], 1u);
            asm volatile("s_waitcnt vmcnt(0)" ::: "memory");
        } else {
            XB_SPIN(xb_ld(&bar[XB_XGEN(b.x)]) == gen, bar);
            __builtin_amdgcn_fence(__ATOMIC_ACQUIRE, "agent");
            asm volatile("s_waitcnt vmcnt(0)" ::: "memory");
        }
    }
    if (lead) pf();
    __syncthreads();
}

__device__ __forceinline__ void gemm_phase(LAS unsigned char* lds, const GemmP& P, const Order& S, const int tid, unsigned long long& rp_acc, const XcdBarrier& gbar, const bool pre) {
    unsigned long long rp_t = 0ull; if (RPROBE) rp_t = __builtin_amdgcn_s_memrealtime();
#define RP_MARK(id) do { if (RPROBE) { const unsigned long long _n = __builtin_amdgcn_s_memrealtime(); if (RPROBE == (id) && P.mode == RP_MODE) rp_acc += _n - rp_t; rp_t = _n; } } while (0)
    const int wid = __builtin_amdgcn_readfirstlane(tid >> 6), lane = tid & 63, wr = wid >> 2, wc = wid & 3, fr = lane & 15, fq = lane >> 4;
    constexpr int K = KDIM, nt = K / BK;
    unsigned voffA[2], voffB[2];
#pragma unroll
    for (int i = 0; i < 2; ++i) { int R, C; stage_rc(tid * 16 + i * 8192, R, C); const int Rb = (R & ~31) + perm32(R & 31);
        voffA[i] = (unsigned)(R * K + C) * 2u; voffB[i] = (unsigned)(Rb * K + C) * 2u; }
    constexpr size_t kstep = (size_t)(BK * 2);
    constexpr size_t hstep = (size_t)HALF * K * 2;
    constexpr size_t tstep = 2 * hstep;
    const unsigned ldsw = (unsigned)wid * 1024u;
    const int aoff = lds_byte(wr * 64 + fr, fq * 8), boff = lds_byte(wc * 32 + fr, fq * 8);
#define PG8_SA(b, h) (((b) * 2 + (h)) * HTB)
#define PG8_SB(b, h) ((4 + (b) * 2 + (h)) * HTB)
#define PG8_STAGE(bufoff, gbase, voff) do { _Pragma("unroll") for (int _i = 0; _i < 2; ++_i) \
        __builtin_amdgcn_global_load_lds((const unsigned*)((const char*)(gbase) + (voff)[_i]), (LAS unsigned*)(lds + (bufoff) + ldsw + _i * 8192), 16, 0, 0); } while (0)
#define PG8_LDA(dst, b, h) do { _Pragma("unroll") for (int m = 0; m < 4; ++m) _Pragma("unroll") for (int k = 0; k < 2; ++k) dst[m][k] = *(const LAS bf16x8*)(lds + PG8_SA(b, h) + aoff + m * 2048 + k * 1024); } while (0)
#define PG8_LDB(dst, b, h) do { _Pragma("unroll") for (int n = 0; n < 2; ++n) _Pragma("unroll") for (int k = 0; k < 2; ++k) dst[n][k] = *(const LAS bf16x8*)(lds + PG8_SB(b, h) + boff + n * 2048 + k * 1024); } while (0)
#define PG8_MMA(ai, bj, At, Bt) do { __builtin_amdgcn_s_setprio(1); _Pragma("unroll") for (int m = 0; m < 4; ++m) _Pragma("unroll") for (int n = 0; n < 2; ++n) _Pragma("unroll") for (int k = 0; k < 2; ++k) \
        acc[ai][bj][m][n] = __builtin_amdgcn_mfma_f32_16x16x32_bf16(Bt[n][k], At[m][k], acc[ai][bj][m][n], 0, 0, 0); __builtin_amdgcn_s_setprio(0); } while (0)
#define PG8_WAIT_V(n) asm volatile("s_waitcnt vmcnt(" #n ")" ::: "memory")
#define PG8_WAIT_L(n) asm volatile("s_waitcnt lgkmcnt(" #n ")" ::: "memory")
#define PG8_BAR __builtin_amdgcn_s_barrier()
#define PG8_SCHED __builtin_amdgcn_sched_barrier(0)
    Unit cur, nxt; int ui = 0;
    if (!S.next(0, cur)) return;
    f32x4 acc[2][2][4][2];
#define PG8_ACC_INIT(U) do { int li_ = lane; asm volatile("" : "+v"(li_)); const int fr_ = li_ & 15, fq_ = li_ >> 4;     \
    if (P.mode == EM_OUTPROJ && (U).s == 0 && P.l > 0 && P.fuse_final) { \
          \
        const size_t eo = (size_t)((U).pm * BM + wr * 64 + fr_) * DM + (U).pn * BM + wc * 32 + 8 * fq_; \
        const char* hp = (const char*)(P.ws + WS_XB) + eo * 2; const char* lp = (const char*)(P.ws + WS_XL) + eo * 2; \
        _Pragma("unroll") for (int a = 0; a < 2; ++a) _Pragma("unroll") for (int m = 0; m < 4; ++m) { asm volatile("" : "+v"(hp), "+v"(lp)); \
            _Pragma("unroll") for (int b = 0; b < 2; ++b) { const u32x4 h4 = __builtin_nontemporal_load((const u32x4*)(hp + b * 256)); u32x4 l4 = {0u, 0u, 0u, 0u}; if (RES_LO) l4 = __builtin_nontemporal_load((const u32x4*)(lp + b * 256)); \
                acc[a][b][m][0] = (f32x4){bflo(h4.x) + bflo(l4.x), bfhi(h4.x) + bfhi(l4.x), bflo(h4.y) + bflo(l4.y), bfhi(h4.y) + bfhi(l4.y)}; \
                acc[a][b][m][1] = (f32x4){bflo(h4.z) + bflo(l4.z), bfhi(h4.z) + bfhi(l4.z), bflo(h4.w) + bflo(l4.w), bfhi(h4.w) + bfhi(l4.w)}; } \
            hp += (m == 3 ? (size_t)(HALF - 48) : (size_t)16) * DM * 2; lp += (m == 3 ? (size_t)(HALF - 48) : (size_t)16) * DM * 2; } \
    } else if (P.mode == EM_OUTPROJ && (U).s == 0) { \
        const char* rp = (const char*)(P.l == 0 ? P.xin : (const float*)P.out) + ((size_t)((U).pm * BM + wr * 64 + fr_) * DM + (U).pn * BM + wc * 32 + 8 * fq_) * 4; \
        _Pragma("unroll") for (int a = 0; a < 2; ++a) _Pragma("unroll") for (int m = 0; m < 4; ++m) { asm volatile("" : "+v"(rp)); \
            _Pragma("unroll") for (int b = 0; b < 2; ++b) _Pragma("unroll") for (int n = 0; n < 2; ++n) acc[a][b][m][n] = __builtin_nontemporal_load((const f32x4*)(rp + b * 512 + n * 16)); \
            rp += (m == 3 ? (size_t)(HALF - 48) : (size_t)16) * DM * 4; } \
    } else { _Pragma("unroll") for (int a = 0; a < 2; ++a) _Pragma("unroll") for (int b = 0; b < 2; ++b) _Pragma("unroll") for (int m = 0; m < 4; ++m) _Pragma("unroll") for (int n = 0; n < 2; ++n) acc[a][b][m][n] = (f32x4){0.f, 0.f, 0.f, 0.f}; } } while (0)
    bf16x8 At[4][2], B0[2][2], B1[2][2];
    const char* cA = (cur.s ? (const char*)(P.ws + WS_MEMN) : (const char*)P.A) + (size_t)cur.pm * tstep; const char* cB = (cur.s ? (const char*)(P.ws + WS_WMKV) : (const char*)P.Bt) + (size_t)cur.pn * tstep;
    { auto pf = [&]() { PG8_ACC_INIT(cur); PG8_STAGE(PG8_SB(0, 0), cB, voffB); PG8_STAGE(PG8_SB(0, 1), cB + hstep, voffB); PG8_STAGE(PG8_SB(1, 0), cB + kstep, voffB); PG8_STAGE(PG8_SB(1, 1), cB + hstep + kstep, voffB); };
      if (pre) xcd_barrier_pf(gbar, tid, pf); else pf(); }
    PG8_STAGE(PG8_SA(0, 0), cA, voffA); PG8_STAGE(PG8_SA(0, 1), cA + hstep, voffA);
    PG8_WAIT_V(0); PG8_BAR;
    if (wr == 1) PG8_BAR;
    PG8_BAR;
    PG8_STAGE(PG8_SA(1, 0), cA + kstep, voffA);
    PG8_BAR;
    for (;;) {
        const bool has_next = S.next(ui + 1, nxt);
        const bool strm = has_next && nxt.kind == 0;
        const char* nA = strm ? (nxt.s ? (const char*)(P.ws + WS_MEMN) : (const char*)P.A) + (size_t)nxt.pm * tstep : cA; const char* nB = strm ? (nxt.s ? (const char*)(P.ws + WS_WMKV) : (const char*)P.Bt) + (size_t)nxt.pn * tstep : cB;
        if (cur.kind == 1) {
            PG8_WAIT_V(0); PG8_BAR;
            f32x4 aq[4][2];
#pragma unroll
            for (int m = 0; m < 4; ++m) { aq[m][0] = (f32x4){0.f, 0.f, 0.f, 0.f}; aq[m][1] = (f32x4){0.f, 0.f, 0.f, 0.f}; }
            const char* gA = (const char*)P.A + (size_t)cur.pm * tstep + (size_t)(cur.q >> 1) * hstep;
            const char* gB = (const char*)P.Bt + (size_t)cur.pn * tstep + (size_t)(cur.q & 1) * hstep;
#define QSTAGE(T) do { const int b_ = ((T) & 3) * 32768; const char* ga_ = gA + (size_t)(T) * kstep; const char* gb_ = gB + (size_t)(T) * kstep; asm volatile("" : "+s"(ga_), "+s"(gb_));     \
        PG8_STAGE(b_, ga_, voffA); PG8_STAGE(b_ + 16384, gb_, voffB); } while (0)
            QSTAGE(0); QSTAGE(1); QSTAGE(2);
#pragma unroll 1
            for (int t = 0; t < nt; ++t) {
                if (t < nt - 2) PG8_WAIT_V(8); else if (t == nt - 2) PG8_WAIT_V(4); else PG8_WAIT_V(0);
                PG8_BAR;
                if (t + 3 < nt) QSTAGE(t + 3);
                const int b_ = (t & 3) * 32768;
                bf16x8 Aq[4][2], Bq[2][2];
#pragma unroll
                for (int m = 0; m < 4; ++m)
#pragma unroll
                    for (int k = 0; k < 2; ++k) Aq[m][k] = *(const LAS bf16x8*)(lds + b_ + aoff + m * 2048 + k * 1024);
#pragma unroll
                for (int n = 0; n < 2; ++n)
#pragma unroll
                    for (int k = 0; k < 2; ++k) Bq[n][k] = *(const LAS bf16x8*)(lds + b_ + 16384 + boff + n * 2048 + k * 1024);
#pragma unroll
                for (int m = 0; m < 4; ++m)
#pragma unroll
                    for (int n = 0; n < 2; ++n)
#pragma unroll
                        for (int k = 0; k < 2; ++k) aq[m][n] = __builtin_amdgcn_mfma_f32_16x16x32_bf16(Bq[n][k], Aq[m][k], aq[m][n], 0, 0, 0);
            }
#undef QSTAGE
            { int lane_q = lane; asm volatile("" : "+v"(lane_q)); epi_quad(P, aq, cur, wr, wc, lane_q & 15, lane_q >> 4); }
            _Pragma("unroll") for (int a = 0; a < 2; ++a) _Pragma("unroll") for (int b = 0; b < 2; ++b) _Pragma("unroll") for (int m = 0; m < 4; ++m) { acc[a][b][m][0] = (f32x4){0.f, 0.f, 0.f, 0.f}; acc[a][b][m][1] = (f32x4){0.f, 0.f, 0.f, 0.f}; }
        } else {
        for (int t = 0; t < nt; t += 2) {
            const bool last = (t == nt - 2);
            const char* a1 = cA + (size_t)(t + 1) * kstep;
            const char* a2 = last ? nA : cA + (size_t)(t + 2) * kstep; const char* b2 = last ? nB : cB + (size_t)(t + 2) * kstep;
            const char* a3 = a2 + kstep; const char* b3 = b2 + kstep;
            PG8_LDB(B0, 0, 0); PG8_LDB(B1, 0, 1); PG8_SCHED; PG8_LDA(At, 0, 0); PG8_STAGE(PG8_SA(1, 1), a1 + hstep, voffA);
            PG8_WAIT_V(8); PG8_WAIT_L(0); PG8_BAR; PG8_MMA(0, 0, At, B0); PG8_MMA(0, 1, At, B1); PG8_BAR; PG8_SCHED;
            PG8_LDA(At, 0, 1); PG8_STAGE(PG8_SB(0, 0), b2, voffB); PG8_STAGE(PG8_SB(0, 1), b2 + hstep, voffB); PG8_STAGE(PG8_SA(0, 0), a2, voffA);
            PG8_WAIT_V(8); PG8_WAIT_L(0); PG8_BAR; PG8_MMA(1, 0, At, B0); PG8_MMA(1, 1, At, B1); PG8_BAR; PG8_SCHED;
            PG8_LDB(B0, 1, 0); PG8_LDB(B1, 1, 1); PG8_SCHED; PG8_LDA(At, 1, 0); PG8_STAGE(PG8_SA(0, 1), a2 + hstep, voffA);
            PG8_WAIT_V(8); PG8_WAIT_L(0); PG8_BAR; PG8_MMA(0, 0, At, B0); PG8_MMA(0, 1, At, B1); PG8_BAR; PG8_SCHED;
            PG8_LDA(At, 1, 1); PG8_STAGE(PG8_SB(1, 0), b3, voffB); PG8_STAGE(PG8_SB(1, 1), b3 + hstep, voffB); PG8_STAGE(PG8_SA(1, 0), a3, voffA);
            PG8_WAIT_V(8); PG8_WAIT_L(0); PG8_BAR; PG8_MMA(1, 0, At, B0); PG8_MMA(1, 1, At, B1); PG8_BAR; PG8_SCHED;
            if (RPROBE) { if (t == 0 && ui == 0) RP_MARK(1); }
        }
        RP_MARK(2);
        if (wr == 0) PG8_BAR;
        { int lane_e = lane; asm volatile("" : "+v"(lane_e));
          epi_run(P, acc, cur, wr, wc, lane_e & 15, lane_e >> 4); }
        }
        RP_MARK(3);
        if (!has_next) break;
        if (nxt.kind == 0) { PG8_ACC_INIT(nxt); cA = nA; cB = nB; }
        cur = nxt; ++ui;
        if (cur.kind == 0) { if (wr == 1) PG8_BAR; }
    }
    PG8_WAIT_V(0);
    PG8_BAR;
    RP_MARK(4);
#undef PG8_ACC_INIT
#undef PG8_SA
#undef PG8_SB
#undef PG8_STAGE
#undef PG8_LDA
#undef PG8_LDB
#undef PG8_MMA
#undef PG8_WAIT_V
#undef PG8_WAIT_L
#undef PG8_BAR
#undef PG8_SCHED
}

struct KVD { int kvsel, koff, voff, kd1, ks, L, kt0, ksub, koff1, nst; };
struct AU { int qoff, qs, qrow_w, band, causal, pair, whalf, moba_n, tbase, kmoff; };
struct AE { int epi, ooff, os, goff, gs, lseoff, lses, has_sink; float sink; };
__device__ __forceinline__ int crow(int r, int hi) { return (r & 3) + 8 * (r >> 2) + 4 * hi; }
typedef short v4i16_t __attribute__((ext_vector_type(4)));
template <int OFF> __device__ __forceinline__ s16x4 tr_read(int vb) { return __builtin_bit_cast(s16x4, __builtin_amdgcn_ds_read_tr16_b64_v4i16((LAS v4i16_t*)(uintptr_t)(unsigned)(vb + OFF))); }
template <int D> __device__ __forceinline__ int kswz(int row, int colB) { if constexpr (D == 128) return row * 256 + (colB ^ ((row & 7) << 4)); else return row * 128 + (colB ^ (((row >> 1) & 7) << 4)); }
template <int D> __device__ __forceinline__ int v_st(int k, int c) { const int kk = (k & ~0xC) | ((k & 4) << 1) | ((k & 8) >> 1); return ((kk >> 3) * (D / 32) + (c >> 5)) * 512 + ((kk & 7) * 32 + (c & 31)) * 2; }
__device__ __forceinline__ int v_rd_base(int lane) { return ((lane & 3) << 3) | (((lane >> 2) & 3) << 6) | (((lane >> 4) & 1) << 5) | (((lane >> 5) & 1) << 8); }
template <int D> constexpr int v_rd_off(int d0, int ks, int half) { return d0 * 512 + (ks * 2 + half) * (D / 32) * 512; }

template <int D, int D0, int HF> __device__ __forceinline__ void pv_half(f32x16& od, int vb, bf16x8 pa, bf16x8 pb) {
    const s16x4 l0 = tr_read<v_rd_off<D>(D0, 2 * HF, 0)>(vb), h0 = tr_read<v_rd_off<D>(D0, 2 * HF, 1)>(vb), l1 = tr_read<v_rd_off<D>(D0, 2 * HF + 1, 0)>(vb), h1 = tr_read<v_rd_off<D>(D0, 2 * HF + 1, 1)>(vb);
#define PKV(Lx, Hx) (bf16x8){Lx[0], Lx[1], Lx[2], Lx[3], Hx[0], Hx[1], Hx[2], Hx[3]}
    od = __builtin_amdgcn_mfma_f32_32x32x16_bf16(pa, PKV(l0, h0), od, 0, 0, 0);
    od = __builtin_amdgcn_mfma_f32_32x32x16_bf16(pb, PKV(l1, h1), od, 0, 0, 0);
#undef PKV
}
template <int D, int HF> __device__ __forceinline__ void pv_all(f32x16* o, int vb, bf16x8 pa, bf16x8 pb) {
    pv_half<D, 0, HF>(o[0], vb, pa, pb); pv_half<D, 1, HF>(o[1], vb, pa, pb);
    if constexpr (D == 128) { pv_half<D, 2, HF>(o[2], vb, pa, pb); pv_half<D, 3, HF>(o[3], vb, pa, pb); }
}
template <int D> struct ACfg { static constexpr int NSUB = (D == 128) ? 2 : 3, KTB = 64 * D * 2; };
constexpr int ABUF = 65536;
__device__ __forceinline__ int swap23(int k) { return (k & ~0xC) | ((k & 4) << 1) | ((k & 8) >> 1); }
template <int D> __device__ __forceinline__ void stage_dma(const KVD& d, const unsigned char* ws, int sub, LAS unsigned char* buf, int slot, int wid, int lane) {
    constexpr int NSUB = ACfg<D>::NSUB, KTB = ACfg<D>::KTB, NBLK = D / 32, NP = KTB / 8192;
    const bf16_t* KVp = (const bf16_t*)(ws + (d.kvsel ? WS_MKV : WS_QKV));
    const int kb = d.kt0 + sub * d.ksub;
    LAS unsigned char* Kt = buf + slot * KTB; LAS unsigned char* Vt = buf + NSUB * KTB + slot * KTB;
#pragma unroll
    for (int i = 0; i < NP; ++i) {
        const int piece = wid + 8 * i;
        int row, c;
        if constexpr (D == 128) { row = piece * 4 + (lane >> 4); c = (lane & 15) ^ (row & 7); } else { row = piece * 8 + (lane >> 3); c = (lane & 7) ^ ((row >> 1) & 7); }
        { const int half = row >> 5; int a = kb + (row & 31) + half * d.koff1; a = a < 0 ? 0 : (a > d.L - 1 ? d.L - 1 : a);
          const bf16_t* src = KVp + d.koff + (size_t)a * d.ks + half * d.kd1 + c * 8;
          __builtin_amdgcn_global_load_lds((const unsigned*)src, (LAS unsigned*)(Kt + piece * 1024), 16, 0, 0); }
        { const int p = piece * 1024 + lane * 16, st = p >> 9, q = (p & 511) >> 1, kk = (st / NBLK) * 8 + (q >> 5), k = swap23(kk), col = (st % NBLK) * 32 + (q & 31);
          const int half = k >> 5; int a = kb + (k & 31) + half * d.koff1; a = a < 0 ? 0 : (a > d.L - 1 ? d.L - 1 : a);
          const bf16_t* src = KVp + d.voff + (size_t)a * d.ks + half * d.kd1 + col;
          __builtin_amdgcn_global_load_lds((const unsigned*)src, (LAS unsigned*)(Vt + piece * 1024), 16, 0, 0); }
    }
}
template <int D> __device__ __forceinline__ void cold_start(const KVD& d, const unsigned char* ws, LAS unsigned char* buf, int wid, int lane) {
#pragma unroll
    for (int sl = 0; sl < ACfg<D>::NSUB; ++sl) if (sl < d.nst) stage_dma<D>(d, ws, sl, buf, sl, wid, lane);
    asm volatile("s_waitcnt vmcnt(0)" ::: "memory");
    __syncthreads();
}

template <int D>
__device__ __forceinline__ void attn_main(const AU& u, const KVD& d, const KVD& dn, const int pre, int& pb, unsigned char* ws, LAS unsigned char* lds, int tid, int wid, int lane,
                                          float& m_out, float& l_out, f32x16 (&o)[D / 32]) {
    constexpr int NQ = D / 16, NB = D / 32, NSUB = ACfg<D>::NSUB, KTB = ACfg<D>::KTB;
    constexpr float SCALE = (D == 128) ? 0.088388347648318440f : 0.125f;
    constexpr float C = SCALE * 1.4426950408889634f;
    constexpr float THRS = 8.0f / SCALE;
    const int r32 = lane & 31, hi = lane >> 5;
    LAS float* wsf = (LAS float*)(lds + XTBL_OFF + wid * 256);
    bf16x8 qr[NQ];
    { const bf16_t* qrow = (const bf16_t*)(ws + WS_QKV) + (size_t)u.qoff + (size_t)(u.qrow_w + r32) * u.qs + hi * 8;
#pragma unroll
      for (int d0 = 0; d0 < NQ; ++d0) qr[d0] = *(const bf16x8*)(qrow + d0 * 16); }
    float m_reg = -1e30f, l_reg = 0.f;
#pragma unroll
    for (int dd = 0; dd < NB; ++dd)
#pragma unroll
        for (int r = 0; r < 16; ++r) o[dd][r] = 0.f;
    const int qidx = u.qrow_w + r32;
    unsigned selmask = 0;
    if constexpr (D == 128) {
        if (u.moba_n > 0) {
            const int n = u.moba_n; float g[7];
            LAS float* kmL = (LAS float*)(lds + KMBUF_OFF);
            if (tid < n * 32) { const f32x4 x = *(const f32x4*)((const float*)(ws + WS_CTL) + CW_KM + u.kmoff + (tid >> 5) * 128 + (tid & 31) * 4); *(LAS f32x4*)(kmL + tid * 4) = x; }
            LDS_WAIT(); __syncthreads();
#pragma unroll
            for (int j = 0; j < 7; ++j) {
                g[j] = -INFINITY;
                if (j < n) {
                    const LAS float* kmj = kmL + j * 128 + hi * 8; float s = 0.f;
#pragma unroll
                    for (int d0 = 0; d0 < NQ; ++d0) { const f32x4 a = *(const LAS f32x4*)(kmj + d0 * 16), b = *(const LAS f32x4*)(kmj + d0 * 16 + 4);
                        const u32x4 qw = __builtin_bit_cast(u32x4, qr[d0]);
                        s += bflo(qw.x) * a[0] + bfhi(qw.x) * a[1] + bflo(qw.y) * a[2] + bfhi(qw.y) * a[3] + bflo(qw.z) * b[0] + bfhi(qw.z) * b[1] + bflo(qw.w) * b[2] + bfhi(qw.w) * b[3]; }
                    auto rr = __builtin_amdgcn_permlane32_swap(__float_as_uint(s), __float_as_uint(s), false, false);
                    g[j] = __uint_as_float(rr[0]) + __uint_as_float(rr[1]);
                }
            }
#pragma unroll
            for (int j = 0; j < 7; ++j) { int cnt = 0;
#pragma unroll
                for (int i = 0; i < 7; ++i) if (i != j) cnt += (i < n && (g[i] > g[j] || (g[i] == g[j] && i < j))) ? 1 : 0;
                if (j < n && cnt < 3) selmask |= (1u << j); }
        }
    }
    const int nsteps = (d.nst + NSUB - 1) / NSUB;
    for (int st = 0; st < nsteps; ++st) {
        LAS unsigned char* bufc = lds + pb * ABUF; LAS unsigned char* bufn = lds + (pb ^ 1) * ABUF;
        const bool lastst = (st + 1 == nsteps);
#pragma unroll 1
        for (int sl = 0; sl < NSUB; ++sl) {
            const int sub = st * NSUB + sl;
            if (!lastst) { if (sub + NSUB < d.nst) stage_dma<D>(d, ws, sub + NSUB, bufn, sl, wid, lane); }
            else if (pre == 1) { if (sl < dn.nst) stage_dma<D>(dn, ws, sl, bufn, sl, wid, lane); }
            if (sub < d.nst) {
                const int kb0 = d.kt0 + sub * d.ksub, kb1 = kb0 + d.koff1;
                int lo_q, hi_q;
                const int tabs = u.tbase + sub;
                const bool rowm = (u.moba_n >= 0 && tabs < 4 * u.moba_n);
                if (rowm) { const bool sel = (selmask >> (tabs >> 2)) & 1u; lo_q = sel ? -(1 << 28) : (1 << 28); hi_q = sel ? (1 << 28) : -(1 << 28); }
                else { lo_q = qidx - u.band; hi_q = u.causal ? qidx : (1 << 28); }
                bool any0 = __any(lo_q <= kb0 + 31 && hi_q >= kb0), any1 = __any(lo_q <= kb1 + 31 && hi_q >= kb1);
                if (u.pair) { any0 = any0 && (u.whalf == 0); any1 = any1 && (u.whalf == 1); }
#define HALF_STEP(HF, ANY, KBH) do { if (ANY) { \
                    const bool allv = __all(lo_q <= (KBH) && hi_q >= (KBH) + 31); \
                    f32x16 p; _Pragma("unroll") for (int r = 0; r < 16; ++r) p[r] = 0.f; \
                    LAS unsigned char* Kt = bufc + sl * KTB; \
                    _Pragma("unroll") for (int d0 = 0; d0 < NQ; ++d0) { const bf16x8 bk = *(const LAS bf16x8*)(Kt + kswz<D>(32 * (HF) + r32, (d0 * 16 + hi * 8) * 2)); p = __builtin_amdgcn_mfma_f32_32x32x16_bf16(bk, qr[d0], p, 0, 0, 0); } \
                    if (!allv) { if (rowm) { const bool keep_ = lo_q < hi_q; _Pragma("unroll") for (int r = 0; r < 16; ++r) p[r] = keep_ ? p[r] : -INFINITY; } \
                        else { _Pragma("unroll") for (int r = 0; r < 16; ++r) { const int kk = (KBH) + crow(r, hi); if (kk < lo_q || kk > hi_q) p[r] = -INFINITY; } } } \
                    float pmax = p[0]; _Pragma("unroll") for (int r = 1; r < 16; ++r) pmax = fmaxf(pmax, p[r]); \
                    { auto rr = __builtin_amdgcn_permlane32_swap(__float_as_uint(pmax), __float_as_uint(pmax), false, false); pmax = fmaxf(__uint_as_float(rr[0]), __uint_as_float(rr[1])); } \
                    float alpha = 1.f; \
                    if (!__all(pmax - m_reg <= THRS)) { const float mn = fmaxf(m_reg, pmax); alpha = __builtin_amdgcn_exp2f((m_reg - mn) * C); m_reg = mn; } \
                    const float mnC = -m_reg * C; float ps = 0.f; \
                    _Pragma("unroll") for (int r = 0; r < 16; ++r) { p[r] = __builtin_amdgcn_exp2f(fmaf(p[r], C, mnC)); ps += p[r]; } \
                    { auto rr = __builtin_amdgcn_permlane32_swap(__float_as_uint(ps), __float_as_uint(ps), false, false); ps = __uint_as_float(rr[0]) + __uint_as_float(rr[1]); } \
                    l_reg = l_reg * alpha + ps; \
                    if (__any(alpha < 1.f)) { if (hi == 0) wsf[r32] = alpha; LDS_WAIT(); \
                        _Pragma("unroll") for (int dd = 0; dd < NB; ++dd) _Pragma("unroll") for (int r = 0; r < 16; ++r) o[dd][r] *= wsf[crow(r, hi)]; \
                        LDS_WAIT(); } \
                    bf16x8 paA, paB; PK4(p, 0, paA); PK4(p, 8, paB); \
                    const int vb = (int)(uintptr_t)(bufc + NSUB * KTB + sl * KTB) + v_rd_base(lane); \
                    pv_all<D, HF>(o, vb, paA, paB); } } while (0)
#define PK4(P, BASE, OUT) do { unsigned a0 = cvt_pk_bf16(P[BASE + 0], P[BASE + 1]), a1 = cvt_pk_bf16(P[BASE + 2], P[BASE + 3]);   \
    unsigned b0 = cvt_pk_bf16(P[BASE + 4], P[BASE + 5]), b1 = cvt_pk_bf16(P[BASE + 6], P[BASE + 7]);                              \
    auto r0 = __builtin_amdgcn_permlane32_swap(a0, b0, false, false); auto r1 = __builtin_amdgcn_permlane32_swap(a1, b1, false, false); \
    u32x4 w = {r0[0], r1[0], r0[1], r1[1]}; OUT = __builtin_bit_cast(bf16x8, w); } while (0)
                HALF_STEP(0, any0, kb0);
                HALF_STEP(1, any1, kb1);
#undef PK4
#undef HALF_STEP
            }
        }
        asm volatile("s_waitcnt vmcnt(0)" ::: "memory");
        __syncthreads();
        pb ^= 1;
    }
    m_out = m_reg; l_out = l_reg;
}

__device__ __forceinline__ void attn_c_main(const AU& u, const KVD& d, const KVD& dn, const int pre, int& pb, unsigned char* ws, LAS unsigned char* lds, int wid, int lane,
                                            float (&m_out)[2], float (&l_out)[2], f32x16 (&oA)[2], f32x16 (&oB)[2]) {
    constexpr int D = 64, NQ = 4, NSUB = 3, KTB = 8192;
    constexpr float SCALE = 0.125f, C = SCALE * 1.4426950408889634f, THRS = 8.0f / SCALE;
    const int r32 = lane & 31, hi = lane >> 5;
    LAS float* wsf = (LAS float*)(lds + XTBL_OFF + wid * 256);
    bf16x8 qA[NQ], qB[NQ];
    { const bf16_t* qrow = (const bf16_t*)(ws + WS_QKV) + (size_t)u.qoff + (size_t)(u.qrow_w + r32) * u.qs + hi * 8;
#pragma unroll
      for (int d0 = 0; d0 < NQ; ++d0) { qA[d0] = *(const bf16x8*)(qrow + d0 * 16); qB[d0] = *(const bf16x8*)(qrow + (size_t)32 * u.qs + d0 * 16); } }
    float mA = -1e30f, lA = 0.f, mB = -1e30f, lB = 0.f;
#pragma unroll
    for (int dd = 0; dd < 2; ++dd)
#pragma unroll
        for (int r = 0; r < 16; ++r) { oA[dd][r] = 0.f; oB[dd][r] = 0.f; }
    const int qiA = u.qrow_w + r32, qiB = qiA + 32;
    const int loA = qiA - u.band, loB = qiB - u.band;
    LAS unsigned char* bufc = lds + pb * ABUF; LAS unsigned char* bufn = lds + (pb ^ 1) * ABUF;
#define PK4(P, BASE, OUT) do { unsigned a0 = cvt_pk_bf16(P[BASE + 0], P[BASE + 1]), a1 = cvt_pk_bf16(P[BASE + 2], P[BASE + 3]);   \
    unsigned b0 = cvt_pk_bf16(P[BASE + 4], P[BASE + 5]), b1 = cvt_pk_bf16(P[BASE + 6], P[BASE + 7]);                              \
    auto r0 = __builtin_amdgcn_permlane32_swap(a0, b0, false, false); auto r1 = __builtin_amdgcn_permlane32_swap(a1, b1, false, false); \
    u32x4 w = {r0[0], r1[0], r0[1], r1[1]}; OUT = __builtin_bit_cast(bf16x8, w); } while (0)
#define PKV(Lx, Hx) (bf16x8){Lx[0], Lx[1], Lx[2], Lx[3], Hx[0], Hx[1], Hx[2], Hx[3]}
#define C_SINGLE(HF, KBH, QF, LOQ, HIQ, MR, LR, OO) do { \
        f32x16 p; _Pragma("unroll") for (int r = 0; r < 16; ++r) p[r] = 0.f; \
        _Pragma("unroll") for (int d0 = 0; d0 < NQ; ++d0) { const bf16x8 bk = *(const LAS bf16x8*)(Kt + kswz<D>(32 * (HF) + r32, (d0 * 16 + hi * 8) * 2)); p = __builtin_amdgcn_mfma_f32_32x32x16_bf16(bk, QF[d0], p, 0, 0, 0); } \
        _Pragma("unroll") for (int r = 0; r < 16; ++r) { const int kk = (KBH) + crow(r, hi); if (kk < (LOQ) || kk > (HIQ)) p[r] = -INFINITY; } \
        float pmax = p[0]; _Pragma("unroll") for (int r = 1; r < 16; ++r) pmax = fmaxf(pmax, p[r]); \
        { auto rr = __builtin_amdgcn_permlane32_swap(__float_as_uint(pmax), __float_as_uint(pmax), false, false); pmax = fmaxf(__uint_as_float(rr[0]), __uint_as_float(rr[1])); } \
        float alpha = 1.f; if (!__all(pmax - MR <= THRS)) { const float mn = fmaxf(MR, pmax); alpha = __builtin_amdgcn_exp2f((MR - mn) * C); MR = mn; } \
        const float mnC = -MR * C; float ps = 0.f; \
        _Pragma("unroll") for (int r = 0; r < 16; ++r) { p[r] = __builtin_amdgcn_exp2f(fmaf(p[r], C, mnC)); ps += p[r]; } \
        { auto rr = __builtin_amdgcn_permlane32_swap(__float_as_uint(ps), __float_as_uint(ps), false, false); ps = __uint_as_float(rr[0]) + __uint_as_float(rr[1]); } \
        LR = LR * alpha + ps; \
        if (__any(alpha < 1.f)) { if (hi == 0) wsf[r32] = alpha; LDS_WAIT(); \
            _Pragma("unroll") for (int dd = 0; dd < 2; ++dd) _Pragma("unroll") for (int r = 0; r < 16; ++r) OO[dd][r] *= wsf[crow(r, hi)]; LDS_WAIT(); } \
        bf16x8 pa, pb2; PK4(p, 0, pa); PK4(p, 8, pb2); \
        pv_all<D, HF>(OO, vb, pa, pb2); } while (0)
#define C_DUAL(HF, KBH) do { \
        f32x16 pa_, pb_; _Pragma("unroll") for (int r = 0; r < 16; ++r) { pa_[r] = 0.f; pb_[r] = 0.f; } \
        _Pragma("unroll") for (int d0 = 0; d0 < NQ; ++d0) { const bf16x8 bk = *(const LAS bf16x8*)(Kt + kswz<D>(32 * (HF) + r32, (d0 * 16 + hi * 8) * 2)); \
            pa_ = __builtin_amdgcn_mfma_f32_32x32x16_bf16(bk, qA[d0], pa_, 0, 0, 0); pb_ = __builtin_amdgcn_mfma_f32_32x32x16_bf16(bk, qB[d0], pb_, 0, 0, 0); } \
        _Pragma("unroll") for (int r = 0; r < 16; ++r) { const int kk = (KBH) + crow(r, hi); if (kk < loA || kk > qiA) pa_[r] = -INFINITY; if (kk < loB || kk > qiB) pb_[r] = -INFINITY; } \
        float xa = pa_[0], xb = pb_[0]; _Pragma("unroll") for (int r = 1; r < 16; ++r) { xa = fmaxf(xa, pa_[r]); xb = fmaxf(xb, pb_[r]); } \
        { auto rr = __builtin_amdgcn_permlane32_swap(__float_as_uint(xa), __float_as_uint(xa), false, false); xa = fmaxf(__uint_as_float(rr[0]), __uint_as_float(rr[1])); } \
        { auto rr = __builtin_amdgcn_permlane32_swap(__float_as_uint(xb), __float_as_uint(xb), false, false); xb = fmaxf(__uint_as_float(rr[0]), __uint_as_float(rr[1])); } \
        float alA = 1.f, alB = 1.f; \
        if (!__all(xa - mA <= THRS && xb - mB <= THRS)) { const float na = fmaxf(mA, xa), nb = fmaxf(mB, xb); alA = __builtin_amdgcn_exp2f((mA - na) * C); alB = __builtin_amdgcn_exp2f((mB - nb) * C); mA = na; mB = nb; } \
        const float cA_ = -mA * C, cB_ = -mB * C; float sa = 0.f, sb = 0.f; \
        _Pragma("unroll") for (int r = 0; r < 16; ++r) { pa_[r] = __builtin_amdgcn_exp2f(fmaf(pa_[r], C, cA_)); sa += pa_[r]; pb_[r] = __builtin_amdgcn_exp2f(fmaf(pb_[r], C, cB_)); sb += pb_[r]; } \
        { auto rr = __builtin_amdgcn_permlane32_swap(__float_as_uint(sa), __float_as_uint(sa), false, false); sa = __uint_as_float(rr[0]) + __uint_as_float(rr[1]); } \
        { auto rr = __builtin_amdgcn_permlane32_swap(__float_as_uint(sb), __float_as_uint(sb), false, false); sb = __uint_as_float(rr[0]) + __uint_as_float(rr[1]); } \
        lA = lA * alA + sa; lB = lB * alB + sb; \
        if (__any(alA < 1.f || alB < 1.f)) { if (hi == 0) { wsf[r32] = alA; wsf[32 + r32] = alB; } LDS_WAIT(); \
            _Pragma("unroll") for (int dd = 0; dd < 2; ++dd) _Pragma("unroll") for (int r = 0; r < 16; ++r) { oA[dd][r] *= wsf[crow(r, hi)]; oB[dd][r] *= wsf[32 + crow(r, hi)]; } LDS_WAIT(); } \
        bf16x8 a0_, a1_, b0_, b1_; PK4(pa_, 0, a0_); PK4(pa_, 8, a1_); PK4(pb_, 0, b0_); PK4(pb_, 8, b1_); \
        _Pragma("unroll") for (int d0 = 0; d0 < 2; ++d0) { \
            const s16x4 l0 = __builtin_bit_cast(s16x4, __builtin_amdgcn_ds_read_tr16_b64_v4i16((LAS v4i16_t*)(uintptr_t)(unsigned)(vb + d0 * 512 + ((2 * (HF)) * 2 + 0) * 1024))), \
                        h0 = __builtin_bit_cast(s16x4, __builtin_amdgcn_ds_read_tr16_b64_v4i16((LAS v4i16_t*)(uintptr_t)(unsigned)(vb + d0 * 512 + ((2 * (HF)) * 2 + 1) * 1024))), \
                        l1 = __builtin_bit_cast(s16x4, __builtin_amdgcn_ds_read_tr16_b64_v4i16((LAS v4i16_t*)(uintptr_t)(unsigned)(vb + d0 * 512 + ((2 * (HF) + 1) * 2 + 0) * 1024))), \
                        h1 = __builtin_bit_cast(s16x4, __builtin_amdgcn_ds_read_tr16_b64_v4i16((LAS v4i16_t*)(uintptr_t)(unsigned)(vb + d0 * 512 + ((2 * (HF) + 1) * 2 + 1) * 1024))); \
            const bf16x8 v0_ = PKV(l0, h0), v1_ = PKV(l1, h1); \
            oA[d0] = __builtin_amdgcn_mfma_f32_32x32x16_bf16(a0_, v0_, oA[d0], 0, 0, 0); oB[d0] = __builtin_amdgcn_mfma_f32_32x32x16_bf16(b0_, v0_, oB[d0], 0, 0, 0); \
            oA[d0] = __builtin_amdgcn_mfma_f32_32x32x16_bf16(a1_, v1_, oA[d0], 0, 0, 0); oB[d0] = __builtin_amdgcn_mfma_f32_32x32x16_bf16(b1_, v1_, oB[d0], 0, 0, 0); } } while (0)
#pragma unroll 1
    for (int sl = 0; sl < NSUB; ++sl) {
        if (pre == 1) { if (sl < dn.nst) stage_dma<D>(dn, ws, sl, bufn, sl, wid, lane); }
        if (sl < d.nst) {
            LAS unsigned char* Kt = bufc + sl * KTB;
            const int vb = (int)(uintptr_t)(bufc + NSUB * KTB + sl * KTB) + v_rd_base(lane);
            const int kb0 = d.kt0 + sl * 64, kb1 = kb0 + 32;
            { const bool anA = __any(loA <= kb0 + 31 && qiA >= kb0), anB = __any(loB <= kb0 + 31 && qiB >= kb0);
              if (anA && anB) C_DUAL(0, kb0); else if (anA) C_SINGLE(0, kb0, qA, loA, qiA, mA, lA, oA); else if (anB) C_SINGLE(0, kb0, qB, loB, qiB, mB, lB, oB); }
            { const bool anA = __any(loA <= kb1 + 31 && qiA >= kb1), anB = __any(loB <= kb1 + 31 && qiB >= kb1);
              if (anA && anB) C_DUAL(1, kb1); else if (anA) C_SINGLE(1, kb1, qA, loA, qiA, mA, lA, oA); else if (anB) C_SINGLE(1, kb1, qB, loB, qiB, mB, lB, oB); }
        }
    }
#undef C_DUAL
#undef C_SINGLE
#undef PKV
#undef PK4
    asm volatile("s_waitcnt vmcnt(0)" ::: "memory");
    __syncthreads();
    pb ^= 1;
    m_out[0] = mA; m_out[1] = mB; l_out[0] = lA; l_out[1] = lB;
}

template <int D, bool PRE = false>
__device__ __forceinline__ void attn_epi(const AE& e, int qrow_w, int pbl, unsigned char* ws, LAS unsigned char* lds, int wid, int lane, float m_reg, float l_reg, const f32x16 (&o)[D / 32], const u32x4* gpre = nullptr) {
    constexpr int NB = D / 32;
    constexpr float SCALE = (D == 128) ? 0.088388347648318440f : 0.125f;
    const int r32 = lane & 31, hi = lane >> 5;
    LAS float* wsf = (LAS float*)(lds + XTBL_OFF + wid * 256);
    LAS bf16_t* stg = (LAS bf16_t*)(lds + pbl * ABUF + wid * 8192);
    float lt = l_reg;
    if (e.has_sink) lt += __builtin_amdgcn_exp2f((e.sink - m_reg * SCALE) * 1.4426950408889634f);
    if (hi == 0) wsf[r32] = lt > 0.f ? __builtin_amdgcn_rcpf(lt) : 0.f;
    LDS_WAIT();
    float rli[16];
#pragma unroll
    for (int r = 0; r < 16; ++r) rli[r] = wsf[crow(r, hi)];
    LDS_WAIT();
#pragma unroll
    for (int r = 0; r < 16; ++r) { const int orow = crow(r, hi);
#pragma unroll
        for (int d0 = 0; d0 < NB; ++d0) stg[orow * D + d0 * 32 + r32] = (bf16_t)f2bf(o[d0][r] * rli[r]); }
    LDS_WAIT();
    constexpr int CPR = D / 8, RPP = 64 / CPR;
    bf16_t* OB = (bf16_t*)(ws + (e.epi ? WS_Y : WS_OG));
    const bf16_t* GB = (const bf16_t*)(ws + WS_QKV);
#pragma unroll
    for (int i = 0; i < 32 / RPP; ++i) {
        const int row = i * RPP + lane / CPR, ch = lane % CPR;
        const u32x4 v = *(const LAS u32x4*)(stg + row * D + ch * 8);
        const size_t fidx = (size_t)(qrow_w + row);
        if (e.epi == 1) {
            u32x4 g; if constexpr (PRE) g = gpre[i]; else g = *(const u32x4*)(GB + (size_t)e.goff + fidx * e.gs + ch * 8);
            u32x4 w;
            w.x = cvt_pk_bf16(bflo(v.x) * bflo(g.x), bfhi(v.x) * bfhi(g.x)); w.y = cvt_pk_bf16(bflo(v.y) * bflo(g.y), bfhi(v.y) * bfhi(g.y));
            w.z = cvt_pk_bf16(bflo(v.z) * bflo(g.z), bfhi(v.z) * bfhi(g.z)); w.w = cvt_pk_bf16(bflo(v.w) * bflo(g.w), bfhi(v.w) * bfhi(g.w));
            *(u32x4*)(OB + (size_t)e.ooff + fidx * e.os + ch * 8) = w;
        } else {
            *(u32x4*)(OB + (size_t)e.ooff + fidx * e.os + ch * 8) = v;
        }
    }
    if (e.epi == 0 && hi == 0) ((float*)(ws + WS_LSE))[(size_t)e.lseoff + (size_t)(qrow_w + r32) * e.lses] = l_reg > 0.f ? m_reg * SCALE + __logf(l_reg) : -1e30f;
    LDS_WAIT();
}

__device__ __forceinline__ float wave_sum(float v) {
    v += xor_lt32<1>(v); v += xor_lt32<2>(v); v += xor_lt32<4>(v); v += xor_lt32<8>(v); v += xor_lt32<16>(v); v = add_xor32(v);
    return v;
}
__device__ __forceinline__ int phys_even(int n) {
    if (n >= 4608) return n;
    const int seg = n / 768; if (seg == 2 || seg == 5) return n;
    const int i = n & 127, hb = n - i, ii = i & 63, g = ii >> 2, e = (ii & 3) + ((i >> 6) << 2);
    return hb + 8 * g + e;
}
__device__ __forceinline__ int phys_odd(int n) {
    if (n < 1728) { const int i = n & 63, hb = n - i, ii = i & 31, g = ii >> 2, e = (ii & 3) + ((i >> 5) << 2); return hb + 8 * g + e; }
    if (n < 1920) return n + 64;
    return n + 128;
}
struct CvtD { const float* W; const float* gk; bf16_t* WT; int N, mapkind, rowoff, item; };
#define CVT_LOAD(D_, V_) do { const int nblk_ = (D_).N / 64, kb_ = (D_).item / nblk_, nb_ = (D_).item % nblk_; \
    const float* src_ = (D_).W + (size_t)(64 * kb_ + 16 * (lane >> 4)) * (D_).N + 64 * nb_ + 4 * (lane & 15); \
    _Pragma("unroll") for (int i_ = 0; i_ < 16; ++i_) V_[i_] = __builtin_nontemporal_load((const f32x4*)(src_ + (size_t)i_ * (D_).N)); } while (0)
#define CVT_FINISH(D_, V_) do { const int nblk_ = (D_).N / 64, kb_ = (D_).item / nblk_, nb_ = (D_).item % nblk_, k0_ = 64 * kb_, rq_ = lane >> 4, cq_ = lane & 15, f_ = cq_ & 7; \
    if ((D_).gk) { const f32x4* gp_ = (const f32x4*)((D_).gk + k0_ + 16 * rq_); \
        _Pragma("unroll") for (int i4_ = 0; i4_ < 4; ++i4_) { const f32x4 g_ = gp_[i4_]; V_[4 * i4_] = V_[4 * i4_] * g_.x; V_[4 * i4_ + 1] = V_[4 * i4_ + 1] * g_.y; V_[4 * i4_ + 2] = V_[4 * i4_ + 2] * g_.z; V_[4 * i4_ + 3] = V_[4 * i4_ + 3] * g_.w; } } \
    CVT_COL(V_, x, 0); CVT_COL(V_, y, 1); CVT_COL(V_, z, 2); CVT_COL(V_, w, 3); \
    const int r8_ = lane >> 3, c8_ = lane & 7; \
    _Pragma("unroll") for (int i_ = 0; i_ < 8; ++i_) { const int row_ = i_ * 8 + r8_, nn_ = 64 * nb_ + row_; const int p_ = ((D_).mapkind == 1 ? phys_even(nn_) : ((D_).mapkind == 2 ? phys_odd(nn_) : nn_)) + (D_).rowoff; \
        const u32x4 x_ = *(const LAS u32x4*)(tb + row_ * 128 + ((c8_ ^ ((row_ >> 2) & 7)) * 16)); \
        *(u32x4*)((D_).WT + (size_t)p_ * KDIM + k0_ + c8_ * 8) = x_; } } while (0)
#define CVT_COL(V_, C_, J_) do { const int nl_ = 4 * cq_ + (J_); u32x4 a_, b_; \
    a_.x = pk2(V_[0].C_, V_[1].C_); a_.y = pk2(V_[2].C_, V_[3].C_); a_.z = pk2(V_[4].C_, V_[5].C_); a_.w = pk2(V_[6].C_, V_[7].C_); \
    b_.x = pk2(V_[8].C_, V_[9].C_); b_.y = pk2(V_[10].C_, V_[11].C_); b_.z = pk2(V_[12].C_, V_[13].C_); b_.w = pk2(V_[14].C_, V_[15].C_); \
    *(LAS u32x4*)(tb + nl_ * 128 + (((2 * rq_) ^ f_) * 16)) = a_; *(LAS u32x4*)(tb + nl_ * 128 + (((2 * rq_ + 1) ^ f_) * 16)) = b_; } while (0)

struct Args {
    const float* x; const float* mem; const int* pos;
    const float* even_norm; const float* even_w_in; const float* even_w_mkv; const float* even_w_out;
    const float* odd_norm; const float* odd_w_in; const float* odd_w_mkv; const float* odd_w_out; const float* odd_sinks;
    const float* mem_norm; const float* final_norm;
    float* out; unsigned char* ws;
    int ph_lo, ph_hi;
};
constexpr int N_PHASES = 18;

constexpr int NUNITS_EVEN = 1088, NUNITS_ODD = 512;
__device__ __forceinline__ bool unit_d64(int idx, int l) { return (l & 1) && idx >= 128; }
__device__ __forceinline__ int remap_even(int p) { return p < 336 ? p : (p < 1040 ? p + 48 : 336 + (p - 1040)); }
__device__ __forceinline__ void decode_kv(int idx, int l, KVD& d) {
    d.kvsel = 0; d.kd1 = 0; d.ksub = 64; d.koff1 = 32;
    if (!(l & 1)) {
        if (idx < 384) { const int n = 7 - idx / 48, rem = idx % 48, s = rem / 24, bh = rem % 24, b = bh / 6, h = bh % 6; const int tb = b * SEQ * EVEN_N;
            d.koff = tb + 3072 + h * 128; d.voff = tb + 3840 + h * 128; d.ks = EVEN_N; d.L = SEQ; d.kt0 = 128 * (n + 1) * s; d.nst = 2 * (n + 1);
        } else if (idx < 768) { const int i = idx - 384, pat = i / 192, j = i % 192, bh = j % 24, rr = j / 24, b = bh / 6, h = bh % 6;
            const int dil = pat ? 4 : 1, res = pat ? (rr & 3) : 0, kblk = pat ? (rr >> 2) : rr; const int tb = (b * SEQ + res) * EVEN_N;
            d.koff = tb + 768 + h * 128; d.voff = tb + 1536 + h * 128; d.ks = dil * EVEN_N; d.L = SEQ / dil; d.kt0 = (256 * kblk - 128) < 0 ? 0 : (256 * kblk - 128); d.nst = (256 * kblk + 256 - d.kt0) / 64;
        } else if (idx < 896) { const int i = idx - 768, b = i / 32, hm = (i / 8) % 4;
            d.kvsel = 1; d.koff = b * MEML * 4096 + l * 1024 + hm * 128; d.voff = d.koff + 512; d.ks = 4096; d.L = MEML; d.kt0 = 0; d.nst = 4;
        } else { const int i = idx - 896, bh = i % 24, u8 = i / 24, b = bh / 6, h = bh % 6; const int tp = (b * SEQ + 2 * u8) * EVEN_N;
            d.koff = tp + 768 + h * 128; d.voff = tp + 1536 + h * 128; d.kd1 = EVEN_N; d.ks = 16 * EVEN_N; d.L = 128; d.kt0 = 0; d.nst = 4; d.ksub = 32; d.koff1 = 0;
        }
    } else {
        if (idx < 128) { const int i = idx, b = i / 32, hm = (i / 8) % 4;
            d.kvsel = 1; d.koff = b * MEML * 4096 + l * 1024 + hm * 128; d.voff = d.koff + 512; d.ks = 4096; d.L = MEML; d.kt0 = 0; d.nst = 4;
        } else { const int i = idx - 128, b = i / 96, g = (i / 32) % 3, pblk = i % 32; const int tb = b * SEQ * ODD_NP;
            d.koff = tb + 1536 + g * 64; d.voff = tb + 1792 + g * 64; d.ks = ODD_NP; d.L = SEQ; d.kt0 = (64 * pblk - 128) < 0 ? 0 : (64 * pblk - 128); d.nst = (64 * pblk + 64 - d.kt0) / 64;
        }
    }
}
__device__ __forceinline__ void decode_q(int idx, int l, int wave, AU& u) {
    u.moba_n = -1; u.band = 1 << 28; u.causal = 1; u.pair = 0; u.whalf = 0; u.kmoff = 0; u.tbase = 0;
    if (!(l & 1)) {
        if (idx < 384) { const int n = 7 - idx / 48, rem = idx % 48, s = rem / 24, bh = rem % 24, b = bh / 6, h = bh % 6;
            u.qoff = b * SEQ * EVEN_N + 2304 + h * 128; u.qs = EVEN_N; u.qrow_w = 256 * n + 32 * wave; u.moba_n = n; u.tbase = 2 * (n + 1) * s;
            u.kmoff = (l >> 1) * (4 * 6 * 8 * 128) + ((b * 6 + h) * 8) * 128;
        } else if (idx < 768) { const int i = idx - 384, pat = i / 192, j = i % 192, bh = j % 24, rr = j / 24, b = bh / 6, h = bh % 6;
            const int dil = pat ? 4 : 1, res = pat ? (rr & 3) : 0, kblk = pat ? (rr >> 2) : rr;
            u.qoff = (b * SEQ + res) * EVEN_N + h * 128; u.qs = dil * EVEN_N; u.qrow_w = 256 * kblk + 32 * wave; u.band = 128;
        } else if (idx < 896) { const int i = idx - 768, b = i / 32, hm = (i / 8) % 4, blk = i % 8;
            u.qoff = b * SEQ * EVEN_N + 4608 + hm * 128; u.qs = EVEN_N; u.qrow_w = 256 * blk + 32 * wave; u.causal = 0;
        } else { const int i = idx - 896, bh = i % 24, u8 = i / 24, b = bh / 6, h = bh % 6; const int wh = wave >> 2;
            u.qoff = (b * SEQ + 2 * u8 + wh) * EVEN_N + h * 128; u.qs = 16 * EVEN_N; u.qrow_w = 32 * (wave & 3); u.pair = 1; u.whalf = wh; u.band = 128;
        }
    } else {
        if (idx < 128) { const int i = idx, b = i / 32, hm = (i / 8) % 4, blk = i % 8;
            u.qoff = b * SEQ * ODD_NP + 2048 + hm * 128; u.qs = ODD_NP; u.qrow_w = 256 * blk + 32 * wave; u.causal = 0;
        } else { const int i = idx - 128, b = i / 96, g = (i / 32) % 3, pblk = i % 32, hq = 8 * g + wave;
            u.qoff = b * SEQ * ODD_NP + hq * 64; u.qs = ODD_NP; u.qrow_w = 64 * pblk; u.band = 127;
        }
    }
}
__device__ __forceinline__ void decode_epi(int idx, int l, int wave, const float* sinks, AE& e) {
    e.has_sink = 0; e.sink = 0.f; e.lseoff = 0; e.lses = 0; e.goff = 0; e.gs = 0;
    if (!(l & 1)) {
        if (idx < 384) { const int rem = idx % 48, s = rem / 24, bh = rem % 24, b = bh / 6, h = bh % 6; const int tok0 = b * SEQ;
            e.epi = 0; e.ooff = (3 + s) * NTOK * 768 + tok0 * 768 + h * 128; e.os = 768; e.lseoff = (3 + s) * NTOK * 6 + tok0 * 6 + h; e.lses = 6;
        } else if (idx < 768) { const int i = idx - 384, pat = i / 192, j = i % 192, bh = j % 24, rr = j / 24, b = bh / 6, h = bh % 6;
            const int dil = pat ? 4 : 1, res = pat ? (rr & 3) : 0; const int tok0 = b * SEQ + res;
            e.epi = 0; e.ooff = pat * NTOK * 768 + tok0 * 768 + h * 128; e.os = dil * 768; e.lseoff = pat * NTOK * 6 + tok0 * 6 + h; e.lses = dil * 6;
        } else if (idx < 896) { const int i = idx - 768, b = i / 32, hm = (i / 8) % 4;
            e.epi = 1; e.ooff = b * SEQ * DM + 1536 + hm * 128; e.os = DM; e.goff = b * SEQ * EVEN_N + 5120 + 1536 + hm * 128; e.gs = EVEN_N;
        } else { const int i = idx - 896, bh = i % 24, u8 = i / 24, b = bh / 6, h = bh % 6; const int tokw = b * SEQ + 2 * u8 + (wave >> 2);
            e.epi = 0; e.ooff = 2 * NTOK * 768 + tokw * 768 + h * 128; e.os = 16 * 768; e.lseoff = 2 * NTOK * 6 + tokw * 6 + h; e.lses = 16 * 6;
        }
    } else {
        if (idx < 128) { const int i = idx, b = i / 32, hm = (i / 8) % 4;
            e.epi = 1; e.ooff = b * SEQ * DM + 1536 + hm * 128; e.os = DM; e.goff = b * SEQ * ODD_NP + 2560 + 1536 + hm * 128; e.gs = ODD_NP;
        } else { const int i = idx - 128, b = i / 96, g = (i / 32) % 3, hq = 8 * g + wave;
            e.epi = 1; e.ooff = b * SEQ * DM + hq * 64; e.os = DM; e.goff = b * SEQ * ODD_NP + 2560 + hq * 64; e.gs = ODD_NP;
            e.has_sink = 1; e.sink = sinks[(l >> 1) * 24 + hq];
        }
    }
}


constexpr int I_E = 32 * (EVEN_N / 64), I_O = 32 * (ODD_N / 64), I_W = 32 * (DM / 64), I_M = 32 * (1024 / 64);
constexpr int I_W1A = 512;
constexpr int CV_A = I_E + 4 * I_M, CV_B = CV_A + I_W + I_W1A + I_O, CV_C = CV_B + I_E + (I_W - I_W1A), CV_D = CV_C + I_O + 2 * I_W;
typedef __attribute__((address_space(4))) const Args* KArgsC;
__device__ __forceinline__ void cvt_decode(KArgsC ka, unsigned char* ws, int it, CvtD& d) {
    int r = it;
    if (r < I_E) { d.W = ka->even_w_in; d.gk = ka->even_norm; d.WT = (bf16_t*)(ws + WS_WIN_E0); d.N = EVEN_N; d.mapkind = 1; d.rowoff = 0; d.item = r; return; } r -= I_E;
    if (r < 4 * I_M) { const int l = r / I_M; r -= l * I_M; d.W = ((l & 1) ? ka->odd_w_mkv : ka->even_w_mkv) + (size_t)(l >> 1) * DM * 1024;
        d.gk = nullptr; d.WT = (bf16_t*)(ws + WS_WMKV); d.N = 1024; d.mapkind = 0; d.rowoff = l * 1024; d.item = r; return; } r -= 4 * I_M;
    if (r < I_W + I_W1A) { const int l1 = r >= I_W ? 1 : 0; r -= l1 * I_W; d.W = l1 ? ka->odd_w_out : ka->even_w_out; d.gk = nullptr; d.WT = (bf16_t*)(ws + WS_WOUT + (size_t)l1 * 8 * MiB); d.N = DM; d.mapkind = 0; d.rowoff = 0; d.item = r; return; } r -= I_W + I_W1A;
    if (r < I_O) { d.W = ka->odd_w_in; d.gk = ka->odd_norm; d.WT = (bf16_t*)(ws + WS_WIN_O0); d.N = ODD_N; d.mapkind = 2; d.rowoff = 0; d.item = r; return; } r -= I_O;
    if (r < I_E) { d.W = ka->even_w_in + (size_t)DM * EVEN_N; d.gk = ka->even_norm + DM; d.WT = (bf16_t*)(ws + WS_WIN_E1); d.N = EVEN_N; d.mapkind = 1; d.rowoff = 0; d.item = r; return; } r -= I_E;
    if (r < I_W - I_W1A) { d.W = ka->odd_w_out; d.gk = nullptr; d.WT = (bf16_t*)(ws + WS_WOUT + (size_t)1 * 8 * MiB); d.N = DM; d.mapkind = 0; d.rowoff = 0; d.item = r + I_W1A; return; } r -= I_W - I_W1A;
    if (r < I_O) { d.W = ka->odd_w_in + (size_t)DM * ODD_N; d.gk = ka->odd_norm + DM; d.WT = (bf16_t*)(ws + WS_WIN_O1); d.N = ODD_N; d.mapkind = 2; d.rowoff = 0; d.item = r; return; } r -= I_O;
    { const int l = 2 + r / I_W; r -= (l - 2) * I_W; d.W = ((l & 1) ? ka->odd_w_out : ka->even_w_out) + (size_t)(l >> 1) * DM * DM;
      d.gk = nullptr; d.WT = (bf16_t*)(ws + WS_WOUT + (size_t)l * 8 * MiB); d.N = DM; d.mapkind = 0; d.rowoff = 0; d.item = r; }
}
__device__ __forceinline__ void convert_stage(KArgsC ka, unsigned char* ws, int lo, int hi, int worker, int nworkers, int lane, LAS unsigned char* tb) {
    int it = lo + worker; if (it >= hi) return;
    CvtD d0, d1; f32x4 va[16], vb[16];
#pragma unroll
    for (int j = 0; j < 16; ++j) { va[j] = (f32x4){0.f, 0.f, 0.f, 0.f}; vb[j] = (f32x4){0.f, 0.f, 0.f, 0.f}; }
    cvt_decode(ka, ws, it, d0); d1 = d0; CVT_LOAD(d0, va);
    for (;;) {
        const int it1 = it + nworkers; const bool has1 = it1 < hi;
        if (has1) { cvt_decode(ka, ws, it1, d1); CVT_LOAD(d1, vb); }
        CVT_FINISH(d0, va);
        if (!has1) break;
        const int it2 = it1 + nworkers; const bool has2 = it2 < hi;
        if (has2) { cvt_decode(ka, ws, it2, d0); CVT_LOAD(d0, va); }
        CVT_FINISH(d1, vb);
        if (!has2) break;
        it = it2;
    }
}

}

typedef __attribute__((address_space(4))) const Args* KArgs;
#define LAUNDER_S(p) asm volatile("" : "+s"(p))

__global__ void __launch_bounds__(NWAVES * 64, 2) fwd_kernel(Args args_unused) {
    extern __shared__ __attribute__((aligned(16))) unsigned char lds_raw[];
    LAS unsigned char* lds = (LAS unsigned char*)lds_raw;
    volatile LAS unsigned* MISC = (volatile LAS unsigned*)(lds + MISC_OFF);
    const int tid0 = threadIdx.x;
    int wave0 = __builtin_amdgcn_readfirstlane(tid0 >> 6);
    const int G = gridDim.x; const int bx = blockIdx.x; const int vcu = (G % 8 == 0) ? (bx % 8) * (G / 8) + bx / 8 : bx;
    const KArgs ka0 = (KArgs)__builtin_amdgcn_kernarg_segment_ptr();
    for (int i = tid0; i < (LDS_BYTES - LDSCTL_OFF) / 4; i += NWAVES * 64) ((LAS unsigned*)(lds + LDSCTL_OFF))[i] = 0u;
    __syncthreads();
    XcdBarrier bar; { unsigned char* ws0 = ka0->ws; bar.bar = (unsigned*)(ws0 + WS_CTL) + CW_BAR; bar.x = 0; bar.st = nullptr;
        if (!MK_PER_PHASE) bar = xcd_barrier_post((unsigned*)(ws0 + WS_CTL) + CW_BAR, MISC + 8, tid0 == 0); }
    const int ph_lo = ka0->ph_lo, ph_hi = ka0->ph_hi;

    unsigned long long tp_acc = 0ull;
    for (int ph = ph_lo; ph < ph_hi; ++ph) {
        unsigned long long tp_t0 = 0ull; if (TPROBE_MASK) tp_t0 = __builtin_amdgcn_s_memrealtime();
#define DEF_TID int tid; asm volatile("v_mbcnt_lo_u32_b32 %0, -1, 0\n\tv_mbcnt_hi_u32_b32 %0, -1, %0\n\tv_lshl_add_u32 %0, %1, 6, %0" : "=&v"(tid) : "s"(wave0)); const int lane = tid & 63; const int wave = wave0; (void)lane; (void)wave
        KArgs ka = ka0; LAUNDER_S(ka);
        unsigned char* ws = ka->ws;
        if (ph == 0 && (AN_MASK & 1)) {
            DEF_TID;
            const int gw = vcu * NWAVES + wave, NGW = G * NWAVES;
            convert_stage(ka, ws, 0, CV_A, gw, NGW, lane, lds + wave * 8192);
            bf16_t* XB = (bf16_t*)(ws + WS_XB); bf16_t* MEMN = (bf16_t*)(ws + WS_MEMN); float* SSQ = (float*)(ws + WS_SSQ);
            const float* xin = ka->x; const float* memin = ka->mem; const float* mnorm = ka->mem_norm;
            {
                constexpr int LIM = NTOK + NMEM;
                auto rload = [&](f32x4 (&v)[8], int m) { const bool isx = m < NTOK; const int row = isx ? m : m - NTOK; const f32x4* xr = (const f32x4*)((isx ? xin : memin) + (size_t)row * DM) + lane;
                    _Pragma("unroll") for (int j = 0; j < 8; ++j) v[j] = __builtin_nontemporal_load(xr + 64 * j); };
                auto rdone = [&](f32x4 (&v)[8], int m) { const bool isx = m < NTOK; const int row = isx ? m : m - NTOK; float s = 0.f;
                    _Pragma("unroll") for (int j = 0; j < 8; ++j) s += (v[j].x * v[j].x + v[j].y * v[j].y) + (v[j].z * v[j].z + v[j].w * v[j].w);
                    s = wave_sum(s);
                    unsigned long long* o8 = (unsigned long long*)((isx ? XB : MEMN) + (size_t)row * DM) + lane;
                    if (isx) {
                        if (lane < 8) SSQ[(size_t)lane * NTOK + row] = lane == 0 ? s : 0.f;
                        _Pragma("unroll") for (int j = 0; j < 8; ++j) o8[64 * j] = (unsigned long long)pk2(v[j].x, v[j].y) | ((unsigned long long)pk2(v[j].z, v[j].w) << 32);
                    } else {
                        const float rs = 1.0f / sqrtf(s * (1.0f / DM) + EPS);
                        const f32x4* gr = (const f32x4*)mnorm + lane;
                        _Pragma("unroll") for (int j = 0; j < 8; ++j) { const f32x4 g = gr[64 * j]; o8[64 * j] = (unsigned long long)pk2(v[j].x * rs * g.x, v[j].y * rs * g.y) | ((unsigned long long)pk2(v[j].z * rs * g.z, v[j].w * rs * g.w) << 32); }
                    } };
                f32x4 va[8], vb[8];
#pragma unroll
                for (int j = 0; j < 8; ++j) { va[j] = (f32x4){0.f, 0.f, 0.f, 0.f}; vb[j] = (f32x4){0.f, 0.f, 0.f, 0.f}; }
                int m = (gw + NGW / 2) % NGW;
                if (m < LIM) rload(va, m);
                while (m < LIM) {
                    const int m2 = m + NGW; if (m2 < LIM) rload(vb, m2);
                    rdone(va, m);
                    if (m2 >= LIM) break;
                    const int m3 = m2 + NGW; if (m3 < LIM) rload(va, m3);
                    rdone(vb, m2);
                    m = m3;
                }
            }
            float* CS128 = (float*)(ws + WS_CS128); float* CS64 = (float*)(ws + WS_CS64); const int* posp = ka->pos;
            for (int tk = gw; tk < NTOK; tk += NGW) {
                const float pf = (float)posp[tk];
                { const float inv = expf((float)lane * (float)(-2.0 * 9.210340371976184 / 128.0)); const float ang = pf * inv;
                  const double rev = (double)ang * 0.15915494309189535; const float fr = (float)(rev - rint(rev));
                  CS128[(size_t)tk * 128 + lane] = __builtin_amdgcn_cosf(fr); CS128[(size_t)tk * 128 + 64 + lane] = __builtin_amdgcn_sinf(fr); }
                if (lane < 32) { const float inv = expf((float)lane * (float)(-2.0 * 9.210340371976184 / 64.0)); const float ang = pf * inv;
                  const double rev = (double)ang * 0.15915494309189535; const float fr = (float)(rev - rint(rev));
                  CS64[(size_t)tk * 64 + lane] = __builtin_amdgcn_cosf(fr); CS64[(size_t)tk * 64 + 32 + lane] = __builtin_amdgcn_sinf(fr); }
            }
        } else if (ph == 17 && (AN_MASK & 2) && G != 256) {
            DEF_TID;
            const int gw = vcu * NWAVES + wave, NGW = G * NWAVES;
            const float* ssq = (const float*)(ws + WS_SSQ) + (size_t)4 * 8 * NTOK; float* outp = ka->out; const float* fnorm = ka->final_norm;
            for (int m = gw; m < NTOK; m += NGW) {
                float sq = 0.f;
#pragma unroll
                for (int j = 0; j < 8; ++j) sq += ssq[(size_t)j * NTOK + m];
                const float rs = 1.0f / sqrtf(sq * (1.0f / DM) + EPS);
                f32x4* xr = (f32x4*)(outp + (size_t)m * DM) + lane; const f32x4* gr = (const f32x4*)fnorm + lane;
#pragma unroll
                for (int j = 0; j < 8; ++j) { f32x4 v = xr[64 * j]; const f32x4 g = gr[64 * j]; v = v * rs * g; xr[64 * j] = v; }
            }
        } else if (ph >= 1 && ph <= 16) {
            const int l = (ph - 1) >> 2, sub = (ph - 1) & 3, odd = l & 1, li = l >> 1;
            if ((sub == 0 && (AN_MASK & 4)) || (sub == 3 && (AN_MASK & 8))) {
                DEF_TID;
                GemmP P; P.ws = ws; P.l = l; P.xin = ka->x; P.out = ka->out; P.lds = lds; P.fnorm = ka->final_norm; P.fuse_final = (G == 256) ? 1 : 0;
                Order S; S.G = G; S.c = bx; S.nM0 = NTOK / 256;
                if (sub == 0) { P.mode = EM_INPROJ; P.A = (const bf16_t*)(ws + WS_XB); P.Bt = (const bf16_t*)(ws + (odd ? (li ? WS_WIN_O1 : WS_WIN_O0) : (li ? WS_WIN_E1 : WS_WIN_E0)));
                    S.nN0 = (odd ? ODD_NP : EVEN_N) / 256; S.nwg1 = (l == 0) ? 64 : 0; S.qt = (odd && G == 256) ? 1 : 0; S.maxi = 2; }
                else { P.mode = EM_OUTPROJ; P.A = (const bf16_t*)(ws + WS_Y); P.Bt = (const bf16_t*)(ws + WS_WOUT + (size_t)l * 8 * MiB); S.nN0 = DM / 256; S.nwg1 = 0; S.qt = 0; S.maxi = 0; }
                S.nwg0 = S.nM0 * S.nN0;
                gemm_phase(lds, P, S, tid, tp_acc, bar, sub == 3 && ph > ph_lo && !MK_PER_PHASE);
                if (sub == 0 && l < 3) {
                    const int nwg = S.nwg0 + S.nwg1, TT = S.qt ? 0 : nwg % G, lo = l == 0 ? CV_A : (l == 1 ? CV_B : CV_C), hi = l == 0 ? CV_B : (l == 1 ? CV_C : CV_D);
                    int lane2; asm volatile("v_mbcnt_lo_u32_b32 %0, -1, 0\n\tv_mbcnt_hi_u32_b32 %0, -1, %0" : "=&v"(lane2));
                    if (TT == 0) convert_stage(ka, ws, lo, hi, bx * NWAVES + wave0, G * NWAVES, lane2, lds + wave0 * 8192);
                    else if (bx >= TT) convert_stage(ka, ws, lo, hi, (bx - TT) * NWAVES + wave0, (G - TT) * NWAVES, lane2, lds + wave0 * 8192);
                }
            } else if (sub == 2 && (AN_MASK & 16)) {
                DEF_TID;
                if (!odd) {
                    const float* LSE = (const float*)(ws + WS_LSE); const bf16_t* OG = (const bf16_t*)(ws + WS_OG); const bf16_t* QKV = (const bf16_t*)(ws + WS_QKV); bf16_t* Y = (bf16_t*)(ws + WS_Y);
                    const long NIT = (long)NTOK * 192, STR = (long)G * 512;
                    constexpr int CB = 3;
                    for (long it0 = (long)bx * 512 + tid; it0 < NIT; it0 += CB * STR) {
                        u32x4 a[CB], b[CB], cc[CB], g[CB]; float l0[CB], l1[CB], l2[CB];
#pragma unroll
                        for (int k = 0; k < CB; ++k) {
                            const long it = it0 + k * STR; const bool ok = it < NIT; const long iu = ok ? it : it0;
                            const int tok = (int)(iu / 192), c = (int)(iu % 192), isb = c >= 96, cc8 = (isb ? c - 96 : c), h = cc8 >> 4, g0 = isb ? 3 : 0;
                            const size_t lb = (size_t)tok * 6 + h, ob = (size_t)tok * 768 + cc8 * 8;
                            l0[k] = LSE[(size_t)g0 * NTOK * 6 + lb]; l1[k] = LSE[(size_t)(g0 + 1) * NTOK * 6 + lb]; l2[k] = isb ? -1e30f : LSE[(size_t)2 * NTOK * 6 + lb];
                            a[k] = *(const u32x4*)(OG + (size_t)g0 * NTOK * 768 + ob); b[k] = *(const u32x4*)(OG + (size_t)(g0 + 1) * NTOK * 768 + ob);
                            cc[k] = (u32x4){0u, 0u, 0u, 0u}; if (!isb) cc[k] = *(const u32x4*)(OG + (size_t)2 * NTOK * 768 + ob);
                            g[k] = *(const u32x4*)(QKV + (size_t)tok * EVEN_N + 5120 + c * 8);
                        }
#pragma unroll
                        for (int k = 0; k < CB; ++k) {
                            const long it = it0 + k * STR; if (it >= NIT) continue;
                            const int tok = (int)(it / 192), c = (int)(it % 192), isb = c >= 96;
                            const float mx = fmaxf(l0[k], fmaxf(l1[k], l2[k]));
                            float w0 = __expf(l0[k] - mx), w1 = __expf(l1[k] - mx), w2 = isb ? 0.f : __expf(l2[k] - mx); const float inv = 1.0f / (w0 + w1 + w2); w0 *= inv; w1 *= inv; w2 *= inv;
                            u32x4 o;
#define CMB(f) cvt_pk_bf16((w0 * bflo(a[k].f) + w1 * bflo(b[k].f) + w2 * bflo(cc[k].f)) * bflo(g[k].f), (w0 * bfhi(a[k].f) + w1 * bfhi(b[k].f) + w2 * bfhi(cc[k].f)) * bfhi(g[k].f))
                            o.x = CMB(x); o.y = CMB(y); o.z = CMB(z); o.w = CMB(w);
#undef CMB
                            *(u32x4*)(Y + (size_t)tok * DM + c * 8) = o;
                        }
                    }
                }
            } else if (sub == 1 && (AN_MASK & 32)) {
                DEF_TID;
                gu32* qctr = (gu32*)(ws + WS_CTL) + CW_Q + 64 * l;
                const int NUNITS = odd ? NUNITS_ODD : NUNITS_EVEN;
                int pidx = bx, pidx1 = G + bx;
                const bool mpf = odd && G == 256 && !MK_PER_PHASE && ph > ph_lo && bx < 128;
                if (!mpf && odd && !unit_d64(pidx, l) && pidx1 < NUNITS && unit_d64(pidx1, l)) { pidx = G + bx; pidx1 = bx; }
                int it = 0, pb = 0; bool warm = mpf;
                if (mpf) { asm volatile("s_waitcnt vmcnt(0)" ::: "memory"); __syncthreads(); }
                while (pidx < NUNITS) {
                    pidx = __builtin_amdgcn_readfirstlane(pidx); pidx1 = __builtin_amdgcn_readfirstlane(pidx1);
                    const int idx = odd ? pidx : remap_even(pidx), idx1 = (odd || pidx1 >= NUNITS) ? pidx1 : remap_even(pidx1);
                    int tid_u; asm volatile("v_mbcnt_lo_u32_b32 %0, -1, 0\n\tv_mbcnt_hi_u32_b32 %0, -1, %0\n\tv_lshl_add_u32 %0, %1, 6, %0" : "=&v"(tid_u) : "s"(wave0)); const int lane_u = tid_u & 63;
                    unsigned nx2 = 0;
                    const bool d64 = unit_d64(idx, l);
                    const int pre = (idx1 < NUNITS) ? (unit_d64(idx1, l) == d64 ? 1 : (d64 ? 2 : 3)) : 0;
                    KVD d, dn; decode_kv(idx, l, d); decode_kv(pre ? idx1 : idx, l, dn);
                    AU u; decode_q(idx, l, wave, u);
                    float m_reg, l_reg;
                    if (d64) { if (!warm) cold_start<64>(d, ws, lds + pb * ABUF, wave, lane_u);
                        u32x4 gA[4], gB[4];
                        { const int ic = idx - 128, bc = ic / 96, gc = (ic / 32) % 3;
                          const bf16_t* GBp = (const bf16_t*)(ws + WS_QKV) + (size_t)(bc * SEQ * ODD_NP + 2560 + (8 * gc + wave) * 64) + (size_t)(u.qrow_w + (lane_u >> 3)) * ODD_NP + (lane_u & 7) * 8;
#pragma unroll
                          for (int i = 0; i < 4; ++i) gA[i] = *(const u32x4*)(GBp + (size_t)(i * 8) * ODD_NP); }
                        f32x16 oA[2], oB[2]; float m2[2], l2[2];
                        attn_c_main(u, d, dn, pre, pb, ws, lds, wave, lane_u, m2, l2, oA, oB);
                        if (tid_u == 0) nx2 = 2u * (unsigned)G + __hip_atomic_fetch_add(qctr, 1u, RLX_AGENT);
                        if (pre == 2) { int i1 = idx1; LAUNDER_S(i1); KVD dq; decode_kv(i1, l, dq); stage_dma<128>(dq, ws, 0, lds + pb * ABUF, 0, wave, lane_u); stage_dma<128>(dq, ws, 1, lds + pb * ABUF, 1, wave, lane_u); }
                        int idx2 = idx; LAUNDER_S(idx2); AE e; decode_epi(idx2, l, wave, ka->odd_sinks, e);
                        { const bf16_t* GBp = (const bf16_t*)(ws + WS_QKV) + (size_t)e.goff + (size_t)(u.qrow_w + 32 + (lane_u >> 3)) * e.gs + (lane_u & 7) * 8;
#pragma unroll
                          for (int i = 0; i < 4; ++i) gB[i] = *(const u32x4*)(GBp + (size_t)(i * 8) * e.gs); }
                        attn_epi<64, true>(e, u.qrow_w, pb ^ 1, ws, lds, wave, lane_u, m2[0], l2[0], oA, gA);
                        attn_epi<64, true>(e, u.qrow_w + 32, pb ^ 1, ws, lds, wave, lane_u, m2[1], l2[1], oB, gB); }
                    else { if (!warm) cold_start<128>(d, ws, lds + pb * ABUF, wave, lane_u);
                        f32x16 o[4]; attn_main<128>(u, d, dn, pre, pb, ws, lds, tid_u, wave, lane_u, m_reg, l_reg, o);
                        if (pre == 3) { int i1 = idx1; LAUNDER_S(i1); KVD dq; decode_kv(i1, l, dq);
#pragma unroll
                            for (int sl = 0; sl < 3; ++sl) if (sl < dq.nst) stage_dma<64>(dq, ws, sl, lds + pb * ABUF, sl, wave, lane_u); }
                        if (tid_u == 0) nx2 = 2u * (unsigned)G + __hip_atomic_fetch_add(qctr, 1u, RLX_AGENT);
                        int idx2 = idx; LAUNDER_S(idx2); AE e; decode_epi(idx2, l, wave, ka->odd_sinks, e); attn_epi<128>(e, u.qrow_w, pb ^ 1, ws, lds, wave, lane_u, m_reg, l_reg, o); }
                    warm = pre != 0;
                    if (tid_u == 0) MISC[18 + (it & 1)] = nx2;
                    if (pre >= 2) asm volatile("s_waitcnt vmcnt(0)" ::: "memory");
                    __syncthreads();
                    pidx = pidx1; pidx1 = (int)MISC[18 + (it & 1)]; ++it;
                }
            }
        }
        {
          const int sb = (ph - 1) & 3, ob = ((ph - 1) >> 2) & 1; const bool inl = ph >= 1 && ph <= 16;
          const bool skip = (ph == 16 && G == 256) || (inl && sb == 2) || (inl && sb == 1 && ob && !MK_PER_PHASE);
          if (ph + 1 < ph_hi && !skip) { int tid3; asm volatile("v_mbcnt_lo_u32_b32 %0, -1, 0\n\tv_mbcnt_hi_u32_b32 %0, -1, %0\n\tv_lshl_add_u32 %0, %1, 6, %0" : "=&v"(tid3) : "s"(wave0));
              if (inl && sb == 0 && ob && G == 256 && !MK_PER_PHASE) {
                  const int lq = (ph - 1) >> 2;
                  auto pf = [&]() { if (bx < 128) { KVD dq; decode_kv(bx, lq, dq); stage_dma<128>(dq, ws, 0, lds, 0, wave0, tid3 & 63); stage_dma<128>(dq, ws, 1, lds, 1, wave0, tid3 & 63); } };
                  xcd_barrier_pf(bar, tid3, pf);
              } else xcd_barrier(bar, tid3 == 0); } }
        if (TPROBE_MASK) { if ((TPROBE_MASK >> ph) & 1) tp_acc += __builtin_amdgcn_s_memrealtime() - tp_t0; }
    }
    if (TPROBE_MASK || RPROBE) { if (bx == 0) { const unsigned long long te = __builtin_amdgcn_s_memrealtime(); while (__builtin_amdgcn_s_memrealtime() - te < 4ull * tp_acc) __builtin_amdgcn_s_sleep(8); } }
}

extern "C" void kernel_launch(void* const* d_in, const int* in_sizes, int n_in, void* d_out, int out_size, void* d_ws, size_t ws_size, hipStream_t stream) {
    static int grid = 0;
    if (grid == 0) {
        if (n_in != 14 || in_sizes[0] != NTOK * DM || out_size != NTOK * DM || ws_size < WS_END) { fprintf(stderr, "kernel_launch: unexpected shapes (n_in %d, in0 %d, out %d, ws %zu)\n", n_in, n_in > 0 ? in_sizes[0] : -1, out_size, ws_size); grid = -1; return; }
        int dev = 0, cus = 0, per_cu = 0;
        if (hipGetDevice(&dev) != hipSuccess || hipDeviceGetAttribute(&cus, hipDeviceAttributeMultiprocessorCount, dev) != hipSuccess) { grid = -1; return; }
        if (hipFuncSetAttribute((const void*)fwd_kernel, hipFuncAttributeMaxDynamicSharedMemorySize, LDS_BYTES) != hipSuccess) { fprintf(stderr, "kernel_launch: hipFuncSetAttribute failed\n"); grid = -1; return; }
        if (hipOccupancyMaxActiveBlocksPerMultiprocessor(&per_cu, (const void*)fwd_kernel, NWAVES * 64, LDS_BYTES) != hipSuccess || per_cu < 1) { fprintf(stderr, "kernel_launch: occupancy query says %d blocks/CU\n", per_cu); }
        (void)hipGetLastError();
        grid = cus;
    }
    if (grid < 0) return;
    (void)hipMemsetAsync((char*)d_ws + WS_CTL, 0, CTL_ZERO_BYTES, stream);
    Args a{};
    a.x = (const float*)d_in[0]; a.mem = (const float*)d_in[1]; a.pos = (const int*)d_in[2];
    a.even_norm = (const float*)d_in[3]; a.even_w_in = (const float*)d_in[4]; a.even_w_mkv = (const float*)d_in[5]; a.even_w_out = (const float*)d_in[6];
    a.odd_norm = (const float*)d_in[7]; a.odd_w_in = (const float*)d_in[8]; a.odd_w_mkv = (const float*)d_in[9]; a.odd_w_out = (const float*)d_in[10]; a.odd_sinks = (const float*)d_in[11];
    a.mem_norm = (const float*)d_in[12]; a.final_norm = (const float*)d_in[13];
    a.out = (float*)d_out; a.ws = (unsigned char*)d_ws;
#if MK_PER_PHASE
    for (int ph = 0; ph < N_PHASES; ++ph) { a.ph_lo = ph; a.ph_hi = ph + 1; hipLaunchKernelGGL(fwd_kernel, dim3(grid), dim3(NWAVES * 64), LDS_BYTES, stream, a); }
#else
    a.ph_lo = 0; a.ph_hi = N_PHASES;
    hipLaunchKernelGGL(fwd_kernel, dim3(grid), dim3(NWAVES * 64), LDS_BYTES, stream, a);
#ifdef PROBE_PHASES
    {
        const int pp[] = PROBE_PHASES;
        (void)hipMemsetAsync((char*)d_ws + WS_CTL + (size_t)CW_Q * 4, 0, 64 * 8 * 4, stream);
        for (unsigned i = 0; i < sizeof(pp) / sizeof(pp[0]); ++i) { a.ph_lo = pp[i]; a.ph_hi = pp[i] + 1; hipLaunchKernelGGL(fwd_kernel, dim3(grid), dim3(NWAVES * 64), LDS_BYTES, stream, a); }
    }
#endif
#endif
    const hipError_t le = hipPeekAtLastError();
    if (le != hipSuccess) fprintf(stderr, "kernel_launch: launch failed: %s\n", hipGetErrorName(le));
}
```
